# Optimizing an MI355X kernel written in HIP

```python
import math
import jax, jax.numpy as jnp
from jax import lax
import numpy as np

D_MODEL = 1024
BATCH = 16
SEQ = 2048
DEPTH = 2

GRID_W = 64
CTX_LEN = 256
EPS = 1e-6
ROPE_THETA = 10000.0
Q_BLOCK = 128
CHUNK = 128
A_GROUPS = 4
A_GROUP_DIM = 128
A_WIDTH = A_GROUPS * A_GROUP_DIM
B_HEADS = 4
B_HEAD_DIM = 64
B_WIDTH = B_HEADS * 2 * B_HEAD_DIM
EVEN_IN = 2 * A_WIDTH + 3 * B_WIDTH
EVEN_OUT = A_WIDTH + B_WIDTH
C_HEADS = 8
C_KV_HEADS = 2
C_GROUP = C_HEADS // C_KV_HEADS
C_HEAD_DIM = 128
ODD_IN = (C_HEADS + 2 * C_KV_HEADS) * C_HEAD_DIM
ODD_OUT = C_HEADS * C_HEAD_DIM
N_EXPERTS = 64
TOP_K = 6
N_GROUPS = 8
TOPK_GROUPS = 4
D_EXPERT = 256
D_SHARED = 256
ROUTE_SCALE = 2.5
EXPERT_BLOCK = 512

kernel_name = 'hybrid_gmlp_diffattn_gqa_moe_prefix_dit'


def rms_norm(x, g):
    xf = x.astype(jnp.float32)
    y = xf * lax.rsqrt(jnp.mean(xf * xf, axis=-1, keepdims=True) + EPS)
    return (y * g.astype(jnp.float32)).astype(x.dtype)


def layer_norm(x, g, b):
    xf = x.astype(jnp.float32)
    mu = jnp.mean(xf, axis=-1, keepdims=True)
    var = jnp.mean(jnp.square(xf - mu), axis=-1, keepdims=True)
    y = (xf - mu) * lax.rsqrt(var + EPS) * g.astype(jnp.float32) + b.astype(jnp.float32)
    return y.astype(x.dtype)


def adaln(cond, w, b):
    return jnp.split(jax.nn.silu(cond) @ w + b, 6, axis=-1)


def modulate(n, shift, scale):
    return n * (1 + scale) + shift


def axial_rope(n_tokens, head_dim):
    rows = n_tokens // GRID_W
    row = jnp.repeat(jnp.arange(rows, dtype=jnp.float32), GRID_W)
    col = jnp.tile(jnp.arange(GRID_W, dtype=jnp.float32), rows)
    n_freq = head_dim // 4
    inv = ROPE_THETA ** (-jnp.arange(n_freq, dtype=jnp.float32) / n_freq)
    ang = jnp.concatenate([row[:, None] * inv, col[:, None] * inv], axis=-1)
    return jnp.cos(ang), jnp.sin(ang)


def apply_rope(x, cos, sin):
    xf = x.astype(jnp.float32)
    x1, x2 = xf[..., 0::2], xf[..., 1::2]
    c, s = cos[None, :, None, :], sin[None, :, None, :]
    y = jnp.stack([x1 * c - x2 * s, x1 * s + x2 * c], axis=-1).reshape(x.shape)
    return y.astype(x.dtype)


def sweep_query_blocks(fn, q):
    b, s = q.shape[:2]
    nb = s // Q_BLOCK
    qb = jnp.moveaxis(q.reshape((b, nb, Q_BLOCK) + q.shape[2:]), 1, 0)
    out = lax.map(fn, qb)
    return jnp.moveaxis(out, 0, 1).reshape((b, s) + out.shape[3:])


def chunk_gmlp(u, v, ln_g, ln_b, ws, bs):
    b, n, _ = u.shape
    v = layer_norm(v, ln_g, ln_b)
    vc = v.reshape(b, n // CHUNK, CHUNK, A_GROUPS, A_GROUP_DIM)
    mixed = jnp.einsum('gpq,bcqgd->bcpgd', ws, vc) + bs.T[:, :, None]
    return u * mixed.reshape(b, n, A_WIDTH)


def gmlp_diff_mixer(nx, nc, w_in, w_out, ln_g, ln_b, ws, bs, q_norm, k_norm,
                    lam_q1, lam_k1, lam_q2, lam_k2, subln_g, layer, cos, sin, need_ctx):
    lam_init = 0.8 - 0.6 * math.exp(-0.3 * layer)
    lam = (jnp.exp(jnp.sum(lam_q1.astype(jnp.float32) * lam_k1.astype(jnp.float32)))
           - jnp.exp(jnp.sum(lam_q2.astype(jnp.float32) * lam_k2.astype(jnp.float32))) + lam_init)
    scale = B_HEAD_DIM ** -0.5
    splits = [A_WIDTH, 2 * A_WIDTH, 2 * A_WIDTH + B_WIDTH, 2 * A_WIDTH + 2 * B_WIDTH]

    def project(n, rope):
        b, s, _ = n.shape
        u, v, q, k, vv = jnp.split(n @ w_in, splits, axis=-1)
        q = rms_norm(q.reshape(b, s, 2 * B_HEADS, B_HEAD_DIM), q_norm)
        k = rms_norm(k.reshape(b, s, 2 * B_HEADS, B_HEAD_DIM), k_norm)
        if rope is not None:
            q = apply_rope(q, *rope)
            k = apply_rope(k, *rope)
        return (jax.nn.gelu(u, approximate=False), jax.nn.gelu(v, approximate=False),
                q.reshape(b, s, B_HEADS, 2, B_HEAD_DIM), k.reshape(b, s, B_HEADS, 2, B_HEAD_DIM),
                vv.reshape(b, s, B_HEADS, 2 * B_HEAD_DIM))

    def attend(qb, kk, vv):
        sc = jnp.einsum('bqhmd,bkhmd->bhmqk', qb, kk, preferred_element_type=jnp.float32) * scale
        p = jax.nn.softmax(sc, axis=-1)
        a = p[:, :, 0] - lam * p[:, :, 1]
        return jnp.einsum('bhqk,bkhe->bqhe', a.astype(vv.dtype), vv)

    def finish(o, u, v):
        b, s = u.shape[:2]
        o = rms_norm(o, subln_g) * (1 - lam_init)
        a = chunk_gmlp(u, v, ln_g, ln_b, ws, bs)
        return jnp.concatenate([a, o.reshape(b, s, B_WIDTH)], axis=-1) @ w_out

    ux, vx, qx, kx, vvx = project(nx, (cos, sin))
    uc, vc, qc, kc, vvc = project(nc, None)
    k_all = jnp.concatenate([kc, kx], axis=1)
    v_all = jnp.concatenate([vvc, vvx], axis=1)
    yx = finish(sweep_query_blocks(lambda qb: attend(qb, k_all, v_all), qx), ux, vx)
    yc = finish(attend(qc, kc, vvc), uc, vc) if need_ctx else None
    return yx, yc


def axial_gqa_mixer(nx, nc, w_qkv, w_out, q_norm, k_norm, cos, sin, need_ctx):
    scale = C_HEAD_DIM ** -0.5
    splits = [C_HEADS * C_HEAD_DIM, (C_HEADS + C_KV_HEADS) * C_HEAD_DIM]

    def project(n, rope):
        b, s, _ = n.shape
        q, k, v = jnp.split(n @ w_qkv, splits, axis=-1)
        q = rms_norm(q.reshape(b, s, C_HEADS, C_HEAD_DIM), q_norm)
        k = rms_norm(k.reshape(b, s, C_KV_HEADS, C_HEAD_DIM), k_norm)
        if rope is not None:
            q = apply_rope(q, *rope)
            k = apply_rope(k, *rope)
        return q.reshape(b, s, C_KV_HEADS, C_GROUP, C_HEAD_DIM), k, v.reshape(b, s, C_KV_HEADS, C_HEAD_DIM)

    def attend(qb, kk, vv):
        sc = jnp.einsum('bqngd,bknd->bngqk', qb, kk, preferred_element_type=jnp.float32) * scale
        p = jax.nn.softmax(sc, axis=-1)
        return jnp.einsum('bngqk,bknd->bqngd', p.astype(vv.dtype), vv)

    def finish(o):
        b, s = o.shape[:2]
        return o.reshape(b, s, ODD_OUT) @ w_out

    qx, kx, vx = project(nx, (cos, sin))
    qc, kc, vc = project(nc, None)
    k_all = jnp.concatenate([kc, kx], axis=1)
    v_all = jnp.concatenate([vc, vx], axis=1)
    yx = finish(sweep_query_blocks(lambda qb: attend(qb, k_all, v_all), qx))
    yc = finish(attend(qc, kc, vc)) if need_ctx else None
    return yx, yc


def swiglu(x, wg, wu, wd):
    return (jax.nn.silu(x @ wg) * (x @ wu)) @ wd


def routed_experts(xf, eidx, w, w_gate, w_up, w_down):
    t = xf.shape[0]
    n_slots = t * TOP_K
    n_blocks = -(-(n_slots + N_EXPERTS * (EXPERT_BLOCK - 1)) // EXPERT_BLOCK)
    n_rows = n_blocks * EXPERT_BLOCK
    e_flat = eidx.reshape(-1)
    order = jnp.argsort(e_flat)
    e_sorted = e_flat[order]
    tok_sorted = (order // TOP_K).astype(jnp.int32)
    w_sorted = w.reshape(-1)[order]
    counts = jnp.bincount(e_flat, length=N_EXPERTS)
    padded = (counts + EXPERT_BLOCK - 1) // EXPERT_BLOCK * EXPERT_BLOCK
    start = jnp.cumsum(counts) - counts
    pend = jnp.cumsum(padded)
    pstart = pend - padded
    dest = pstart[e_sorted] + jnp.arange(n_slots) - start[e_sorted]
    tok_rows = jnp.zeros((n_rows,), jnp.int32).at[dest].set(tok_sorted)
    w_rows = jnp.zeros((n_rows,), w.dtype).at[dest].set(w_sorted)
    block_expert = jnp.clip(jnp.searchsorted(pend, jnp.arange(n_blocks) * EXPERT_BLOCK, side='right'),
                            0, N_EXPERTS - 1)

    def block_ffn(args):
        tok, e = args
        return swiglu(xf[tok], w_gate[e], w_up[e], w_down[e])

    y = lax.map(block_ffn, (tok_rows.reshape(n_blocks, EXPERT_BLOCK), block_expert))
    y = y.reshape(n_rows, -1) * w_rows[:, None].astype(xf.dtype)
    return jnp.zeros_like(xf).at[tok_rows].add(y)


def moe_ffn(x, w_router, router_bias, w_gate, w_up, w_down, sw_gate, sw_up, sw_down):
    shp = x.shape
    xf = x.reshape(-1, shp[-1])
    t = xf.shape[0]
    scores = jax.nn.sigmoid((xf @ w_router).astype(jnp.float32))
    sel = scores + router_bias.astype(jnp.float32)
    grp_score = jnp.sum(lax.top_k(sel.reshape(t, N_GROUPS, N_EXPERTS // N_GROUPS), 2)[0], axis=-1)
    _, gidx = lax.top_k(grp_score, TOPK_GROUPS)
    gmask = jnp.any(gidx[..., None] == jnp.arange(N_GROUPS), axis=-2)
    emask = jnp.repeat(gmask, N_EXPERTS // N_GROUPS, axis=-1)
    _, eidx = lax.top_k(jnp.where(emask, sel, -jnp.inf), TOP_K)
    w = jnp.take_along_axis(scores, eidx, axis=-1)
    w = w / jnp.sum(w, axis=-1, keepdims=True) * ROUTE_SCALE
    out = routed_experts(xf, eidx, w, w_gate, w_up, w_down) + swiglu(xf, sw_gate, sw_up, sw_down)
    return out.reshape(shp)


def setup_inputs(seed: int = 0) -> dict:
    key = jax.random.key(seed)
    ks = iter(jax.random.split(key, 48))
    n_even = (DEPTH + 1) // 2
    n_odd = DEPTH // 2
    D = D_MODEL

    def nrm(shape, scale):
        return jax.random.normal(next(ks), shape, jnp.float32) * scale

    def gain(shape):
        return 1.0 + nrm(shape, 0.05)

    return {
        'x': nrm((BATCH, SEQ, D), 1.0),
        'c': nrm((BATCH, D), 1.0),
        'ctx': nrm((BATCH, CTX_LEN, D), 1.0),
        'c_ctx': nrm((D,), 1.0),
        'mod_w': nrm((DEPTH, D, 6 * D), 0.5 * D ** -0.5),
        'mod_b': nrm((DEPTH, 6 * D), 0.02),
        'norm1_g': gain((DEPTH, D)),
        'norm2_g': gain((DEPTH, D)),
        'ev_w_in': nrm((n_even, D, EVEN_IN), D ** -0.5),
        'ev_w_out': nrm((n_even, EVEN_OUT, D), EVEN_OUT ** -0.5),
        'a_ln_g': gain((n_even, A_WIDTH)),
        'a_ln_b': nrm((n_even, A_WIDTH), 0.02),
        'a_ws': nrm((n_even, A_GROUPS, CHUNK, CHUNK), CHUNK ** -0.5),
        'a_bs': gain((n_even, A_GROUPS, CHUNK)),
        'b_q_norm': gain((n_even, B_HEAD_DIM)),
        'b_k_norm': gain((n_even, B_HEAD_DIM)),
        'b_lam_q1': nrm((n_even, B_HEAD_DIM), 0.1),
        'b_lam_k1': nrm((n_even, B_HEAD_DIM), 0.1),
        'b_lam_q2': nrm((n_even, B_HEAD_DIM), 0.1),
        'b_lam_k2': nrm((n_even, B_HEAD_DIM), 0.1),
        'b_subln': gain((n_even, 2 * B_HEAD_DIM)),
        'od_w_qkv': nrm((n_odd, D, ODD_IN), D ** -0.5),
        'od_w_out': nrm((n_odd, ODD_OUT, D), ODD_OUT ** -0.5),
        'c_q_norm': gain((n_odd, C_HEAD_DIM)),
        'c_k_norm': gain((n_odd, C_HEAD_DIM)),
        'moe_router': nrm((DEPTH, D, N_EXPERTS), D ** -0.5),
        'moe_bias': nrm((DEPTH, N_EXPERTS), 0.01),
        'moe_w_gate': nrm((DEPTH, N_EXPERTS, D, D_EXPERT), D ** -0.5),
        'moe_w_up': nrm((DEPTH, N_EXPERTS, D, D_EXPERT), D ** -0.5),
        'moe_w_down': nrm((DEPTH, N_EXPERTS, D_EXPERT, D), D_EXPERT ** -0.5),
        'sh_w_gate': nrm((DEPTH, D, D_SHARED), D ** -0.5),
        'sh_w_up': nrm((DEPTH, D, D_SHARED), D ** -0.5),
        'sh_w_down': nrm((DEPTH, D_SHARED, D), D_SHARED ** -0.5),
    }


def reference(x, c, ctx, c_ctx, mod_w, mod_b, norm1_g, norm2_g, ev_w_in, ev_w_out,
              a_ln_g, a_ln_b, a_ws, a_bs, b_q_norm, b_k_norm, b_lam_q1, b_lam_k1,
              b_lam_q2, b_lam_k2, b_subln, od_w_qkv, od_w_out, c_q_norm, c_k_norm,
              moe_router, moe_bias, moe_w_gate, moe_w_up, moe_w_down,
              sh_w_gate, sh_w_up, sh_w_down):
    n_lat = x.shape[1]
    n_ctx = ctx.shape[1]
    cos_b, sin_b = axial_rope(n_lat, B_HEAD_DIM)
    cos_c, sin_c = axial_rope(n_lat, C_HEAD_DIM)
    hx, hc = x, ctx
    for layer in range(DEPTH):
        last = layer == DEPTH - 1
        i = layer // 2
        mx = [m[:, None, :] for m in adaln(c, mod_w[layer], mod_b[layer])]
        mc = adaln(c_ctx, mod_w[layer], mod_b[layer])
        nx = modulate(rms_norm(hx, norm1_g[layer]), mx[0], mx[1])
        nc = modulate(rms_norm(hc, norm1_g[layer]), mc[0], mc[1])
        if layer % 2 == 0:
            yx, yc = gmlp_diff_mixer(nx, nc, ev_w_in[i], ev_w_out[i], a_ln_g[i], a_ln_b[i], a_ws[i], a_bs[i],
                                     b_q_norm[i], b_k_norm[i], b_lam_q1[i], b_lam_k1[i], b_lam_q2[i],
                                     b_lam_k2[i], b_subln[i], layer, cos_b, sin_b, not last)
        else:
            yx, yc = axial_gqa_mixer(nx, nc, od_w_qkv[i], od_w_out[i], c_q_norm[i], c_k_norm[i],
                                     cos_c, sin_c, not last)
        hx = hx + mx[2] * yx
        moe_args = (moe_router[layer], moe_bias[layer], moe_w_gate[layer], moe_w_up[layer],
                    moe_w_down[layer], sh_w_gate[layer], sh_w_up[layer], sh_w_down[layer])
        nx2 = modulate(rms_norm(hx, norm2_g[layer]), mx[3], mx[4])
        if last:
            hx = hx + mx[5] * moe_ffn(nx2, *moe_args)
        else:
            hc = hc + mc[2] * yc
            nc2 = modulate(rms_norm(hc, norm2_g[layer]), mc[3], mc[4])
            y_all = moe_ffn(jnp.concatenate([nc2, nx2], axis=1), *moe_args)
            hc = hc + mc[5] * y_all[:, :n_ctx]
            hx = hx + mx[5] * y_all[:, n_ctx:]
    return hx
```

```cpp
#include <hip/hip_runtime.h>
#include <hip/hip_cooperative_groups.h>
#include <cstdio>
#include <cstdint>
#include <cstring>
namespace cg = cooperative_groups;

#define DEVI __device__ __forceinline__
#define LAS __attribute__((address_space(3)))
typedef unsigned short bf16_t;
typedef short bf16x8 __attribute__((ext_vector_type(8)));
typedef float f32x4 __attribute__((ext_vector_type(4)));
typedef unsigned u32x4 __attribute__((ext_vector_type(4)));
typedef unsigned u32x2 __attribute__((ext_vector_type(2)));

constexpr int D = 1024, NB = 16, S = 2048, NC = 256, SB = 2304, T = NB * SB, TX = NB * S;
constexpr int NE = 64, TOPK = 6, DE = 256;
constexpr int EVEN_IN = 2560, ODD_IN = 1536;
constexpr float EPS = 1e-6f;

constexpr size_t al256(size_t x) { return (x + 255) & ~(size_t)255; }
constexpr size_t OFF_ZERO = 0, ZERO_BYTES = 65536;
constexpr size_t OFF_CNT = 16384;
constexpr size_t OFF_XRANK = 20608;
constexpr size_t OFF_STEAL = 20480;
constexpr size_t OFF_TAB64 = OFF_ZERO + ZERO_BYTES;
constexpr size_t OFF_TAB128 = OFF_TAB64 + 64 * 16 * 8;
constexpr size_t OFF_LAM = OFF_TAB128 + 64 * 32 * 8;
constexpr size_t OFF_MODV = al256(OFF_LAM + 256);
constexpr size_t OFF_SMALL = al256(OFF_MODV + (size_t)2 * 17 * 6144 * 4);
enum { SM_N1G = 0, SM_N2G = 2048, SM_ALNG = 4096, SM_ALNB = 4608, SM_ABS = 5120, SM_BQN = 5632, SM_BKN = 5696, SM_SUBLN = 5760, SM_CQN = 5888, SM_CKN = 6016, SM_MBIAS = 6144,
       SM_AWSF = 8192, SM_ROUTER = 73728, SM_END = 204800 };
constexpr size_t OFF_WIN0T = al256(OFF_SMALL + (size_t)SM_END * 4);
constexpr size_t OFF_WOUT0T = OFF_WIN0T + (size_t)EVEN_IN * D * 2;
constexpr size_t OFF_WQKV1T = OFF_WOUT0T + (size_t)D * D * 2;
constexpr size_t OFF_WOUT1T = OFF_WQKV1T + (size_t)ODD_IN * D * 2;
constexpr size_t OFF_WSA = OFF_WOUT1T + (size_t)D * D * 2;
constexpr size_t OFF_WRT = OFF_WSA + (size_t)4 * 128 * 128 * 2;
constexpr size_t OFF_SHGU = OFF_WRT + (size_t)2 * NE * D * 2;
constexpr size_t OFF_SHD = OFF_SHGU + (size_t)2 * 512 * D * 2;
constexpr size_t OFF_EGU = OFF_SHD + (size_t)2 * D * DE * 2;
constexpr size_t OFF_ED = OFF_EGU + (size_t)NE * 512 * D;
constexpr size_t OFF_HB = OFF_ED + (size_t)NE * D * DE;
constexpr size_t OFF_HC = OFF_HB;
constexpr size_t OFF_ACT = OFF_HB + (size_t)T * D * 2;
constexpr size_t OFF_TOPW = OFF_ACT + (size_t)T * D * 2;
constexpr size_t OFF_TOPP = al256(OFF_TOPW + (size_t)T * 6 * 4);
constexpr size_t OFF_LIST = al256(OFF_TOPP + (size_t)T * 6 * 4);
constexpr int LCAP = 36864;
constexpr size_t OFF_R = al256(OFF_LIST + (size_t)NE * LCAP * 4);
constexpr size_t OFF_PROJ = OFF_R;
constexpr size_t OFF_SLOT = OFF_R;
constexpr size_t OFF_HID = al256(OFF_SLOT + (size_t)258048 * D);
constexpr size_t OFF_ACT8 = al256(OFF_HID + (size_t)(258048 + 256) * DE);
constexpr size_t WS_TOTAL = OFF_ACT8 + (size_t)T * D;
static_assert(OFF_HID >= OFF_R + (size_t)0, "layout");
static_assert(OFF_R + (size_t)T * EVEN_IN * 2 <= WS_TOTAL, "proj fits");
static_assert(WS_TOTAL <= 636368384ull, "workspace budget");

struct Params {
  float* out;
  unsigned char* ws;
  const float* x; const float* ctx;
};
struct PrepIn { const float* in[33]; };
typedef __attribute__((address_space(1))) unsigned char* gptr_t;
__device__ __forceinline__ Params launder(const Params& p) {
  unsigned long long a = (unsigned long long)p.out, b = (unsigned long long)p.ws, c = (unsigned long long)p.x, d = (unsigned long long)p.ctx;
  asm volatile("" : "+s"(a), "+s"(b), "+s"(c), "+s"(d));
  Params q; q.out = (float*)(gptr_t)a; q.ws = (unsigned char*)(gptr_t)b; q.x = (const float*)(gptr_t)c; q.ctx = (const float*)(gptr_t)d; return q; }
enum { I_X = 0, I_C, I_CTX, I_CCTX, I_MODW, I_MODB, I_N1G, I_N2G, I_EVWIN, I_EVWOUT, I_ALNG, I_ALNB, I_AWS, I_ABS, I_BQN, I_BKN,
       I_LQ1, I_LK1, I_LQ2, I_LK2, I_SUBLN, I_ODQKV, I_ODOUT, I_CQN, I_CKN, I_ROUTER, I_MBIAS, I_WG, I_WU, I_WD, I_SG, I_SU, I_SD };

extern __shared__ __attribute__((aligned(16))) unsigned char smem[];
constexpr int SMEM_BYTES = 152 * 1024;
constexpr int LDS_WTAB = SMEM_BYTES - 512;
DEVI int ltid() {
  const unsigned slot = (unsigned)__builtin_amdgcn_s_getreg(63492) & 0x3fu;
  const int wv = __builtin_amdgcn_readfirstlane(*(volatile LAS int*)((LAS unsigned char*)smem + LDS_WTAB + slot * 4));
  int l; asm volatile("v_mbcnt_lo_u32_b32 %0, -1, 0\n\tv_mbcnt_hi_u32_b32 %0, -1, %0" : "=v"(l));
  return wv * 64 + l;
}
constexpr int LDS_VBID = LDS_WTAB + 256;
DEVI int vbid() { return __builtin_amdgcn_readfirstlane(*(volatile LAS int*)((LAS unsigned char*)smem + LDS_VBID)); }
DEVI void ltid_init() {
  const unsigned slot = (unsigned)__builtin_amdgcn_s_getreg(63492) & 0x3fu;
  if ((threadIdx.x & 63) == 0) *(volatile LAS int*)((LAS unsigned char*)smem + LDS_WTAB + slot * 4) = (int)(threadIdx.x >> 6);
  __syncthreads();
}
template <int M> DEVI float shx(float v) { static_assert(M == 1 || M == 2 || M == 4 || M == 8 || M == 16, "xor mask");
  return __int_as_float(__builtin_amdgcn_ds_swizzle(__float_as_int(v), (M << 10) | 0x1f)); }
template <int CTRL> DEVI float dppf(float v) { return __int_as_float(__builtin_amdgcn_update_dpp(0, __float_as_int(v), CTRL, 0xf, 0xf, true)); }
DEVI float rlane(float v, int l) { return __int_as_float(__builtin_amdgcn_readlane(__float_as_int(v), l)); }
DEVI float wsum_dpp(float v) { v += dppf<0xB1>(v); v += dppf<0x4E>(v); v += dppf<0x141>(v); v += dppf<0x140>(v); return (rlane(v, 0) + rlane(v, 16)) + (rlane(v, 32) + rlane(v, 48)); }
DEVI float wmax_dpp(float v) { v = fmaxf(v, dppf<0xB1>(v)); v = fmaxf(v, dppf<0x4E>(v)); v = fmaxf(v, dppf<0x141>(v)); v = fmaxf(v, dppf<0x140>(v)); return fmaxf(fmaxf(rlane(v, 0), rlane(v, 16)), fmaxf(rlane(v, 32), rlane(v, 48))); }
DEVI float max8_dpp(float v) { v = fmaxf(v, dppf<0xB1>(v)); v = fmaxf(v, dppf<0x4E>(v)); return fmaxf(v, dppf<0x141>(v)); }
DEVI float sum32x(float v) { auto r = __builtin_amdgcn_permlane32_swap(__float_as_uint(v), __float_as_uint(v), false, false); return __uint_as_float(r[0]) + __uint_as_float(r[1]); }
DEVI float max32x(float v) { auto r = __builtin_amdgcn_permlane32_swap(__float_as_uint(v), __float_as_uint(v), false, false); return fmaxf(__uint_as_float(r[0]), __uint_as_float(r[1])); }
DEVI bf16_t f2bf(float f) { unsigned u = __float_as_uint(f); u += 0x7FFFu + ((u >> 16) & 1u); return (bf16_t)(u >> 16); }
DEVI float bf2f(bf16_t b) { return __uint_as_float(((unsigned)b) << 16); }
DEVI unsigned pack2(float lo, float hi) { return (unsigned)f2bf(lo) | ((unsigned)f2bf(hi) << 16); }
DEVI float wsum(float v) { v += shx<1>(v); v += shx<2>(v); v += shx<4>(v); v += shx<8>(v); v += shx<16>(v); return sum32x(v); }
DEVI float wmax(float v) { v = fmaxf(v, shx<1>(v)); v = fmaxf(v, shx<2>(v)); v = fmaxf(v, shx<4>(v)); v = fmaxf(v, shx<8>(v)); v = fmaxf(v, shx<16>(v)); return max32x(v); }
DEVI float gelu_exact(float v) { return 0.5f * v * (1.0f + erff(v * 0.70710678118654752f)); }
DEVI float silu(float v) { return v / (1.0f + __expf(-v)); }

template <class Tp> DEVI Tp* wsp(const Params& p, size_t off) { return (Tp*)(p.ws + off); }
DEVI const float* sm(const Params& p, int off) { return (const float*)(p.ws + OFF_SMALL) + off; }
DEVI const float* in_row(const Params& p, int t) { int b = t / SB, j = t - b * SB;
  unsigned long long xa = (unsigned long long)p.x, ca = (unsigned long long)p.ctx; asm volatile("" : "+s"(xa), "+s"(ca));
  const float* xp = (const float*)(gptr_t)xa; const float* cp = (const float*)(gptr_t)ca;
  return j < NC ? cp + ((size_t)(b * NC + j)) * D : xp + ((size_t)(b * S + j - NC)) * D; }
DEVI f32x4 bf4(u32x2 r) { return (f32x4){__uint_as_float(r.x << 16), __uint_as_float(r.x & 0xffff0000u), __uint_as_float(r.y << 16), __uint_as_float(r.y & 0xffff0000u)}; }
DEVI float* hid_row(const Params& p, int t) { int b = t / SB, j = t - b * SB;
  return j < NC ? wsp<float>(p, OFF_HC) + ((size_t)(b * NC + j)) * D : p.out + ((size_t)(b * S + j - NC)) * D; }
DEVI const float* modv(const Params& p, int l, int t, int which) { int b = t / SB, j = t - b * SB; int r = j < NC ? 16 : b;
  return wsp<float>(p, OFF_MODV) + ((size_t)(l * 17 + r)) * 6144 + which * D; }

#define XB_TMO      128
#define XB_XCNT(j)  (256  + 64 * (j))
#define XB_XSUB(j)  (1280 + 64 * (j))
#define XB_XGEN(j)  (2304 + 64 * (j))
#define XB_TOP      3328
#define XB_TOPGEN   3392
#define XCD_BAR_WORDS 3456
#define XB_SPIN_CAP (1u << 22)
DEVI unsigned xb_ld(unsigned* p) { return __hip_atomic_load(p, __ATOMIC_RELAXED, __HIP_MEMORY_SCOPE_AGENT); }
DEVI unsigned xb_add(unsigned* p, unsigned v) { return __hip_atomic_fetch_add(p, v, __ATOMIC_RELAXED, __HIP_MEMORY_SCOPE_AGENT); }
DEVI unsigned xb_xcc_id() { return (unsigned)__builtin_amdgcn_s_getreg((3 << 11) | 20) & 0xFu; }
#define XB_SPIN(cond, bar) do { unsigned _sp = 0; while (cond) { __builtin_amdgcn_s_sleep(1); \
    if ((++_sp & 255u) == 0u) { if (xb_ld(&(bar)[XB_TMO])) break; if (_sp > XB_SPIN_CAP) { atomicAdd(&(bar)[XB_TMO], 1u); break; } } } } while (0)
struct XcdBarrier { unsigned* bar; unsigned x; volatile LAS unsigned* st; };
DEVI XcdBarrier xcd_barrier_post(unsigned* bar, volatile LAS unsigned* st) {
  XcdBarrier b; b.bar = bar; b.x = xb_xcc_id(); b.st = st;
  if (ltid() == 0) (void)xb_add(&bar[XB_XCNT(b.x)], 1u);
  return b;
}
DEVI void xcd_barrier_complete(unsigned* bar, unsigned x, unsigned& nloc, unsigned& nx) {
  const unsigned G = gridDim.x * gridDim.y * gridDim.z;
  unsigned sum, cnt, mine, sp = 0u;
  for (;;) {
    sum = 0u; cnt = 0u; mine = 0u;
#pragma unroll
    for (unsigned j = 0; j < 16; ++j) { const unsigned c = xb_ld(&bar[XB_XCNT(j)]); sum += c; cnt += (c > 0u) ? 1u : 0u; mine = (j == x) ? c : mine; }
    if (sum == G) break;
    __builtin_amdgcn_s_sleep(1);
    if ((++sp & 255u) == 0u) { if (xb_ld(&bar[XB_TMO])) break; if (sp > XB_SPIN_CAP) { atomicAdd(&bar[XB_TMO], 1u); break; } }
  }
  nloc = mine > 0u ? mine : 1u; nx = cnt > 0u ? cnt : 1u;
}
DEVI void xcd_barrier(const XcdBarrier& b) {
  asm volatile("s_waitcnt vmcnt(0)" ::: "memory");
  __syncthreads();
  if (ltid() == 0) {
    unsigned* bar = b.bar;
    __builtin_amdgcn_s_waitcnt(0);
    unsigned nloc = b.st[0], nx = b.st[1];
    if (nloc == 0u) { xcd_barrier_complete(bar, b.x, nloc, nx); b.st[0] = nloc; b.st[1] = nx; }
    const unsigned old = xb_add(&bar[XB_XSUB(b.x)], 1u);
    const unsigned gen = old / nloc;
    if (old + 1u == (gen + 1u) * nloc) {
      __builtin_amdgcn_fence(__ATOMIC_RELEASE, "agent");
      asm volatile("s_waitcnt vmcnt(0)" ::: "memory");
      const unsigned og = xb_add(&bar[XB_TOP], 1u);
      const unsigned tg = og / nx;
      if (og + 1u == (tg + 1u) * nx) xb_add(&bar[XB_TOPGEN], 1u);
      else XB_SPIN(xb_ld(&bar[XB_TOPGEN]) == tg, bar);
      __builtin_amdgcn_fence(__ATOMIC_ACQUIRE, "agent");
      xb_add(&bar[XB_XGEN(b.x)], 1u);
      asm volatile("s_waitcnt vmcnt(0)" ::: "memory");
    } else {
      XB_SPIN(xb_ld(&bar[XB_XGEN(b.x)]) == gen, bar);
      __builtin_amdgcn_fence(__ATOMIC_ACQUIRE, "agent");
      asm volatile("s_waitcnt vmcnt(0)" ::: "memory");
    }
  }
  __syncthreads();
}

DEVI void transpose_tiles(const float* srcb, unsigned char* dstb, int K, int N, int nb, size_t sstride, size_t dstride, unsigned char* smem, int& goff) {
  const int G = gridDim.x, tk = K / 128, tn = N / 256, per = tk * tn, total = per * nb, tid = ltid();
  const int first = (((int)blockIdx.x - goff) % G + G) % G;
  const int n4 = tid & 63, kp0 = tid >> 6;
  f32x4 va[8], vb[8];
  auto issue = [&](int ti) { const int m = ti / per, r = ti - m * per, kb = r / tn, nb_ = r - kb * tn;
    const float* src = srcb + (size_t)m * sstride + (size_t)(kb * 128) * N + nb_ * 256 + n4 * 4;
#pragma unroll
    for (int i = 0; i < 8; ++i) { const int kp = kp0 + 8 * i; va[i] = __builtin_nontemporal_load((const f32x4*)(src + (size_t)(2 * kp) * N)); vb[i] = __builtin_nontemporal_load((const f32x4*)(src + (size_t)(2 * kp + 1) * N)); } };
  if (first < total) issue(first);
  int par = 0;
  for (int ti = first; ti < total; ti += G, par ^= 1) {
    unsigned* Tb = (unsigned*)smem + par * 16384;
#pragma unroll
    for (int i = 0; i < 8; ++i) { const int kp = kp0 + 8 * i;
#pragma unroll
      for (int j = 0; j < 4; ++j) { const int n = n4 * 4 + j; Tb[n * 64 + (kp ^ (((n >> 2) & 7) << 2))] = pack2(va[i][j], vb[i][j]); } }
    if (ti + G < total) issue(ti + G);
    __syncthreads();
    const int m = ti / per, r = ti - m * per, kb = r / tn, nb_ = r - kb * tn;
    bf16_t* dst = (bf16_t*)dstb + (size_t)m * dstride + (size_t)(nb_ * 256) * K + kb * 128;
#pragma unroll
    for (int i = 0; i < 8; ++i) { const int pc = tid + 512 * i, n = pc >> 4, q = pc & 15;
      const u32x4 w = *(const u32x4*)(Tb + n * 64 + ((4 * q) ^ (((n >> 2) & 7) << 2)));
      *(u32x4*)(dst + (size_t)n * K + 8 * q) = w; }
  }
  __syncthreads();
  goff = (goff + total) % G;
}

constexpr int WD_SHIFT = 4, H_SHIFT = 2, WG_SHIFT = 5, X_SHIFT = 3, WQ_SHIFT = 5;
constexpr bool IN1_FP8 = true, IN0_FP8 = true;
DEVI void transpose_panel8(const float* src0, unsigned char* dst0, int K, int N, int kb, int nb_, unsigned char* smem, int shift = WD_SHIFT) {
  const int tid = ltid(), n4 = tid & 63, kq0 = tid >> 6; unsigned* Tb = (unsigned*)smem;
  const float* src = src0 + (size_t)(kb * 128) * N + nb_ * 256 + n4 * 4; unsigned char* dst = dst0 + (size_t)(nb_ * 256) * K + kb * 128;
  f32x4 v[4][4];
#pragma unroll
  for (int i = 0; i < 4; ++i)
#pragma unroll
    for (int r = 0; r < 4; ++r) v[i][r] = __builtin_nontemporal_load((const f32x4*)(src + (size_t)(4 * (kq0 + 8 * i) + r) * N));
  const float sc = (float)(1 << shift);
#pragma unroll
  for (int i = 0; i < 4; ++i) { const int kq = kq0 + 8 * i;
#pragma unroll
    for (int j = 0; j < 4; ++j) { const int n = n4 * 4 + j; int w = 0;
      w = __builtin_amdgcn_cvt_pk_fp8_f32(v[i][0][j] * sc, v[i][1][j] * sc, w, false); w = __builtin_amdgcn_cvt_pk_fp8_f32(v[i][2][j] * sc, v[i][3][j] * sc, w, true);
      Tb[n * 32 + (kq ^ (((n >> 2) & 7) << 2))] = (unsigned)w; } }
  __syncthreads();
#pragma unroll
  for (int i = 0; i < 4; ++i) { const int pc = tid + 512 * i, n = pc >> 3, q = pc & 7;
    const u32x4 w = *(const u32x4*)(Tb + n * 32 + ((4 * q) ^ (((n >> 2) & 7) << 2)));
    *(u32x4*)(dst + (size_t)n * K + 16 * q) = w; }
}
DEVI void transpose_all8(const float* src, unsigned char* dst, int K, int N, int shift, unsigned char* smem, int& goff) {
  const int G = gridDim.x, tk = K / 128, tn = N / 256, total = tk * tn;
  const int first = (((int)blockIdx.x - goff) % G + G) % G;
  for (int ti = first; ti < total; ti += G) { __syncthreads(); const int kb = ti / tn, nb_ = ti - kb * tn; transpose_panel8(src, dst, K, N, kb, nb_, smem, shift); }
  __syncthreads();
  goff = (goff + total) % G;
}
DEVI void stage_prep(const Params& p, const PrepIn& pin, unsigned char* smem) {
  const int tid = ltid(), bid = blockIdx.x, G = gridDim.x;
  {
    float* sl = (float*)smem;
    for (int i = tid; i < 17 * 1024; i += 512) { int r = i >> 10, k = i & 1023; float v; if (r < 16) v = pin.in[I_C][r * 1024 + k]; else v = pin.in[I_CCTX][k]; sl[i] = silu(v); }
    __syncthreads();
    float* part = (float*)(smem + 17 * 1024 * 4);
    for (int cb = bid; cb < 256; cb += G) {
      const int col0 = cb * 48;
      if (tid < 384) {
        const int kc = tid / 48, c = tid - kc * 48, gc = col0 + c, l = gc / 6144, n = gc - l * 6144;
        const float* w = pin.in[I_MODW] + (size_t)l * 1024 * 6144 + n;
        float acc[17];
#pragma unroll
        for (int r = 0; r < 17; ++r) acc[r] = 0.f;
        for (int k = kc * 128; k < kc * 128 + 128; ++k) { float wv = w[(size_t)k * 6144];
#pragma unroll
          for (int r = 0; r < 17; ++r) acc[r] += sl[r * 1024 + k] * wv; }
#pragma unroll
        for (int r = 0; r < 17; ++r) part[(kc * 17 + r) * 48 + c] = acc[r];
      }
      __syncthreads();
      for (int i = tid; i < 17 * 48; i += 512) { int r = i / 48, c = i - r * 48, gc = col0 + c, l = gc / 6144, n = gc - l * 6144;
        float s = pin.in[I_MODB][l * 6144 + n];
        for (int kc = 0; kc < 8; ++kc) s += part[(kc * 17 + r) * 48 + c];
        wsp<float>(p, OFF_MODV)[((size_t)(l * 17 + r)) * 6144 + n] = s; }
      __syncthreads();
    }
  }
  if (bid == 0) {
    float2* t64 = wsp<float2>(p, OFF_TAB64); float2* t128 = wsp<float2>(p, OFF_TAB128);
    for (int i = tid; i < 64 * 16; i += 512) { int pos = i >> 4, f = i & 15; float inv = exp2f(-(float)f * (13.287712379549449f / 16.0f)); float a = (float)pos * inv; t64[i] = make_float2(__cosf(a), __sinf(a)); }
    for (int i = tid; i < 64 * 32; i += 512) { int pos = i >> 5, f = i & 31; float inv = exp2f(-(float)f * (13.287712379549449f / 32.0f)); float a = (float)pos * inv; t128[i] = make_float2(__cosf(a), __sinf(a)); }
    if (tid < 64) { float a = pin.in[I_LQ1][tid] * pin.in[I_LK1][tid], b = pin.in[I_LQ2][tid] * pin.in[I_LK2][tid]; a = wsum(a); b = wsum(b);
      if (tid == 0) wsp<float>(p, OFF_LAM)[0] = expf(a) - expf(b) + 0.2f; }
  }
  { float* smw = wsp<float>(p, OFF_SMALL); const int gt = bid * 512 + tid, gs = G * 512;
#define CPY(idx, off, n) for (int i = gt; i < (n); i += gs) smw[(off) + i] = pin.in[idx][i];
    CPY(I_N1G, SM_N1G, 2048) CPY(I_N2G, SM_N2G, 2048) CPY(I_ALNG, SM_ALNG, 512) CPY(I_ALNB, SM_ALNB, 512) CPY(I_ABS, SM_ABS, 512) CPY(I_BQN, SM_BQN, 64) CPY(I_BKN, SM_BKN, 64)
    CPY(I_SUBLN, SM_SUBLN, 128) CPY(I_CQN, SM_CQN, 128) CPY(I_CKN, SM_CKN, 128) CPY(I_MBIAS, SM_MBIAS, 128) CPY(I_AWS, SM_AWSF, 65536) CPY(I_ROUTER, SM_ROUTER, 131072)
#undef CPY
  }
  for (int i = bid * 512 + tid; i < 2 * NE * D; i += G * 512) { const int l = i >> 16, e = (i >> 10) & 63, kk = i & 1023; wsp<bf16_t>(p, OFF_WRT)[i] = f2bf(pin.in[I_ROUTER][((size_t)l * D + kk) * NE + e]); }
  for (int i = bid * 512 + tid; i < 4 * 128 * 128; i += G * 512) wsp<bf16_t>(p, OFF_WSA)[i] = f2bf(pin.in[I_AWS][i]);
  int goff = 0;
  const size_t EW = (size_t)D * DE;
  __syncthreads();
  if (IN0_FP8) transpose_all8(pin.in[I_EVWIN], p.ws + OFF_WIN0T, D, EVEN_IN, WQ_SHIFT, smem, goff);
  else transpose_tiles(pin.in[I_EVWIN], p.ws + OFF_WIN0T, D, EVEN_IN, 1, 0, 0, smem, goff);
  transpose_tiles(pin.in[I_EVWOUT], p.ws + OFF_WOUT0T, D, D, 1, 0, 0, smem, goff);
  if (IN1_FP8) transpose_all8(pin.in[I_ODQKV], p.ws + OFF_WQKV1T, D, ODD_IN, WQ_SHIFT, smem, goff);
  else transpose_tiles(pin.in[I_ODQKV], p.ws + OFF_WQKV1T, D, ODD_IN, 1, 0, 0, smem, goff);
  transpose_tiles(pin.in[I_ODOUT], p.ws + OFF_WOUT1T, D, D, 1, 0, 0, smem, goff);
  for (int pi = bid; pi < 32; pi += G) { __syncthreads(); const int l = pi >> 4, up = (pi >> 3) & 1, kb = pi & 7;
    const float* sgu; if (up) sgu = pin.in[I_SU]; else sgu = pin.in[I_SG]; asm volatile("" : "+s"(sgu));
    transpose_panel8(sgu + (size_t)l * EW, p.ws + OFF_SHGU + (size_t)l * 512 * D + (size_t)up * 256 * D, D, DE, kb, 0, smem, WG_SHIFT); }
  __syncthreads();
  for (int pi = bid; pi < 16; pi += G) { __syncthreads(); const int l = pi >> 3, rr = pi & 7; transpose_panel8(pin.in[I_SD] + (size_t)l * EW, p.ws + OFF_SHD + (size_t)l * EW, DE, D, rr >> 2, rr & 3, smem); }
  __syncthreads();
}
DEVI void transpose_panel(const float* src0, bf16_t* dst0, int K, int N, int kb, int nb_, unsigned char* smem) {
  const int tid = ltid(), n4 = tid & 63, kp0 = tid >> 6; unsigned* Tb = (unsigned*)smem;
  const float* src = src0 + (size_t)(kb * 128) * N + nb_ * 256 + n4 * 4; bf16_t* dst = dst0 + (size_t)(nb_ * 256) * K + kb * 128;
  f32x4 va[8], vb[8];
#pragma unroll
  for (int i = 0; i < 8; ++i) { const int kp = kp0 + 8 * i; va[i] = __builtin_nontemporal_load((const f32x4*)(src + (size_t)(2 * kp) * N)); vb[i] = __builtin_nontemporal_load((const f32x4*)(src + (size_t)(2 * kp + 1) * N)); }
#pragma unroll
  for (int i = 0; i < 8; ++i) { const int kp = kp0 + 8 * i;
#pragma unroll
    for (int j = 0; j < 4; ++j) { const int n = n4 * 4 + j; Tb[n * 64 + (kp ^ (((n >> 2) & 7) << 2))] = pack2(va[i][j], vb[i][j]); } }
  __syncthreads();
#pragma unroll
  for (int i = 0; i < 8; ++i) { const int pc = tid + 512 * i, n = pc >> 4, q = pc & 15;
    const u32x4 w = *(const u32x4*)(Tb + n * 64 + ((4 * q) ^ (((n >> 2) & 7) << 2)));
    *(u32x4*)(dst + (size_t)n * K + 8 * q) = w; }
}
DEVI void expert_prep_steal(const Params& p, const PrepIn& pin, unsigned char* smem, int layer) {
  const size_t EW = (size_t)D * DE, lo = (size_t)layer * NE * EW; int* ctr = (int*)(p.ws + OFF_STEAL) + layer; int* bc = (int*)(smem + 65536);
  for (;;) {
    __syncthreads();
    if (ltid() == 0) bc[0] = atomicAdd(ctr, 1);
    __syncthreads();
    const int idx = bc[0]; if (idx >= 3 * 512) break;
    const int j = idx >> 9, r = idx & 511, m = r >> 3, rr = r & 7;
    if (j == 0) transpose_panel8(pin.in[I_WG] + lo + (size_t)m * EW, p.ws + OFF_EGU + (size_t)m * 512 * D, D, DE, rr, 0, smem, WG_SHIFT);
    else if (j == 1) transpose_panel8(pin.in[I_WU] + lo + (size_t)m * EW, p.ws + OFF_EGU + (size_t)m * 512 * D + (size_t)256 * D, D, DE, rr, 0, smem, WG_SHIFT);
    else transpose_panel8(pin.in[I_WD] + lo + (size_t)m * EW, p.ws + OFF_ED + (size_t)m * EW, DE, D, rr >> 2, rr & 3, smem);
  }
}
DEVI void stage_prep_experts(const Params& p, const PrepIn& pin, unsigned char* smem, int layer) {
  int goff = 0; const size_t EW = (size_t)D * DE, lo = (size_t)layer * NE * EW;
  __syncthreads();
  transpose_tiles(pin.in[I_WG] + lo, p.ws + OFF_EGU, D, DE, 64, EW, (size_t)512 * D, smem, goff);
  transpose_tiles(pin.in[I_WU] + lo, p.ws + OFF_EGU + (size_t)256 * D * 2, D, DE, 64, EW, (size_t)512 * D, smem, goff);
  transpose_tiles(pin.in[I_WD] + lo, p.ws + OFF_ED, DE, D, 64, EW, EW, smem, goff);
  __syncthreads();
}

template <int LAYER> DEVI void stage_norm1(const Params& p) {
  const int wid = ltid() >> 6, lane = ltid() & 63;
  const float* g = sm(p, SM_N1G + LAYER * D);
  bf16_t* act = wsp<bf16_t>(p, OFF_ACT);
  for (int t = blockIdx.x * 8 + wid; t < T; t += gridDim.x * 8) {
    const float* row = LAYER == 0 ? in_row(p, t) : (const float*)hid_row(p, t);
    const float* sh = modv(p, LAYER, t, 0); const float* sc = modv(p, LAYER, t, 1);
    f32x4 v[4]; float ss = 0.f;
#pragma unroll
    for (int i = 0; i < 4; ++i) { v[i] = *(const f32x4*)(row + (i * 64 + lane) * 4); ss += v[i][0] * v[i][0] + v[i][1] * v[i][1] + v[i][2] * v[i][2] + v[i][3] * v[i][3]; }
    ss = wsum(ss); const float rstd = rsqrtf(ss * (1.0f / D) + EPS);
#pragma unroll
    for (int i = 0; i < 4; ++i) { const int c = (i * 64 + lane) * 4; const f32x4 gg = *(const f32x4*)(g + c), s1 = *(const f32x4*)(sc + c), s0 = *(const f32x4*)(sh + c);
      float y[4];
#pragma unroll
      for (int q = 0; q < 4; ++q) y[q] = v[i][q] * rstd * gg[q] * (1.0f + s1[q]) + s0[q];
      if ((LAYER == 0 && IN0_FP8) || (LAYER == 1 && IN1_FP8)) { const float xs = (float)(1 << X_SHIFT); int w8 = 0;
        w8 = __builtin_amdgcn_cvt_pk_fp8_f32(__builtin_amdgcn_fmed3f(y[0] * xs, -440.f, 440.f), __builtin_amdgcn_fmed3f(y[1] * xs, -440.f, 440.f), w8, false);
        w8 = __builtin_amdgcn_cvt_pk_fp8_f32(__builtin_amdgcn_fmed3f(y[2] * xs, -440.f, 440.f), __builtin_amdgcn_fmed3f(y[3] * xs, -440.f, 440.f), w8, true);
        *(int*)(p.ws + OFF_ACT8 + (size_t)t * D + c) = w8; }
      else { u32x2 w; w.x = pack2(y[0], y[1]); w.y = pack2(y[2], y[3]);
        *(u32x2*)(act + (size_t)t * D + c) = w; } }
  }
}

template <class GA, class GB, class ST>
DEVI void ngemm(int MT, int NT, int K, GA getA, GB getB, ST store) {
  const int wid = ltid() >> 6, lane = ltid() & 63, fr = lane & 15, fq = lane >> 4;
  const long nw = (long)gridDim.x * 8;
  for (long tile = (long)blockIdx.x * 8 + wid; tile < (long)MT * NT; tile += nw) {
    const int tm = (int)(tile / NT), tn = (int)(tile - (long)tm * NT);
    const bf16_t* a0 = getA(tm * 32 + fr); const bf16_t* a1 = getA(tm * 32 + 16 + fr);
    const bf16_t* b0 = getB(tn * 32 + fr); const bf16_t* b1 = getB(tn * 32 + 16 + fr);
    f32x4 c00 = {0.f, 0.f, 0.f, 0.f}, c01 = c00, c10 = c00, c11 = c00;
    const bf16x8 z = {0, 0, 0, 0, 0, 0, 0, 0};
    for (int k = 0; k < K; k += 32) {
      const bf16x8 A0 = a0 ? *(const bf16x8*)(a0 + k + fq * 8) : z, A1 = a1 ? *(const bf16x8*)(a1 + k + fq * 8) : z;
      const bf16x8 B0 = *(const bf16x8*)(b0 + k + fq * 8), B1 = *(const bf16x8*)(b1 + k + fq * 8);
      c00 = __builtin_amdgcn_mfma_f32_16x16x32_bf16(A0, B0, c00, 0, 0, 0);
      c01 = __builtin_amdgcn_mfma_f32_16x16x32_bf16(A0, B1, c01, 0, 0, 0);
      c10 = __builtin_amdgcn_mfma_f32_16x16x32_bf16(A1, B0, c10, 0, 0, 0);
      c11 = __builtin_amdgcn_mfma_f32_16x16x32_bf16(A1, B1, c11, 0, 0, 0);
    }
#pragma unroll
    for (int j = 0; j < 4; ++j) {
      store(tm * 32 + fq * 4 + j, tn * 32 + fr, tn * 32 + 16 + fr, c00[j], c01[j]);
      store(tm * 32 + 16 + fq * 4 + j, tn * 32 + fr, tn * 32 + 16 + fr, c10[j], c11[j]);
    }
  }
}

DEVI void n_inproj0(const Params& p) {
  const bf16_t* act = wsp<bf16_t>(p, OFF_ACT); const bf16_t* w = wsp<bf16_t>(p, OFF_WIN0T); bf16_t* proj = wsp<bf16_t>(p, OFF_PROJ);
  ngemm(T / 32, EVEN_IN / 32, D,
        [&](int r) { return act + (size_t)r * D; }, [&](int n) { return w + (size_t)n * D; },
        [&](int r, int n0, int n1, float v0, float v1) { proj[(size_t)r * EVEN_IN + n0] = f2bf(v0); proj[(size_t)r * EVEN_IN + n1] = f2bf(v1); });
}
DEVI void n_post0(const Params& p) {
  const int wid = ltid() >> 6, lane = ltid() & 63;
  bf16_t* proj = wsp<bf16_t>(p, OFF_PROJ); const float2* t64 = wsp<float2>(p, OFF_TAB64);
  for (int t = blockIdx.x * 8 + wid; t < T; t += gridDim.x * 8) {
    bf16_t* row = proj + (size_t)t * EVEN_IN; const int b = t / SB, j = t - b * SB;
    for (int i = 0; i < 16; ++i) { int c = i * 64 + lane; row[c] = f2bf(gelu_exact(bf2f(row[c]))); }
    for (int hh = 0; hh < 16; ++hh) {
      const int c = 1024 + hh * 64 + lane; float v = bf2f(row[c]);
      float ss = wsum(v * v); float g = sm(p, hh < 8 ? SM_BQN : SM_BKN)[lane];
      float y = v * rsqrtf(ss * (1.0f / 64) + EPS) * g;
      y = bf2f(f2bf(y));
      if (j >= NC) { const int pos = j - NC, pr = lane >> 1; const int ps = pr < 16 ? (pos >> 6) : (pos & 63); const float2 cs = t64[ps * 16 + (pr & 15)];
        const float other = shx<1>(y);
        y = (lane & 1) ? (other * cs.y + y * cs.x) : (y * cs.x - other * cs.y); }
      row[c] = f2bf(y);
    }
  }
}

DEVI void attn_row(const bf16_t* q, int dq, const bf16_t* kb, int ldk, const bf16_t* vb, int ldv, int nkeys, float scale,
                   volatile float* sc, volatile float* qs, float& o0, float& o1) {
  const int lane = ltid() & 63;
  for (int d = lane; d < dq; d += 64) qs[d] = bf2f(q[d]);
  float mx = -1e30f;
  for (int key = lane; key < nkeys; key += 64) { const bf16_t* kr = kb + (size_t)key * ldk; float dot = 0.f;
    for (int d = 0; d < dq; d += 8) { const bf16x8 kv = *(const bf16x8*)(kr + d);
#pragma unroll
      for (int e = 0; e < 8; ++e) dot += qs[d + e] * bf2f((bf16_t)kv[e]); }
    dot *= scale; sc[key] = dot; mx = fmaxf(mx, dot); }
  mx = wmax(mx); float sum = 0.f;
  for (int key = lane; key < nkeys; key += 64) { float pv = __expf(sc[key] - mx); sc[key] = pv; sum += pv; }
  sum = wsum(sum); float a0 = 0.f, a1 = 0.f;
  for (int key = 0; key < nkeys; ++key) { const float pv = sc[key]; const unsigned vv = *(const unsigned*)(vb + (size_t)key * ldv + 2 * lane);
    a0 += pv * bf2f((bf16_t)(vv & 0xffff)); a1 += pv * bf2f((bf16_t)(vv >> 16)); }
  const float inv = 1.0f / sum; o0 = a0 * inv; o1 = a1 * inv;
}
DEVI void n_attn0(const Params& p, unsigned char* smem) {
  const int wid = ltid() >> 6, lane = ltid() & 63;
  volatile float* sc = (volatile float*)(smem + wid * (2304 * 4 + 512)); volatile float* qs = sc + 2304;
  const bf16_t* proj = wsp<bf16_t>(p, OFF_PROJ); bf16_t* cat = wsp<bf16_t>(p, OFF_ACT);
  const float lam = wsp<float>(p, OFF_LAM)[0];
  for (int task = blockIdx.x * 8 + wid; task < T * 4; task += gridDim.x * 8) {
    const int t = task >> 2, h = task & 3, b = t / SB, j = t - b * SB; const int nkeys = j < NC ? NC : SB;
    const bf16_t* kbase = proj + (size_t)(b * SB) * EVEN_IN + 1536 + h * 128; const bf16_t* vbase = proj + (size_t)(b * SB) * EVEN_IN + 2048 + h * 128;
    const bf16_t* q = proj + (size_t)t * EVEN_IN + 1024 + h * 128;
    float a0, a1, b0, b1;
    attn_row(q, 64, kbase, EVEN_IN, vbase, EVEN_IN, nkeys, 0.125f, sc, qs, a0, a1);
    attn_row(q + 64, 64, kbase + 64, EVEN_IN, vbase, EVEN_IN, nkeys, 0.125f, sc, qs, b0, b1);
    float o0 = a0 - lam * b0, o1 = a1 - lam * b1;
    float ss = wsum(o0 * o0 + o1 * o1); const float r = rsqrtf(ss * (1.0f / 128) + EPS) * 0.8f;
    o0 = o0 * r * sm(p, SM_SUBLN)[2 * lane]; o1 = o1 * r * sm(p, SM_SUBLN)[2 * lane + 1];
    *(unsigned*)(cat + (size_t)t * D + 512 + h * 128 + 2 * lane) = pack2(o0, o1);
  }
}
DEVI void n_gmlp(const Params& p, unsigned char* smem) {
  const int tid = ltid(), wid = tid >> 6, lane = tid & 63;
  bf16_t* lv = (bf16_t*)smem;
  const bf16_t* proj = wsp<bf16_t>(p, OFF_PROJ); bf16_t* cat = wsp<bf16_t>(p, OFF_ACT);
  for (int ch = blockIdx.x; ch < T / 128; ch += gridDim.x) {
    __syncthreads();
    for (int r = wid; r < 128; r += 8) { const bf16_t* vr = proj + (size_t)(ch * 128 + r) * EVEN_IN + 512;
      float v[8]; float s = 0.f;
#pragma unroll
      for (int i = 0; i < 8; ++i) { v[i] = bf2f(vr[i * 64 + lane]); s += v[i]; }
      s = wsum(s); const float mu = s * (1.0f / 512); float q = 0.f;
#pragma unroll
      for (int i = 0; i < 8; ++i) { const float d = v[i] - mu; q += d * d; }
      q = wsum(q); const float rstd = rsqrtf(q * (1.0f / 512) + EPS);
#pragma unroll
      for (int i = 0; i < 8; ++i) { const int c = i * 64 + lane; lv[r * 512 + c] = f2bf((v[i] - mu) * rstd * sm(p, SM_ALNG)[c] + sm(p, SM_ALNB)[c]); } }
    __syncthreads();
    const int c = tid, g = c >> 7;
    const float* wsg = sm(p, SM_AWSF) + (size_t)g * 128 * 128;
    for (int pp = 0; pp < 128; ++pp) { float acc = 0.f; const float* wr = wsg + pp * 128;
      for (int q = 0; q < 128; ++q) acc += wr[q] * bf2f(lv[q * 512 + c]);
      acc += sm(p, SM_ABS)[g * 128 + pp];
      const size_t t = (size_t)ch * 128 + pp; const float u = bf2f(proj[t * EVEN_IN + c]);
      cat[t * D + c] = f2bf(u * acc); }
  }
}
template <int LAYER> DEVI void n_outproj(const Params& p) {
  const bf16_t* cat = wsp<bf16_t>(p, OFF_ACT); const bf16_t* w = wsp<bf16_t>(p, LAYER == 0 ? OFF_WOUT0T : OFF_WOUT1T);
  auto st1 = [&](int r, int n, float v) { const int b = r / SB, j = r - b * SB; if (LAYER == 1 && j < NC) return;
    const float* res = LAYER == 0 ? in_row(p, r) : (const float*)hid_row(p, r); float* dst = hid_row(p, r);
    dst[n] = res[n] + modv(p, LAYER, r, 2)[n] * v; };
  ngemm(T / 32, D / 32, D, [&](int r) { return cat + (size_t)r * D; }, [&](int n) { return w + (size_t)n * D; },
        [&](int r, int n0, int n1, float v0, float v1) { st1(r, n0, v0); st1(r, n1, v1); });
}

struct LCfg { int l, npb, j0, nph; };
DEVI int act_tok(const LCfg& c, int half, int tl) { const int bl = tl / c.npb, jj = tl - bl * c.npb; return (half * 8 + bl) * SB + c.j0 + jj; }
DEVI void stage_router(const Params& p, const LCfg c, unsigned char* smem) {
  const int wid = ltid() >> 6, lane = ltid() & 63, fr = lane & 15, fq = lane >> 4;
  float* lgs = (float*)smem + wid * 4096;
  int* ksl = (int*)lgs + 2048;
  const float* g = sm(p, SM_N2G + c.l * D); bf16_t* act = wsp<bf16_t>(p, OFF_ACT);
  const bf16_t* wrt = wsp<bf16_t>(p, OFF_WRT) + (size_t)c.l * NE * D; const float bias = sm(p, SM_MBIAS)[c.l * NE + lane];
  int* cnt = (int*)(p.ws + OFF_CNT) + c.l * 128; int* list = wsp<int>(p, OFF_LIST); float* topw = wsp<float>(p, OFF_TOPW);
  const int nact = c.nph, nwv = gridDim.x * 8, chunk0 = (nact + nwv - 1) / nwv, chunk = chunk0 < 32 ? chunk0 : 32;
  const bool agg = (nact == nwv * chunk);
  LAS int* blk = (LAS int*)((LAS unsigned char*)smem + 131072); LAS int* blkb = blk + 64;
  if (agg) {
    if (ltid() < 64) blk[ltid()] = 0;
    const u32x4* src = (const u32x4*)wrt;
    for (int i = ltid(); i < NE * 128; i += 512) { const int row = i >> 7, ch = i & 127; *(LAS u32x4*)((LAS unsigned char*)smem + row * 2048 + ((ch ^ (row & 7)) << 4)) = src[i]; }
    __syncthreads(); }
  for (int ga0 = (blockIdx.x * 8 + wid) * chunk; ga0 < nact; ga0 += nwv * chunk) {
    const int ntk = (nact - ga0) < chunk ? (nact - ga0) : chunk;
    f32x4 gg[4], s1v[4], s0v[4]; int curb = -1;
#pragma unroll
    for (int i = 0; i < 4; ++i) gg[i] = *(const f32x4*)(g + (i * 64 + lane) * 4);
    for (int j0 = 0; j0 < ntk; j0 += 3) {
      f32x4 v[3][4]; int tt[3];
#pragma unroll
      for (int u = 0; u < 3; ++u) { int j = j0 + u; j = j < ntk ? j : ntk - 1; const int ga = ga0 + j, half = ga / c.nph, tl = ga - half * c.nph; tt[u] = act_tok(c, half, tl);
        const bf16_t* row = wsp<bf16_t>(p, OFF_HB) + (size_t)tt[u] * D;
#pragma unroll
        for (int i = 0; i < 4; ++i) v[u][i] = bf4(*(const u32x2*)(row + (i * 64 + lane) * 4)); }
#pragma unroll
      for (int u = 0; u < 3; ++u) { float ss = 0.f;
#pragma unroll
        for (int i = 0; i < 4; ++i) ss += v[u][i][0] * v[u][i][0] + v[u][i][1] * v[u][i][1] + v[u][i][2] * v[u][i][2] + v[u][i][3] * v[u][i][3];
        const float rstd = rsqrtf(wsum_dpp(ss) * (1.0f / D) + EPS);
        const int bt = tt[u] / SB, jt = tt[u] - bt * SB, mrow = jt < NC ? 16 : bt;
        if (mrow != curb) { curb = mrow; const float* sh = modv(p, c.l, tt[u], 3); const float* sc = modv(p, c.l, tt[u], 4);
#pragma unroll
          for (int i = 0; i < 4; ++i) { s0v[i] = *(const f32x4*)(sh + (i * 64 + lane) * 4); s1v[i] = *(const f32x4*)(sc + (i * 64 + lane) * 4); } }
        if (j0 + u < ntk) {
#pragma unroll
          for (int i = 0; i < 4; ++i) { const int cc = (i * 64 + lane) * 4;
            float y[4];
#pragma unroll
            for (int q = 0; q < 4; ++q) y[q] = v[u][i][q] * rstd * gg[i][q] * (1.0f + s1v[i][q]) + s0v[i][q];
            u32x2 w; w.x = pack2(y[0], y[1]); w.y = pack2(y[2], y[3]);
            *(u32x2*)(act + (size_t)tt[u] * D + cc) = w;
            const float xs = (float)(1 << X_SHIFT); int w8 = 0;
            w8 = __builtin_amdgcn_cvt_pk_fp8_f32(__builtin_amdgcn_fmed3f(y[0] * xs, -440.f, 440.f), __builtin_amdgcn_fmed3f(y[1] * xs, -440.f, 440.f), w8, false);
            w8 = __builtin_amdgcn_cvt_pk_fp8_f32(__builtin_amdgcn_fmed3f(y[2] * xs, -440.f, 440.f), __builtin_amdgcn_fmed3f(y[3] * xs, -440.f, 440.f), w8, true);
            *(int*)(p.ws + OFF_ACT8 + (size_t)tt[u] * D + cc) = w8; } }
      }
    }
    asm volatile("s_waitcnt vmcnt(0)" ::: "memory");
    const bf16_t* ar[2];
#pragma unroll
    for (int m = 0; m < 2; ++m) { int jj = m * 16 + fr; jj = jj < ntk ? jj : 0; const int ga = ga0 + jj, half = ga / c.nph, tl = ga - half * c.nph; ar[m] = act + (size_t)act_tok(c, half, tl) * D + fq * 8; }
    const bf16_t* br = wrt + (size_t)fr * D + fq * 8;
    f32x4 acc[2][4];
#pragma unroll
    for (int m = 0; m < 2; ++m)
#pragma unroll
      for (int n = 0; n < 4; ++n) acc[m][n] = (f32x4){0.f, 0.f, 0.f, 0.f};
    if (agg) {
      const LAS unsigned char* bl = (const LAS unsigned char*)smem + fr * 2048; const int sw = fr & 7;
#pragma unroll 8
      for (int k0 = 0; k0 < D; k0 += 32) {
        bf16x8 af[2], bfr[4];
#pragma unroll
        for (int m = 0; m < 2; ++m) af[m] = *(const bf16x8*)(ar[m] + k0);
#pragma unroll
        for (int n = 0; n < 4; ++n) bfr[n] = *(const LAS bf16x8*)(bl + n * 32768 + ((((k0 >> 3) + fq) ^ sw) << 4));
#pragma unroll
        for (int m = 0; m < 2; ++m)
#pragma unroll
          for (int n = 0; n < 4; ++n) acc[m][n] = __builtin_amdgcn_mfma_f32_16x16x32_bf16(af[m], bfr[n], acc[m][n], 0, 0, 0);
      }
      __syncthreads();
    } else {
#pragma unroll 4
    for (int k0 = 0; k0 < D; k0 += 32) {
      bf16x8 af[2], bfr[4];
#pragma unroll
      for (int m = 0; m < 2; ++m) af[m] = *(const bf16x8*)(ar[m] + k0);
#pragma unroll
      for (int n = 0; n < 4; ++n) bfr[n] = *(const bf16x8*)(br + (size_t)(16 * n) * D + k0);
#pragma unroll
      for (int m = 0; m < 2; ++m)
#pragma unroll
        for (int n = 0; n < 4; ++n) acc[m][n] = __builtin_amdgcn_mfma_f32_16x16x32_bf16(af[m], bfr[n], acc[m][n], 0, 0, 0);
    }
    }
    __builtin_amdgcn_wave_barrier();
#pragma unroll
    for (int m = 0; m < 2; ++m)
#pragma unroll
      for (int n = 0; n < 4; ++n)
#pragma unroll
        for (int r = 0; r < 4; ++r) lgs[(m * 16 + 4 * fq + r) * 64 + 16 * n + fr] = acc[m][n][r];
    __builtin_amdgcn_fence(__ATOMIC_RELEASE, "wavefront"); __builtin_amdgcn_wave_barrier();
    const int half0 = ga0 / c.nph, half1 = (ga0 + ntk - 1) / c.nph;
    unsigned cm0 = 0u, cm1 = 0u;
    for (int j0 = 0; j0 < ntk; j0 += 3) {
      float wq[3]; int kq[3];
#pragma unroll
      for (int u = 0; u < 3; ++u) { const int j = (j0 + u) < ntk ? (j0 + u) : j0;
        const float lg = ((volatile float*)lgs)[j * 64 + lane];
        const float score = __builtin_amdgcn_rcpf(1.0f + __expf(-lg)); const float sel = score + bias;
        const float m1 = max8_dpp(sel);
        const unsigned long long isb = __ballot(sel == m1); const int gbase = lane & ~7; const unsigned gm = (unsigned)((isb >> gbase) & 0xffull);
        const int first = gbase + __builtin_ctz(gm);
        const float m2 = max8_dpp((lane == first) ? -INFINITY : sel);
        const float gs = m1 + m2; const int gi = lane >> 3; int grank = 0;
#pragma unroll
        for (int g2 = 0; g2 < 8; ++g2) { const float og = rlane(gs, g2 * 8); grank += (og > gs || (og == gs && g2 < gi)) ? 1 : 0; }
        float cur = grank < 4 ? sel : -INFINITY;
        int myk = -1; float wsumv = 0.f;
#pragma unroll
        for (int kk = 0; kk < TOPK; ++kk) { const float mxv = wmax_dpp(cur); const unsigned long long bm = __ballot(cur == mxv); const int win = __builtin_ctzll(bm);
          if (lane == win) { myk = kk; cur = -INFINITY; } wsumv += rlane(score, win); }
        wq[u] = score * __builtin_amdgcn_rcpf(wsumv) * 2.5f; kq[u] = myk; }
#pragma unroll
      for (int u = 0; u < 3; ++u) { const int j = j0 + u;
        if (j < ntk) { ((volatile float*)lgs)[j * 64 + lane] = wq[u]; ((volatile int*)ksl)[j * 64 + lane] = kq[u];
          const bool inh0 = (ga0 + j) / c.nph == half0;
          if (kq[u] >= 0) { if (inh0) cm0 |= 1u << j; else cm1 |= 1u << j; } } }
    }
    int base0 = 0, base1 = 0;
    if (agg) {
      const int n0 = __builtin_popcount(cm0); int wb = 0;
      if (n0) wb = __atomic_fetch_add(&blk[lane], n0, __ATOMIC_RELAXED);
      __syncthreads();
      if (wid == 0) { const int tot = blk[lane]; int gb = 0; if (tot) gb = atomicAdd(&cnt[half0 * 64 + lane], tot); blkb[lane] = gb; }
      __syncthreads();
      base0 = blkb[lane] + wb;
    } else {
      if (cm0) base0 = atomicAdd(&cnt[half0 * 64 + lane], __builtin_popcount(cm0));
      if (cm1) base1 = atomicAdd(&cnt[half1 * 64 + lane], __builtin_popcount(cm1));
    }
    for (int j = 0; j < ntk; ++j) {
      const int myk = ((volatile int*)ksl)[j * 64 + lane];
      if (myk >= 0) { const int ga = ga0 + j, half = ga / c.nph, tl = ga - half * c.nph; const unsigned below = (1u << j) - 1u;
        const int pos = half == half0 ? base0 + __builtin_popcount(cm0 & below) : base1 + __builtin_popcount(cm1 & below);
        list[((size_t)(half * 64 + lane)) * LCAP + pos] = tl * 6 + myk; topw[(size_t)ga * 6 + myk] = ((volatile float*)lgs)[j * 64 + lane]; wsp<int>(p, OFF_TOPP)[(size_t)ga * 6 + myk] = (lane << 24) | pos; }
    }
    __builtin_amdgcn_wave_barrier();
  }
}

DEVI void n_moe_gu(const Params& p, const LCfg c, int half) {
  const bf16_t* act = wsp<bf16_t>(p, OFF_ACT); bf16_t* hid = wsp<bf16_t>(p, OFF_HID);
  const int* cnt = (const int*)(p.ws + OFF_CNT) + c.l * 128 + half * 64; const int* list = wsp<int>(p, OFF_LIST) + (size_t)half * 64 * LCAP;
  int off = 0;
  for (int e = 0; e <= NE; ++e) {
    const int n = e < NE ? cnt[e] : c.nph;
    const bf16_t* w = e < NE ? wsp<bf16_t>(p, OFF_EGU) + (size_t)e * 512 * D : wsp<bf16_t>(p, OFF_SHGU) + (size_t)c.l * 512 * D;
    const int* le = list + (size_t)e * LCAP;
    ngemm((n + 31) / 32, DE / 16, D,
          [&](int r) -> const bf16_t* { if (r >= n) return nullptr; const int tl = e < NE ? le[r] / 6 : r; return act + (size_t)act_tok(c, half, tl) * D; },
          [&](int nn) { const int tn = nn >> 5, i = (nn >> 4) & 1, fr = nn & 15; return w + (size_t)(i * 256 + tn * 16 + fr) * D; },
          [&](int r, int n0, int n1, float v0, float v1) { if (r < n) hid[(size_t)(off + r) * DE + (n0 >> 5) * 16 + (n0 & 15)] = f2bf(silu(v0) * v1); });
    off += n;
  }
}
DEVI void n_moe_down(const Params& p, const LCfg c, int half) {
  const bf16_t* hid = wsp<bf16_t>(p, OFF_HID); bf16_t* slot = wsp<bf16_t>(p, OFF_SLOT);
  const int* cnt = (const int*)(p.ws + OFF_CNT) + c.l * 128 + half * 64; const int* list = wsp<int>(p, OFF_LIST) + (size_t)half * 64 * LCAP;
  int off = 0;
  for (int e = 0; e <= NE; ++e) {
    const int n = e < NE ? cnt[e] : c.nph;
    const bf16_t* w = e < NE ? wsp<bf16_t>(p, OFF_ED) + (size_t)e * D * DE : wsp<bf16_t>(p, OFF_SHD) + (size_t)c.l * D * DE;
    const int* le = list + (size_t)e * LCAP;
    auto st1 = [&](int r, int nn, float v) { if (r >= n) return;
      if (e < NE) slot[(size_t)le[r] * D + nn] = f2bf(v);
      else { const int t = act_tok(c, half, r); float* h = hid_row(p, t); h[nn] += modv(p, c.l, t, 5)[nn] * v; } };
    ngemm((n + 31) / 32, D / 32, DE,
          [&](int r) -> const bf16_t* { return r < n ? hid + (size_t)(off + r) * DE : nullptr; },
          [&](int nn) { return w + (size_t)nn * DE; },
          [&](int r, int n0, int n1, float v0, float v1) { st1(r, n0, v0); st1(r, n1, v1); });
    off += n;
  }
}
template <bool FUSE_NORM1> DEVI void stage_combine(const Params& p, const LCfg c, int half, unsigned char* smem, float dscale = 1.0f) {
  const int wid = ltid() >> 6, lane = ltid() & 63;
  int* off = (int*)smem;
  __syncthreads();
  if (ltid() == 0) { const int* cnt = (const int*)(p.ws + OFF_CNT) + c.l * 128 + half * 64; int o = 0; for (int e = 0; e < NE; ++e) { off[e] = o; o += cnt[e]; } off[NE] = o; }
  __syncthreads();
  const unsigned char* slot = p.ws + OFF_SLOT; const float* topw = wsp<float>(p, OFF_TOPW); const int* topp = wsp<int>(p, OFF_TOPP);
  for (int tl = blockIdx.x * 8 + wid; tl < c.nph; tl += gridDim.x * 8) {
    const int t = act_tok(c, half, tl); bf16_t* h = wsp<bf16_t>(p, OFF_HB) + (size_t)t * D; const float* g5 = modv(p, c.l, t, 5);
    float* orow = p.out + ((size_t)((t / SB) * S + (t % SB) - NC)) * D;
    const float* w = topw + ((size_t)(half * c.nph + tl)) * 6; const int* pp = topp + ((size_t)(half * c.nph + tl)) * 6;
    float wk[7]; size_t ro[7];
#pragma unroll
    for (int k = 0; k < 6; ++k) { wk[k] = w[k]; const int q = pp[k]; ro[k] = (size_t)(off[q >> 24] + (q & 0xffffff)) * D; }
    wk[6] = 1.0f; ro[6] = (size_t)(off[NE] + tl) * D;
    unsigned sv[4][7]; f32x4 hv[4];
#pragma unroll
    for (int i = 0; i < 4; ++i) { const int cc = (i * 64 + lane) * 4; hv[i] = bf4(*(const u32x2*)(h + cc));
#pragma unroll
      for (int k = 0; k < 7; ++k) sv[i][k] = *(const unsigned*)(slot + ro[k] + cc); }
#pragma unroll
    for (int i = 0; i < 4; ++i) { const int cc = (i * 64 + lane) * 4; f32x4 acc = {0.f, 0.f, 0.f, 0.f};
#pragma unroll
      for (int k = 0; k < 7; ++k) { const auto lo = __builtin_amdgcn_cvt_pk_f32_fp8((int)sv[i][k], false); const auto hi = __builtin_amdgcn_cvt_pk_f32_fp8((int)sv[i][k], true);
        acc[0] += wk[k] * lo[0]; acc[1] += wk[k] * lo[1]; acc[2] += wk[k] * hi[0]; acc[3] += wk[k] * hi[1]; }
      const f32x4 gg = *(const f32x4*)(g5 + cc);
#pragma unroll
      for (int q = 0; q < 4; ++q) hv[i][q] += gg[q] * acc[q] * dscale;
      if (FUSE_NORM1) { u32x2 w; w.x = pack2(hv[i][0], hv[i][1]); w.y = pack2(hv[i][2], hv[i][3]); *(u32x2*)(h + cc) = w; }
      else *(f32x4*)(orow + cc) = hv[i]; }
    if (FUSE_NORM1) {
      float ss = 0.f;
#pragma unroll
      for (int i = 0; i < 4; ++i) ss += hv[i][0] * hv[i][0] + hv[i][1] * hv[i][1] + hv[i][2] * hv[i][2] + hv[i][3] * hv[i][3];
      const float rstd = rsqrtf(wsum_dpp(ss) * (1.0f / D) + EPS);
      const float* g1 = sm(p, SM_N1G + (c.l + 1) * D); const float* sh = modv(p, c.l + 1, t, 0); const float* sc = modv(p, c.l + 1, t, 1);
      bf16_t* act = wsp<bf16_t>(p, OFF_ACT);
#pragma unroll
      for (int i = 0; i < 4; ++i) { const int cc = (i * 64 + lane) * 4; const f32x4 gg = *(const f32x4*)(g1 + cc), s1 = *(const f32x4*)(sc + cc), s0 = *(const f32x4*)(sh + cc);
        float y[4];
#pragma unroll
        for (int q = 0; q < 4; ++q) y[q] = hv[i][q] * rstd * gg[q] * (1.0f + s1[q]) + s0[q];
        if (IN1_FP8) { const float xs = (float)(1 << X_SHIFT); int w8 = 0;
          w8 = __builtin_amdgcn_cvt_pk_fp8_f32(__builtin_amdgcn_fmed3f(y[0] * xs, -440.f, 440.f), __builtin_amdgcn_fmed3f(y[1] * xs, -440.f, 440.f), w8, false);
          w8 = __builtin_amdgcn_cvt_pk_fp8_f32(__builtin_amdgcn_fmed3f(y[2] * xs, -440.f, 440.f), __builtin_amdgcn_fmed3f(y[3] * xs, -440.f, 440.f), w8, true);
          *(int*)(p.ws + OFF_ACT8 + (size_t)t * D + cc) = w8; }
        else { u32x2 w; w.x = pack2(y[0], y[1]); w.y = pack2(y[2], y[3]);
          *(u32x2*)(act + (size_t)t * D + cc) = w; } }
    }
  }
}

DEVI void n_inproj1(const Params& p) {
  const bf16_t* act = wsp<bf16_t>(p, OFF_ACT); const bf16_t* w = wsp<bf16_t>(p, OFF_WQKV1T); bf16_t* proj = wsp<bf16_t>(p, OFF_PROJ);
  ngemm(T / 32, ODD_IN / 32, D, [&](int r) { return act + (size_t)r * D; }, [&](int n) { return w + (size_t)n * D; },
        [&](int r, int n0, int n1, float v0, float v1) { proj[(size_t)r * ODD_IN + n0] = f2bf(v0); proj[(size_t)r * ODD_IN + n1] = f2bf(v1); });
}
DEVI void n_post1(const Params& p) {
  const int wid = ltid() >> 6, lane = ltid() & 63;
  bf16_t* proj = wsp<bf16_t>(p, OFF_PROJ); const float2* t128 = wsp<float2>(p, OFF_TAB128);
  for (int t = blockIdx.x * 8 + wid; t < T; t += gridDim.x * 8) {
    bf16_t* row = proj + (size_t)t * ODD_IN; const int b = t / SB, j = t - b * SB;
    for (int hh = 0; hh < 10; ++hh) {
      unsigned* pp = (unsigned*)(row + hh * 128 + 2 * lane); const unsigned u = *pp;
      float x1 = __uint_as_float(u << 16), x2 = __uint_as_float(u & 0xffff0000u);
      const float ss = wsum(x1 * x1 + x2 * x2); const float r = rsqrtf(ss * (1.0f / 128) + EPS);
      const float* g = sm(p, hh < 8 ? SM_CQN : SM_CKN);
      x1 = x1 * r * g[2 * lane]; x2 = x2 * r * g[2 * lane + 1];
      if (j >= NC) { const int pos = j - NC; const int ps = lane < 32 ? (pos >> 6) : (pos & 63); const float2 cs = t128[ps * 32 + (lane & 31)];
        const float y1 = x1 * cs.x - x2 * cs.y, y2 = x1 * cs.y + x2 * cs.x; x1 = y1; x2 = y2; }
      *pp = pack2(x1, x2);
    }
  }
}
DEVI void n_attn1(const Params& p, unsigned char* smem) {
  const int wid = ltid() >> 6, lane = ltid() & 63;
  volatile float* sc = (volatile float*)(smem + wid * (2304 * 4 + 512)); volatile float* qs = sc + 2304;
  const bf16_t* proj = wsp<bf16_t>(p, OFF_PROJ); bf16_t* att = wsp<bf16_t>(p, OFF_ACT);
  for (int task = blockIdx.x * 8 + wid; task < TX * 8; task += gridDim.x * 8) {
    const int tx = task >> 3, h = task & 7, b = tx / S, i = tx - b * S, t = b * SB + NC + i, kvh = h >> 2;
    const bf16_t* kbase = proj + (size_t)(b * SB) * ODD_IN + 1024 + kvh * 128; const bf16_t* vbase = kbase + 256;
    float o0, o1;
    attn_row(proj + (size_t)t * ODD_IN + h * 128, 128, kbase, ODD_IN, vbase, ODD_IN, SB, 0.08838834764831845f, sc, qs, o0, o1);
    *(unsigned*)(att + (size_t)t * D + h * 128 + 2 * lane) = pack2(o0, o1);
  }
}

namespace fg {
constexpr int BM = 256, BK = 64, HALF = 128, HTB = HALF * BK * 2, STAGE_BYTES = 8 * HTB;
constexpr int LDS_XCH = STAGE_BYTES, LDS_TAB = STAGE_BYTES + 4096, LDS_ROPE = STAGE_BYTES + 6144, LDS_GAIN = LDS_ROPE + 16384;
DEVI int lds_byte(int r, int c) { const int st = (r >> 4) * 2 + (c >> 5), rr = r & 15, cc = c & 31, ob = rr * 64 + cc * 2; return st * 1024 + (ob ^ (((ob >> 9) & 1) << 5)); }
DEVI void stage_rc(int b, int& R, int& C) { const int st = b / 1024, sb = b % 1024, swz = sb ^ (((sb >> 9) & 1) << 5); R = (st >> 1) * 16 + swz / 64; C = (st & 1) * 32 + (swz % 64) / 2; }
DEVI int perm32(int rho) { const int n = rho >> 4, i = rho & 15; return 8 * (i >> 2) + 4 * n + (i & 3); }
DEVI unsigned cvt_pk_bf16(float lo, float hi) { unsigned r; asm volatile("v_cvt_pk_bf16_f32 %0, %1, %2" : "=v"(r) : "v"(lo), "v"(hi)); return r; }
typedef float f32x2 __attribute__((ext_vector_type(2)));
DEVI f32x2 gelu_pk(f32x2 v) {
  const f32x2 av = __builtin_elementwise_abs(v), d = av * 0.2316418882f + 1.0f;
  f32x2 t; t.x = __builtin_amdgcn_rcpf(d.x); t.y = __builtin_amdgcn_rcpf(d.y);
  f32x2 q = t * 0.5307027145f + (-0.7265760135f); q = q * t + 0.7107068705f; q = q * t + (-0.142248368f); q = q * t + 0.127414796f; q = q * t;
  const f32x2 s = (v * v) * (-0.72134752044f);
  f32x2 e; e.x = __builtin_amdgcn_exp2f(s.x); e.y = __builtin_amdgcn_exp2f(s.y);
  const f32x2 m = v * (q * e), r = v - m;
  f32x2 o; o.x = v.x < 0.f ? m.x : r.x; o.y = v.y < 0.f ? m.y : r.y; return o;
}
struct Unit { const char* A; const char* B0; const char* B1; int pm, pn, e, cnt, off; };
typedef f32x4 Acc[2][2][4][2];
typedef int v8i_t __attribute__((ext_vector_type(8)));
template <int K> DEVI unsigned boff_m1(int R, int C) { return (unsigned)((64 * (R >> 5) + perm32(R & 31)) * K + C) * 2u; }
template <int K> DEVI unsigned boff_m2(int R, int C) { return (unsigned)(((R & ~31) + perm32(R & 31)) * K + C) * 2u; }

template <class Job>
DEVI void gemm_phase(LAS unsigned char* lds, Job& J) {
  constexpr int K = Job::K, nt = K / BK;
  const int tid = ltid(), wid = __builtin_amdgcn_readfirstlane(tid >> 6), lane = tid & 63, wr = wid >> 2, wc = wid & 3, fr = lane & 15, fq = lane >> 4;
  int Rr[2], Cc[2];
#pragma unroll
  for (int i = 0; i < 2; ++i) stage_rc(tid * 16 + i * 8192, Rr[i], Cc[i]);
  unsigned voffB[2];
#pragma unroll
  for (int i = 0; i < 2; ++i) voffB[i] = J.boff(Rr[i], Cc[i]);
  unsigned cv[2][2]; unsigned nv[2][2];
  constexpr size_t AH = Job::GATHER ? 0 : (size_t)HALF * K * 2;
#define CV1 cv[Job::GATHER ? 1 : 0]
  constexpr size_t kstep = (size_t)(BK * 2);
  const unsigned ldsw = (unsigned)wid * 1024u;
  const int aoff = lds_byte(wr * 64 + fr, fq * 8), boff = lds_byte(wc * 32 + fr, fq * 8);
  LAS unsigned char* abase = lds + aoff; LAS unsigned char* bbase = lds + 4 * HTB + boff;
  asm volatile("" : "+v"(abase), "+v"(bbase));
#define FG_SA(b, h) (((b) * 2 + (h)) * HTB)
#define FG_SB(b, h) ((4 + (b) * 2 + (h)) * HTB)
#define FG_STAGE(bufoff, gbase, voff) do { _Pragma("unroll") for (int _i = 0; _i < 2; ++_i) { \
    const unsigned _la = (unsigned)(uintptr_t)(lds + ldsw) + (unsigned)((bufoff) + _i * 8192); const char* _gb = (const char*)(gbase); \
    asm volatile("s_mov_b32 m0, %0\n\ts_nop 0\n\tglobal_load_lds_dwordx4 %1, %2" :: "s"(_la), "v"((voff)[_i]), "s"(_gb) : "memory", "m0"); } } while (0)
#define FG_LDA(dst, b, h) do { _Pragma("unroll") for (int m = 0; m < 4; ++m) _Pragma("unroll") for (int k = 0; k < 2; ++k) dst[m][k] = *(const LAS bf16x8*)(abase + (FG_SA(b, h) + m * 2048 + k * 1024)); } while (0)
#define FG_LDB(dst, b, h) do { _Pragma("unroll") for (int n = 0; n < 2; ++n) _Pragma("unroll") for (int k = 0; k < 2; ++k) dst[n][k] = *(const LAS bf16x8*)(bbase + (FG_SB(b, h) - 4 * HTB + n * 2048 + k * 1024)); } while (0)
#define FG_MMA(ai, bj, At, Bt) do { __builtin_amdgcn_s_setprio(1); _Pragma("unroll") for (int m = 0; m < 4; ++m) _Pragma("unroll") for (int n = 0; n < 2; ++n) _Pragma("unroll") for (int k = 0; k < 2; ++k) \
    acc[ai][bj][m][n] = __builtin_amdgcn_mfma_f32_16x16x32_bf16(Bt[n][k], At[m][k], acc[ai][bj][m][n], 0, 0, 0); __builtin_amdgcn_s_setprio(0); } while (0)
#define FG_MMA8(ai, bj, At, Bt) do { __builtin_amdgcn_s_setprio(1); _Pragma("unroll") for (int m = 0; m < 4; ++m) _Pragma("unroll") for (int n = 0; n < 2; ++n) { \
      v8i_t _b, _a; { const u32x4 b0 = *(const u32x4*)&Bt[n][0], b1 = *(const u32x4*)&Bt[n][1], a0 = *(const u32x4*)&At[m][0], a1 = *(const u32x4*)&At[m][1]; \
        _b = (v8i_t){(int)b0[0], (int)b0[1], (int)b0[2], (int)b0[3], (int)b1[0], (int)b1[1], (int)b1[2], (int)b1[3]}; _a = (v8i_t){(int)a0[0], (int)a0[1], (int)a0[2], (int)a0[3], (int)a1[0], (int)a1[1], (int)a1[2], (int)a1[3]}; } \
      acc[ai][bj][m][n] = __builtin_amdgcn_mfma_scale_f32_16x16x128_f8f6f4(_b, _a, acc[ai][bj][m][n], 0, 0, 0, Job::SCALE, 0, Job::SCALE); } __builtin_amdgcn_s_setprio(0); } while (0)
#define FG_WAIT_V(n) asm volatile("s_waitcnt vmcnt(" #n ")" ::: "memory")
#define FG_WAIT_L(n) asm volatile("s_waitcnt lgkmcnt(" #n ")" ::: "memory")
#define FG_MM(ai, bj, At, Bt) do { if constexpr (Job::FP8) FG_MMA8(ai, bj, At, Bt); else FG_MMA(ai, bj, At, Bt); } while (0)
#define FG_BAR __builtin_amdgcn_s_barrier()
#define FG_SCHED __builtin_amdgcn_sched_barrier(0)
  Unit cur, nxt;
  if (!J.next(cur)) return;
  Acc acc;
#pragma unroll
  for (int a = 0; a < 2; ++a)
#pragma unroll
    for (int b = 0; b < 2; ++b)
#pragma unroll
      for (int m = 0; m < 4; ++m)
#pragma unroll
        for (int n = 0; n < 2; ++n) acc[a][b][m][n] = (f32x4){0.f, 0.f, 0.f, 0.f};
  bf16x8 At[4][2], B0[2][2], B1[2][2];
  J.aoffs(cur, Rr, Cc, cv);
  asm volatile("s_waitcnt vmcnt(0)" ::: "memory");
  FG_STAGE(FG_SB(0, 0), cur.B0, voffB); FG_STAGE(FG_SA(0, 0), cur.A, cv[0]); FG_STAGE(FG_SB(0, 1), cur.B1, voffB); FG_STAGE(FG_SA(0, 1), cur.A + AH, CV1);
  if (wr == 1) FG_BAR;
  FG_WAIT_V(4); FG_BAR;
  FG_STAGE(FG_SB(1, 0), cur.B0 + kstep, voffB); FG_STAGE(FG_SA(1, 0), cur.A + kstep, cv[0]); FG_STAGE(FG_SB(1, 1), cur.B1 + kstep, voffB);
  FG_WAIT_V(6); FG_BAR;
  for (;;) {
    const bool has_next = J.next(nxt);
    const char* nA = has_next ? nxt.A : cur.A; const char* nB0 = has_next ? nxt.B0 : cur.B0; const char* nB1 = has_next ? nxt.B1 : cur.B1;
    for (int t = 0; t < nt; t += 2) {
      const bool last = (t == nt - 2);
      const char* a1 = cur.A + (size_t)(t + 1) * kstep;
      const char* a2 = last ? nA : cur.A + (size_t)(t + 2) * kstep;
      const char* b20 = last ? nB0 : cur.B0 + (size_t)(t + 2) * kstep; const char* b21 = last ? nB1 : cur.B1 + (size_t)(t + 2) * kstep;
      const char* a3 = a2 + kstep; const char* b30 = b20 + kstep; const char* b31 = b21 + kstep;
      asm volatile("" : "+s"(a1), "+s"(a2), "+s"(a3), "+s"(b20), "+s"(b21), "+s"(b30), "+s"(b31));
      if constexpr (Job::GATHER) { if (last && has_next) { J.aoffs(nxt, Rr, Cc, nv); asm volatile("s_waitcnt vmcnt(0)" ::: "memory"); } }
      FG_LDB(B0, 0, 0); FG_SCHED; FG_LDA(At, 0, 0); FG_STAGE(FG_SA(1, 1), a1 + AH, CV1);
      if constexpr (Job::GATHER) { if (last && has_next) { cv[0][0] = nv[0][0]; cv[0][1] = nv[0][1]; cv[1][0] = nv[1][0]; cv[1][1] = nv[1][1]; } }
      FG_WAIT_L(8); FG_BAR; FG_WAIT_L(0); FG_MM(0, 0, At, B0); FG_BAR; FG_SCHED;
      FG_LDB(B1, 0, 1); FG_STAGE(FG_SB(0, 0), b20, voffB);
      FG_BAR; FG_WAIT_L(0); FG_MM(0, 1, At, B1); FG_BAR;
      FG_LDA(At, 0, 1); FG_STAGE(FG_SA(0, 0), a2, cv[0]);
      FG_BAR; FG_WAIT_L(0); FG_MM(1, 0, At, B0); FG_BAR; FG_SCHED;
      FG_STAGE(FG_SB(0, 1), b21, voffB);
      FG_WAIT_V(6); FG_BAR; FG_MM(1, 1, At, B1); FG_BAR;
      FG_LDB(B0, 1, 0); FG_SCHED; FG_LDA(At, 1, 0); FG_STAGE(FG_SA(0, 1), a2 + AH, CV1);
      FG_WAIT_L(8); FG_BAR; FG_WAIT_L(0); FG_MM(0, 0, At, B0); FG_BAR; FG_SCHED;
      FG_LDB(B1, 1, 1); FG_STAGE(FG_SB(1, 0), b30, voffB);
      FG_BAR; FG_WAIT_L(0); FG_MM(0, 1, At, B1); FG_BAR;
      FG_LDA(At, 1, 1); FG_STAGE(FG_SA(1, 0), a3, cv[0]);
      FG_BAR; FG_WAIT_L(0); FG_MM(1, 0, At, B0); FG_BAR; FG_SCHED;
      FG_STAGE(FG_SB(1, 1), b31, voffB);
      FG_WAIT_V(6); FG_BAR; FG_MM(1, 1, At, B1); FG_BAR;
    }
    if (wr == 0) FG_BAR;
    { int l2; asm volatile("v_mbcnt_lo_u32_b32 %0, -1, 0\n\tv_mbcnt_hi_u32_b32 %0, -1, %0" : "=v"(l2));
      J.epilogue(acc, cur, wr, wc, l2 & 15, l2 >> 4, lds); }
    if (!has_next) break;
#pragma unroll
    for (int a = 0; a < 2; ++a)
#pragma unroll
      for (int b = 0; b < 2; ++b)
#pragma unroll
        for (int m = 0; m < 4; ++m)
#pragma unroll
          for (int n = 0; n < 2; ++n) acc[a][b][m][n] = (f32x4){0.f, 0.f, 0.f, 0.f};
    cur = nxt;
    if (wr == 1) FG_BAR;
  }
  FG_WAIT_V(0);
  FG_BAR;
#undef CV1
#undef FG_SA
#undef FG_SB
#undef FG_STAGE
#undef FG_LDA
#undef FG_LDB
#undef FG_MMA
#undef FG_MMA8
#undef FG_MM
#undef FG_WAIT_V
#undef FG_WAIT_L
#undef FG_BAR
#undef FG_SCHED
}

DEVI bool dense_decode(long L, int nM, int nN, int& pm, int& pn) {
  const int nwg = nM * nN; if (L >= nwg) return false;
  int wgid = (int)L; { const int q = nwg / 8, r = nwg % 8, xcd = wgid % 8, off = wgid / 8; wgid = (xcd < r ? xcd * (q + 1) : r * (q + 1) + (xcd - r) * q) + off; }
  const int nig = 8 * nN, gid = wgid / nig, fm = gid * 8, gsz = (nM - fm) < 8 ? (nM - fm) : 8;
  pm = fm + ((wgid % nig) % gsz); pn = (wgid % nig) / gsz; return true;
}
template <int K> DEVI void dense_aoffs(const int (&Rr)[2], const int (&Cc)[2], unsigned (&v)[2][2]) {
#pragma unroll
  for (int i = 0; i < 2; ++i) { v[0][i] = (unsigned)(Rr[i] * K + Cc[i]) * 2u; v[1][i] = 0u; }
}


struct Slab { LAS unsigned char* w0; LAS unsigned char* wf; LAS unsigned char* r0; };
DEVI Slab slab_init(LAS unsigned char* lds, int wid, int fr, int fq) {
  Slab s; LAS unsigned char* b = lds + 3 * HTB + wid * 1024;
  s.w0 = b + fr * 64 + fq * 16; s.wf = b + (fq >> 1) * 8192 + fr * 64 + (fq & 1) * 32; s.r0 = b + (fq * 16 + fr) * 16; return s; }
DEVI void slab_x16(const Slab& s, u32x4 a, u32x4 b, u32x4& ra, u32x4& rb) { *(LAS u32x4*)s.w0 = a; *(LAS u32x4*)(s.w0 + 8192) = b; ra = *(LAS u32x4*)s.r0; rb = *(LAS u32x4*)(s.r0 + 8192); }
DEVI void slab_x16(const Slab& s, u32x4 a, u32x4& ra) { *(LAS u32x4*)s.w0 = a; ra = *(LAS u32x4*)s.r0; }
DEVI void slab_x32(const Slab& s, f32x4 a, f32x4 b, f32x4& ra, f32x4& rb) { *(LAS f32x4*)s.wf = a; *(LAS f32x4*)(s.wf + 16) = b; ra = *(LAS f32x4*)s.r0; rb = *(LAS f32x4*)(s.r0 + 8192); }

template <int LAYER> struct JobOut {
  static constexpr int K = D; static constexpr bool GATHER = false, FP8 = false;
  const Params& p; int i, c, G;
  DEVI JobOut(const Params& p_) : p(p_), i(0), c(vbid()), G(gridDim.x) {}
  DEVI unsigned boff(int R, int C) const { return boff_m2<K>(R, C); }
  DEVI bool next(Unit& u) {
    for (;;) { int pm, pn; if (!dense_decode((long)i * G + c, T / 256, D / 256, pm, pn)) return false; ++i;
      if (LAYER == 1 && pm % 9 == 0) continue;
      u.pm = pm; u.pn = pn; u.A = (const char*)wsp<bf16_t>(p, OFF_ACT) + (size_t)pm * 256 * K * 2;
      u.B0 = (const char*)wsp<bf16_t>(p, LAYER == 0 ? OFF_WOUT0T : OFF_WOUT1T) + (size_t)(256 * pn) * K * 2; u.B1 = u.B0 + (size_t)128 * K * 2; return true; }
  }
  DEVI void aoffs(const Unit&, const int (&Rr)[2], const int (&Cc)[2], unsigned (&v)[2][2]) const { dense_aoffs<K>(Rr, Cc, v); }
  DEVI void epilogue(const Acc& acc, const Unit& u, int wr, int wc, int fr, int fq, LAS unsigned char* lds) const {
    asm volatile("" : "+v"(fr), "+v"(fq));
    const int t0 = u.pm * 256;
    const float* res = in_row(p, t0); bf16_t* dst = wsp<bf16_t>(p, OFF_HB) + (size_t)t0 * D;
    const float* gate = modv(p, LAYER, t0, 2);
    const int col0 = u.pn * 256 + wc * 32 + 8 * fq, lane = fq * 16 + fr;
    const Slab sl = slab_init(lds, wr * 4 + wc, fr, fq);
    const size_t rb = (size_t)(wr * 64 + (lane >> 2)) * D + u.pn * 256 + wc * 32 + 4 * (lane & 3);
    res += rb; dst += rb;
    asm volatile("" : "+v"(res), "+v"(dst));
    f32x4 gv[2][2];
#pragma unroll
    for (int bj = 0; bj < 2; ++bj)
#pragma unroll
      for (int n = 0; n < 2; ++n) gv[bj][n] = *(const f32x4*)(gate + col0 + bj * 128 + 4 * n);
#pragma unroll
    for (int ai = 0; ai < 2; ++ai) {
      f32x4 r4[4][2][2];
#pragma unroll
      for (int m = 0; m < 4; ++m) { const size_t ro = (size_t)(ai * 128 + m * 16) * D;
#pragma unroll
        for (int bj = 0; bj < 2; ++bj) {
          if (LAYER == 0) { r4[m][bj][0] = *(const f32x4*)(res + ro + bj * 128); r4[m][bj][1] = *(const f32x4*)(res + ro + bj * 128 + 16); }
          else { r4[m][bj][0] = bf4(*(const u32x2*)(dst + ro + bj * 128)); r4[m][bj][1] = bf4(*(const u32x2*)(dst + ro + bj * 128 + 16)); } } }
#pragma unroll
      for (int m = 0; m < 4; ++m) { const size_t ro = (size_t)(ai * 128 + m * 16) * D;
#pragma unroll
        for (int bj = 0; bj < 2; ++bj) { f32x4 x0, x1; slab_x32(sl, gv[bj][0] * acc[ai][bj][m][0], gv[bj][1] * acc[ai][bj][m][1], x0, x1);
          x0 += r4[m][bj][0]; x1 += r4[m][bj][1];
          u32x2 w0, w1; w0.x = pack2(x0[0], x0[1]); w0.y = pack2(x0[2], x0[3]); w1.x = pack2(x1[0], x1[1]); w1.y = pack2(x1[2], x1[3]);
          *(u32x2*)(dst + ro + bj * 128) = w0; *(u32x2*)(dst + ro + bj * 128 + 16) = w1; } }
      asm volatile("" ::: "memory"); }
  }
};

DEVI void load_rope_lds(const Params& p, size_t tab_off, int nrope, int gq, int gk, int ng, LAS unsigned char* lds) {
  const int tid = ltid(); __syncthreads();
  const f32x4* src = (const f32x4*)(p.ws + tab_off); LAS f32x4* dst = (LAS f32x4*)(lds + LDS_ROPE);
  for (int i = tid; i < nrope; i += 512) dst[i] = src[i];
  LAS float* g = (LAS float*)(lds + LDS_GAIN);
  if (tid < 2 * ng) g[tid] = tid < ng ? sm(p, gq)[tid] : sm(p, gk)[tid - ng];
  __syncthreads();
}
struct JobIn0 {
  static constexpr int K = IN0_FP8 ? D / 2 : D; static constexpr bool GATHER = false, FP8 = IN0_FP8;
  static constexpr int SCALE = 0x01010101 * (127 - (WQ_SHIFT + X_SHIFT) / 2);
  const Params& p; int i, c, G; int dry;
  DEVI JobIn0(const Params& p_, int dry_ = 0) : p(p_), i(0), c(vbid()), G(gridDim.x), dry(dry_) {}
  DEVI unsigned boff(int R, int C) const { return boff_m1<K>(R, C); }
  DEVI bool next(Unit& u) {
    int pm, pn; if (!dense_decode((long)i * G + c, T / 256, EVEN_IN / 256, pm, pn)) return false; ++i;
    u.pm = pm; u.pn = pn; u.A = (const char*)(p.ws + (IN0_FP8 ? OFF_ACT8 : OFF_ACT)) + (size_t)pm * 256 * K * 2;
    u.B0 = (const char*)wsp<bf16_t>(p, OFF_WIN0T) + (size_t)(256 * pn) * K * 2; u.B1 = u.B0 + (size_t)32 * K * 2; return true;
  }
  DEVI void aoffs(const Unit&, const int (&Rr)[2], const int (&Cc)[2], unsigned (&v)[2][2]) const { dense_aoffs<K>(Rr, Cc, v); }
  DEVI void epilogue(const Acc& acc, const Unit& u, int wr, int wc, int fr, int fq, LAS unsigned char* lds) const {
    asm volatile("" : "+v"(fr), "+v"(fq));
    if (dry == 1) {
#pragma unroll
      for (int ai = 0; ai < 2; ++ai)
#pragma unroll
        for (int bj = 0; bj < 2; ++bj)
#pragma unroll
          for (int m = 0; m < 4; ++m)
#pragma unroll
            for (int n = 0; n < 2; ++n) asm volatile("" :: "v"(acc[ai][bj][m][n]));
      return; }
    const int lane = fq * 16 + fr; const Slab sl = slab_init(lds, wr * 4 + wc, fr, fq);
    bf16_t* outp = wsp<bf16_t>(p, OFF_PROJ) + (size_t)(u.pm * 256 + wr * 64 + (lane >> 2)) * EVEN_IN + u.pn * 256 + wc * 64 + 8 * (lane & 3);
    asm volatile("" : "+v"(outp));
    const int pn = u.pn;
    if (pn < 4) {
#pragma unroll
      for (int ai = 0; ai < 2; ++ai)
#pragma unroll
        for (int m = 0; m < 4; ++m) {
          u32x4 wq[2];
#pragma unroll
          for (int bj = 0; bj < 2; ++bj) { const f32x4 v0 = acc[ai][bj][m][0], v1 = acc[ai][bj][m][1];
            const f32x2 a = gelu_pk((f32x2){v0[0], v0[1]}), b = gelu_pk((f32x2){v0[2], v0[3]}), c2 = gelu_pk((f32x2){v1[0], v1[1]}), d = gelu_pk((f32x2){v1[2], v1[3]});
            u32x4 w; w.x = cvt_pk_bf16(a.x, a.y); w.y = cvt_pk_bf16(b.x, b.y); w.z = cvt_pk_bf16(c2.x, c2.y); w.w = cvt_pk_bf16(d.x, d.y);
            wq[bj] = w; }
          { u32x4 ra, rb; slab_x16(sl, wq[0], wq[1], ra, rb); *(u32x4*)(outp + (size_t)(ai * 128 + m * 16) * EVEN_IN) = ra; *(u32x4*)(outp + (size_t)(ai * 128 + m * 16) * EVEN_IN + 32) = rb; } }
    } else if (pn >= 8) {
#pragma unroll
      for (int ai = 0; ai < 2; ++ai)
#pragma unroll
        for (int m = 0; m < 4; ++m) {
          u32x4 wq[2];
#pragma unroll
          for (int bj = 0; bj < 2; ++bj) { const f32x4 v0 = acc[ai][bj][m][0], v1 = acc[ai][bj][m][1];
            u32x4 w; w.x = cvt_pk_bf16(v0[0], v0[1]); w.y = cvt_pk_bf16(v0[2], v0[3]); w.z = cvt_pk_bf16(v1[0], v1[1]); w.w = cvt_pk_bf16(v1[2], v1[3]);
            wq[bj] = w; }
          { u32x4 ra, rb; slab_x16(sl, wq[0], wq[1], ra, rb); *(u32x4*)(outp + (size_t)(ai * 128 + m * 16) * EVEN_IN) = ra; *(u32x4*)(outp + (size_t)(ai * 128 + m * 16) * EVEN_IN + 32) = rb; } }
    } else {
      LAS const float* gn = (LAS const float*)(lds + LDS_GAIN) + (pn < 6 ? 0 : 64) + 8 * fq;
      f32x4 g4[2][2];
#pragma unroll
      for (int bj = 0; bj < 2; ++bj)
#pragma unroll
        for (int n = 0; n < 2; ++n) g4[bj][n] = *(LAS const f32x4*)(gn + bj * 32 + 4 * n);
      const int jt = u.pm % 9; const bool lat = jt != 0;
      LAS const f32x4* t64 = (LAS const f32x4*)(lds + LDS_ROPE);
#pragma unroll
      for (int ai = 0; ai < 2; ++ai)
#pragma unroll
        for (int m = 0; m < 4; ++m) {
          f32x4 cs[2][2];
          if (lat) { const int il = (jt - 1) * 256 + ai * 128 + wr * 64 + m * 16 + fr; const int prow = il >> 6, pcol = il & 63;
#pragma unroll
            for (int bj = 0; bj < 2; ++bj)
#pragma unroll
              for (int n = 0; n < 2; ++n) cs[bj][n] = t64[(bj ? pcol : prow) * 8 + 2 * fq + n]; }
          float ss = 0.f;
#pragma unroll
          for (int bj = 0; bj < 2; ++bj)
#pragma unroll
            for (int n = 0; n < 2; ++n) { const f32x4 x = acc[ai][bj][m][n]; ss += (x[0] * x[0] + x[1] * x[1]) + (x[2] * x[2] + x[3] * x[3]); }
          ss += shx<16>(ss); ss = sum32x(ss);
          const float rstd = rsqrtf(ss * (1.0f / 64) + EPS);
          u32x4 wq[2];
#pragma unroll
          for (int bj = 0; bj < 2; ++bj) { f32x4 y[2];
#pragma unroll
            for (int n = 0; n < 2; ++n) { f32x4 x = acc[ai][bj][m][n] * rstd * g4[bj][n];
              if (lat) { const f32x4 c4 = cs[bj][n]; x = (f32x4){x[0] * c4[0] - x[1] * c4[1], x[0] * c4[1] + x[1] * c4[0], x[2] * c4[2] - x[3] * c4[3], x[2] * c4[3] + x[3] * c4[2]}; }
              y[n] = x; }
            u32x4 w; w.x = cvt_pk_bf16(y[0][0], y[0][1]); w.y = cvt_pk_bf16(y[0][2], y[0][3]); w.z = cvt_pk_bf16(y[1][0], y[1][1]); w.w = cvt_pk_bf16(y[1][2], y[1][3]);
            wq[bj] = w; }
          { u32x4 ra, rb; slab_x16(sl, wq[0], wq[1], ra, rb); *(u32x4*)(outp + (size_t)(ai * 128 + m * 16) * EVEN_IN) = ra; *(u32x4*)(outp + (size_t)(ai * 128 + m * 16) * EVEN_IN + 32) = rb; }
          asm volatile("" ::: "memory");
        }
    }
  }
};

struct JobIn1 {
  static constexpr int K = IN1_FP8 ? D / 2 : D; static constexpr bool GATHER = false, FP8 = IN1_FP8;
  static constexpr int SCALE = 0x01010101 * (127 - (WQ_SHIFT + X_SHIFT) / 2); static_assert((WQ_SHIFT + X_SHIFT) % 2 == 0, "");
  const Params& p; int i, c, G;
  DEVI JobIn1(const Params& p_) : p(p_), i(0), c(vbid()), G(gridDim.x) {}
  DEVI unsigned boff(int R, int C) const { return boff_m1<K>(R, C); }
  DEVI bool next(Unit& u) {
    for (;;) { int pm, pn; if (!dense_decode((long)i * G + c, T / 256, ODD_IN / 256, pm, pn)) return false; ++i;
      if (pm % 9 == 0 && pn < 4) continue;
      u.pm = pm; u.pn = pn; u.A = (const char*)(p.ws + (IN1_FP8 ? OFF_ACT8 : OFF_ACT)) + (size_t)pm * 256 * K * 2;
      u.B0 = (const char*)wsp<bf16_t>(p, OFF_WQKV1T) + (size_t)(256 * pn) * K * 2; u.B1 = u.B0 + (size_t)32 * K * 2; return true; }
  }
  DEVI void aoffs(const Unit&, const int (&Rr)[2], const int (&Cc)[2], unsigned (&v)[2][2]) const { dense_aoffs<K>(Rr, Cc, v); }
  DEVI void epilogue(const Acc& acc, const Unit& u, int wr, int wc, int fr, int fq, LAS unsigned char* lds) const {
    asm volatile("" : "+v"(fr), "+v"(fq));
    const int lane = fq * 16 + fr; const Slab sl = slab_init(lds, wr * 4 + wc, fr, fq);
    int ooff = (u.pm * 256 + wr * 64 + (lane >> 2)) * ODD_IN + u.pn * 256 + wc * 64 + 8 * (lane & 3);
    asm volatile("" : "+v"(ooff));
    bf16_t* outp = wsp<bf16_t>(p, OFF_PROJ) + ooff;
    asm volatile("" : "+v"(outp));
    const int pn = u.pn;
    if (pn == 5) {
#pragma unroll
      for (int ai = 0; ai < 2; ++ai)
#pragma unroll
        for (int m = 0; m < 4; ++m) {
          u32x4 wq[2];
#pragma unroll
          for (int bj = 0; bj < 2; ++bj) { const f32x4 v0 = acc[ai][bj][m][0], v1 = acc[ai][bj][m][1];
            u32x4 w; w.x = cvt_pk_bf16(v0[0], v0[1]); w.y = cvt_pk_bf16(v0[2], v0[3]); w.z = cvt_pk_bf16(v1[0], v1[1]); w.w = cvt_pk_bf16(v1[2], v1[3]);
            wq[bj] = w; }
          { u32x4 ra, rb; slab_x16(sl, wq[0], wq[1], ra, rb); *(u32x4*)(outp + (size_t)(ai * 128 + m * 16) * ODD_IN) = ra; *(u32x4*)(outp + (size_t)(ai * 128 + m * 16) * ODD_IN + 32) = rb; } }
    } else {
      const int wid = wr * 4 + wc;
      LAS float* xw = (LAS float*)(lds + LDS_XCH) + wid * 128 + fr; LAS float* xr = (LAS float*)(lds + LDS_XCH) + (wid ^ 1) * 128 + fr;
      asm volatile("" : "+v"(xw), "+v"(xr));
      float ssr[2][4];
#pragma unroll
      for (int ai = 0; ai < 2; ++ai)
#pragma unroll
        for (int m = 0; m < 4; ++m) { float ss = 0.f;
#pragma unroll
          for (int bj = 0; bj < 2; ++bj)
#pragma unroll
            for (int n = 0; n < 2; ++n) { const f32x4 x = acc[ai][bj][m][n]; ss += (x[0] * x[0] + x[1] * x[1]) + (x[2] * x[2] + x[3] * x[3]); }
          ss += shx<16>(ss); ss = sum32x(ss); ssr[ai][m] = ss;
          if (fq == 0) xw[ai * 64 + m * 16] = ss; }
      asm volatile("s_waitcnt lgkmcnt(0)" ::: "memory"); __builtin_amdgcn_s_barrier(); asm volatile("" ::: "memory");
#pragma unroll
      for (int ai = 0; ai < 2; ++ai)
#pragma unroll
        for (int m = 0; m < 4; ++m) ssr[ai][m] += xr[ai * 64 + m * 16];
      const int hh = wc & 1;
      LAS const float* gn = (LAS const float*)(lds + LDS_GAIN) + (pn < 4 ? 0 : 128) + 64 * hh + 8 * fq;
      asm volatile("" : "+v"(gn));
      const int jt = u.pm % 9; const bool lat = jt != 0;
      LAS const f32x4* t128 = (LAS const f32x4*)(lds + LDS_ROPE);
#pragma unroll
      for (int ai = 0; ai < 2; ++ai)
#pragma unroll
        for (int m = 0; m < 4; ++m) {
          f32x4 g4[2][2];
#pragma unroll
          for (int bj = 0; bj < 2; ++bj)
#pragma unroll
            for (int n = 0; n < 2; ++n) g4[bj][n] = *(LAS const f32x4*)(gn + bj * 32 + 4 * n);
          f32x4 cs[2][2];
          if (lat) { const int il = (jt - 1) * 256 + ai * 128 + wr * 64 + m * 16 + fr; const int pos = hh ? (il & 63) : (il >> 6);
#pragma unroll
            for (int bj = 0; bj < 2; ++bj)
#pragma unroll
              for (int n = 0; n < 2; ++n) cs[bj][n] = t128[pos * 16 + 8 * bj + 2 * fq + n]; }
          const float rstd = rsqrtf(ssr[ai][m] * (1.0f / 128) + EPS);
          u32x4 wq[2];
#pragma unroll
          for (int bj = 0; bj < 2; ++bj) { f32x4 y[2];
#pragma unroll
            for (int n = 0; n < 2; ++n) { f32x4 x = acc[ai][bj][m][n] * rstd * g4[bj][n];
              if (lat) { const f32x4 c4 = cs[bj][n]; x = (f32x4){x[0] * c4[0] - x[1] * c4[1], x[0] * c4[1] + x[1] * c4[0], x[2] * c4[2] - x[3] * c4[3], x[2] * c4[3] + x[3] * c4[2]}; }
              y[n] = x; }
            u32x4 w; w.x = cvt_pk_bf16(y[0][0], y[0][1]); w.y = cvt_pk_bf16(y[0][2], y[0][3]); w.z = cvt_pk_bf16(y[1][0], y[1][1]); w.w = cvt_pk_bf16(y[1][2], y[1][3]);
            wq[bj] = w; }
          { u32x4 ra, rb; slab_x16(sl, wq[0], wq[1], ra, rb); *(u32x4*)(outp + (size_t)(ai * 128 + m * 16) * ODD_IN) = ra; *(u32x4*)(outp + (size_t)(ai * 128 + m * 16) * ODD_IN + 32) = rb; }
          asm volatile("" ::: "memory");
        }
    }
  }
};

DEVI void moe_tables(const Params& p, const LCfg c, int half, int nN, LAS unsigned char* lds) {
  LAS int* tb = (LAS int*)(lds + LDS_TAB);
  const int tid = ltid();
  __syncthreads();
  if (tid <= NE) tb[tid] = tid < NE ? ((const int*)(p.ws + OFF_CNT))[c.l * 128 + half * 64 + tid] : c.nph;
  __syncthreads();
  if (tid == 0) { int up = 0, off = 0; for (int e = 0; e <= NE; ++e) { const int n = tb[e]; tb[72 + e] = up; tb[144 + e] = off; up += ((n + 255) >> 8) * nN; off += n; } tb[72 + 65] = up; tb[144 + 65] = off; }
  __syncthreads();
}
struct MoeIter {
  int g, gend, step, e;
  DEVI void init(LAS const int* tb) { const int vb = vbid(); const int U = __builtin_amdgcn_readfirstlane(tb[72 + 65]), chunk = (U + 7) >> 3, x = vb & 7; g = x * chunk + (vb >> 3); gend = (x + 1) * chunk < U ? (x + 1) * chunk : U; step = gridDim.x >> 3; e = 0; }
  DEVI bool next(LAS const int* tb, int nN, int& ee, int& mt, int& pn) { if (g >= gend) return false; while (__builtin_amdgcn_readfirstlane(tb[72 + e + 1]) <= g) ++e; const int r = g - __builtin_amdgcn_readfirstlane(tb[72 + e]); mt = r / nN; pn = r - mt * nN; ee = e; g += step; return true; }
};
struct JobGU {
  static constexpr int K = D / 2; static constexpr bool GATHER = true, FP8 = true;
  static constexpr int SCALE = 0x01010101 * (127 - (WG_SHIFT + X_SHIFT) / 2); static_assert((WG_SHIFT + X_SHIFT) % 2 == 0, "");
  const Params& p; const LCfg c; int half; LAS const int* tb; MoeIter it; int dry;
  DEVI JobGU(const Params& p_, const LCfg c_, int half_, LAS unsigned char* lds, int dry_ = 0) : p(p_), c(c_), half(half_), tb((LAS const int*)(lds + LDS_TAB)), dry(dry_) { it.init(tb); }
  DEVI unsigned boff(int R, int C) const { return boff_m2<K>(R, C); }
  DEVI bool next(Unit& u) {
    int e, mt, pn; if (!it.next(tb, 2, e, mt, pn)) return false;
    u.e = e; u.pm = mt; u.pn = pn; u.cnt = __builtin_amdgcn_readfirstlane(tb[e]); u.off = __builtin_amdgcn_readfirstlane(tb[144 + e]); u.A = (const char*)(p.ws + OFF_ACT8);
    const char* w = e < NE ? (const char*)wsp<bf16_t>(p, OFF_EGU) + (size_t)e * 512 * K * 2 : (const char*)wsp<bf16_t>(p, OFF_SHGU) + (size_t)c.l * 512 * K * 2;
    u.B0 = w + (size_t)(128 * pn) * K * 2; u.B1 = w + (size_t)(256 + 128 * pn) * K * 2; return true;
  }
  DEVI void aoffs(const Unit& u, const int (&Rr)[2], const int (&Cc)[2], unsigned (&v)[2][2]) const {
    const int* le = wsp<int>(p, OFF_LIST) + ((size_t)(half * 64 + (u.e < NE ? u.e : 0))) * LCAP;
#pragma unroll
    for (int h = 0; h < 2; ++h)
#pragma unroll
      for (int i = 0; i < 2; ++i) { int r = u.pm * 256 + h * 128 + Rr[i]; r = r < u.cnt ? r : 0;
        int tl = r; if (u.e < NE) tl = le[r] / 6;
        v[h][i] = (unsigned)(act_tok(c, half, tl) * K + Cc[i]) * 2u; }
  }
  DEVI void epilogue(const Acc& acc, const Unit& u, int wr, int wc, int fr, int fq, LAS unsigned char* lds) const {
    asm volatile("" : "+v"(fr), "+v"(fq));
    if (dry == 1) {
#pragma unroll
      for (int ai = 0; ai < 2; ++ai)
#pragma unroll
        for (int bj = 0; bj < 2; ++bj)
#pragma unroll
          for (int m = 0; m < 4; ++m)
#pragma unroll
            for (int n = 0; n < 2; ++n) asm volatile("" :: "v"(acc[ai][bj][m][n]));
      return; }
    const int lane = fq * 16 + fr;
    LAS unsigned char* sb = lds + 3 * HTB + (wr * 4 + wc) * 1024;
    const int r0 = u.pm * 256 + wr * 64 + (lane >> 2);
    unsigned char* hid = p.ws + OFF_HID + ((size_t)u.off + r0) * DE + u.pn * 128 + wc * 32 + 8 * (lane & 3);
    asm volatile("" : "+v"(hid));
    const float hs = (float)(1 << H_SHIFT);
#pragma unroll
    for (int ai = 0; ai < 2; ++ai)
#pragma unroll
      for (int m = 0; m < 4; ++m) { const int r = r0 + ai * 128 + m * 16;
        float h[8];
#pragma unroll
        for (int n = 0; n < 2; ++n)
#pragma unroll
          for (int j = 0; j < 4; ++j) { const float gg = acc[ai][0][m][n][j]; h[n * 4 + j] = __builtin_amdgcn_fmed3f(gg * __builtin_amdgcn_rcpf(1.0f + __expf(-gg)) * acc[ai][1][m][n][j] * hs, -440.f, 440.f); }
        int lo = 0, hi = 0;
        lo = __builtin_amdgcn_cvt_pk_fp8_f32(h[0], h[1], lo, false); lo = __builtin_amdgcn_cvt_pk_fp8_f32(h[2], h[3], lo, true);
        hi = __builtin_amdgcn_cvt_pk_fp8_f32(h[4], h[5], hi, false); hi = __builtin_amdgcn_cvt_pk_fp8_f32(h[6], h[7], hi, true);
        *(LAS u32x2*)(sb + fr * 32 + fq * 8) = (u32x2){(unsigned)lo, (unsigned)hi};
        const u32x2 rw = *(LAS u32x2*)(sb + lane * 8);
        if (r < u.cnt) *(u32x2*)(hid + (size_t)(ai * 128 + m * 16) * DE) = rw; }
  }
};
struct JobDown {
  static constexpr int K = DE / 2; static constexpr bool GATHER = false, FP8 = true;
  static constexpr int SCALE = 0x01010101 * (127 - (WD_SHIFT + H_SHIFT) / 2); static_assert((WD_SHIFT + H_SHIFT) % 2 == 0, "");
  const Params& p; const LCfg c; int half; LAS const int* tb; MoeIter it; float dscale;
  DEVI JobDown(const Params& p_, const LCfg c_, int half_, LAS unsigned char* lds, float ds = 1.0f) : p(p_), c(c_), half(half_), tb((LAS const int*)(lds + LDS_TAB)), dscale(ds) { it.init(tb); }
  DEVI unsigned boff(int R, int C) const { return boff_m1<K>(R, C); }
  DEVI bool next(Unit& u) {
    int e, mt, pn; if (!it.next(tb, 4, e, mt, pn)) return false;
    u.e = e; u.pm = mt; u.pn = pn; u.cnt = __builtin_amdgcn_readfirstlane(tb[e]); u.off = __builtin_amdgcn_readfirstlane(tb[144 + e]);
    u.A = (const char*)wsp<bf16_t>(p, OFF_HID) + ((size_t)(u.off + mt * 256)) * K * 2;
    const char* w = e < NE ? (const char*)wsp<bf16_t>(p, OFF_ED) + (size_t)e * D * K * 2 : (const char*)wsp<bf16_t>(p, OFF_SHD) + (size_t)c.l * D * K * 2;
    u.B0 = w + (size_t)(256 * pn) * K * 2; u.B1 = u.B0 + (size_t)32 * K * 2; return true;
  }
  DEVI void aoffs(const Unit&, const int (&Rr)[2], const int (&Cc)[2], unsigned (&v)[2][2]) const { dense_aoffs<K>(Rr, Cc, v); }
  DEVI void epilogue(const Acc& acc, const Unit& u, int wr, int wc, int fr, int fq, LAS unsigned char* lds) const {
    asm volatile("" : "+v"(fr), "+v"(fq));
    const int lane = fq * 16 + fr;
    if (dscale < 0.f) {
#pragma unroll
      for (int ai = 0; ai < 2; ++ai)
#pragma unroll
        for (int bj = 0; bj < 2; ++bj)
#pragma unroll
          for (int m = 0; m < 4; ++m)
#pragma unroll
            for (int n = 0; n < 2; ++n) asm volatile("" :: "v"(acc[ai][bj][m][n]));
      return; }
    LAS unsigned char* sb = lds + 3 * HTB + (wr * 4 + wc) * 1024;
    const int r0 = u.pm * 256 + wr * 64 + (lane >> 2);
    unsigned char* slot = p.ws + OFF_SLOT + ((size_t)u.off + r0) * D + u.pn * 256 + wc * 64 + 16 * (lane & 3);
    asm volatile("" : "+v"(slot));
#pragma unroll
    for (int ai = 0; ai < 2; ++ai)
#pragma unroll
      for (int m = 0; m < 4; ++m) {
#pragma unroll
        for (int bj = 0; bj < 2; ++bj) { f32x4 v0 = acc[ai][bj][m][0], v1 = acc[ai][bj][m][1]; int lo = 0, hi = 0;
#pragma unroll
          for (int j = 0; j < 4; ++j) { v0[j] = __builtin_amdgcn_fmed3f(v0[j], -440.f, 440.f); v1[j] = __builtin_amdgcn_fmed3f(v1[j], -440.f, 440.f); }
          lo = __builtin_amdgcn_cvt_pk_fp8_f32(v0[0], v0[1], lo, false); lo = __builtin_amdgcn_cvt_pk_fp8_f32(v0[2], v0[3], lo, true);
          hi = __builtin_amdgcn_cvt_pk_fp8_f32(v1[0], v1[1], hi, false); hi = __builtin_amdgcn_cvt_pk_fp8_f32(v1[2], v1[3], hi, true);
          *(LAS u32x2*)(sb + fr * 64 + bj * 32 + fq * 8) = (u32x2){(unsigned)lo, (unsigned)hi}; }
        const u32x4 rw = *(LAS u32x4*)(sb + lane * 16);
        if (r0 + ai * 128 + m * 16 < u.cnt) *(u32x4*)(slot + (size_t)(ai * 128 + m * 16) * D) = rw; }
  }
};
}
namespace fa {
constexpr int NW = 8, QBLK = 32, KVBLK = 64;
constexpr float THR = 8.f;
constexpr size_t SHM_V = KVBLK * 128 * 2, SHM_K = KVBLK * 128 * 2, SHM_ATTN = 2 * SHM_V + 2 * SHM_K + NW * 64 * 4;
using s16x4 = __attribute__((ext_vector_type(4))) short;
using f32x16 = __attribute__((ext_vector_type(16))) float;
#define KSWZ(row, colB) ((row) * 256 + ((colB) ^ (((row) & 7) << 4)))
#define SBAR() __builtin_amdgcn_sched_barrier(0)
DEVI int crow(int r, int hi) { return (r & 3) + 8 * (r >> 2) + 4 * hi; }
DEVI unsigned cvtpk(float lo, float hi) { unsigned r; asm volatile("v_cvt_pk_bf16_f32 %0, %1, %2" : "=v"(r) : "v"(lo), "v"(hi)); return r; }

template <int SCALE_NUM> struct ScaleC;
DEVI void partialSM(f32x16& p0, f32x16& p1, float& m_reg, float& mn, float& alpha, const float SCALE) {
  const float C = SCALE * 1.4426950408889634f;
  float pmax = p0[0];
#pragma unroll
  for (int r = 1; r < 16; ++r) pmax = fmaxf(pmax, p0[r]);
#pragma unroll
  for (int r = 0; r < 16; ++r) pmax = fmaxf(pmax, p1[r]);
  { auto rr = __builtin_amdgcn_permlane32_swap(__float_as_uint(pmax), __float_as_uint(pmax), false, false);
    pmax = fmaxf(__uint_as_float(rr[0]), __uint_as_float(rr[1])); }
  if (__builtin_expect(__all(pmax - m_reg <= THR / SCALE), 1)) { mn = m_reg; alpha = 1.f; }
  else { mn = fmaxf(m_reg, pmax); alpha = __builtin_amdgcn_exp2f((m_reg - mn) * C); m_reg = mn; }
  float mnC = -mn * C;
#pragma unroll
  for (int r = 0; r < 16; ++r) p0[r] = fmaf(p0[r], C, mnC);
#pragma unroll
  for (int r = 0; r < 16; ++r) p1[r] = fmaf(p1[r], C, mnC);
#pragma unroll
  for (int r = 0; r < 16; ++r) p0[r] = __builtin_amdgcn_exp2f(p0[r]);
}
DEVI float partialSM_max(const f32x16& p0, const f32x16& p1, float& m_reg, float& mn, float& alpha, const float SCALE) {
  const float C = SCALE * 1.4426950408889634f;
  float pmax = p0[0];
#pragma unroll
  for (int r = 1; r < 16; ++r) pmax = fmaxf(pmax, p0[r]);
#pragma unroll
  for (int r = 0; r < 16; ++r) pmax = fmaxf(pmax, p1[r]);
  { auto rr = __builtin_amdgcn_permlane32_swap(__float_as_uint(pmax), __float_as_uint(pmax), false, false);
    pmax = fmaxf(__uint_as_float(rr[0]), __uint_as_float(rr[1])); }
  if (__builtin_expect(__all(pmax - m_reg <= THR / SCALE), 1)) { mn = m_reg; alpha = 1.f; }
  else { mn = fmaxf(m_reg, pmax); alpha = __builtin_amdgcn_exp2f((m_reg - mn) * C); m_reg = mn; }
  return -mn * C;
}
template <int BASE> DEVI void sm_piece(f32x16& p0, f32x16& p1, const float C, const float mnC) {
#pragma unroll
  for (int r = BASE; r < BASE + 4; ++r) { p0[r] = __builtin_amdgcn_exp2f(fmaf(p0[r], C, mnC)); p1[r] = fmaf(p1[r], C, mnC); }
}
DEVI void finishSM(f32x16& p0, f32x16& p1, float alpha, float& l_reg, bf16x8& pa0, bf16x8& pa1, bf16x8& pa2, bf16x8& pa3) {
#pragma unroll
  for (int r = 0; r < 16; ++r) p1[r] = __builtin_amdgcn_exp2f(p1[r]);
  float ps = 0;
#pragma unroll
  for (int r = 0; r < 16; ++r) ps += p0[r];
#pragma unroll
  for (int r = 0; r < 16; ++r) ps += p1[r];
  { auto rr = __builtin_amdgcn_permlane32_swap(__float_as_uint(ps), __float_as_uint(ps), false, false);
    ps = __uint_as_float(rr[0]) + __uint_as_float(rr[1]); }
  l_reg = l_reg * alpha + ps;
#define PK4(P, BASE, OUT) do { unsigned a0 = cvtpk(P[BASE + 0], P[BASE + 1]), a1 = cvtpk(P[BASE + 2], P[BASE + 3]);   \
    unsigned b0 = cvtpk(P[BASE + 4], P[BASE + 5]), b1 = cvtpk(P[BASE + 6], P[BASE + 7]);                              \
    auto r0 = __builtin_amdgcn_permlane32_swap(a0, b0, false, false); auto r1 = __builtin_amdgcn_permlane32_swap(a1, b1, false, false); \
    u32x4 w = {r0[0], r1[0], r0[1], r1[1]}; OUT = *reinterpret_cast<bf16x8*>(&w); } while (0)
  PK4(p0, 0, pa0); PK4(p0, 8, pa1); PK4(p1, 0, pa2); PK4(p1, 8, pa3);
#undef PK4
}
template <int ND0> DEVI void qkt(f32x16& p0, f32x16& p1, const char* Ks, const bf16x8* qr, int r32, int hi, int cbase) {
  p0 = f32x16{}; p1 = f32x16{};
  bf16x8 b0, b1, n0, n1;
  { const int cb = cbase + (hi * 8) * 2; b0 = *reinterpret_cast<const bf16x8*>(Ks + KSWZ(r32, cb)); b1 = *reinterpret_cast<const bf16x8*>(Ks + KSWZ(32 + r32, cb)); }
#pragma unroll
  for (int d0 = 0; d0 < ND0; ++d0) {
    if (d0 + 1 < ND0) { const int cb = cbase + ((d0 + 1) * 16 + hi * 8) * 2;
      n0 = *reinterpret_cast<const bf16x8*>(Ks + KSWZ(r32, cb)); n1 = *reinterpret_cast<const bf16x8*>(Ks + KSWZ(32 + r32, cb)); }
    p0 = __builtin_amdgcn_mfma_f32_32x32x16_bf16(b0, qr[d0], p0, 0, 0, 0);
    p1 = __builtin_amdgcn_mfma_f32_32x32x16_bf16(b1, qr[d0], p1, 0, 0, 0);
    b0 = n0; b1 = n1; }
}
DEVI int v_st(int k, int c) { const int kk = (k & ~0xC) | ((k & 4) << 1) | ((k & 8) >> 1); return ((kk >> 3) * 4 + (c >> 5)) * 512 + ((kk & 7) * 32 + (c & 31)) * 2; }
DEVI int v_rd_base(int lane) { return ((lane & 3) << 3) | (((lane >> 2) & 3) << 6) | (((lane >> 4) & 1) << 5) | (((lane >> 5) & 1) << 8); }
constexpr int v_rd_off(int d0, int ks, int half) { return d0 * 512 + ks * 4096 + half * 2048; }
template <int OFF> DEVI s16x4 tr_read(int vb) { s16x4 r; asm volatile("ds_read_b64_tr_b16 %0, %1 offset:%2" : "=&v"(r) : "v"(vb), "i"(OFF) : "memory"); return r; }
template <int D0> DEVI void pv_one(f32x16& od, int vb, bf16x8 pa0, bf16x8 pa1, bf16x8 pa2, bf16x8 pa3) {
  const s16x4 l0 = tr_read<v_rd_off(D0, 0, 0)>(vb), h0 = tr_read<v_rd_off(D0, 0, 1)>(vb), l1 = tr_read<v_rd_off(D0, 1, 0)>(vb), h1 = tr_read<v_rd_off(D0, 1, 1)>(vb);
  const s16x4 l2 = tr_read<v_rd_off(D0, 2, 0)>(vb), h2 = tr_read<v_rd_off(D0, 2, 1)>(vb), l3 = tr_read<v_rd_off(D0, 3, 0)>(vb), h3 = tr_read<v_rd_off(D0, 3, 1)>(vb);
  asm volatile("s_waitcnt lgkmcnt(0)" ::: "memory"); SBAR();
#define PK(L, H) (bf16x8){L[0], L[1], L[2], L[3], H[0], H[1], H[2], H[3]}
  od = __builtin_amdgcn_mfma_f32_32x32x16_bf16(pa0, PK(l0, h0), od, 0, 0, 0);
  od = __builtin_amdgcn_mfma_f32_32x32x16_bf16(pa1, PK(l1, h1), od, 0, 0, 0);
  od = __builtin_amdgcn_mfma_f32_32x32x16_bf16(pa2, PK(l2, h2), od, 0, 0, 0);
  od = __builtin_amdgcn_mfma_f32_32x32x16_bf16(pa3, PK(l3, h3), od, 0, 0, 0);
#undef PK
}
DEVI void pv_d0(f32x16* o, int vb, bf16x8 pa0, bf16x8 pa1, bf16x8 pa2, bf16x8 pa3) {
  pv_one<0>(o[0], vb, pa0, pa1, pa2, pa3); pv_one<1>(o[1], vb, pa0, pa1, pa2, pa3); pv_one<2>(o[2], vb, pa0, pa1, pa2, pa3); pv_one<3>(o[3], vb, pa0, pa1, pa2, pa3);
}

template <int ND0, int LD>
DEVI void attn_loop(const bf16_t* __restrict__ Qw, const bf16_t* __restrict__ Kh, const bf16_t* __restrict__ Vh, int seq, char* lds, int kcol_bytes, const float SCALE,
                    f32x16 (&o)[4], float& l_out) {
  const int tid = ltid(), wid = tid >> 6, lane = tid & 63, r32 = lane & 31, hi = lane >> 5;
  char* V_lds = lds; char* K_lds = lds + 2 * SHM_V;
  float* ws = (float*)(lds + 2 * SHM_V + 2 * SHM_K) + wid * 64; float* al_l = ws + 32;
  float m_reg = -1e30f, l_reg = 0; bf16x8 qr[ND0];
#pragma unroll
  for (int d = 0; d < 4; ++d) o[d] = f32x16{};
#pragma unroll
  for (int d0 = 0; d0 < ND0; ++d0) qr[d0] = *reinterpret_cast<const bf16x8*>(Qw + d0 * 16);
  const int sr = tid >> 4, sc = (tid & 15) * 8, vst0 = v_st(sr, sc), vst1 = v_st(32 + sr, sc);
  const int vb0 = (int)(uintptr_t)V_lds + v_rd_base(lane);
  struct { bf16x8 vs0, vs1, ks0, ks1; } sr_[2];
#define SLOAD(i, k0) do { sr_[i].vs0 = *reinterpret_cast<const bf16x8*>(&Vh[(long)((k0) + sr) * LD + sc]); sr_[i].vs1 = *reinterpret_cast<const bf16x8*>(&Vh[(long)((k0) + 32 + sr) * LD + sc]); \
    sr_[i].ks0 = *reinterpret_cast<const bf16x8*>(&Kh[(long)((k0) + sr) * LD + sc]); sr_[i].ks1 = *reinterpret_cast<const bf16x8*>(&Kh[(long)((k0) + 32 + sr) * LD + sc]); } while (0)
#define SWRITE(b, i) do { *(bf16x8*)(V_lds + (b) * SHM_V + vst0) = sr_[i].vs0;          \
    *(bf16x8*)(V_lds + (b) * SHM_V + vst1) = sr_[i].vs1; int kc = sc * 2;               \
    *(bf16x8*)(K_lds + (b) * SHM_K + KSWZ(sr, kc)) = sr_[i].ks0;                       \
    *(bf16x8*)(K_lds + (b) * SHM_K + KSWZ(32 + sr, kc)) = sr_[i].ks1; } while (0)
#define SWAIT() asm volatile("s_waitcnt vmcnt(4)" ::: "memory")
#define RESC(a) do { if (__any((a) < 1.f)) { if (hi == 0) al_l[r32] = (a); asm volatile("s_waitcnt lgkmcnt(0)" ::: "memory"); \
    _Pragma("unroll") for (int d = 0; d < 4; ++d) _Pragma("unroll") for (int r = 0; r < 16; ++r) o[d][r] *= al_l[crow(r, hi)]; } } while (0)
#define PVSM(vb, P0, P1, mn, al) do { const float _mc = partialSM_max(P0, P1, m_reg, mn, al, SCALE); const float _C = SCALE * 1.4426950408889634f; \
    pv_one<0>(o[0], vb, pa0, pa1, pa2, pa3); sm_piece<0>(P0, P1, _C, _mc); pv_one<1>(o[1], vb, pa0, pa1, pa2, pa3); sm_piece<4>(P0, P1, _C, _mc); \
    pv_one<2>(o[2], vb, pa0, pa1, pa2, pa3); sm_piece<8>(P0, P1, _C, _mc); pv_one<3>(o[3], vb, pa0, pa1, pa2, pa3); sm_piece<12>(P0, P1, _C, _mc); asm volatile("" : "+v"(P0), "+v"(P1)); SBAR(); } while (0)
  f32x16 pA0, pA1, pB0, pB1; float mnA, mnB, alA, alB; bf16x8 pa0, pa1, pa2, pa3; const int NT = seq / KVBLK;
  constexpr int SE = 0, SO = 1;
  SLOAD(SE, 0); asm volatile("s_waitcnt vmcnt(0)" ::: "memory"); SWRITE(0, SE); __syncthreads();
  qkt<ND0>(pA0, pA1, K_lds, qr, r32, hi, kcol_bytes); partialSM(pA0, pA1, m_reg, mnA, alA, SCALE);
  SLOAD(SO, KVBLK); if (2 < NT) SLOAD(SE, 2 * KVBLK);
  SWAIT(); SWRITE(1, SO); __syncthreads();
  for (int j = 1; j + 1 < NT; j += 2) {
    SBAR(); qkt<ND0>(pB0, pB1, K_lds + SHM_K, qr, r32, hi, kcol_bytes);
    finishSM(pA0, pA1, alA, l_reg, pa0, pa1, pa2, pa3); SBAR();
    SLOAD(SO, (j + 2) * KVBLK); SBAR();
    PVSM(vb0, pB0, pB1, mnB, alB);
    __syncthreads(); SWAIT(); SWRITE(0, SE);
    RESC(alB); __syncthreads();
    SBAR(); qkt<ND0>(pA0, pA1, K_lds, qr, r32, hi, kcol_bytes);
    finishSM(pB0, pB1, alB, l_reg, pa0, pa1, pa2, pa3); SBAR();
    if (j + 3 < NT) SLOAD(SE, (j + 3) * KVBLK); SBAR();
    PVSM(vb0 + (int)SHM_V, pA0, pA1, mnA, alA);
    __syncthreads(); SWAIT(); SWRITE(1, SO);
    RESC(alA); __syncthreads();
  }
  SBAR(); qkt<ND0>(pB0, pB1, K_lds + SHM_K, qr, r32, hi, kcol_bytes);
  finishSM(pA0, pA1, alA, l_reg, pa0, pa1, pa2, pa3); SBAR();
  pv_d0(o, vb0, pa0, pa1, pa2, pa3); partialSM(pB0, pB1, m_reg, mnB, alB, SCALE);
  __syncthreads(); RESC(alB);
  finishSM(pB0, pB1, alB, l_reg, pa0, pa1, pa2, pa3); SBAR();
  pv_d0(o, vb0 + (int)SHM_V, pa0, pa1, pa2, pa3);
  asm volatile("s_waitcnt vmcnt(0)" ::: "memory");
  l_out = l_reg;
#undef PVSM
#undef SLOAD
#undef SWRITE
#undef SWAIT
#undef RESC
}

DEVI void store_tile_bf16(const f32x16 (&o)[4], const float (&scl)[16], bf16_t* Ow, int ldo, int r32, int hi) {
#pragma unroll
  for (int d0 = 0; d0 < 4; ++d0)
#pragma unroll
    for (int r = 0; r < 16; r += 2) {
      const float va = o[d0][r] * scl[r], vb = o[d0][r + 1] * scl[r + 1];
      const float snd = (r32 & 1) ? va : vb; const float got = shx<1>(snd);
      const int row = (r32 & 1) ? crow(r + 1, hi) : crow(r, hi); const int col = d0 * 32 + (r32 & ~1);
      const unsigned w = (r32 & 1) ? cvtpk(got, vb) : cvtpk(va, got);
      *(unsigned*)(Ow + (long)row * ldo + col) = w; }
}

DEVI void phase_attn1(const Params& p, const PrepIn& pin, unsigned char* smem) {
  const bf16_t* qkv = wsp<bf16_t>(p, OFF_PROJ); bf16_t* att = wsp<bf16_t>(p, OFF_ACT);
  const int vb_ = vbid(); const int xcd = vb_ & 7, slot = vb_ >> 3, nslot = gridDim.x >> 3;
  for (int it = slot; it < 4 * 32; it += nslot) {
    int tid = ltid(); asm volatile("" : "+v"(tid));
    const int wid = tid >> 6, lane = tid & 63, r32 = lane & 31, hi = lane >> 5;
    float* li_l = (float*)((char*)smem + 2 * SHM_V + 2 * SHM_K) + wid * 64;
    const int g = xcd + 8 * (it >> 5), item = it & 31, b = g >> 1, kvh = g & 1, h = kvh * 4 + (item >> 3), qb = item & 7;
    const bf16_t* Qb = qkv + (size_t)(b * SB + NC + qb * 256) * ODD_IN + h * 128;
    const bf16_t* Kh = qkv + (size_t)(b * SB) * ODD_IN + 1024 + kvh * 128; const bf16_t* Vh = Kh + 256;
    f32x16 o[4]; float l;
    __syncthreads();
    attn_loop<8, ODD_IN>(Qb + (long)(wid * QBLK + r32) * ODD_IN + hi * 8, Kh, Vh, SB, (char*)smem, 0, 0.08838834764831845f, o, l);
    if (hi == 0) li_l[r32] = l; asm volatile("s_waitcnt lgkmcnt(0)" ::: "memory");
    float rli[16];
#pragma unroll
    for (int r = 0; r < 16; ++r) rli[r] = __builtin_amdgcn_rcpf(li_l[crow(r, hi)]);
    store_tile_bf16(o, rli, att + (size_t)(b * SB + NC + qb * 256 + wid * QBLK) * D + h * 128, D, r32, hi);
  }
}

DEVI void phase_attn0(const Params& p, const PrepIn& pin, unsigned char* smem) {
  const bf16_t* proj = wsp<bf16_t>(p, OFF_PROJ); bf16_t* cat = wsp<bf16_t>(p, OFF_ACT);
  const int tid = ltid(), wid = tid >> 6, lane = tid & 63, r32 = lane & 31, hi = lane >> 5, mp = wid >> 2, w4 = wid & 3;
  const int vb_ = vbid(); const int xcd = vb_ & 7, slot = vb_ >> 3, nslot = gridDim.x >> 3;
  float* li_l = (float*)((char*)smem + 2 * SHM_V + 2 * SHM_K) + wid * 64;
  float* ex = (float*)smem + (size_t)w4 * 4096 + lane;
  const float lam = wsp<float>(p, OFF_LAM)[0];
  const float* subln = sm(p, SM_SUBLN);
  for (int it = slot; it < 8 * 18; it += nslot) {
    int g, qrow0, seq;
    if (it < 128) { g = xcd + 8 * (it >> 4); qrow0 = NC + (it & 15) * 128; seq = SB; }
    else { const int j = it - 128; g = xcd + 8 * (j >> 1); qrow0 = (j & 1) * 128; seq = NC; }
    const int b = g >> 2, h = g & 3;
    const bf16_t* Qw = proj + (size_t)(b * SB + qrow0 + w4 * QBLK + r32) * EVEN_IN + 1024 + h * 128 + mp * 64 + hi * 8;
    const bf16_t* Kh = proj + (size_t)(b * SB) * EVEN_IN + 1536 + h * 128; const bf16_t* Vh = Kh + 512;
    f32x16 o[4]; float l;
    __syncthreads();
    attn_loop<4, EVEN_IN>(Qw, Kh, Vh, seq, (char*)smem, mp * 128, 0.125f, o, l);
    if (hi == 0) li_l[r32] = l; asm volatile("s_waitcnt lgkmcnt(0)" ::: "memory");
    float rli[16];
#pragma unroll
    for (int r = 0; r < 16; ++r) rli[r] = __builtin_amdgcn_rcpf(li_l[crow(r, hi)]);
    __syncthreads();
    if (mp == 1) {
#pragma unroll
      for (int d0 = 0; d0 < 4; ++d0)
#pragma unroll
        for (int r = 0; r < 16; ++r) ex[(d0 * 16 + r) * 64] = o[d0][r] * rli[r];
    }
    __syncthreads();
    if (mp == 0) {
      float ss[16];
#pragma unroll
      for (int r = 0; r < 16; ++r) ss[r] = 0.f;
#pragma unroll
      for (int d0 = 0; d0 < 4; ++d0) { const float gcol = subln[d0 * 32 + r32];
#pragma unroll
        for (int r = 0; r < 16; ++r) { const float dv = o[d0][r] * rli[r] - lam * ex[(d0 * 16 + r) * 64]; ss[r] += dv * dv; o[d0][r] = dv * gcol; } }
#pragma unroll
      for (int r = 0; r < 16; ++r) { float v = ss[r];
        v += shx<1>(v); v += shx<2>(v); v += shx<4>(v); v += shx<8>(v); v += shx<16>(v);
        ss[r] = rsqrtf(v * (1.0f / 128) + EPS) * 0.8f; }
      store_tile_bf16(o, ss, cat + (size_t)(b * SB + qrow0 + w4 * QBLK) * D + 512 + h * 128, D, r32, hi);
    }
  }
}

DEVI void phase_gmlp(const Params& p, unsigned char* smem) {
  const bf16_t* proj = wsp<bf16_t>(p, OFF_PROJ); bf16_t* cat = wsp<bf16_t>(p, OFF_ACT); const bf16_t* wsa = wsp<bf16_t>(p, OFF_WSA);
  const float* lng = sm(p, SM_ALNG); const float* lnb = sm(p, SM_ALNB); const float* abs_ = sm(p, SM_ABS);
  for (int it = blockIdx.x; it < (T / 128 + 1) / 2; it += gridDim.x) {
    const int tid = ltid(), hf = tid >> 8, ht = tid & 255, wl = ht >> 6, lane = tid & 63, fr = lane & 15, fq = lane >> 4;
    bf16_t* Tl = (bf16_t*)(smem + hf * 36864);
    const int ch = it * 2 + hf; const bool live = ch < T / 128; const int t0 = (live ? ch : 0) * 128;
    const int q = ht >> 1, part = ht & 1;
    float mu, rstd;
    { const bf16_t* vr = proj + (size_t)(t0 + q) * EVEN_IN + 512 + part * 256;
      float s = 0.f, s2 = 0.f;
#pragma unroll
      for (int i = 0; i < 32; ++i) { const u32x4 x = *(const u32x4*)(vr + i * 8);
#pragma unroll
        for (int e = 0; e < 4; ++e) { const float f0 = __uint_as_float(x[e] << 16), f1 = __uint_as_float(x[e] & 0xffff0000u); s += f0 + f1; s2 += f0 * f0 + f1 * f1; } }
      s += shx<1>(s); s2 += shx<1>(s2);
      mu = s * (1.0f / 512); rstd = rsqrtf(fmaxf(s2 * (1.0f / 512) - mu * mu, 0.f) + EPS); }
    for (int g = 0; g < 4; ++g) {
      __syncthreads();
      { const bf16_t* vg = proj + (size_t)(t0 + q) * EVEN_IN + 512 + g * 128 + part * 64;
#pragma unroll
        for (int i = 0; i < 8; ++i) { const u32x4 x = *(const u32x4*)(vg + i * 8); const int d0 = part * 64 + i * 8;
          const f32x4 ga = *(const f32x4*)(lng + g * 128 + d0), gb = *(const f32x4*)(lng + g * 128 + d0 + 4), ba = *(const f32x4*)(lnb + g * 128 + d0), bb = *(const f32x4*)(lnb + g * 128 + d0 + 4);
#pragma unroll
          for (int e = 0; e < 4; ++e) { const float f0 = __uint_as_float(x[e] << 16), f1 = __uint_as_float(x[e] & 0xffff0000u);
            const float gg0 = e < 2 ? ga[2 * e] : gb[2 * e - 4], gg1 = e < 2 ? ga[2 * e + 1] : gb[2 * e - 3], bb0 = e < 2 ? ba[2 * e] : bb[2 * e - 4], bb1 = e < 2 ? ba[2 * e + 1] : bb[2 * e - 3];
            const unsigned w = cvtpk((f0 - mu) * rstd * gg0 + bb0, (f1 - mu) * rstd * gg1 + bb1);
            Tl[(d0 + 2 * e) * 136 + q] = (bf16_t)(w & 0xffff); Tl[(d0 + 2 * e + 1) * 136 + q] = (bf16_t)(w >> 16); } }
      }
      __syncthreads();
      bf16x8 af[2][4];
#pragma unroll
      for (int m = 0; m < 2; ++m)
#pragma unroll
        for (int k = 0; k < 4; ++k) af[m][k] = *(const bf16x8*)(wsa + (size_t)(g * 128 + wl * 32 + m * 16 + fr) * 128 + k * 32 + fq * 8);
      f32x4 acc[2][8];
#pragma unroll
      for (int m = 0; m < 2; ++m)
#pragma unroll
        for (int n = 0; n < 8; ++n) acc[m][n] = (f32x4){0.f, 0.f, 0.f, 0.f};
#pragma unroll
      for (int k = 0; k < 4; ++k)
#pragma unroll
        for (int n = 0; n < 8; ++n) { const bf16x8 bfr = *(const bf16x8*)(Tl + (16 * n + fr) * 136 + k * 32 + fq * 8);
          acc[0][n] = __builtin_amdgcn_mfma_f32_16x16x32_bf16(bfr, af[0][k], acc[0][n], 0, 0, 0);
          acc[1][n] = __builtin_amdgcn_mfma_f32_16x16x32_bf16(bfr, af[1][k], acc[1][n], 0, 0, 0); }
      if (live) {
#pragma unroll
        for (int m = 0; m < 2; ++m) { const int pp = wl * 32 + m * 16 + fr; const size_t t = (size_t)t0 + pp; const float bias = abs_[g * 128 + pp];
#pragma unroll
          for (int n = 0; n < 8; ++n) { const int c = g * 128 + 16 * n + 4 * fq;
            const u32x2 uu = *(const u32x2*)(proj + t * EVEN_IN + c);
            const float o0 = __uint_as_float(uu.x << 16) * (acc[m][n][0] + bias), o1 = __uint_as_float(uu.x & 0xffff0000u) * (acc[m][n][1] + bias);
            const float o2 = __uint_as_float(uu.y << 16) * (acc[m][n][2] + bias), o3 = __uint_as_float(uu.y & 0xffff0000u) * (acc[m][n][3] + bias);
            u32x2 w; w.x = cvtpk(o0, o1); w.y = cvtpk(o2, o3);
            *(u32x2*)(cat + t * D + c) = w; } }
      }
    }
  }
}
#undef KSWZ
#undef SBAR
}
#define REP_PREP 1
#define REP_NORM1 1
#define REP_IN0 1
#define REP_ATT0 1
#define REP_GMLP 1
#define REP_OUT0 1
#define REP_GU 1
#define REP_IN1 1
#define REP_ATT1 1
#define REP_SYNC 0
#define DRY_IN0 0
#define DRY_DOWN 0
#define DRY_GU 0
#define REP_ROUTER 1
#define REP_DOWN 1
#define REP_COMB 1
#define REPEAT(n, stmt) { int _n = (n); if ((n) > 1) asm volatile("" : "+s"(_n)); for (int _r = 0; _r < _n; ++_r) { stmt; if (_r + 1 < _n) GSYNC(); } }
__global__ __launch_bounds__(512) void mega(Params p0, PrepIn pin) {
  cg::grid_group grid = cg::this_grid();
  LAS unsigned char* lds = (LAS unsigned char*)smem;
  volatile LAS unsigned* xst = (volatile LAS unsigned*)(lds + SMEM_BYTES - 16);
  if (threadIdx.x == 0) { xst[0] = 0u; xst[1] = 0u; }
  ltid_init();
  XcdBarrier xb = xcd_barrier_post((unsigned*)(p0.ws + OFF_ZERO), xst);
  if (threadIdx.x == 0) { volatile LAS int* vbp = (volatile LAS int*)(lds + LDS_VBID); vbp[0] = (int)blockIdx.x;
    vbp[1] = (int)xb_add((unsigned*)(p0.ws + OFF_XRANK) + xb.x, 1u); }
#define GSYNC() xcd_barrier(xb)
#define ROUTER(c) { int _n = REP_ROUTER; if (REP_ROUTER > 1) asm volatile("" : "+s"(_n)); for (int _r = 0; _r < _n; ++_r) { \
      if (_r > 0) { if (blockIdx.x == 0 && threadIdx.x < 128) ((int*)(p0.ws + OFF_CNT))[c.l * 128 + threadIdx.x] = 0; GSYNC(); } \
      stage_router(launder(p0), c, smem); if (_r + 1 < _n) GSYNC(); } }
#define MOE_HALF(c, half, FUSE) do { \
    REPEAT(REP_GU, { const Params pl = launder(p0); fg::moe_tables(pl, c, half, 2, lds); int dry = (DRY_GU && _r > 0) ? DRY_GU : 0; if (DRY_GU) { asm volatile("" : "+v"(dry)); dry = __builtin_amdgcn_readfirstlane(dry); } fg::JobGU J(pl, c, half, lds, dry); fg::gemm_phase(lds, J); }) \
    GSYNC(); \
    { int _n = REP_DOWN; if (REP_DOWN > 1) asm volatile("" : "+s"(_n)); for (int _r = 0; _r < _n; ++_r) { float ds = _r == 0 ? 1.0f : (DRY_DOWN ? -1.0f : 0.0f); if (REP_DOWN > 1) { asm volatile("" : "+v"(ds)); ds = __int_as_float(__builtin_amdgcn_readfirstlane(__float_as_int(ds))); } \
        const Params pl = launder(p0); fg::moe_tables(pl, c, half, 4, lds); fg::JobDown J(pl, c, half, lds, ds); fg::gemm_phase(lds, J); if (_r + 1 < _n) GSYNC(); } } \
    GSYNC(); \
    { int _n = REP_COMB; if (REP_COMB > 1) asm volatile("" : "+s"(_n)); for (int _r = 0; _r < _n; ++_r) { float ds = _r == 0 ? 1.0f : 0.0f; if (REP_COMB > 1) asm volatile("" : "+v"(ds)); \
        stage_combine<FUSE>(launder(p0), c, half, smem, ds); if (_r + 1 < _n) GSYNC(); } } \
    } while (0)
  for (int _r = 0; _r < REP_PREP; ++_r) { stage_prep(p0, pin, smem); if (_r + 1 < REP_PREP) __syncthreads(); }
  grid.sync();
  if (threadIdx.x == 0) {
    bool ok = true; const unsigned per = gridDim.x >> 3;
    for (int j = 0; j < 16; ++j) { const unsigned c = xb_ld((unsigned*)(p0.ws + OFF_XRANK) + j); ok = ok && (c == (j < 8 ? per : 0u)); }
    volatile LAS int* vbp = (volatile LAS int*)(lds + LDS_VBID);
    if (ok && (gridDim.x & 7) == 0) vbp[0] = (int)xb.x + 8 * vbp[1]; }
  __syncthreads();
  REPEAT(REP_NORM1, stage_norm1<0>(launder(p0))) GSYNC();
  REPEAT(REP_IN0, { const Params pl = launder(p0); fg::load_rope_lds(pl, OFF_TAB64, 512, SM_BQN, SM_BKN, 64, lds); int dry = (DRY_IN0 && _r > 0) ? DRY_IN0 : 0; if (DRY_IN0) { asm volatile("" : "+v"(dry)); dry = __builtin_amdgcn_readfirstlane(dry); } fg::JobIn0 J(pl, dry); fg::gemm_phase(lds, J); })
  GSYNC();
  REPEAT(REP_ATT0, fa::phase_attn0(launder(p0), pin, smem))
  REPEAT(REP_GMLP, fa::phase_gmlp(launder(p0), smem))
  GSYNC();
  REPEAT(REP_OUT0, { const Params pl = launder(p0); fg::JobOut<0> J(pl); fg::gemm_phase(lds, J); })
  expert_prep_steal(launder(p0), pin, smem, 0);
  GSYNC();
  { const LCfg c{0, SB, 0, 16 * SB};
    ROUTER(c); GSYNC();
    MOE_HALF(c, 0, true); GSYNC(); }
  { int _n = REP_SYNC; if (REP_SYNC > 0) asm volatile("" : "+s"(_n)); for (int _r = 0; _r < _n; ++_r) GSYNC(); }
  REPEAT(REP_IN1, { const Params pl = launder(p0); fg::load_rope_lds(pl, OFF_TAB128, 1024, SM_CQN, SM_CKN, 128, lds); fg::JobIn1 J(pl); fg::gemm_phase(lds, J); })
  expert_prep_steal(launder(p0), pin, smem, 1);
  GSYNC();
  REPEAT(REP_ATT1, fa::phase_attn1(launder(p0), pin, smem))
  GSYNC();
  { const Params pl = launder(p0); fg::JobOut<1> J(pl); fg::gemm_phase(lds, J); }
  GSYNC();
  { const LCfg c{1, S, NC, 16 * S};
    ROUTER(c); GSYNC();
    MOE_HALF(c, 0, false); }
}

extern "C" void kernel_launch(void* const* d_in, const int* in_sizes, int n_in, void* d_out, int out_size, void* d_ws, size_t ws_size, hipStream_t stream) {
  static int grid_blocks = 0;
  if (!grid_blocks) {
    if (n_in != 33 || ws_size < WS_TOTAL) { fprintf(stderr, "kernel_launch: bad n_in %d or ws %zu < %zu\n", n_in, ws_size, (size_t)WS_TOTAL); return; }
    if (hipFuncSetAttribute((const void*)mega, hipFuncAttributeMaxDynamicSharedMemorySize, SMEM_BYTES) != hipSuccess) { fprintf(stderr, "set attr failed\n"); return; }
    int dev = 0, cus = 0, per_cu = 0;
    hipGetDevice(&dev); hipDeviceGetAttribute(&cus, hipDeviceAttributeMultiprocessorCount, dev);
    hipOccupancyMaxActiveBlocksPerMultiprocessor(&per_cu, mega, 512, SMEM_BYTES);
    if (per_cu < 1) { fprintf(stderr, "occupancy 0\n"); return; }
    grid_blocks = cus;
  }
  Params p; memset(&p, 0, sizeof(p)); PrepIn pin; memset(&pin, 0, sizeof(pin));
  for (int i = 0; i < 33; ++i) pin.in[i] = (const float*)d_in[i];
  p.out = (float*)d_out; p.ws = (unsigned char*)d_ws;
  p.x = pin.in[I_X]; p.ctx = pin.in[I_CTX];
  hipMemsetAsync(d_ws, 0, ZERO_BYTES, stream);
  void* args[] = {&p, &pin};
  hipError_t e = hipLaunchCooperativeKernel((void*)mega, dim3(grid_blocks), dim3(512), args, SMEM_BYTES, stream);
  if (e != hipSuccess) fprintf(stderr, "cooperative launch failed: %s (grid %d)\n", hipGetErrorString(e), grid_blocks);
}
```

```cpp
#include <hip/hip_runtime.h>
#include <hip/hip_cooperative_groups.h>
#include <cstdio>
#include <cstdint>
#include <cstring>
namespace cg = cooperative_groups;

#define DEVI __device__ __forceinline__
#define LAS __attribute__((address_space(3)))
typedef unsigned short bf16_t;
typedef short bf16x8 __attribute__((ext_vector_type(8)));
typedef float f32x4 __attribute__((ext_vector_type(4)));
typedef unsigned u32x4 __attribute__((ext_vector_type(4)));
typedef unsigned u32x2 __attribute__((ext_vector_type(2)));

constexpr int D = 1024, NB = 16, S = 2048, NC = 256, SB = 2304, T = NB * SB, TX = NB * S;
constexpr int NE = 64, TOPK = 6, DE = 256;
constexpr int EVEN_IN = 2560, ODD_IN = 1536;
constexpr float EPS = 1e-6f;

constexpr size_t al256(size_t x) { return (x + 255) & ~(size_t)255; }
constexpr size_t OFF_ZERO = 0, ZERO_BYTES = 65536;
constexpr size_t OFF_CNT = 16384;
constexpr size_t OFF_XRANK = 20608;
constexpr size_t OFF_STEAL = 20480;
constexpr size_t OFF_TAB64 = OFF_ZERO + ZERO_BYTES;
constexpr size_t OFF_TAB128 = OFF_TAB64 + 64 * 16 * 8;
constexpr size_t OFF_LAM = OFF_TAB128 + 64 * 32 * 8;
constexpr size_t OFF_MODV = al256(OFF_LAM + 256);
constexpr size_t OFF_SMALL = al256(OFF_MODV + (size_t)2 * 17 * 6144 * 4);
enum { SM_N1G = 0, SM_N2G = 2048, SM_ALNG = 4096, SM_ALNB = 4608, SM_ABS = 5120, SM_BQN = 5632, SM_BKN = 5696, SM_SUBLN = 5760, SM_CQN = 5888, SM_CKN = 6016, SM_MBIAS = 6144,
       SM_AWSF = 8192, SM_ROUTER = 73728, SM_END = 204800 };
constexpr size_t OFF_WIN0T = al256(OFF_SMALL + (size_t)SM_END * 4);
constexpr size_t OFF_WOUT0T = OFF_WIN0T + (size_t)EVEN_IN * D * 2;
constexpr size_t OFF_WQKV1T = OFF_WOUT0T + (size_t)D * D * 2;
constexpr size_t OFF_WOUT1T = OFF_WQKV1T + (size_t)ODD_IN * D * 2;
constexpr size_t OFF_WSA = OFF_WOUT1T + (size_t)D * D * 2;
constexpr size_t OFF_WRT = OFF_WSA + (size_t)4 * 128 * 128 * 2;
constexpr size_t OFF_SHGU = OFF_WRT + (size_t)2 * NE * D * 2;
constexpr size_t OFF_SHD = OFF_SHGU + (size_t)2 * 512 * D * 2;
constexpr size_t OFF_EGU = OFF_SHD + (size_t)2 * D * DE * 2;
constexpr size_t OFF_ED = OFF_EGU + (size_t)NE * 512 * D;
constexpr size_t OFF_HB = OFF_ED + (size_t)NE * D * DE;
constexpr size_t OFF_HC = OFF_HB;
constexpr size_t OFF_ACT = OFF_HB + (size_t)T * D * 2;
constexpr size_t OFF_TOPW = OFF_ACT + (size_t)T * D * 2;
constexpr size_t OFF_TOPP = al256(OFF_TOPW + (size_t)T * 6 * 4);
constexpr size_t OFF_LIST = al256(OFF_TOPP + (size_t)T * 6 * 4);
constexpr int LCAP = 36864;
constexpr size_t OFF_R = al256(OFF_LIST + (size_t)NE * LCAP * 4);
constexpr size_t OFF_PROJ = OFF_R;
constexpr size_t OFF_SLOT = OFF_R;
constexpr size_t OFF_HID = al256(OFF_SLOT + (size_t)258048 * D);
constexpr size_t OFF_ACT8 = al256(OFF_HID + (size_t)(258048 + 256) * DE);
constexpr size_t WS_TOTAL = OFF_ACT8 + (size_t)T * D;
static_assert(OFF_HID >= OFF_R + (size_t)0, "layout");
static_assert(OFF_R + (size_t)T * EVEN_IN * 2 <= WS_TOTAL, "proj fits");
static_assert(WS_TOTAL <= 636368384ull, "workspace budget");

struct Params {
  float* out;
  unsigned char* ws;
  const float* x; const float* ctx;
};
struct PrepIn { const float* in[33]; };
typedef __attribute__((address_space(1))) unsigned char* gptr_t;
__device__ __forceinline__ Params launder(const Params& p) {
  unsigned long long a = (unsigned long long)p.out, b = (unsigned long long)p.ws, c = (unsigned long long)p.x, d = (unsigned long long)p.ctx;
  asm volatile("" : "+s"(a), "+s"(b), "+s"(c), "+s"(d));
  Params q; q.out = (float*)(gptr_t)a; q.ws = (unsigned char*)(gptr_t)b; q.x = (const float*)(gptr_t)c; q.ctx = (const float*)(gptr_t)d; return q; }
enum { I_X = 0, I_C, I_CTX, I_CCTX, I_MODW, I_MODB, I_N1G, I_N2G, I_EVWIN, I_EVWOUT, I_ALNG, I_ALNB, I_AWS, I_ABS, I_BQN, I_BKN,
       I_LQ1, I_LK1, I_LQ2, I_LK2, I_SUBLN, I_ODQKV, I_ODOUT, I_CQN, I_CKN, I_ROUTER, I_MBIAS, I_WG, I_WU, I_WD, I_SG, I_SU, I_SD };

extern __shared__ __attribute__((aligned(16))) unsigned char smem[];
constexpr int SMEM_BYTES = 152 * 1024;
constexpr int LDS_WTAB = SMEM_BYTES - 512;
DEVI int ltid() {
  const unsigned slot = (unsigned)__builtin_amdgcn_s_getreg(63492) & 0x3fu;
  const int wv = __builtin_amdgcn_readfirstlane(*(volatile LAS int*)((LAS unsigned char*)smem + LDS_WTAB + slot * 4));
  int l; asm volatile("v_mbcnt_lo_u32_b32 %0, -1, 0\n\tv_mbcnt_hi_u32_b32 %0, -1, %0" : "=v"(l));
  return wv * 64 + l;
}
constexpr int LDS_VBID = LDS_WTAB + 256;
DEVI int vbid() { return __builtin_amdgcn_readfirstlane(*(volatile LAS int*)((LAS unsigned char*)smem + LDS_VBID)); }
DEVI void ltid_init() {
  const unsigned slot = (unsigned)__builtin_amdgcn_s_getreg(63492) & 0x3fu;
  if ((threadIdx.x & 63) == 0) *(volatile LAS int*)((LAS unsigned char*)smem + LDS_WTAB + slot * 4) = (int)(threadIdx.x >> 6);
  __syncthreads();
}
template <int M> DEVI float shx(float v) { static_assert(M == 1 || M == 2 || M == 4 || M == 8 || M == 16, "xor mask");
  return __int_as_float(__builtin_amdgcn_ds_swizzle(__float_as_int(v), (M << 10) | 0x1f)); }
template <int CTRL> DEVI float dppf(float v) { return __int_as_float(__builtin_amdgcn_update_dpp(0, __float_as_int(v), CTRL, 0xf, 0xf, true)); }
DEVI float rlane(float v, int l) { return __int_as_float(__builtin_amdgcn_readlane(__float_as_int(v), l)); }
DEVI float wsum_dpp(float v) { v += dppf<0xB1>(v); v += dppf<0x4E>(v); v += dppf<0x141>(v); v += dppf<0x140>(v); return (rlane(v, 0) + rlane(v, 16)) + (rlane(v, 32) + rlane(v, 48)); }
DEVI float wmax_dpp(float v) { v = fmaxf(v, dppf<0xB1>(v)); v = fmaxf(v, dppf<0x4E>(v)); v = fmaxf(v, dppf<0x141>(v)); v = fmaxf(v, dppf<0x140>(v)); return fmaxf(fmaxf(rlane(v, 0), rlane(v, 16)), fmaxf(rlane(v, 32), rlane(v, 48))); }
DEVI float max8_dpp(float v) { v = fmaxf(v, dppf<0xB1>(v)); v = fmaxf(v, dppf<0x4E>(v)); return fmaxf(v, dppf<0x141>(v)); }
DEVI float sum32x(float v) { auto r = __builtin_amdgcn_permlane32_swap(__float_as_uint(v), __float_as_uint(v), false, false); return __uint_as_float(r[0]) + __uint_as_float(r[1]); }
DEVI float max32x(float v) { auto r = __builtin_amdgcn_permlane32_swap(__float_as_uint(v), __float_as_uint(v), false, false); return fmaxf(__uint_as_float(r[0]), __uint_as_float(r[1])); }
DEVI bf16_t f2bf(float f) { unsigned u = __float_as_uint(f); u += 0x7FFFu + ((u >> 16) & 1u); return (bf16_t)(u >> 16); }
DEVI float bf2f(bf16_t b) { return __uint_as_float(((unsigned)b) << 16); }
DEVI unsigned pack2(float lo, float hi) { return (unsigned)f2bf(lo) | ((unsigned)f2bf(hi) << 16); }
DEVI float wsum(float v) { v += shx<1>(v); v += shx<2>(v); v += shx<4>(v); v += shx<8>(v); v += shx<16>(v); return sum32x(v); }
DEVI float wmax(float v) { v = fmaxf(v, shx<1>(v)); v = fmaxf(v, shx<2>(v)); v = fmaxf(v, shx<4>(v)); v = fmaxf(v, shx<8>(v)); v = fmaxf(v, shx<16>(v)); return max32x(v); }
DEVI float gelu_exact(float v) { return 0.5f * v * (1.0f + erff(v * 0.70710678118654752f)); }
DEVI float silu(float v) { return v / (1.0f + __expf(-v)); }

template <class Tp> DEVI Tp* wsp(const Params& p, size_t off) { return (Tp*)(p.ws + off); }
DEVI const float* sm(const Params& p, int off) { return (const float*)(p.ws + OFF_SMALL) + off; }
DEVI const float* in_row(const Params& p, int t) { int b = t / SB, j = t - b * SB;
  unsigned long long xa = (unsigned long long)p.x, ca = (unsigned long long)p.ctx; asm volatile("" : "+s"(xa), "+s"(ca));
  const float* xp = (const float*)(gptr_t)xa; const float* cp = (const float*)(gptr_t)ca;
  return j < NC ? cp + ((size_t)(b * NC + j)) * D : xp + ((size_t)(b * S + j - NC)) * D; }
DEVI f32x4 bf4(u32x2 r) { return (f32x4){__uint_as_float(r.x << 16), __uint_as_float(r.x & 0xffff0000u), __uint_as_float(r.y << 16), __uint_as_float(r.y & 0xffff0000u)}; }
DEVI float* hid_row(const Params& p, int t) { int b = t / SB, j = t - b * SB;
  return j < NC ? wsp<float>(p, OFF_HC) + ((size_t)(b * NC + j)) * D : p.out + ((size_t)(b * S + j - NC)) * D; }
DEVI const float* modv(const Params& p, int l, int t, int which) { int b = t / SB, j = t - b * SB; int r = j < NC ? 16 : b;
  return wsp<float>(p, OFF_MODV) + ((size_t)(l * 17 + r)) * 6144 + which * D; }

#define XB_TMO      128
#define XB_XCNT(j)  (256  + 64 * (j))
#define XB_XSUB(j)  (1280 + 64 * (j))
#define XB_XGEN(j)  (2304 + 64 * (j))
#define XB_TOP      3328
#define XB_TOPGEN   3392
#define XCD_BAR_WORDS 3456
#define XB_SPIN_CAP (1u << 22)
DEVI unsigned xb_ld(unsigned* p) { return __hip_atomic_load(p, __ATOMIC_RELAXED, __HIP_MEMORY_SCOPE_AGENT); }
DEVI unsigned xb_add(unsigned* p, unsigned v) { return __hip_atomic_fetch_add(p, v, __ATOMIC_RELAXED, __HIP_MEMORY_SCOPE_AGENT); }
DEVI unsigned xb_xcc_id() { return (unsigned)__builtin_amdgcn_s_getreg((3 << 11) | 20) & 0xFu; }
#define XB_SPIN(cond, bar) do { unsigned _sp = 0; while (cond) { __builtin_amdgcn_s_sleep(1); \
    if ((++_sp & 255u) == 0u) { if (xb_ld(&(bar)[XB_TMO])) break; if (_sp > XB_SPIN_CAP) { atomicAdd(&(bar)[XB_TMO], 1u); break; } } } } while (0)
struct XcdBarrier { unsigned* bar; unsigned x; volatile LAS unsigned* st; };
DEVI XcdBarrier xcd_barrier_post(unsigned* bar, volatile LAS unsigned* st) {
  XcdBarrier b; b.bar = bar; b.x = xb_xcc_id(); b.st = st;
  if (ltid() == 0) (void)xb_add(&bar[XB_XCNT(b.x)], 1u);
  return b;
}
DEVI void xcd_barrier_complete(unsigned* bar, unsigned x, unsigned& nloc, unsigned& nx) {
  const unsigned G = gridDim.x * gridDim.y * gridDim.z;
  unsigned sum, cnt, mine, sp = 0u;
  for (;;) {
    sum = 0u; cnt = 0u; mine = 0u;
#pragma unroll
    for (unsigned j = 0; j < 16; ++j) { const unsigned c = xb_ld(&bar[XB_XCNT(j)]); sum += c; cnt += (c > 0u) ? 1u : 0u; mine = (j == x) ? c : mine; }
    if (sum == G) break;
    __builtin_amdgcn_s_sleep(1);
    if ((++sp & 255u) == 0u) { if (xb_ld(&bar[XB_TMO])) break; if (sp > XB_SPIN_CAP) { atomicAdd(&bar[XB_TMO], 1u); break; } }
  }
  nloc = mine > 0u ? mine : 1u; nx = cnt > 0u ? cnt : 1u;
}
DEVI void xcd_barrier(const XcdBarrier& b) {
  asm volatile("s_waitcnt vmcnt(0)" ::: "memory");
  __syncthreads();
  if (ltid() == 0) {
    unsigned* bar = b.bar;
    __builtin_amdgcn_s_waitcnt(0);
    unsigned nloc = b.st[0], nx = b.st[1];
    if (nloc == 0u) { xcd_barrier_complete(bar, b.x, nloc, nx); b.st[0] = nloc; b.st[1] = nx; }
    const unsigned old = xb_add(&bar[XB_XSUB(b.x)], 1u);
    const unsigned gen = old / nloc;
    if (old + 1u == (gen + 1u) * nloc) {
      __builtin_amdgcn_fence(__ATOMIC_RELEASE, "agent");
      asm volatile("s_waitcnt vmcnt(0)" ::: "memory");
      const unsigned og = xb_add(&bar[XB_TOP], 1u);
      const unsigned tg = og / nx;
      if (og + 1u == (tg + 1u) * nx) xb_add(&bar[XB_TOPGEN], 1u);
      else XB_SPIN(xb_ld(&bar[XB_TOPGEN]) == tg, bar);
      __builtin_amdgcn_fence(__ATOMIC_ACQUIRE, "agent");
      xb_add(&bar[XB_XGEN(b.x)], 1u);
      asm volatile("s_waitcnt vmcnt(0)" ::: "memory");
    } else {
      XB_SPIN(xb_ld(&bar[XB_XGEN(b.x)]) == gen, bar);
      __builtin_amdgcn_fence(__ATOMIC_ACQUIRE, "agent");
      asm volatile("s_waitcnt vmcnt(0)" ::: "memory");
    }
  }
  __syncthreads();
}

DEVI void transpose_tiles(const float* srcb, unsigned char* dstb, int K, int N, int nb, size_t sstride, size_t dstride, unsigned char* smem, int& goff) {
  const int G = gridDim.x, tk = K / 128, tn = N / 256, per = tk * tn, total = per * nb, tid = ltid();
  const int first = (((int)blockIdx.x - goff) % G + G) % G;
  const int n4 = tid & 63, kp0 = tid >> 6;
  f32x4 va[8], vb[8];
  auto issue = [&](int ti) { const int m = ti / per, r = ti - m * per, kb = r / tn, nb_ = r - kb * tn;
    const float* src = srcb + (size_t)m * sstride + (size_t)(kb * 128) * N + nb_ * 256 + n4 * 4;
#pragma unroll
    for (int i = 0; i < 8; ++i) { const int kp = kp0 + 8 * i; va[i] = __builtin_nontemporal_load((const f32x4*)(src + (size_t)(2 * kp) * N)); vb[i] = __builtin_nontemporal_load((const f32x4*)(src + (size_t)(2 * kp + 1) * N)); } };
  if (first < total) issue(first);
  int par = 0;
  for (int ti = first; ti < total; ti += G, par ^= 1) {
    unsigned* Tb = (unsigned*)smem + par * 16384;
#pragma unroll
    for (int i = 0; i < 8; ++i) { const int kp = kp0 + 8 * i;
#pragma unroll
      for (int j = 0; j < 4; ++j) { const int n = n4 * 4 + j; Tb[n * 64 + (kp ^ (((n >> 2) & 7) << 2))] = pack2(va[i][j], vb[i][j]); } }
    if (ti + G < total) issue(ti + G);
    __syncthreads();
    const int m = ti / per, r = ti - m * per, kb = r / tn, nb_ = r - kb * tn;
    bf16_t* dst = (bf16_t*)dstb + (size_t)m * dstride + (size_t)(nb_ * 256) * K + kb * 128;
#pragma unroll
    for (int i = 0; i < 8; ++i) { const int pc = tid + 512 * i, n = pc >> 4, q = pc & 15;
      const u32x4 w = *(const u32x4*)(Tb + n * 64 + ((4 * q) ^ (((n >> 2) & 7) << 2)));
      *(u32x4*)(dst + (size_t)n * K + 8 * q) = w; }
  }
  __syncthreads();
  goff = (goff + total) % G;
}

constexpr int WD_SHIFT = 4, H_SHIFT = 2, WG_SHIFT = 5, X_SHIFT = 3, WQ_SHIFT = 5;
constexpr bool IN1_FP8 = true, IN0_FP8 = true, OUT0_FP8 = true, OUT1_FP8 = true;
constexpr int A_SHIFT = 3;
DEVI void transpose_panel8(const float* src0, unsigned char* dst0, int K, int N, int kb, int nb_, unsigned char* smem, int shift = WD_SHIFT) {
  const int tid = ltid(), n4 = tid & 63, kq0 = tid >> 6; unsigned* Tb = (unsigned*)smem;
  const float* src = src0 + (size_t)(kb * 128) * N + nb_ * 256 + n4 * 4; unsigned char* dst = dst0 + (size_t)(nb_ * 256) * K + kb * 128;
  f32x4 v[4][4];
#pragma unroll
  for (int i = 0; i < 4; ++i)
#pragma unroll
    for (int r = 0; r < 4; ++r) v[i][r] = __builtin_nontemporal_load((const f32x4*)(src + (size_t)(4 * (kq0 + 8 * i) + r) * N));
  const float sc = (float)(1 << shift);
#pragma unroll
  for (int i = 0; i < 4; ++i) { const int kq = kq0 + 8 * i;
#pragma unroll
    for (int j = 0; j < 4; ++j) { const int n = n4 * 4 + j; int w = 0;
      w = __builtin_amdgcn_cvt_pk_fp8_f32(v[i][0][j] * sc, v[i][1][j] * sc, w, false); w = __builtin_amdgcn_cvt_pk_fp8_f32(v[i][2][j] * sc, v[i][3][j] * sc, w, true);
      Tb[n * 32 + (kq ^ (((n >> 2) & 7) << 2))] = (unsigned)w; } }
  __syncthreads();
#pragma unroll
  for (int i = 0; i < 4; ++i) { const int pc = tid + 512 * i, n = pc >> 3, q = pc & 7;
    const u32x4 w = *(const u32x4*)(Tb + n * 32 + ((4 * q) ^ (((n >> 2) & 7) << 2)));
    *(u32x4*)(dst + (size_t)n * K + 16 * q) = w; }
}
DEVI void transpose_all8(const float* src, unsigned char* dst, int K, int N, int shift, unsigned char* smem, int& goff) {
  const int G = gridDim.x, tk = K / 128, tn = N / 256, total = tk * tn;
  const int first = (((int)blockIdx.x - goff) % G + G) % G;
  for (int ti = first; ti < total; ti += G) { __syncthreads(); const int kb = ti / tn, nb_ = ti - kb * tn; transpose_panel8(src, dst, K, N, kb, nb_, smem, shift); }
  __syncthreads();
  goff = (goff + total) % G;
}
DEVI void stage_prep(const Params& p, const PrepIn& pin, unsigned char* smem) {
  const int tid = ltid(), bid = blockIdx.x, G = gridDim.x;
  {
    float* sl = (float*)smem;
    for (int i = tid; i < 17 * 1024; i += 512) { int r = i >> 10, k = i & 1023; float v; if (r < 16) v = pin.in[I_C][r * 1024 + k]; else v = pin.in[I_CCTX][k]; sl[i] = silu(v); }
    __syncthreads();
    float* part = (float*)(smem + 17 * 1024 * 4);
    for (int cb = bid; cb < 256; cb += G) {
      const int col0 = cb * 48;
      if (tid < 384) {
        const int kc = tid / 48, c = tid - kc * 48, gc = col0 + c, l = gc / 6144, n = gc - l * 6144;
        const float* w = pin.in[I_MODW] + (size_t)l * 1024 * 6144 + n;
        float acc[17];
#pragma unroll
        for (int r = 0; r < 17; ++r) acc[r] = 0.f;
        for (int k = kc * 128; k < kc * 128 + 128; ++k) { float wv = w[(size_t)k * 6144];
#pragma unroll
          for (int r = 0; r < 17; ++r) acc[r] += sl[r * 1024 + k] * wv; }
#pragma unroll
        for (int r = 0; r < 17; ++r) part[(kc * 17 + r) * 48 + c] = acc[r];
      }
      __syncthreads();
      for (int i = tid; i < 17 * 48; i += 512) { int r = i / 48, c = i - r * 48, gc = col0 + c, l = gc / 6144, n = gc - l * 6144;
        float s = pin.in[I_MODB][l * 6144 + n];
        for (int kc = 0; kc < 8; ++kc) s += part[(kc * 17 + r) * 48 + c];
        wsp<float>(p, OFF_MODV)[((size_t)(l * 17 + r)) * 6144 + n] = s; }
      __syncthreads();
    }
  }
  if (bid == 0) {
    float2* t64 = wsp<float2>(p, OFF_TAB64); float2* t128 = wsp<float2>(p, OFF_TAB128);
    for (int i = tid; i < 64 * 16; i += 512) { int pos = i >> 4, f = i & 15; float inv = exp2f(-(float)f * (13.287712379549449f / 16.0f)); float a = (float)pos * inv; t64[i] = make_float2(__cosf(a), __sinf(a)); }
    for (int i = tid; i < 64 * 32; i += 512) { int pos = i >> 5, f = i & 31; float inv = exp2f(-(float)f * (13.287712379549449f / 32.0f)); float a = (float)pos * inv; t128[i] = make_float2(__cosf(a), __sinf(a)); }
    if (tid < 64) { float a = pin.in[I_LQ1][tid] * pin.in[I_LK1][tid], b = pin.in[I_LQ2][tid] * pin.in[I_LK2][tid]; a = wsum(a); b = wsum(b);
      if (tid == 0) wsp<float>(p, OFF_LAM)[0] = expf(a) - expf(b) + 0.2f; }
  }
  { float* smw = wsp<float>(p, OFF_SMALL); const int gt = bid * 512 + tid, gs = G * 512;
#define CPY(idx, off, n) for (int i = gt; i < (n); i += gs) smw[(off) + i] = pin.in[idx][i];
    CPY(I_N1G, SM_N1G, 2048) CPY(I_N2G, SM_N2G, 2048) CPY(I_ALNG, SM_ALNG, 512) CPY(I_ALNB, SM_ALNB, 512) CPY(I_ABS, SM_ABS, 512) CPY(I_BQN, SM_BQN, 64) CPY(I_BKN, SM_BKN, 64)
    CPY(I_SUBLN, SM_SUBLN, 128) CPY(I_CQN, SM_CQN, 128) CPY(I_CKN, SM_CKN, 128) CPY(I_MBIAS, SM_MBIAS, 128) CPY(I_AWS, SM_AWSF, 65536) CPY(I_ROUTER, SM_ROUTER, 131072)
#undef CPY
  }
  for (int i = bid * 512 + tid; i < 2 * NE * D; i += G * 512) { const int l = i >> 16, e = (i >> 10) & 63, kk = i & 1023; wsp<bf16_t>(p, OFF_WRT)[i] = f2bf(pin.in[I_ROUTER][((size_t)l * D + kk) * NE + e]); }
  for (int i = bid * 512 + tid; i < 4 * 128 * 128; i += G * 512) wsp<bf16_t>(p, OFF_WSA)[i] = f2bf(pin.in[I_AWS][i]);
  int goff = 0;
  const size_t EW = (size_t)D * DE;
  __syncthreads();
  if (IN0_FP8) transpose_all8(pin.in[I_EVWIN], p.ws + OFF_WIN0T, D, EVEN_IN, WQ_SHIFT, smem, goff);
  else transpose_tiles(pin.in[I_EVWIN], p.ws + OFF_WIN0T, D, EVEN_IN, 1, 0, 0, smem, goff);
  if (OUT0_FP8) transpose_all8(pin.in[I_EVWOUT], p.ws + OFF_WOUT0T, D, D, WQ_SHIFT, smem, goff);
  else transpose_tiles(pin.in[I_EVWOUT], p.ws + OFF_WOUT0T, D, D, 1, 0, 0, smem, goff);
  if (IN1_FP8) transpose_all8(pin.in[I_ODQKV], p.ws + OFF_WQKV1T, D, ODD_IN, WQ_SHIFT, smem, goff);
  else transpose_tiles(pin.in[I_ODQKV], p.ws + OFF_WQKV1T, D, ODD_IN, 1, 0, 0, smem, goff);
  if (OUT1_FP8) transpose_all8(pin.in[I_ODOUT], p.ws + OFF_WOUT1T, D, D, WQ_SHIFT, smem, goff);
  else transpose_tiles(pin.in[I_ODOUT], p.ws + OFF_WOUT1T, D, D, 1, 0, 0, smem, goff);
  for (int pi = bid; pi < 32; pi += G) { __syncthreads(); const int l = pi >> 4, up = (pi >> 3) & 1, kb = pi & 7;
    const float* sgu; if (up) sgu = pin.in[I_SU]; else sgu = pin.in[I_SG]; asm volatile("" : "+s"(sgu));
    transpose_panel8(sgu + (size_t)l * EW, p.ws + OFF_SHGU + (size_t)l * 512 * D + (size_t)up * 256 * D, D, DE, kb, 0, smem, WG_SHIFT); }
  __syncthreads();
  for (int pi = bid; pi < 16; pi += G) { __syncthreads(); const int l = pi >> 3, rr = pi & 7; transpose_panel8(pin.in[I_SD] + (size_t)l * EW, p.ws + OFF_SHD + (size_t)l * EW, DE, D, rr >> 2, rr & 3, smem); }
  __syncthreads();
}
DEVI void transpose_panel(const float* src0, bf16_t* dst0, int K, int N, int kb, int nb_, unsigned char* smem) {
  const int tid = ltid(), n4 = tid & 63, kp0 = tid >> 6; unsigned* Tb = (unsigned*)smem;
  const float* src = src0 + (size_t)(kb * 128) * N + nb_ * 256 + n4 * 4; bf16_t* dst = dst0 + (size_t)(nb_ * 256) * K + kb * 128;
  f32x4 va[8], vb[8];
#pragma unroll
  for (int i = 0; i < 8; ++i) { const int kp = kp0 + 8 * i; va[i] = __builtin_nontemporal_load((const f32x4*)(src + (size_t)(2 * kp) * N)); vb[i] = __builtin_nontemporal_load((const f32x4*)(src + (size_t)(2 * kp + 1) * N)); }
#pragma unroll
  for (int i = 0; i < 8; ++i) { const int kp = kp0 + 8 * i;
#pragma unroll
    for (int j = 0; j < 4; ++j) { const int n = n4 * 4 + j; Tb[n * 64 + (kp ^ (((n >> 2) & 7) << 2))] = pack2(va[i][j], vb[i][j]); } }
  __syncthreads();
#pragma unroll
  for (int i = 0; i < 8; ++i) { const int pc = tid + 512 * i, n = pc >> 4, q = pc & 15;
    const u32x4 w = *(const u32x4*)(Tb + n * 64 + ((4 * q) ^ (((n >> 2) & 7) << 2)));
    *(u32x4*)(dst + (size_t)n * K + 8 * q) = w; }
}
DEVI void expert_prep_steal(const Params& p, const PrepIn& pin, unsigned char* smem, int layer) {
  const size_t EW = (size_t)D * DE, lo = (size_t)layer * NE * EW; int* ctr = (int*)(p.ws + OFF_STEAL) + layer; int* bc = (int*)(smem + 65536);
  for (;;) {
    __syncthreads();
    if (ltid() == 0) bc[0] = atomicAdd(ctr, 1);
    __syncthreads();
    const int idx = bc[0]; if (idx >= 3 * 512) break;
    const int j = idx >> 9, r = idx & 511, m = r >> 3, rr = r & 7;
    if (j == 0) transpose_panel8(pin.in[I_WG] + lo + (size_t)m * EW, p.ws + OFF_EGU + (size_t)m * 512 * D, D, DE, rr, 0, smem, WG_SHIFT);
    else if (j == 1) transpose_panel8(pin.in[I_WU] + lo + (size_t)m * EW, p.ws + OFF_EGU + (size_t)m * 512 * D + (size_t)256 * D, D, DE, rr, 0, smem, WG_SHIFT);
    else transpose_panel8(pin.in[I_WD] + lo + (size_t)m * EW, p.ws + OFF_ED + (size_t)m * EW, DE, D, rr >> 2, rr & 3, smem);
  }
}
DEVI void stage_prep_experts(const Params& p, const PrepIn& pin, unsigned char* smem, int layer) {
  int goff = 0; const size_t EW = (size_t)D * DE, lo = (size_t)layer * NE * EW;
  __syncthreads();
  transpose_tiles(pin.in[I_WG] + lo, p.ws + OFF_EGU, D, DE, 64, EW, (size_t)512 * D, smem, goff);
  transpose_tiles(pin.in[I_WU] + lo, p.ws + OFF_EGU + (size_t)256 * D * 2, D, DE, 64, EW, (size_t)512 * D, smem, goff);
  transpose_tiles(pin.in[I_WD] + lo, p.ws + OFF_ED, DE, D, 64, EW, EW, smem, goff);
  __syncthreads();
}

template <int LAYER> DEVI void stage_norm1(const Params& p) {
  const int wid = ltid() >> 6, lane = ltid() & 63;
  const float* g = sm(p, SM_N1G + LAYER * D);
  bf16_t* act = wsp<bf16_t>(p, OFF_ACT);
  for (int t = blockIdx.x * 8 + wid; t < T; t += gridDim.x * 8) {
    const float* row = LAYER == 0 ? in_row(p, t) : (const float*)hid_row(p, t);
    const float* sh = modv(p, LAYER, t, 0); const float* sc = modv(p, LAYER, t, 1);
    f32x4 v[4]; float ss = 0.f;
#pragma unroll
    for (int i = 0; i < 4; ++i) { v[i] = *(const f32x4*)(row + (i * 64 + lane) * 4); ss += v[i][0] * v[i][0] + v[i][1] * v[i][1] + v[i][2] * v[i][2] + v[i][3] * v[i][3]; }
    ss = wsum(ss); const float rstd = rsqrtf(ss * (1.0f / D) + EPS);
#pragma unroll
    for (int i = 0; i < 4; ++i) { const int c = (i * 64 + lane) * 4; const f32x4 gg = *(const f32x4*)(g + c), s1 = *(const f32x4*)(sc + c), s0 = *(const f32x4*)(sh + c);
      float y[4];
#pragma unroll
      for (int q = 0; q < 4; ++q) y[q] = v[i][q] * rstd * gg[q] * (1.0f + s1[q]) + s0[q];
      if ((LAYER == 0 && IN0_FP8) || (LAYER == 1 && IN1_FP8)) { const float xs = (float)(1 << X_SHIFT); int w8 = 0;
        w8 = __builtin_amdgcn_cvt_pk_fp8_f32(__builtin_amdgcn_fmed3f(y[0] * xs, -440.f, 440.f), __builtin_amdgcn_fmed3f(y[1] * xs, -440.f, 440.f), w8, false);
        w8 = __builtin_amdgcn_cvt_pk_fp8_f32(__builtin_amdgcn_fmed3f(y[2] * xs, -440.f, 440.f), __builtin_amdgcn_fmed3f(y[3] * xs, -440.f, 440.f), w8, true);
        *(int*)(p.ws + OFF_ACT8 + (size_t)t * D + c) = w8; }
      else { u32x2 w; w.x = pack2(y[0], y[1]); w.y = pack2(y[2], y[3]);
        *(u32x2*)(act + (size_t)t * D + c) = w; } }
  }
}

template <class GA, class GB, class ST>
DEVI void ngemm(int MT, int NT, int K, GA getA, GB getB, ST store) {
  const int wid = ltid() >> 6, lane = ltid() & 63, fr = lane & 15, fq = lane >> 4;
  const long nw = (long)gridDim.x * 8;
  for (long tile = (long)blockIdx.x * 8 + wid; tile < (long)MT * NT; tile += nw) {
    const int tm = (int)(tile / NT), tn = (int)(tile - (long)tm * NT);
    const bf16_t* a0 = getA(tm * 32 + fr); const bf16_t* a1 = getA(tm * 32 + 16 + fr);
    const bf16_t* b0 = getB(tn * 32 + fr); const bf16_t* b1 = getB(tn * 32 + 16 + fr);
    f32x4 c00 = {0.f, 0.f, 0.f, 0.f}, c01 = c00, c10 = c00, c11 = c00;
    const bf16x8 z = {0, 0, 0, 0, 0, 0, 0, 0};
    for (int k = 0; k < K; k += 32) {
      const bf16x8 A0 = a0 ? *(const bf16x8*)(a0 + k + fq * 8) : z, A1 = a1 ? *(const bf16x8*)(a1 + k + fq * 8) : z;
      const bf16x8 B0 = *(const bf16x8*)(b0 + k + fq * 8), B1 = *(const bf16x8*)(b1 + k + fq * 8);
      c00 = __builtin_amdgcn_mfma_f32_16x16x32_bf16(A0, B0, c00, 0, 0, 0);
      c01 = __builtin_amdgcn_mfma_f32_16x16x32_bf16(A0, B1, c01, 0, 0, 0);
      c10 = __builtin_amdgcn_mfma_f32_16x16x32_bf16(A1, B0, c10, 0, 0, 0);
      c11 = __builtin_amdgcn_mfma_f32_16x16x32_bf16(A1, B1, c11, 0, 0, 0);
    }
#pragma unroll
    for (int j = 0; j < 4; ++j) {
      store(tm * 32 + fq * 4 + j, tn * 32 + fr, tn * 32 + 16 + fr, c00[j], c01[j]);
      store(tm * 32 + 16 + fq * 4 + j, tn * 32 + fr, tn * 32 + 16 + fr, c10[j], c11[j]);
    }
  }
}

DEVI void n_inproj0(const Params& p) {
  const bf16_t* act = wsp<bf16_t>(p, OFF_ACT); const bf16_t* w = wsp<bf16_t>(p, OFF_WIN0T); bf16_t* proj = wsp<bf16_t>(p, OFF_PROJ);
  ngemm(T / 32, EVEN_IN / 32, D,
        [&](int r) { return act + (size_t)r * D; }, [&](int n) { return w + (size_t)n * D; },
        [&](int r, int n0, int n1, float v0, float v1) { proj[(size_t)r * EVEN_IN + n0] = f2bf(v0); proj[(size_t)r * EVEN_IN + n1] = f2bf(v1); });
}
DEVI void n_post0(const Params& p) {
  const int wid = ltid() >> 6, lane = ltid() & 63;
  bf16_t* proj = wsp<bf16_t>(p, OFF_PROJ); const float2* t64 = wsp<float2>(p, OFF_TAB64);
  for (int t = blockIdx.x * 8 + wid; t < T; t += gridDim.x * 8) {
    bf16_t* row = proj + (size_t)t * EVEN_IN; const int b = t / SB, j = t - b * SB;
    for (int i = 0; i < 16; ++i) { int c = i * 64 + lane; row[c] = f2bf(gelu_exact(bf2f(row[c]))); }
    for (int hh = 0; hh < 16; ++hh) {
      const int c = 1024 + hh * 64 + lane; float v = bf2f(row[c]);
      float ss = wsum(v * v); float g = sm(p, hh < 8 ? SM_BQN : SM_BKN)[lane];
      float y = v * rsqrtf(ss * (1.0f / 64) + EPS) * g;
      y = bf2f(f2bf(y));
      if (j >= NC) { const int pos = j - NC, pr = lane >> 1; const int ps = pr < 16 ? (pos >> 6) : (pos & 63); const float2 cs = t64[ps * 16 + (pr & 15)];
        const float other = shx<1>(y);
        y = (lane & 1) ? (other * cs.y + y * cs.x) : (y * cs.x - other * cs.y); }
      row[c] = f2bf(y);
    }
  }
}

DEVI void attn_row(const bf16_t* q, int dq, const bf16_t* kb, int ldk, const bf16_t* vb, int ldv, int nkeys, float scale,
                   volatile float* sc, volatile float* qs, float& o0, float& o1) {
  const int lane = ltid() & 63;
  for (int d = lane; d < dq; d += 64) qs[d] = bf2f(q[d]);
  float mx = -1e30f;
  for (int key = lane; key < nkeys; key += 64) { const bf16_t* kr = kb + (size_t)key * ldk; float dot = 0.f;
    for (int d = 0; d < dq; d += 8) { const bf16x8 kv = *(const bf16x8*)(kr + d);
#pragma unroll
      for (int e = 0; e < 8; ++e) dot += qs[d + e] * bf2f((bf16_t)kv[e]); }
    dot *= scale; sc[key] = dot; mx = fmaxf(mx, dot); }
  mx = wmax(mx); float sum = 0.f;
  for (int key = lane; key < nkeys; key += 64) { float pv = __expf(sc[key] - mx); sc[key] = pv; sum += pv; }
  sum = wsum(sum); float a0 = 0.f, a1 = 0.f;
  for (int key = 0; key < nkeys; ++key) { const float pv = sc[key]; const unsigned vv = *(const unsigned*)(vb + (size_t)key * ldv + 2 * lane);
    a0 += pv * bf2f((bf16_t)(vv & 0xffff)); a1 += pv * bf2f((bf16_t)(vv >> 16)); }
  const float inv = 1.0f / sum; o0 = a0 * inv; o1 = a1 * inv;
}
DEVI void n_attn0(const Params& p, unsigned char* smem) {
  const int wid = ltid() >> 6, lane = ltid() & 63;
  volatile float* sc = (volatile float*)(smem + wid * (2304 * 4 + 512)); volatile float* qs = sc + 2304;
  const bf16_t* proj = wsp<bf16_t>(p, OFF_PROJ); bf16_t* cat = wsp<bf16_t>(p, OFF_ACT);
  const float lam = wsp<float>(p, OFF_LAM)[0];
  for (int task = blockIdx.x * 8 + wid; task < T * 4; task += gridDim.x * 8) {
    const int t = task >> 2, h = task & 3, b = t / SB, j = t - b * SB; const int nkeys = j < NC ? NC : SB;
    const bf16_t* kbase = proj + (size_t)(b * SB) * EVEN_IN + 1536 + h * 128; const bf16_t* vbase = proj + (size_t)(b * SB) * EVEN_IN + 2048 + h * 128;
    const bf16_t* q = proj + (size_t)t * EVEN_IN + 1024 + h * 128;
    float a0, a1, b0, b1;
    attn_row(q, 64, kbase, EVEN_IN, vbase, EVEN_IN, nkeys, 0.125f, sc, qs, a0, a1);
    attn_row(q + 64, 64, kbase + 64, EVEN_IN, vbase, EVEN_IN, nkeys, 0.125f, sc, qs, b0, b1);
    float o0 = a0 - lam * b0, o1 = a1 - lam * b1;
    float ss = wsum(o0 * o0 + o1 * o1); const float r = rsqrtf(ss * (1.0f / 128) + EPS) * 0.8f;
    o0 = o0 * r * sm(p, SM_SUBLN)[2 * lane]; o1 = o1 * r * sm(p, SM_SUBLN)[2 * lane + 1];
    *(unsigned*)(cat + (size_t)t * D + 512 + h * 128 + 2 * lane) = pack2(o0, o1);
  }
}
DEVI void n_gmlp(const Params& p, unsigned char* smem) {
  const int tid = ltid(), wid = tid >> 6, lane = tid & 63;
  bf16_t* lv = (bf16_t*)smem;
  const bf16_t* proj = wsp<bf16_t>(p, OFF_PROJ); bf16_t* cat = wsp<bf16_t>(p, OFF_ACT);
  for (int ch = blockIdx.x; ch < T / 128; ch += gridDim.x) {
    __syncthreads();
    for (int r = wid; r < 128; r += 8) { const bf16_t* vr = proj + (size_t)(ch * 128 + r) * EVEN_IN + 512;
      float v[8]; float s = 0.f;
#pragma unroll
      for (int i = 0; i < 8; ++i) { v[i] = bf2f(vr[i * 64 + lane]); s += v[i]; }
      s = wsum(s); const float mu = s * (1.0f / 512); float q = 0.f;
#pragma unroll
      for (int i = 0; i < 8; ++i) { const float d = v[i] - mu; q += d * d; }
      q = wsum(q); const float rstd = rsqrtf(q * (1.0f / 512) + EPS);
#pragma unroll
      for (int i = 0; i < 8; ++i) { const int c = i * 64 + lane; lv[r * 512 + c] = f2bf((v[i] - mu) * rstd * sm(p, SM_ALNG)[c] + sm(p, SM_ALNB)[c]); } }
    __syncthreads();
    const int c = tid, g = c >> 7;
    const float* wsg = sm(p, SM_AWSF) + (size_t)g * 128 * 128;
    for (int pp = 0; pp < 128; ++pp) { float acc = 0.f; const float* wr = wsg + pp * 128;
      for (int q = 0; q < 128; ++q) acc += wr[q] * bf2f(lv[q * 512 + c]);
      acc += sm(p, SM_ABS)[g * 128 + pp];
      const size_t t = (size_t)ch * 128 + pp; const float u = bf2f(proj[t * EVEN_IN + c]);
      cat[t * D + c] = f2bf(u * acc); }
  }
}
template <int LAYER> DEVI void n_outproj(const Params& p) {
  const bf16_t* cat = wsp<bf16_t>(p, OFF_ACT); const bf16_t* w = wsp<bf16_t>(p, LAYER == 0 ? OFF_WOUT0T : OFF_WOUT1T);
  auto st1 = [&](int r, int n, float v) { const int b = r / SB, j = r - b * SB; if (LAYER == 1 && j < NC) return;
    const float* res = LAYER == 0 ? in_row(p, r) : (const float*)hid_row(p, r); float* dst = hid_row(p, r);
    dst[n] = res[n] + modv(p, LAYER, r, 2)[n] * v; };
  ngemm(T / 32, D / 32, D, [&](int r) { return cat + (size_t)r * D; }, [&](int n) { return w + (size_t)n * D; },
        [&](int r, int n0, int n1, float v0, float v1) { st1(r, n0, v0); st1(r, n1, v1); });
}

struct LCfg { int l, npb, j0, nph; };
DEVI int act_tok(const LCfg& c, int half, int tl) { const int bl = tl / c.npb, jj = tl - bl * c.npb; return (half * 8 + bl) * SB + c.j0 + jj; }
DEVI void stage_router(const Params& p, const LCfg c, unsigned char* smem) {
  const int wid = ltid() >> 6, lane = ltid() & 63, fr = lane & 15, fq = lane >> 4;
  float* lgs = (float*)smem + wid * 4096;
  int* ksl = (int*)lgs + 2048;
  const float* g = sm(p, SM_N2G + c.l * D); bf16_t* act = wsp<bf16_t>(p, OFF_ACT);
  const bf16_t* wrt = wsp<bf16_t>(p, OFF_WRT) + (size_t)c.l * NE * D; const float bias = sm(p, SM_MBIAS)[c.l * NE + lane];
  int* cnt = (int*)(p.ws + OFF_CNT) + c.l * 128; int* list = wsp<int>(p, OFF_LIST); float* topw = wsp<float>(p, OFF_TOPW);
  const int nact = c.nph, nwv = gridDim.x * 8, chunk0 = (nact + nwv - 1) / nwv, chunk = chunk0 < 32 ? chunk0 : 32;
  const bool agg = (nact == nwv * chunk);
  LAS int* blk = (LAS int*)((LAS unsigned char*)smem + 131072); LAS int* blkb = blk + 64;
  if (agg) {
    if (ltid() < 64) blk[ltid()] = 0;
    const u32x4* src = (const u32x4*)wrt;
    for (int i = ltid(); i < NE * 128; i += 512) { const int row = i >> 7, ch = i & 127; *(LAS u32x4*)((LAS unsigned char*)smem + row * 2048 + ((ch ^ (row & 7)) << 4)) = src[i]; }
    __syncthreads(); }
  for (int ga0 = (blockIdx.x * 8 + wid) * chunk; ga0 < nact; ga0 += nwv * chunk) {
    const int ntk = (nact - ga0) < chunk ? (nact - ga0) : chunk;
    f32x4 gg[4], s1v[4], s0v[4]; int curb = -1;
#pragma unroll
    for (int i = 0; i < 4; ++i) gg[i] = *(const f32x4*)(g + (i * 64 + lane) * 4);
    for (int j0 = 0; j0 < ntk; j0 += 3) {
      f32x4 v[3][4]; int tt[3];
#pragma unroll
      for (int u = 0; u < 3; ++u) { int j = j0 + u; j = j < ntk ? j : ntk - 1; const int ga = ga0 + j, half = ga / c.nph, tl = ga - half * c.nph; tt[u] = act_tok(c, half, tl);
        const bf16_t* row = wsp<bf16_t>(p, OFF_HB) + (size_t)tt[u] * D;
#pragma unroll
        for (int i = 0; i < 4; ++i) v[u][i] = bf4(*(const u32x2*)(row + (i * 64 + lane) * 4)); }
#pragma unroll
      for (int u = 0; u < 3; ++u) { float ss = 0.f;
#pragma unroll
        for (int i = 0; i < 4; ++i) ss += v[u][i][0] * v[u][i][0] + v[u][i][1] * v[u][i][1] + v[u][i][2] * v[u][i][2] + v[u][i][3] * v[u][i][3];
        const float rstd = rsqrtf(wsum_dpp(ss) * (1.0f / D) + EPS);
        const int bt = tt[u] / SB, jt = tt[u] - bt * SB, mrow = jt < NC ? 16 : bt;
        if (mrow != curb) { curb = mrow; const float* sh = modv(p, c.l, tt[u], 3); const float* sc = modv(p, c.l, tt[u], 4);
#pragma unroll
          for (int i = 0; i < 4; ++i) { s0v[i] = *(const f32x4*)(sh + (i * 64 + lane) * 4); s1v[i] = *(const f32x4*)(sc + (i * 64 + lane) * 4); } }
        if (j0 + u < ntk) {
#pragma unroll
          for (int i = 0; i < 4; ++i) { const int cc = (i * 64 + lane) * 4;
            float y[4];
#pragma unroll
            for (int q = 0; q < 4; ++q) y[q] = v[u][i][q] * rstd * gg[i][q] * (1.0f + s1v[i][q]) + s0v[i][q];
            u32x2 w; w.x = pack2(y[0], y[1]); w.y = pack2(y[2], y[3]);
            *(u32x2*)(act + (size_t)tt[u] * D + cc) = w;
            const float xs = (float)(1 << X_SHIFT); int w8 = 0;
            w8 = __builtin_amdgcn_cvt_pk_fp8_f32(__builtin_amdgcn_fmed3f(y[0] * xs, -440.f, 440.f), __builtin_amdgcn_fmed3f(y[1] * xs, -440.f, 440.f), w8, false);
            w8 = __builtin_amdgcn_cvt_pk_fp8_f32(__builtin_amdgcn_fmed3f(y[2] * xs, -440.f, 440.f), __builtin_amdgcn_fmed3f(y[3] * xs, -440.f, 440.f), w8, true);
            *(int*)(p.ws + OFF_ACT8 + (size_t)tt[u] * D + cc) = w8; } }
      }
    }
    asm volatile("s_waitcnt vmcnt(0)" ::: "memory");
    const bf16_t* ar[2];
#pragma unroll
    for (int m = 0; m < 2; ++m) { int jj = m * 16 + fr; jj = jj < ntk ? jj : 0; const int ga = ga0 + jj, half = ga / c.nph, tl = ga - half * c.nph; ar[m] = act + (size_t)act_tok(c, half, tl) * D + fq * 8; }
    const bf16_t* br = wrt + (size_t)fr * D + fq * 8;
    f32x4 acc[2][4];
#pragma unroll
    for (int m = 0; m < 2; ++m)
#pragma unroll
      for (int n = 0; n < 4; ++n) acc[m][n] = (f32x4){0.f, 0.f, 0.f, 0.f};
    if (agg) {
      const LAS unsigned char* bl = (const LAS unsigned char*)smem + fr * 2048; const int sw = fr & 7;
#pragma unroll 8
      for (int k0 = 0; k0 < D; k0 += 32) {
        bf16x8 af[2], bfr[4];
#pragma unroll
        for (int m = 0; m < 2; ++m) af[m] = *(const bf16x8*)(ar[m] + k0);
#pragma unroll
        for (int n = 0; n < 4; ++n) bfr[n] = *(const LAS bf16x8*)(bl + n * 32768 + ((((k0 >> 3) + fq) ^ sw) << 4));
#pragma unroll
        for (int m = 0; m < 2; ++m)
#pragma unroll
          for (int n = 0; n < 4; ++n) acc[m][n] = __builtin_amdgcn_mfma_f32_16x16x32_bf16(af[m], bfr[n], acc[m][n], 0, 0, 0);
      }
      __syncthreads();
    } else {
#pragma unroll 4
    for (int k0 = 0; k0 < D; k0 += 32) {
      bf16x8 af[2], bfr[4];
#pragma unroll
      for (int m = 0; m < 2; ++m) af[m] = *(const bf16x8*)(ar[m] + k0);
#pragma unroll
      for (int n = 0; n < 4; ++n) bfr[n] = *(const bf16x8*)(br + (size_t)(16 * n) * D + k0);
#pragma unroll
      for (int m = 0; m < 2; ++m)
#pragma unroll
        for (int n = 0; n < 4; ++n) acc[m][n] = __builtin_amdgcn_mfma_f32_16x16x32_bf16(af[m], bfr[n], acc[m][n], 0, 0, 0);
    }
    }
    __builtin_amdgcn_wave_barrier();
#pragma unroll
    for (int m = 0; m < 2; ++m)
#pragma unroll
      for (int n = 0; n < 4; ++n)
#pragma unroll
        for (int r = 0; r < 4; ++r) lgs[(m * 16 + 4 * fq + r) * 64 + 16 * n + fr] = acc[m][n][r];
    __builtin_amdgcn_fence(__ATOMIC_RELEASE, "wavefront"); __builtin_amdgcn_wave_barrier();
    const int half0 = ga0 / c.nph, half1 = (ga0 + ntk - 1) / c.nph;
    unsigned cm0 = 0u, cm1 = 0u;
    for (int j0 = 0; j0 < ntk; j0 += 3) {
      float wq[3]; int kq[3];
#pragma unroll
      for (int u = 0; u < 3; ++u) { const int j = (j0 + u) < ntk ? (j0 + u) : j0;
        const float lg = ((volatile float*)lgs)[j * 64 + lane];
        const float score = __builtin_amdgcn_rcpf(1.0f + __expf(-lg)); const float sel = score + bias;
        const float m1 = max8_dpp(sel);
        const unsigned long long isb = __ballot(sel == m1); const int gbase = lane & ~7; const unsigned gm = (unsigned)((isb >> gbase) & 0xffull);
        const int first = gbase + __builtin_ctz(gm);
        const float m2 = max8_dpp((lane == first) ? -INFINITY : sel);
        const float gs = m1 + m2; const int gi = lane >> 3; int grank = 0;
#pragma unroll
        for (int g2 = 0; g2 < 8; ++g2) { const float og = rlane(gs, g2 * 8); grank += (og > gs || (og == gs && g2 < gi)) ? 1 : 0; }
        float cur = grank < 4 ? sel : -INFINITY;
        int myk = -1; float wsumv = 0.f;
#pragma unroll
        for (int kk = 0; kk < TOPK; ++kk) { const float mxv = wmax_dpp(cur); const unsigned long long bm = __ballot(cur == mxv); const int win = __builtin_ctzll(bm);
          if (lane == win) { myk = kk; cur = -INFINITY; } wsumv += rlane(score, win); }
        wq[u] = score * __builtin_amdgcn_rcpf(wsumv) * 2.5f; kq[u] = myk; }
#pragma unroll
      for (int u = 0; u < 3; ++u) { const int j = j0 + u;
        if (j < ntk) { ((volatile float*)lgs)[j * 64 + lane] = wq[u]; ((volatile int*)ksl)[j * 64 + lane] = kq[u];
          const bool inh0 = (ga0 + j) / c.nph == half0;
          if (kq[u] >= 0) { if (inh0) cm0 |= 1u << j; else cm1 |= 1u << j; } } }
    }
    int base0 = 0, base1 = 0;
    if (agg) {
      const int n0 = __builtin_popcount(cm0); int wb = 0;
      if (n0) wb = __atomic_fetch_add(&blk[lane], n0, __ATOMIC_RELAXED);
      __syncthreads();
      if (wid == 0) { const int tot = blk[lane]; int gb = 0; if (tot) gb = atomicAdd(&cnt[half0 * 64 + lane], tot); blkb[lane] = gb; }
      __syncthreads();
      base0 = blkb[lane] + wb;
    } else {
      if (cm0) base0 = atomicAdd(&cnt[half0 * 64 + lane], __builtin_popcount(cm0));
      if (cm1) base1 = atomicAdd(&cnt[half1 * 64 + lane], __builtin_popcount(cm1));
    }
    for (int j = 0; j < ntk; ++j) {
      const int myk = ((volatile int*)ksl)[j * 64 + lane];
      if (myk >= 0) { const int ga = ga0 + j, half = ga / c.nph, tl = ga - half * c.nph; const unsigned below = (1u << j) - 1u;
        const int pos = half == half0 ? base0 + __builtin_popcount(cm0 & below) : base1 + __builtin_popcount(cm1 & below);
        list[((size_t)(half * 64 + lane)) * LCAP + pos] = tl * 6 + myk; topw[(size_t)ga * 6 + myk] = ((volatile float*)lgs)[j * 64 + lane]; wsp<int>(p, OFF_TOPP)[(size_t)ga * 6 + myk] = (lane << 24) | pos; }
    }
    __builtin_amdgcn_wave_barrier();
  }
}

DEVI void n_moe_gu(const Params& p, const LCfg c, int half) {
  const bf16_t* act = wsp<bf16_t>(p, OFF_ACT); bf16_t* hid = wsp<bf16_t>(p, OFF_HID);
  const int* cnt = (const int*)(p.ws + OFF_CNT) + c.l * 128 + half * 64; const int* list = wsp<int>(p, OFF_LIST) + (size_t)half * 64 * LCAP;
  int off = 0;
  for (int e = 0; e <= NE; ++e) {
    const int n = e < NE ? cnt[e] : c.nph;
    const bf16_t* w = e < NE ? wsp<bf16_t>(p, OFF_EGU) + (size_t)e * 512 * D : wsp<bf16_t>(p, OFF_SHGU) + (size_t)c.l * 512 * D;
    const int* le = list + (size_t)e * LCAP;
    ngemm((n + 31) / 32, DE / 16, D,
          [&](int r) -> const bf16_t* { if (r >= n) return nullptr; const int tl = e < NE ? le[r] / 6 : r; return act + (size_t)act_tok(c, half, tl) * D; },
          [&](int nn) { const int tn = nn >> 5, i = (nn >> 4) & 1, fr = nn & 15; return w + (size_t)(i * 256 + tn * 16 + fr) * D; },
          [&](int r, int n0, int n1, float v0, float v1) { if (r < n) hid[(size_t)(off + r) * DE + (n0 >> 5) * 16 + (n0 & 15)] = f2bf(silu(v0) * v1); });
    off += n;
  }
}
DEVI void n_moe_down(const Params& p, const LCfg c, int half) {
  const bf16_t* hid = wsp<bf16_t>(p, OFF_HID); bf16_t* slot = wsp<bf16_t>(p, OFF_SLOT);
  const int* cnt = (const int*)(p.ws + OFF_CNT) + c.l * 128 + half * 64; const int* list = wsp<int>(p, OFF_LIST) + (size_t)half * 64 * LCAP;
  int off = 0;
  for (int e = 0; e <= NE; ++e) {
    const int n = e < NE ? cnt[e] : c.nph;
    const bf16_t* w = e < NE ? wsp<bf16_t>(p, OFF_ED) + (size_t)e * D * DE : wsp<bf16_t>(p, OFF_SHD) + (size_t)c.l * D * DE;
    const int* le = list + (size_t)e * LCAP;
    auto st1 = [&](int r, int nn, float v) { if (r >= n) return;
      if (e < NE) slot[(size_t)le[r] * D + nn] = f2bf(v);
      else { const int t = act_tok(c, half, r); float* h = hid_row(p, t); h[nn] += modv(p, c.l, t, 5)[nn] * v; } };
    ngemm((n + 31) / 32, D / 32, DE,
          [&](int r) -> const bf16_t* { return r < n ? hid + (size_t)(off + r) * DE : nullptr; },
          [&](int nn) { return w + (size_t)nn * DE; },
          [&](int r, int n0, int n1, float v0, float v1) { st1(r, n0, v0); st1(r, n1, v1); });
    off += n;
  }
}
template <bool FUSE_NORM1> DEVI void stage_combine(const Params& p, const LCfg c, int half, unsigned char* smem, float dscale = 1.0f) {
  const int wid = ltid() >> 6, lane = ltid() & 63;
  int* off = (int*)smem;
  __syncthreads();
  if (ltid() == 0) { const int* cnt = (const int*)(p.ws + OFF_CNT) + c.l * 128 + half * 64; int o = 0; for (int e = 0; e < NE; ++e) { off[e] = o; o += cnt[e]; } off[NE] = o; }
  __syncthreads();
  const unsigned char* slot = p.ws + OFF_SLOT; const float* topw = wsp<float>(p, OFF_TOPW); const int* topp = wsp<int>(p, OFF_TOPP);
  for (int tl = blockIdx.x * 8 + wid; tl < c.nph; tl += gridDim.x * 8) {
    const int t = act_tok(c, half, tl); bf16_t* h = wsp<bf16_t>(p, OFF_HB) + (size_t)t * D; const float* g5 = modv(p, c.l, t, 5);
    float* orow = p.out + ((size_t)((t / SB) * S + (t % SB) - NC)) * D;
    const float* w = topw + ((size_t)(half * c.nph + tl)) * 6; const int* pp = topp + ((size_t)(half * c.nph + tl)) * 6;
    float wk[7]; size_t ro[7];
#pragma unroll
    for (int k = 0; k < 6; ++k) { wk[k] = w[k]; const int q = pp[k]; ro[k] = (size_t)(off[q >> 24] + (q & 0xffffff)) * D; }
    wk[6] = 1.0f; ro[6] = (size_t)(off[NE] + tl) * D;
    unsigned sv[4][7]; f32x4 hv[4];
#pragma unroll
    for (int i = 0; i < 4; ++i) { const int cc = (i * 64 + lane) * 4; hv[i] = bf4(*(const u32x2*)(h + cc));
#pragma unroll
      for (int k = 0; k < 7; ++k) sv[i][k] = *(const unsigned*)(slot + ro[k] + cc); }
#pragma unroll
    for (int i = 0; i < 4; ++i) { const int cc = (i * 64 + lane) * 4; f32x4 acc = {0.f, 0.f, 0.f, 0.f};
#pragma unroll
      for (int k = 0; k < 7; ++k) { const auto lo = __builtin_amdgcn_cvt_pk_f32_fp8((int)sv[i][k], false); const auto hi = __builtin_amdgcn_cvt_pk_f32_fp8((int)sv[i][k], true);
        acc[0] += wk[k] * lo[0]; acc[1] += wk[k] * lo[1]; acc[2] += wk[k] * hi[0]; acc[3] += wk[k] * hi[1]; }
      const f32x4 gg = *(const f32x4*)(g5 + cc);
#pragma unroll
      for (int q = 0; q < 4; ++q) hv[i][q] += gg[q] * acc[q] * dscale;
      if (FUSE_NORM1) { u32x2 w; w.x = pack2(hv[i][0], hv[i][1]); w.y = pack2(hv[i][2], hv[i][3]); *(u32x2*)(h + cc) = w; }
      else *(f32x4*)(orow + cc) = hv[i]; }
    if (FUSE_NORM1) {
      float ss = 0.f;
#pragma unroll
      for (int i = 0; i < 4; ++i) ss += hv[i][0] * hv[i][0] + hv[i][1] * hv[i][1] + hv[i][2] * hv[i][2] + hv[i][3] * hv[i][3];
      const float rstd = rsqrtf(wsum_dpp(ss) * (1.0f / D) + EPS);
      const float* g1 = sm(p, SM_N1G + (c.l + 1) * D); const float* sh = modv(p, c.l + 1, t, 0); const float* sc = modv(p, c.l + 1, t, 1);
      bf16_t* act = wsp<bf16_t>(p, OFF_ACT);
#pragma unroll
      for (int i = 0; i < 4; ++i) { const int cc = (i * 64 + lane) * 4; const f32x4 gg = *(const f32x4*)(g1 + cc), s1 = *(const f32x4*)(sc + cc), s0 = *(const f32x4*)(sh + cc);
        float y[4];
#pragma unroll
        for (int q = 0; q < 4; ++q) y[q] = hv[i][q] * rstd * gg[q] * (1.0f + s1[q]) + s0[q];
        if (IN1_FP8) { const float xs = (float)(1 << X_SHIFT); int w8 = 0;
          w8 = __builtin_amdgcn_cvt_pk_fp8_f32(__builtin_amdgcn_fmed3f(y[0] * xs, -440.f, 440.f), __builtin_amdgcn_fmed3f(y[1] * xs, -440.f, 440.f), w8, false);
          w8 = __builtin_amdgcn_cvt_pk_fp8_f32(__builtin_amdgcn_fmed3f(y[2] * xs, -440.f, 440.f), __builtin_amdgcn_fmed3f(y[3] * xs, -440.f, 440.f), w8, true);
          *(int*)(p.ws + OFF_ACT8 + (size_t)t * D + cc) = w8; }
        else { u32x2 w; w.x = pack2(y[0], y[1]); w.y = pack2(y[2], y[3]);
          *(u32x2*)(act + (size_t)t * D + cc) = w; } }
    }
  }
}

DEVI void n_inproj1(const Params& p) {
  const bf16_t* act = wsp<bf16_t>(p, OFF_ACT); const bf16_t* w = wsp<bf16_t>(p, OFF_WQKV1T); bf16_t* proj = wsp<bf16_t>(p, OFF_PROJ);
  ngemm(T / 32, ODD_IN / 32, D, [&](int r) { return act + (size_t)r * D; }, [&](int n) { return w + (size_t)n * D; },
        [&](int r, int n0, int n1, float v0, float v1) { proj[(size_t)r * ODD_IN + n0] = f2bf(v0); proj[(size_t)r * ODD_IN + n1] = f2bf(v1); });
}
DEVI void n_post1(const Params& p) {
  const int wid = ltid() >> 6, lane = ltid() & 63;
  bf16_t* proj = wsp<bf16_t>(p, OFF_PROJ); const float2* t128 = wsp<float2>(p, OFF_TAB128);
  for (int t = blockIdx.x * 8 + wid; t < T; t += gridDim.x * 8) {
    bf16_t* row = proj + (size_t)t * ODD_IN; const int b = t / SB, j = t - b * SB;
    for (int hh = 0; hh < 10; ++hh) {
      unsigned* pp = (unsigned*)(row + hh * 128 + 2 * lane); const unsigned u = *pp;
      float x1 = __uint_as_float(u << 16), x2 = __uint_as_float(u & 0xffff0000u);
      const float ss = wsum(x1 * x1 + x2 * x2); const float r = rsqrtf(ss * (1.0f / 128) + EPS);
      const float* g = sm(p, hh < 8 ? SM_CQN : SM_CKN);
      x1 = x1 * r * g[2 * lane]; x2 = x2 * r * g[2 * lane + 1];
      if (j >= NC) { const int pos = j - NC; const int ps = lane < 32 ? (pos >> 6) : (pos & 63); const float2 cs = t128[ps * 32 + (lane & 31)];
        const float y1 = x1 * cs.x - x2 * cs.y, y2 = x1 * cs.y + x2 * cs.x; x1 = y1; x2 = y2; }
      *pp = pack2(x1, x2);
    }
  }
}
DEVI void n_attn1(const Params& p, unsigned char* smem) {
  const int wid = ltid() >> 6, lane = ltid() & 63;
  volatile float* sc = (volatile float*)(smem + wid * (2304 * 4 + 512)); volatile float* qs = sc + 2304;
  const bf16_t* proj = wsp<bf16_t>(p, OFF_PROJ); bf16_t* att = wsp<bf16_t>(p, OFF_ACT);
  for (int task = blockIdx.x * 8 + wid; task < TX * 8; task += gridDim.x * 8) {
    const int tx = task >> 3, h = task & 7, b = tx / S, i = tx - b * S, t = b * SB + NC + i, kvh = h >> 2;
    const bf16_t* kbase = proj + (size_t)(b * SB) * ODD_IN + 1024 + kvh * 128; const bf16_t* vbase = kbase + 256;
    float o0, o1;
    attn_row(proj + (size_t)t * ODD_IN + h * 128, 128, kbase, ODD_IN, vbase, ODD_IN, SB, 0.08838834764831845f, sc, qs, o0, o1);
    *(unsigned*)(att + (size_t)t * D + h * 128 + 2 * lane) = pack2(o0, o1);
  }
}

namespace fg {
constexpr int BM = 256, BK = 64, HALF = 128, HTB = HALF * BK * 2, STAGE_BYTES = 8 * HTB;
constexpr int LDS_XCH = STAGE_BYTES, LDS_TAB = STAGE_BYTES + 4096, LDS_ROPE = STAGE_BYTES + 6144, LDS_GAIN = LDS_ROPE + 16384;
DEVI int lds_byte(int r, int c) { const int st = (r >> 4) * 2 + (c >> 5), rr = r & 15, cc = c & 31, ob = rr * 64 + cc * 2; return st * 1024 + (ob ^ (((ob >> 9) & 1) << 5)); }
DEVI void stage_rc(int b, int& R, int& C) { const int st = b / 1024, sb = b % 1024, swz = sb ^ (((sb >> 9) & 1) << 5); R = (st >> 1) * 16 + swz / 64; C = (st & 1) * 32 + (swz % 64) / 2; }
DEVI int perm32(int rho) { const int n = rho >> 4, i = rho & 15; return 8 * (i >> 2) + 4 * n + (i & 3); }
DEVI unsigned cvt_pk_bf16(float lo, float hi) { unsigned r; asm volatile("v_cvt_pk_bf16_f32 %0, %1, %2" : "=v"(r) : "v"(lo), "v"(hi)); return r; }
typedef float f32x2 __attribute__((ext_vector_type(2)));
DEVI f32x2 gelu_pk(f32x2 v) {
  const f32x2 av = __builtin_elementwise_abs(v), d = av * 0.2316418882f + 1.0f;
  f32x2 t; t.x = __builtin_amdgcn_rcpf(d.x); t.y = __builtin_amdgcn_rcpf(d.y);
  f32x2 q = t * 0.5307027145f + (-0.7265760135f); q = q * t + 0.7107068705f; q = q * t + (-0.142248368f); q = q * t + 0.127414796f; q = q * t;
  const f32x2 s = (v * v) * (-0.72134752044f);
  f32x2 e; e.x = __builtin_amdgcn_exp2f(s.x); e.y = __builtin_amdgcn_exp2f(s.y);
  const f32x2 m = v * (q * e), r = v - m;
  f32x2 o; o.x = v.x < 0.f ? m.x : r.x; o.y = v.y < 0.f ? m.y : r.y; return o;
}
struct Unit { const char* A; const char* B0; const char* B1; int pm, pn, e, cnt, off; };
typedef f32x4 Acc[2][2][4][2];
typedef int v8i_t __attribute__((ext_vector_type(8)));
template <int K> DEVI unsigned boff_m1(int R, int C) { return (unsigned)((64 * (R >> 5) + perm32(R & 31)) * K + C) * 2u; }
template <int K> DEVI unsigned boff_m2(int R, int C) { return (unsigned)(((R & ~31) + perm32(R & 31)) * K + C) * 2u; }

template <class Job>
DEVI void gemm_phase(LAS unsigned char* lds, Job& J) {
  constexpr int K = Job::K, nt = K / BK;
  const int tid = ltid(), wid = __builtin_amdgcn_readfirstlane(tid >> 6), lane = tid & 63, wr = wid >> 2, wc = wid & 3, fr = lane & 15, fq = lane >> 4;
  int Rr[2], Cc[2];
#pragma unroll
  for (int i = 0; i < 2; ++i) stage_rc(tid * 16 + i * 8192, Rr[i], Cc[i]);
  unsigned voffB[2];
#pragma unroll
  for (int i = 0; i < 2; ++i) voffB[i] = J.boff(Rr[i], Cc[i]);
  unsigned cv[2][2]; unsigned nv[2][2];
  constexpr size_t AH = Job::GATHER ? 0 : (size_t)HALF * K * 2;
#define CV1 cv[Job::GATHER ? 1 : 0]
  constexpr size_t kstep = (size_t)(BK * 2);
  const unsigned ldsw = (unsigned)wid * 1024u;
  const int aoff = lds_byte(wr * 64 + fr, fq * 8), boff = lds_byte(wc * 32 + fr, fq * 8);
  LAS unsigned char* abase = lds + aoff; LAS unsigned char* bbase = lds + 4 * HTB + boff;
  asm volatile("" : "+v"(abase), "+v"(bbase));
#define FG_SA(b, h) (((b) * 2 + (h)) * HTB)
#define FG_SB(b, h) ((4 + (b) * 2 + (h)) * HTB)
#define FG_STAGE(bufoff, gbase, voff) do { _Pragma("unroll") for (int _i = 0; _i < 2; ++_i) { \
    const unsigned _la = (unsigned)(uintptr_t)(lds + ldsw) + (unsigned)((bufoff) + _i * 8192); const char* _gb = (const char*)(gbase); \
    asm volatile("s_mov_b32 m0, %0\n\ts_nop 0\n\tglobal_load_lds_dwordx4 %1, %2" :: "s"(_la), "v"((voff)[_i]), "s"(_gb) : "memory", "m0"); } } while (0)
#define FG_LDA(dst, b, h) do { _Pragma("unroll") for (int m = 0; m < 4; ++m) _Pragma("unroll") for (int k = 0; k < 2; ++k) dst[m][k] = *(const LAS bf16x8*)(abase + (FG_SA(b, h) + m * 2048 + k * 1024)); } while (0)
#define FG_LDB(dst, b, h) do { _Pragma("unroll") for (int n = 0; n < 2; ++n) _Pragma("unroll") for (int k = 0; k < 2; ++k) dst[n][k] = *(const LAS bf16x8*)(bbase + (FG_SB(b, h) - 4 * HTB + n * 2048 + k * 1024)); } while (0)
#define FG_MMA(ai, bj, At, Bt) do { __builtin_amdgcn_s_setprio(1); _Pragma("unroll") for (int m = 0; m < 4; ++m) _Pragma("unroll") for (int n = 0; n < 2; ++n) _Pragma("unroll") for (int k = 0; k < 2; ++k) \
    acc[ai][bj][m][n] = __builtin_amdgcn_mfma_f32_16x16x32_bf16(Bt[n][k], At[m][k], acc[ai][bj][m][n], 0, 0, 0); __builtin_amdgcn_s_setprio(0); } while (0)
#define FG_MMA8(ai, bj, At, Bt) do { __builtin_amdgcn_s_setprio(1); _Pragma("unroll") for (int m = 0; m < 4; ++m) _Pragma("unroll") for (int n = 0; n < 2; ++n) { \
      v8i_t _b, _a; { const u32x4 b0 = *(const u32x4*)&Bt[n][0], b1 = *(const u32x4*)&Bt[n][1], a0 = *(const u32x4*)&At[m][0], a1 = *(const u32x4*)&At[m][1]; \
        _b = (v8i_t){(int)b0[0], (int)b0[1], (int)b0[2], (int)b0[3], (int)b1[0], (int)b1[1], (int)b1[2], (int)b1[3]}; _a = (v8i_t){(int)a0[0], (int)a0[1], (int)a0[2], (int)a0[3], (int)a1[0], (int)a1[1], (int)a1[2], (int)a1[3]}; } \
      acc[ai][bj][m][n] = __builtin_amdgcn_mfma_scale_f32_16x16x128_f8f6f4(_b, _a, acc[ai][bj][m][n], 0, 0, 0, Job::SCALE, 0, Job::SCALE); } __builtin_amdgcn_s_setprio(0); } while (0)
#define FG_WAIT_V(n) asm volatile("s_waitcnt vmcnt(" #n ")" ::: "memory")
#define FG_WAIT_L(n) asm volatile("s_waitcnt lgkmcnt(" #n ")" ::: "memory")
#define FG_MM(ai, bj, At, Bt) do { if constexpr (Job::FP8) FG_MMA8(ai, bj, At, Bt); else FG_MMA(ai, bj, At, Bt); } while (0)
#define FG_BAR __builtin_amdgcn_s_barrier()
#define FG_SCHED __builtin_amdgcn_sched_barrier(0)
  Unit cur, nxt;
  if (!J.next(cur)) return;
  Acc acc;
#pragma unroll
  for (int a = 0; a < 2; ++a)
#pragma unroll
    for (int b = 0; b < 2; ++b)
#pragma unroll
      for (int m = 0; m < 4; ++m)
#pragma unroll
        for (int n = 0; n < 2; ++n) acc[a][b][m][n] = (f32x4){0.f, 0.f, 0.f, 0.f};
  bf16x8 At[4][2], B0[2][2], B1[2][2];
  J.aoffs(cur, Rr, Cc, cv);
  asm volatile("s_waitcnt vmcnt(0)" ::: "memory");
  FG_STAGE(FG_SB(0, 0), cur.B0, voffB); FG_STAGE(FG_SA(0, 0), cur.A, cv[0]); FG_STAGE(FG_SB(0, 1), cur.B1, voffB); FG_STAGE(FG_SA(0, 1), cur.A + AH, CV1);
  if (wr == 1) FG_BAR;
  FG_WAIT_V(4); FG_BAR;
  FG_STAGE(FG_SB(1, 0), cur.B0 + kstep, voffB); FG_STAGE(FG_SA(1, 0), cur.A + kstep, cv[0]); FG_STAGE(FG_SB(1, 1), cur.B1 + kstep, voffB);
  FG_WAIT_V(6); FG_BAR;
  for (;;) {
    const bool has_next = J.next(nxt);
    const char* nA = has_next ? nxt.A : cur.A; const char* nB0 = has_next ? nxt.B0 : cur.B0; const char* nB1 = has_next ? nxt.B1 : cur.B1;
    for (int t = 0; t < nt; t += 2) {
      const bool last = (t == nt - 2);
      const char* a1 = cur.A + (size_t)(t + 1) * kstep;
      const char* a2 = last ? nA : cur.A + (size_t)(t + 2) * kstep;
      const char* b20 = last ? nB0 : cur.B0 + (size_t)(t + 2) * kstep; const char* b21 = last ? nB1 : cur.B1 + (size_t)(t + 2) * kstep;
      const char* a3 = a2 + kstep; const char* b30 = b20 + kstep; const char* b31 = b21 + kstep;
      asm volatile("" : "+s"(a1), "+s"(a2), "+s"(a3), "+s"(b20), "+s"(b21), "+s"(b30), "+s"(b31));
      if constexpr (Job::GATHER) { if (last && has_next) { J.aoffs(nxt, Rr, Cc, nv); asm volatile("s_waitcnt vmcnt(0)" ::: "memory"); } }
      FG_LDB(B0, 0, 0); FG_SCHED; FG_LDA(At, 0, 0); FG_STAGE(FG_SA(1, 1), a1 + AH, CV1);
      if constexpr (Job::GATHER) { if (last && has_next) { cv[0][0] = nv[0][0]; cv[0][1] = nv[0][1]; cv[1][0] = nv[1][0]; cv[1][1] = nv[1][1]; } }
      FG_WAIT_L(8); FG_BAR; FG_WAIT_L(0); FG_MM(0, 0, At, B0); FG_BAR; FG_SCHED;
      FG_LDB(B1, 0, 1); FG_STAGE(FG_SB(0, 0), b20, voffB);
      FG_BAR; FG_WAIT_L(0); FG_MM(0, 1, At, B1); FG_BAR;
      FG_LDA(At, 0, 1); FG_STAGE(FG_SA(0, 0), a2, cv[0]);
      FG_BAR; FG_WAIT_L(0); FG_MM(1, 0, At, B0); FG_BAR; FG_SCHED;
      FG_STAGE(FG_SB(0, 1), b21, voffB);
      FG_WAIT_V(6); FG_BAR; FG_MM(1, 1, At, B1); FG_BAR;
      FG_LDB(B0, 1, 0); FG_SCHED; FG_LDA(At, 1, 0); FG_STAGE(FG_SA(0, 1), a2 + AH, CV1);
      FG_WAIT_L(8); FG_BAR; FG_WAIT_L(0); FG_MM(0, 0, At, B0); FG_BAR; FG_SCHED;
      FG_LDB(B1, 1, 1); FG_STAGE(FG_SB(1, 0), b30, voffB);
      FG_BAR; FG_WAIT_L(0); FG_MM(0, 1, At, B1); FG_BAR;
      FG_LDA(At, 1, 1); FG_STAGE(FG_SA(1, 0), a3, cv[0]);
      FG_BAR; FG_WAIT_L(0); FG_MM(1, 0, At, B0); FG_BAR; FG_SCHED;
      FG_STAGE(FG_SB(1, 1), b31, voffB);
      FG_WAIT_V(6); FG_BAR; FG_MM(1, 1, At, B1); FG_BAR;
    }
    if (wr == 0) FG_BAR;
    { int l2; asm volatile("v_mbcnt_lo_u32_b32 %0, -1, 0\n\tv_mbcnt_hi_u32_b32 %0, -1, %0" : "=v"(l2));
      J.epilogue(acc, cur, wr, wc, l2 & 15, l2 >> 4, lds); }
    if (!has_next) break;
#pragma unroll
    for (int a = 0; a < 2; ++a)
#pragma unroll
      for (int b = 0; b < 2; ++b)
#pragma unroll
        for (int m = 0; m < 4; ++m)
#pragma unroll
          for (int n = 0; n < 2; ++n) acc[a][b][m][n] = (f32x4){0.f, 0.f, 0.f, 0.f};
    cur = nxt;
    if (wr == 1) FG_BAR;
  }
  FG_WAIT_V(0);
  FG_BAR;
#undef CV1
#undef FG_SA
#undef FG_SB
#undef FG_STAGE
#undef FG_LDA
#undef FG_LDB
#undef FG_MMA
#undef FG_MMA8
#undef FG_MM
#undef FG_WAIT_V
#undef FG_WAIT_L
#undef FG_BAR
#undef FG_SCHED
}

DEVI bool dense_decode(long L, int nM, int nN, int& pm, int& pn) {
  const int nwg = nM * nN; if (L >= nwg) return false;
  int wgid = (int)L; { const int q = nwg / 8, r = nwg % 8, xcd = wgid % 8, off = wgid / 8; wgid = (xcd < r ? xcd * (q + 1) : r * (q + 1) + (xcd - r) * q) + off; }
  const int nig = 8 * nN, gid = wgid / nig, fm = gid * 8, gsz = (nM - fm) < 8 ? (nM - fm) : 8;
  pm = fm + ((wgid % nig) % gsz); pn = (wgid % nig) / gsz; return true;
}
template <int K> DEVI void dense_aoffs(const int (&Rr)[2], const int (&Cc)[2], unsigned (&v)[2][2]) {
#pragma unroll
  for (int i = 0; i < 2; ++i) { v[0][i] = (unsigned)(Rr[i] * K + Cc[i]) * 2u; v[1][i] = 0u; }
}


struct Slab { LAS unsigned char* w0; LAS unsigned char* wf; LAS unsigned char* r0; };
DEVI Slab slab_init(LAS unsigned char* lds, int wid, int fr, int fq) {
  Slab s; LAS unsigned char* b = lds + 3 * HTB + wid * 1024;
  s.w0 = b + fr * 64 + fq * 16; s.wf = b + (fq >> 1) * 8192 + fr * 64 + (fq & 1) * 32; s.r0 = b + (fq * 16 + fr) * 16; return s; }
DEVI void slab_x16(const Slab& s, u32x4 a, u32x4 b, u32x4& ra, u32x4& rb) { *(LAS u32x4*)s.w0 = a; *(LAS u32x4*)(s.w0 + 8192) = b; ra = *(LAS u32x4*)s.r0; rb = *(LAS u32x4*)(s.r0 + 8192); }
DEVI void slab_x16(const Slab& s, u32x4 a, u32x4& ra) { *(LAS u32x4*)s.w0 = a; ra = *(LAS u32x4*)s.r0; }
DEVI void slab_x32(const Slab& s, f32x4 a, f32x4 b, f32x4& ra, f32x4& rb) { *(LAS f32x4*)s.wf = a; *(LAS f32x4*)(s.wf + 16) = b; ra = *(LAS f32x4*)s.r0; rb = *(LAS f32x4*)(s.r0 + 8192); }

template <int LAYER> struct JobOut {
  static constexpr bool FP8 = LAYER == 0 ? OUT0_FP8 : OUT1_FP8;
  static constexpr int K = FP8 ? D / 2 : D; static constexpr bool GATHER = false;
  static constexpr int SCALE = 0x01010101 * (127 - (WQ_SHIFT + A_SHIFT) / 2); static_assert((WQ_SHIFT + A_SHIFT) % 2 == 0, "");
  const Params& p; int i, c, G;
  DEVI JobOut(const Params& p_) : p(p_), i(0), c(vbid()), G(gridDim.x) {}
  DEVI unsigned boff(int R, int C) const { return boff_m2<K>(R, C); }
  DEVI bool next(Unit& u) {
    for (;;) { int pm, pn; if (!dense_decode((long)i * G + c, T / 256, D / 256, pm, pn)) return false; ++i;
      if (LAYER == 1 && pm % 9 == 0) continue;
      u.pm = pm; u.pn = pn; u.A = (const char*)(p.ws + (FP8 ? OFF_ACT8 : OFF_ACT)) + (size_t)pm * 256 * K * 2;
      u.B0 = (const char*)wsp<bf16_t>(p, LAYER == 0 ? OFF_WOUT0T : OFF_WOUT1T) + (size_t)(256 * pn) * K * 2; u.B1 = u.B0 + (size_t)128 * K * 2; return true; }
  }
  DEVI void aoffs(const Unit&, const int (&Rr)[2], const int (&Cc)[2], unsigned (&v)[2][2]) const { dense_aoffs<K>(Rr, Cc, v); }
  DEVI void epilogue(const Acc& acc, const Unit& u, int wr, int wc, int fr, int fq, LAS unsigned char* lds) const {
    asm volatile("" : "+v"(fr), "+v"(fq));
    const int t0 = u.pm * 256;
    const float* res = in_row(p, t0); bf16_t* dst = wsp<bf16_t>(p, OFF_HB) + (size_t)t0 * D;
    const float* gate = modv(p, LAYER, t0, 2);
    const int col0 = u.pn * 256 + wc * 32 + 8 * fq, lane = fq * 16 + fr;
    const Slab sl = slab_init(lds, wr * 4 + wc, fr, fq);
    const size_t rb = (size_t)(wr * 64 + (lane >> 2)) * D + u.pn * 256 + wc * 32 + 4 * (lane & 3);
    res += rb; dst += rb;
    asm volatile("" : "+v"(res), "+v"(dst));
    f32x4 gv[2][2];
#pragma unroll
    for (int bj = 0; bj < 2; ++bj)
#pragma unroll
      for (int n = 0; n < 2; ++n) gv[bj][n] = *(const f32x4*)(gate + col0 + bj * 128 + 4 * n);
#pragma unroll
    for (int ai = 0; ai < 2; ++ai) {
      f32x4 r4[4][2][2];
#pragma unroll
      for (int m = 0; m < 4; ++m) { const size_t ro = (size_t)(ai * 128 + m * 16) * D;
#pragma unroll
        for (int bj = 0; bj < 2; ++bj) {
          if (LAYER == 0) { r4[m][bj][0] = *(const f32x4*)(res + ro + bj * 128); r4[m][bj][1] = *(const f32x4*)(res + ro + bj * 128 + 16); }
          else { r4[m][bj][0] = bf4(*(const u32x2*)(dst + ro + bj * 128)); r4[m][bj][1] = bf4(*(const u32x2*)(dst + ro + bj * 128 + 16)); } } }
#pragma unroll
      for (int m = 0; m < 4; ++m) { const size_t ro = (size_t)(ai * 128 + m * 16) * D;
#pragma unroll
        for (int bj = 0; bj < 2; ++bj) { f32x4 x0, x1; slab_x32(sl, gv[bj][0] * acc[ai][bj][m][0], gv[bj][1] * acc[ai][bj][m][1], x0, x1);
          x0 += r4[m][bj][0]; x1 += r4[m][bj][1];
          u32x2 w0, w1; w0.x = pack2(x0[0], x0[1]); w0.y = pack2(x0[2], x0[3]); w1.x = pack2(x1[0], x1[1]); w1.y = pack2(x1[2], x1[3]);
          *(u32x2*)(dst + ro + bj * 128) = w0; *(u32x2*)(dst + ro + bj * 128 + 16) = w1; } }
      asm volatile("" ::: "memory"); }
  }
};

DEVI void load_rope_lds(const Params& p, size_t tab_off, int nrope, int gq, int gk, int ng, LAS unsigned char* lds) {
  const int tid = ltid(); __syncthreads();
  const f32x4* src = (const f32x4*)(p.ws + tab_off); LAS f32x4* dst = (LAS f32x4*)(lds + LDS_ROPE);
  for (int i = tid; i < nrope; i += 512) dst[i] = src[i];
  LAS float* g = (LAS float*)(lds + LDS_GAIN);
  if (tid < 2 * ng) g[tid] = tid < ng ? sm(p, gq)[tid] : sm(p, gk)[tid - ng];
  __syncthreads();
}
struct JobIn0 {
  static constexpr int K = IN0_FP8 ? D / 2 : D; static constexpr bool GATHER = false, FP8 = IN0_FP8;
  static constexpr int SCALE = 0x01010101 * (127 - (WQ_SHIFT + X_SHIFT) / 2);
  const Params& p; int i, c, G; int dry;
  DEVI JobIn0(const Params& p_, int dry_ = 0) : p(p_), i(0), c(vbid()), G(gridDim.x), dry(dry_) {}
  DEVI unsigned boff(int R, int C) const { return boff_m1<K>(R, C); }
  DEVI bool next(Unit& u) {
    int pm, pn; if (!dense_decode((long)i * G + c, T / 256, EVEN_IN / 256, pm, pn)) return false; ++i;
    u.pm = pm; u.pn = pn; u.A = (const char*)(p.ws + (IN0_FP8 ? OFF_ACT8 : OFF_ACT)) + (size_t)pm * 256 * K * 2;
    u.B0 = (const char*)wsp<bf16_t>(p, OFF_WIN0T) + (size_t)(256 * pn) * K * 2; u.B1 = u.B0 + (size_t)32 * K * 2; return true;
  }
  DEVI void aoffs(const Unit&, const int (&Rr)[2], const int (&Cc)[2], unsigned (&v)[2][2]) const { dense_aoffs<K>(Rr, Cc, v); }
  DEVI void epilogue(const Acc& acc, const Unit& u, int wr, int wc, int fr, int fq, LAS unsigned char* lds) const {
    asm volatile("" : "+v"(fr), "+v"(fq));
    if (dry == 1) {
#pragma unroll
      for (int ai = 0; ai < 2; ++ai)
#pragma unroll
        for (int bj = 0; bj < 2; ++bj)
#pragma unroll
          for (int m = 0; m < 4; ++m)
#pragma unroll
            for (int n = 0; n < 2; ++n) asm volatile("" :: "v"(acc[ai][bj][m][n]));
      return; }
    const int lane = fq * 16 + fr; const Slab sl = slab_init(lds, wr * 4 + wc, fr, fq);
    bf16_t* outp = wsp<bf16_t>(p, OFF_PROJ) + (size_t)(u.pm * 256 + wr * 64 + (lane >> 2)) * EVEN_IN + u.pn * 256 + wc * 64 + 8 * (lane & 3);
    asm volatile("" : "+v"(outp));
    const int pn = u.pn;
    if (pn < 4) {
#pragma unroll
      for (int ai = 0; ai < 2; ++ai)
#pragma unroll
        for (int m = 0; m < 4; ++m) {
          u32x4 wq[2];
#pragma unroll
          for (int bj = 0; bj < 2; ++bj) { const f32x4 v0 = acc[ai][bj][m][0], v1 = acc[ai][bj][m][1];
            const f32x2 a = gelu_pk((f32x2){v0[0], v0[1]}), b = gelu_pk((f32x2){v0[2], v0[3]}), c2 = gelu_pk((f32x2){v1[0], v1[1]}), d = gelu_pk((f32x2){v1[2], v1[3]});
            u32x4 w; w.x = cvt_pk_bf16(a.x, a.y); w.y = cvt_pk_bf16(b.x, b.y); w.z = cvt_pk_bf16(c2.x, c2.y); w.w = cvt_pk_bf16(d.x, d.y);
            wq[bj] = w; }
          { u32x4 ra, rb; slab_x16(sl, wq[0], wq[1], ra, rb); *(u32x4*)(outp + (size_t)(ai * 128 + m * 16) * EVEN_IN) = ra; *(u32x4*)(outp + (size_t)(ai * 128 + m * 16) * EVEN_IN + 32) = rb; } }
    } else if (pn >= 8) {
#pragma unroll
      for (int ai = 0; ai < 2; ++ai)
#pragma unroll
        for (int m = 0; m < 4; ++m) {
          u32x4 wq[2];
#pragma unroll
          for (int bj = 0; bj < 2; ++bj) { const f32x4 v0 = acc[ai][bj][m][0], v1 = acc[ai][bj][m][1];
            u32x4 w; w.x = cvt_pk_bf16(v0[0], v0[1]); w.y = cvt_pk_bf16(v0[2], v0[3]); w.z = cvt_pk_bf16(v1[0], v1[1]); w.w = cvt_pk_bf16(v1[2], v1[3]);
            wq[bj] = w; }
          { u32x4 ra, rb; slab_x16(sl, wq[0], wq[1], ra, rb); *(u32x4*)(outp + (size_t)(ai * 128 + m * 16) * EVEN_IN) = ra; *(u32x4*)(outp + (size_t)(ai * 128 + m * 16) * EVEN_IN + 32) = rb; } }
    } else {
      LAS const float* gn = (LAS const float*)(lds + LDS_GAIN) + (pn < 6 ? 0 : 64) + 8 * fq;
      f32x4 g4[2][2];
#pragma unroll
      for (int bj = 0; bj < 2; ++bj)
#pragma unroll
        for (int n = 0; n < 2; ++n) g4[bj][n] = *(LAS const f32x4*)(gn + bj * 32 + 4 * n);
      const int jt = u.pm % 9; const bool lat = jt != 0;
      LAS const f32x4* t64 = (LAS const f32x4*)(lds + LDS_ROPE);
#pragma unroll
      for (int ai = 0; ai < 2; ++ai)
#pragma unroll
        for (int m = 0; m < 4; ++m) {
          f32x4 cs[2][2];
          if (lat) { const int il = (jt - 1) * 256 + ai * 128 + wr * 64 + m * 16 + fr; const int prow = il >> 6, pcol = il & 63;
#pragma unroll
            for (int bj = 0; bj < 2; ++bj)
#pragma unroll
              for (int n = 0; n < 2; ++n) cs[bj][n] = t64[(bj ? pcol : prow) * 8 + 2 * fq + n]; }
          float ss = 0.f;
#pragma unroll
          for (int bj = 0; bj < 2; ++bj)
#pragma unroll
            for (int n = 0; n < 2; ++n) { const f32x4 x = acc[ai][bj][m][n]; ss += (x[0] * x[0] + x[1] * x[1]) + (x[2] * x[2] + x[3] * x[3]); }
          ss += shx<16>(ss); ss = sum32x(ss);
          const float rstd = rsqrtf(ss * (1.0f / 64) + EPS);
          u32x4 wq[2];
#pragma unroll
          for (int bj = 0; bj < 2; ++bj) { f32x4 y[2];
#pragma unroll
            for (int n = 0; n < 2; ++n) { f32x4 x = acc[ai][bj][m][n] * rstd * g4[bj][n];
              if (lat) { const f32x4 c4 = cs[bj][n]; x = (f32x4){x[0] * c4[0] - x[1] * c4[1], x[0] * c4[1] + x[1] * c4[0], x[2] * c4[2] - x[3] * c4[3], x[2] * c4[3] + x[3] * c4[2]}; }
              y[n] = x; }
            u32x4 w; w.x = cvt_pk_bf16(y[0][0], y[0][1]); w.y = cvt_pk_bf16(y[0][2], y[0][3]); w.z = cvt_pk_bf16(y[1][0], y[1][1]); w.w = cvt_pk_bf16(y[1][2], y[1][3]);
            wq[bj] = w; }
          { u32x4 ra, rb; slab_x16(sl, wq[0], wq[1], ra, rb); *(u32x4*)(outp + (size_t)(ai * 128 + m * 16) * EVEN_IN) = ra; *(u32x4*)(outp + (size_t)(ai * 128 + m * 16) * EVEN_IN + 32) = rb; }
          asm volatile("" ::: "memory");
        }
    }
  }
};

struct JobIn1 {
  static constexpr int K = IN1_FP8 ? D / 2 : D; static constexpr bool GATHER = false, FP8 = IN1_FP8;
  static constexpr int SCALE = 0x01010101 * (127 - (WQ_SHIFT + X_SHIFT) / 2); static_assert((WQ_SHIFT + X_SHIFT) % 2 == 0, "");
  const Params& p; int i, c, G;
  DEVI JobIn1(const Params& p_) : p(p_), i(0), c(vbid()), G(gridDim.x) {}
  DEVI unsigned boff(int R, int C) const { return boff_m1<K>(R, C); }
  DEVI bool next(Unit& u) {
    for (;;) { int pm, pn; if (!dense_decode((long)i * G + c, T / 256, ODD_IN / 256, pm, pn)) return false; ++i;
      if (pm % 9 == 0 && pn < 4) continue;
      u.pm = pm; u.pn = pn; u.A = (const char*)(p.ws + (IN1_FP8 ? OFF_ACT8 : OFF_ACT)) + (size_t)pm * 256 * K * 2;
      u.B0 = (const char*)wsp<bf16_t>(p, OFF_WQKV1T) + (size_t)(256 * pn) * K * 2; u.B1 = u.B0 + (size_t)32 * K * 2; return true; }
  }
  DEVI void aoffs(const Unit&, const int (&Rr)[2], const int (&Cc)[2], unsigned (&v)[2][2]) const { dense_aoffs<K>(Rr, Cc, v); }
  DEVI void epilogue(const Acc& acc, const Unit& u, int wr, int wc, int fr, int fq, LAS unsigned char* lds) const {
    asm volatile("" : "+v"(fr), "+v"(fq));
    const int lane = fq * 16 + fr; const Slab sl = slab_init(lds, wr * 4 + wc, fr, fq);
    int ooff = (u.pm * 256 + wr * 64 + (lane >> 2)) * ODD_IN + u.pn * 256 + wc * 64 + 8 * (lane & 3);
    asm volatile("" : "+v"(ooff));
    bf16_t* outp = wsp<bf16_t>(p, OFF_PROJ) + ooff;
    asm volatile("" : "+v"(outp));
    const int pn = u.pn;
    if (pn == 5) {
#pragma unroll
      for (int ai = 0; ai < 2; ++ai)
#pragma unroll
        for (int m = 0; m < 4; ++m) {
          u32x4 wq[2];
#pragma unroll
          for (int bj = 0; bj < 2; ++bj) { const f32x4 v0 = acc[ai][bj][m][0], v1 = acc[ai][bj][m][1];
            u32x4 w; w.x = cvt_pk_bf16(v0[0], v0[1]); w.y = cvt_pk_bf16(v0[2], v0[3]); w.z = cvt_pk_bf16(v1[0], v1[1]); w.w = cvt_pk_bf16(v1[2], v1[3]);
            wq[bj] = w; }
          { u32x4 ra, rb; slab_x16(sl, wq[0], wq[1], ra, rb); *(u32x4*)(outp + (size_t)(ai * 128 + m * 16) * ODD_IN) = ra; *(u32x4*)(outp + (size_t)(ai * 128 + m * 16) * ODD_IN + 32) = rb; } }
    } else {
      const int wid = wr * 4 + wc;
      LAS float* xw = (LAS float*)(lds + LDS_XCH) + wid * 128 + fr; LAS float* xr = (LAS float*)(lds + LDS_XCH) + (wid ^ 1) * 128 + fr;
      asm volatile("" : "+v"(xw), "+v"(xr));
      float ssr[2][4];
#pragma unroll
      for (int ai = 0; ai < 2; ++ai)
#pragma unroll
        for (int m = 0; m < 4; ++m) { float ss = 0.f;
#pragma unroll
          for (int bj = 0; bj < 2; ++bj)
#pragma unroll
            for (int n = 0; n < 2; ++n) { const f32x4 x = acc[ai][bj][m][n]; ss += (x[0] * x[0] + x[1] * x[1]) + (x[2] * x[2] + x[3] * x[3]); }
          ss += shx<16>(ss); ss = sum32x(ss); ssr[ai][m] = ss;
          if (fq == 0) xw[ai * 64 + m * 16] = ss; }
      asm volatile("s_waitcnt lgkmcnt(0)" ::: "memory"); __builtin_amdgcn_s_barrier(); asm volatile("" ::: "memory");
#pragma unroll
      for (int ai = 0; ai < 2; ++ai)
#pragma unroll
        for (int m = 0; m < 4; ++m) ssr[ai][m] += xr[ai * 64 + m * 16];
      const int hh = wc & 1;
      LAS const float* gn = (LAS const float*)(lds + LDS_GAIN) + (pn < 4 ? 0 : 128) + 64 * hh + 8 * fq;
      asm volatile("" : "+v"(gn));
      const int jt = u.pm % 9; const bool lat = jt != 0;
      LAS const f32x4* t128 = (LAS const f32x4*)(lds + LDS_ROPE);
#pragma unroll
      for (int ai = 0; ai < 2; ++ai)
#pragma unroll
        for (int m = 0; m < 4; ++m) {
          f32x4 g4[2][2];
#pragma unroll
          for (int bj = 0; bj < 2; ++bj)
#pragma unroll
            for (int n = 0; n < 2; ++n) g4[bj][n] = *(LAS const f32x4*)(gn + bj * 32 + 4 * n);
          f32x4 cs[2][2];
          if (lat) { const int il = (jt - 1) * 256 + ai * 128 + wr * 64 + m * 16 + fr; const int pos = hh ? (il & 63) : (il >> 6);
#pragma unroll
            for (int bj = 0; bj < 2; ++bj)
#pragma unroll
              for (int n = 0; n < 2; ++n) cs[bj][n] = t128[pos * 16 + 8 * bj + 2 * fq + n]; }
          const float rstd = rsqrtf(ssr[ai][m] * (1.0f / 128) + EPS);
          u32x4 wq[2];
#pragma unroll
          for (int bj = 0; bj < 2; ++bj) { f32x4 y[2];
#pragma unroll
            for (int n = 0; n < 2; ++n) { f32x4 x = acc[ai][bj][m][n] * rstd * g4[bj][n];
              if (lat) { const f32x4 c4 = cs[bj][n]; x = (f32x4){x[0] * c4[0] - x[1] * c4[1], x[0] * c4[1] + x[1] * c4[0], x[2] * c4[2] - x[3] * c4[3], x[2] * c4[3] + x[3] * c4[2]}; }
              y[n] = x; }
            u32x4 w; w.x = cvt_pk_bf16(y[0][0], y[0][1]); w.y = cvt_pk_bf16(y[0][2], y[0][3]); w.z = cvt_pk_bf16(y[1][0], y[1][1]); w.w = cvt_pk_bf16(y[1][2], y[1][3]);
            wq[bj] = w; }
          { u32x4 ra, rb; slab_x16(sl, wq[0], wq[1], ra, rb); *(u32x4*)(outp + (size_t)(ai * 128 + m * 16) * ODD_IN) = ra; *(u32x4*)(outp + (size_t)(ai * 128 + m * 16) * ODD_IN + 32) = rb; }
          asm volatile("" ::: "memory");
        }
    }
  }
};

DEVI void moe_tables(const Params& p, const LCfg c, int half, int nN, LAS unsigned char* lds) {
  LAS int* tb = (LAS int*)(lds + LDS_TAB);
  const int tid = ltid();
  __syncthreads();
  if (tid <= NE) tb[tid] = tid < NE ? ((const int*)(p.ws + OFF_CNT))[c.l * 128 + half * 64 + tid] : c.nph;
  __syncthreads();
  if (tid == 0) { int up = 0, off = 0; for (int e = 0; e <= NE; ++e) { const int n = tb[e]; tb[72 + e] = up; tb[144 + e] = off; up += ((n + 255) >> 8) * nN; off += n; } tb[72 + 65] = up; tb[144 + 65] = off; }
  __syncthreads();
}
struct MoeIter {
  int g, gend, step, e;
  DEVI void init(LAS const int* tb) { const int vb = vbid(); const int U = __builtin_amdgcn_readfirstlane(tb[72 + 65]), chunk = (U + 7) >> 3, x = vb & 7; g = x * chunk + (vb >> 3); gend = (x + 1) * chunk < U ? (x + 1) * chunk : U; step = gridDim.x >> 3; e = 0; }
  DEVI bool next(LAS const int* tb, int nN, int& ee, int& mt, int& pn) { if (g >= gend) return false; while (__builtin_amdgcn_readfirstlane(tb[72 + e + 1]) <= g) ++e; const int r = g - __builtin_amdgcn_readfirstlane(tb[72 + e]); mt = r / nN; pn = r - mt * nN; ee = e; g += step; return true; }
};
struct JobGU {
  static constexpr int K = D / 2; static constexpr bool GATHER = true, FP8 = true;
  static constexpr int SCALE = 0x01010101 * (127 - (WG_SHIFT + X_SHIFT) / 2); static_assert((WG_SHIFT + X_SHIFT) % 2 == 0, "");
  const Params& p; const LCfg c; int half; LAS const int* tb; MoeIter it; int dry;
  DEVI JobGU(const Params& p_, const LCfg c_, int half_, LAS unsigned char* lds, int dry_ = 0) : p(p_), c(c_), half(half_), tb((LAS const int*)(lds + LDS_TAB)), dry(dry_) { it.init(tb); }
  DEVI unsigned boff(int R, int C) const { return boff_m2<K>(R, C); }
  DEVI bool next(Unit& u) {
    int e, mt, pn; if (!it.next(tb, 2, e, mt, pn)) return false;
    u.e = e; u.pm = mt; u.pn = pn; u.cnt = __builtin_amdgcn_readfirstlane(tb[e]); u.off = __builtin_amdgcn_readfirstlane(tb[144 + e]); u.A = (const char*)(p.ws + OFF_ACT8);
    const char* w = e < NE ? (const char*)wsp<bf16_t>(p, OFF_EGU) + (size_t)e * 512 * K * 2 : (const char*)wsp<bf16_t>(p, OFF_SHGU) + (size_t)c.l * 512 * K * 2;
    u.B0 = w + (size_t)(128 * pn) * K * 2; u.B1 = w + (size_t)(256 + 128 * pn) * K * 2; return true;
  }
  DEVI void aoffs(const Unit& u, const int (&Rr)[2], const int (&Cc)[2], unsigned (&v)[2][2]) const {
    const int* le = wsp<int>(p, OFF_LIST) + ((size_t)(half * 64 + (u.e < NE ? u.e : 0))) * LCAP;
#pragma unroll
    for (int h = 0; h < 2; ++h)
#pragma unroll
      for (int i = 0; i < 2; ++i) { int r = u.pm * 256 + h * 128 + Rr[i]; r = r < u.cnt ? r : 0;
        int tl = r; if (u.e < NE) tl = le[r] / 6;
        v[h][i] = (unsigned)(act_tok(c, half, tl) * K + Cc[i]) * 2u; }
  }
  DEVI void epilogue(const Acc& acc, const Unit& u, int wr, int wc, int fr, int fq, LAS unsigned char* lds) const {
    asm volatile("" : "+v"(fr), "+v"(fq));
    if (dry == 1) {
#pragma unroll
      for (int ai = 0; ai < 2; ++ai)
#pragma unroll
        for (int bj = 0; bj < 2; ++bj)
#pragma unroll
          for (int m = 0; m < 4; ++m)
#pragma unroll
            for (int n = 0; n < 2; ++n) asm volatile("" :: "v"(acc[ai][bj][m][n]));
      return; }
    const int lane = fq * 16 + fr;
    LAS unsigned char* sb = lds + 3 * HTB + (wr * 4 + wc) * 1024;
    const int r0 = u.pm * 256 + wr * 64 + (lane >> 2);
    unsigned char* hid = p.ws + OFF_HID + ((size_t)u.off + r0) * DE + u.pn * 128 + wc * 32 + 8 * (lane & 3);
    asm volatile("" : "+v"(hid));
    const float hs = (float)(1 << H_SHIFT);
#pragma unroll
    for (int ai = 0; ai < 2; ++ai)
#pragma unroll
      for (int m = 0; m < 4; ++m) { const int r = r0 + ai * 128 + m * 16;
        float h[8];
#pragma unroll
        for (int n = 0; n < 2; ++n)
#pragma unroll
          for (int j = 0; j < 4; ++j) { const float gg = acc[ai][0][m][n][j]; h[n * 4 + j] = __builtin_amdgcn_fmed3f(gg * __builtin_amdgcn_rcpf(1.0f + __expf(-gg)) * acc[ai][1][m][n][j] * hs, -440.f, 440.f); }
        int lo = 0, hi = 0;
        lo = __builtin_amdgcn_cvt_pk_fp8_f32(h[0], h[1], lo, false); lo = __builtin_amdgcn_cvt_pk_fp8_f32(h[2], h[3], lo, true);
        hi = __builtin_amdgcn_cvt_pk_fp8_f32(h[4], h[5], hi, false); hi = __builtin_amdgcn_cvt_pk_fp8_f32(h[6], h[7], hi, true);
        *(LAS u32x2*)(sb + fr * 32 + fq * 8) = (u32x2){(unsigned)lo, (unsigned)hi};
        const u32x2 rw = *(LAS u32x2*)(sb + lane * 8);
        if (r < u.cnt) *(u32x2*)(hid + (size_t)(ai * 128 + m * 16) * DE) = rw; }
  }
};
struct JobDown {
  static constexpr int K = DE / 2; static constexpr bool GATHER = false, FP8 = true;
  static constexpr int SCALE = 0x01010101 * (127 - (WD_SHIFT + H_SHIFT) / 2); static_assert((WD_SHIFT + H_SHIFT) % 2 == 0, "");
  const Params& p; const LCfg c; int half; LAS const int* tb; MoeIter it; float dscale;
  DEVI JobDown(const Params& p_, const LCfg c_, int half_, LAS unsigned char* lds, float ds = 1.0f) : p(p_), c(c_), half(half_), tb((LAS const int*)(lds + LDS_TAB)), dscale(ds) { it.init(tb); }
  DEVI unsigned boff(int R, int C) const { return boff_m1<K>(R, C); }
  DEVI bool next(Unit& u) {
    int e, mt, pn; if (!it.next(tb, 4, e, mt, pn)) return false;
    u.e = e; u.pm = mt; u.pn = pn; u.cnt = __builtin_amdgcn_readfirstlane(tb[e]); u.off = __builtin_amdgcn_readfirstlane(tb[144 + e]);
    u.A = (const char*)wsp<bf16_t>(p, OFF_HID) + ((size_t)(u.off + mt * 256)) * K * 2;
    const char* w = e < NE ? (const char*)wsp<bf16_t>(p, OFF_ED) + (size_t)e * D * K * 2 : (const char*)wsp<bf16_t>(p, OFF_SHD) + (size_t)c.l * D * K * 2;
    u.B0 = w + (size_t)(256 * pn) * K * 2; u.B1 = u.B0 + (size_t)32 * K * 2; return true;
  }
  DEVI void aoffs(const Unit&, const int (&Rr)[2], const int (&Cc)[2], unsigned (&v)[2][2]) const { dense_aoffs<K>(Rr, Cc, v); }
  DEVI void epilogue(const Acc& acc, const Unit& u, int wr, int wc, int fr, int fq, LAS unsigned char* lds) const {
    asm volatile("" : "+v"(fr), "+v"(fq));
    const int lane = fq * 16 + fr;
    if (dscale < 0.f) {
#pragma unroll
      for (int ai = 0; ai < 2; ++ai)
#pragma unroll
        for (int bj = 0; bj < 2; ++bj)
#pragma unroll
          for (int m = 0; m < 4; ++m)
#pragma unroll
            for (int n = 0; n < 2; ++n) asm volatile("" :: "v"(acc[ai][bj][m][n]));
      return; }
    LAS unsigned char* sb = lds + 3 * HTB + (wr * 4 + wc) * 1024;
    const int r0 = u.pm * 256 + wr * 64 + (lane >> 2);
    unsigned char* slot = p.ws + OFF_SLOT + ((size_t)u.off + r0) * D + u.pn * 256 + wc * 64 + 16 * (lane & 3);
    asm volatile("" : "+v"(slot));
#pragma unroll
    for (int ai = 0; ai < 2; ++ai)
#pragma unroll
      for (int m = 0; m < 4; ++m) {
#pragma unroll
        for (int bj = 0; bj < 2; ++bj) { f32x4 v0 = acc[ai][bj][m][0], v1 = acc[ai][bj][m][1]; int lo = 0, hi = 0;
#pragma unroll
          for (int j = 0; j < 4; ++j) { v0[j] = __builtin_amdgcn_fmed3f(v0[j], -440.f, 440.f); v1[j] = __builtin_amdgcn_fmed3f(v1[j], -440.f, 440.f); }
          lo = __builtin_amdgcn_cvt_pk_fp8_f32(v0[0], v0[1], lo, false); lo = __builtin_amdgcn_cvt_pk_fp8_f32(v0[2], v0[3], lo, true);
          hi = __builtin_amdgcn_cvt_pk_fp8_f32(v1[0], v1[1], hi, false); hi = __builtin_amdgcn_cvt_pk_fp8_f32(v1[2], v1[3], hi, true);
          *(LAS u32x2*)(sb + fr * 64 + bj * 32 + fq * 8) = (u32x2){(unsigned)lo, (unsigned)hi}; }
        const u32x4 rw = *(LAS u32x4*)(sb + lane * 16);
        if (r0 + ai * 128 + m * 16 < u.cnt) *(u32x4*)(slot + (size_t)(ai * 128 + m * 16) * D) = rw; }
  }
};
}
namespace fa {
constexpr int NW = 8, QBLK = 32, KVBLK = 64;
constexpr float THR = 8.f;
constexpr size_t SHM_V = KVBLK * 128 * 2, SHM_K = KVBLK * 128 * 2, SHM_ATTN = 2 * SHM_V + 2 * SHM_K + NW * 64 * 4;
using s16x4 = __attribute__((ext_vector_type(4))) short;
using f32x16 = __attribute__((ext_vector_type(16))) float;
#define KSWZ(row, colB) ((row) * 256 + ((colB) ^ (((row) & 7) << 4)))
#define SBAR() __builtin_amdgcn_sched_barrier(0)
DEVI int crow(int r, int hi) { return (r & 3) + 8 * (r >> 2) + 4 * hi; }
DEVI unsigned cvtpk(float lo, float hi) { unsigned r; asm volatile("v_cvt_pk_bf16_f32 %0, %1, %2" : "=v"(r) : "v"(lo), "v"(hi)); return r; }

template <int SCALE_NUM> struct ScaleC;
DEVI void partialSM(f32x16& p0, f32x16& p1, float& m_reg, float& mn, float& alpha, const float SCALE) {
  const float C = SCALE * 1.4426950408889634f;
  float pmax = p0[0];
#pragma unroll
  for (int r = 1; r < 16; ++r) pmax = fmaxf(pmax, p0[r]);
#pragma unroll
  for (int r = 0; r < 16; ++r) pmax = fmaxf(pmax, p1[r]);
  { auto rr = __builtin_amdgcn_permlane32_swap(__float_as_uint(pmax), __float_as_uint(pmax), false, false);
    pmax = fmaxf(__uint_as_float(rr[0]), __uint_as_float(rr[1])); }
  if (__builtin_expect(__all(pmax - m_reg <= THR / SCALE), 1)) { mn = m_reg; alpha = 1.f; }
  else { mn = fmaxf(m_reg, pmax); alpha = __builtin_amdgcn_exp2f((m_reg - mn) * C); m_reg = mn; }
  float mnC = -mn * C;
#pragma unroll
  for (int r = 0; r < 16; ++r) p0[r] = fmaf(p0[r], C, mnC);
#pragma unroll
  for (int r = 0; r < 16; ++r) p1[r] = fmaf(p1[r], C, mnC);
#pragma unroll
  for (int r = 0; r < 16; ++r) p0[r] = __builtin_amdgcn_exp2f(p0[r]);
}
DEVI void finishSM(f32x16& p0, f32x16& p1, float alpha, float& l_reg, bf16x8& pa0, bf16x8& pa1, bf16x8& pa2, bf16x8& pa3) {
#pragma unroll
  for (int r = 0; r < 16; ++r) p1[r] = __builtin_amdgcn_exp2f(p1[r]);
  float ps = 0;
#pragma unroll
  for (int r = 0; r < 16; ++r) ps += p0[r];
#pragma unroll
  for (int r = 0; r < 16; ++r) ps += p1[r];
  { auto rr = __builtin_amdgcn_permlane32_swap(__float_as_uint(ps), __float_as_uint(ps), false, false);
    ps = __uint_as_float(rr[0]) + __uint_as_float(rr[1]); }
  l_reg = l_reg * alpha + ps;
#define PK4(P, BASE, OUT) do { unsigned a0 = cvtpk(P[BASE + 0], P[BASE + 1]), a1 = cvtpk(P[BASE + 2], P[BASE + 3]);   \
    unsigned b0 = cvtpk(P[BASE + 4], P[BASE + 5]), b1 = cvtpk(P[BASE + 6], P[BASE + 7]);                              \
    auto r0 = __builtin_amdgcn_permlane32_swap(a0, b0, false, false); auto r1 = __builtin_amdgcn_permlane32_swap(a1, b1, false, false); \
    u32x4 w = {r0[0], r1[0], r0[1], r1[1]}; OUT = *reinterpret_cast<bf16x8*>(&w); } while (0)
  PK4(p0, 0, pa0); PK4(p0, 8, pa1); PK4(p1, 0, pa2); PK4(p1, 8, pa3);
#undef PK4
}
template <int ND0> DEVI void qkt(f32x16& p0, f32x16& p1, const char* Ks, const bf16x8* qr, int r32, int hi, int cbase) {
  p0 = f32x16{}; p1 = f32x16{};
#pragma unroll
  for (int d0 = 0; d0 < ND0; ++d0) { int cb = cbase + (d0 * 16 + hi * 8) * 2;
    bf16x8 b0 = *reinterpret_cast<const bf16x8*>(Ks + KSWZ(r32, cb));
    bf16x8 b1 = *reinterpret_cast<const bf16x8*>(Ks + KSWZ(32 + r32, cb));
    p0 = __builtin_amdgcn_mfma_f32_32x32x16_bf16(b0, qr[d0], p0, 0, 0, 0);
    p1 = __builtin_amdgcn_mfma_f32_32x32x16_bf16(b1, qr[d0], p1, 0, 0, 0); }
}
DEVI int v_st(int k, int c) { const int kk = (k & ~0xC) | ((k & 4) << 1) | ((k & 8) >> 1); return ((kk >> 3) * 4 + (c >> 5)) * 512 + ((kk & 7) * 32 + (c & 31)) * 2; }
DEVI int v_rd_base(int lane) { return ((lane & 3) << 3) | (((lane >> 2) & 3) << 6) | (((lane >> 4) & 1) << 5) | (((lane >> 5) & 1) << 8); }
constexpr int v_rd_off(int d0, int ks, int half) { return d0 * 512 + ks * 4096 + half * 2048; }
template <int OFF> DEVI s16x4 tr_read(int vb) { s16x4 r; asm volatile("ds_read_b64_tr_b16 %0, %1 offset:%2" : "=&v"(r) : "v"(vb), "i"(OFF) : "memory"); return r; }
template <int D0> DEVI void pv_one(f32x16& od, int vb, bf16x8 pa0, bf16x8 pa1, bf16x8 pa2, bf16x8 pa3) {
  const s16x4 l0 = tr_read<v_rd_off(D0, 0, 0)>(vb), h0 = tr_read<v_rd_off(D0, 0, 1)>(vb), l1 = tr_read<v_rd_off(D0, 1, 0)>(vb), h1 = tr_read<v_rd_off(D0, 1, 1)>(vb);
  const s16x4 l2 = tr_read<v_rd_off(D0, 2, 0)>(vb), h2 = tr_read<v_rd_off(D0, 2, 1)>(vb), l3 = tr_read<v_rd_off(D0, 3, 0)>(vb), h3 = tr_read<v_rd_off(D0, 3, 1)>(vb);
  asm volatile("s_waitcnt lgkmcnt(0)" ::: "memory"); SBAR();
#define PK(L, H) (bf16x8){L[0], L[1], L[2], L[3], H[0], H[1], H[2], H[3]}
  od = __builtin_amdgcn_mfma_f32_32x32x16_bf16(pa0, PK(l0, h0), od, 0, 0, 0);
  od = __builtin_amdgcn_mfma_f32_32x32x16_bf16(pa1, PK(l1, h1), od, 0, 0, 0);
  od = __builtin_amdgcn_mfma_f32_32x32x16_bf16(pa2, PK(l2, h2), od, 0, 0, 0);
  od = __builtin_amdgcn_mfma_f32_32x32x16_bf16(pa3, PK(l3, h3), od, 0, 0, 0);
#undef PK
}
DEVI void pv_d0(f32x16* o, int vb, bf16x8 pa0, bf16x8 pa1, bf16x8 pa2, bf16x8 pa3) {
  pv_one<0>(o[0], vb, pa0, pa1, pa2, pa3); pv_one<1>(o[1], vb, pa0, pa1, pa2, pa3); pv_one<2>(o[2], vb, pa0, pa1, pa2, pa3); pv_one<3>(o[3], vb, pa0, pa1, pa2, pa3);
}

template <int ND0, int LD>
DEVI void attn_loop(const bf16_t* __restrict__ Qw, const bf16_t* __restrict__ Kh, const bf16_t* __restrict__ Vh, int seq, char* lds, int kcol_bytes, const float SCALE,
                    f32x16 (&o)[4], float& l_out) {
  const int tid = ltid(), wid = tid >> 6, lane = tid & 63, r32 = lane & 31, hi = lane >> 5;
  char* V_lds = lds; char* K_lds = lds + 2 * SHM_V;
  float* ws = (float*)(lds + 2 * SHM_V + 2 * SHM_K) + wid * 64; float* al_l = ws + 32;
  float m_reg = -1e30f, l_reg = 0; bf16x8 qr[ND0];
#pragma unroll
  for (int d = 0; d < 4; ++d) o[d] = f32x16{};
#pragma unroll
  for (int d0 = 0; d0 < ND0; ++d0) qr[d0] = *reinterpret_cast<const bf16x8*>(Qw + d0 * 16);
  const int sr = tid >> 4, sc = (tid & 15) * 8, vst0 = v_st(sr, sc), vst1 = v_st(32 + sr, sc);
  const int vb0 = (int)(uintptr_t)V_lds + v_rd_base(lane);
  struct { bf16x8 vs0, vs1, ks0, ks1; } sr_[2];
#define SLOAD(i, k0) do { sr_[i].vs0 = *reinterpret_cast<const bf16x8*>(&Vh[(long)((k0) + sr) * LD + sc]); sr_[i].vs1 = *reinterpret_cast<const bf16x8*>(&Vh[(long)((k0) + 32 + sr) * LD + sc]); \
    sr_[i].ks0 = *reinterpret_cast<const bf16x8*>(&Kh[(long)((k0) + sr) * LD + sc]); sr_[i].ks1 = *reinterpret_cast<const bf16x8*>(&Kh[(long)((k0) + 32 + sr) * LD + sc]); } while (0)
#define SWRITE(b, i) do { *(bf16x8*)(V_lds + (b) * SHM_V + vst0) = sr_[i].vs0;          \
    *(bf16x8*)(V_lds + (b) * SHM_V + vst1) = sr_[i].vs1; int kc = sc * 2;               \
    *(bf16x8*)(K_lds + (b) * SHM_K + KSWZ(sr, kc)) = sr_[i].ks0;                       \
    *(bf16x8*)(K_lds + (b) * SHM_K + KSWZ(32 + sr, kc)) = sr_[i].ks1; } while (0)
#define SWAIT() asm volatile("s_waitcnt vmcnt(4)" ::: "memory")
#define RESC(a) do { if (__any((a) < 1.f)) { if (hi == 0) al_l[r32] = (a); asm volatile("s_waitcnt lgkmcnt(0)" ::: "memory"); \
    _Pragma("unroll") for (int d = 0; d < 4; ++d) _Pragma("unroll") for (int r = 0; r < 16; ++r) o[d][r] *= al_l[crow(r, hi)]; } } while (0)
  f32x16 pA0, pA1, pB0, pB1; float mnA, mnB, alA, alB; bf16x8 pa0, pa1, pa2, pa3; const int NT = seq / KVBLK;
  constexpr int SE = 0, SO = 1;
  SLOAD(SE, 0); asm volatile("s_waitcnt vmcnt(0)" ::: "memory"); SWRITE(0, SE); __syncthreads();
  qkt<ND0>(pA0, pA1, K_lds, qr, r32, hi, kcol_bytes); partialSM(pA0, pA1, m_reg, mnA, alA, SCALE);
  SLOAD(SO, KVBLK); if (2 < NT) SLOAD(SE, 2 * KVBLK);
  SWAIT(); SWRITE(1, SO); __syncthreads();
  for (int j = 1; j + 1 < NT; j += 2) {
    SBAR(); qkt<ND0>(pB0, pB1, K_lds + SHM_K, qr, r32, hi, kcol_bytes);
    finishSM(pA0, pA1, alA, l_reg, pa0, pa1, pa2, pa3); SBAR();
    SLOAD(SO, (j + 2) * KVBLK); SBAR();
    pv_d0(o, vb0, pa0, pa1, pa2, pa3); partialSM(pB0, pB1, m_reg, mnB, alB, SCALE);
    __syncthreads(); SWAIT(); SWRITE(0, SE);
    RESC(alB); __syncthreads();
    SBAR(); qkt<ND0>(pA0, pA1, K_lds, qr, r32, hi, kcol_bytes);
    finishSM(pB0, pB1, alB, l_reg, pa0, pa1, pa2, pa3); SBAR();
    if (j + 3 < NT) SLOAD(SE, (j + 3) * KVBLK); SBAR();
    pv_d0(o, vb0 + (int)SHM_V, pa0, pa1, pa2, pa3); partialSM(pA0, pA1, m_reg, mnA, alA, SCALE);
    __syncthreads(); SWAIT(); SWRITE(1, SO);
    RESC(alA); __syncthreads();
  }
  SBAR(); qkt<ND0>(pB0, pB1, K_lds + SHM_K, qr, r32, hi, kcol_bytes);
  finishSM(pA0, pA1, alA, l_reg, pa0, pa1, pa2, pa3); SBAR();
  pv_d0(o, vb0, pa0, pa1, pa2, pa3); partialSM(pB0, pB1, m_reg, mnB, alB, SCALE);
  __syncthreads(); RESC(alB);
  finishSM(pB0, pB1, alB, l_reg, pa0, pa1, pa2, pa3); SBAR();
  pv_d0(o, vb0 + (int)SHM_V, pa0, pa1, pa2, pa3);
  asm volatile("s_waitcnt vmcnt(0)" ::: "memory");
  l_out = l_reg;
#undef SLOAD
#undef SWRITE
#undef SWAIT
#undef RESC
}

DEVI void store_tile_bf16(const f32x16 (&o)[4], const float (&scl)[16], bf16_t* Ow, int ldo, int r32, int hi) {
#pragma unroll
  for (int d0 = 0; d0 < 4; ++d0)
#pragma unroll
    for (int r = 0; r < 16; r += 2) {
      const float va = o[d0][r] * scl[r], vb = o[d0][r + 1] * scl[r + 1];
      const float snd = (r32 & 1) ? va : vb; const float got = shx<1>(snd);
      const int row = (r32 & 1) ? crow(r + 1, hi) : crow(r, hi); const int col = d0 * 32 + (r32 & ~1);
      const unsigned w = (r32 & 1) ? cvtpk(got, vb) : cvtpk(va, got);
      *(unsigned*)(Ow + (long)row * ldo + col) = w; }
}

DEVI void store_tile_fp8(const f32x16 (&o)[4], const float (&scl)[16], unsigned char* Ow, int ldo, int r32, int hi, const float xs) {
  const int q = r32 & 3; const bool b0 = q & 1, b1 = q & 2;
#pragma unroll
  for (int d0 = 0; d0 < 4; ++d0)
#pragma unroll
    for (int r4 = 0; r4 < 16; r4 += 4) {
      float v[4];
#pragma unroll
      for (int kk = 0; kk < 4; ++kk) v[kk] = __builtin_amdgcn_fmed3f(o[d0][r4 + kk] * scl[r4 + kk] * xs, -440.f, 440.f);
      const float gA = shx<1>(b0 ? v[0] : v[1]), gB = shx<1>(b0 ? v[2] : v[3]);
      const float aLo = b0 ? gA : v[0], aHi = b0 ? v[1] : gA;
      const float bLo = b0 ? gB : v[2], bHi = b0 ? v[3] : gB;
      const int pA = __builtin_amdgcn_cvt_pk_fp8_f32(aLo, aHi, 0, false) & 0xffff, pB = __builtin_amdgcn_cvt_pk_fp8_f32(bLo, bHi, 0, false) & 0xffff;
      const int got = __float_as_int(shx<2>(__int_as_float(b1 ? pA : pB))) & 0xffff;
      const unsigned w = b1 ? ((unsigned)got | ((unsigned)pB << 16)) : ((unsigned)pA | ((unsigned)got << 16));
      *(unsigned*)(Ow + (long)crow(r4 + q, hi) * ldo + d0 * 32 + (r32 & ~3)) = w; }
}

DEVI void phase_attn1(const Params& p, const PrepIn& pin, unsigned char* smem) {
  const bf16_t* qkv = wsp<bf16_t>(p, OFF_PROJ); bf16_t* att = wsp<bf16_t>(p, OFF_ACT);
  const int tid = ltid(), wid = tid >> 6, lane = tid & 63, r32 = lane & 31, hi = lane >> 5;
  const int vb_ = vbid(); const int xcd = vb_ & 7, slot = vb_ >> 3, nslot = gridDim.x >> 3;
  float* li_l = (float*)((char*)smem + 2 * SHM_V + 2 * SHM_K) + wid * 64;
  for (int it = slot; it < 4 * 32; it += nslot) {
    const int g = xcd + 8 * (it >> 5), item = it & 31, b = g >> 1, kvh = g & 1, h = kvh * 4 + (item >> 3), qb = item & 7;
    const bf16_t* Qb = qkv + (size_t)(b * SB + NC + qb * 256) * ODD_IN + h * 128;
    const bf16_t* Kh = qkv + (size_t)(b * SB) * ODD_IN + 1024 + kvh * 128; const bf16_t* Vh = Kh + 256;
    f32x16 o[4]; float l;
    __syncthreads();
    attn_loop<8, ODD_IN>(Qb + (long)(wid * QBLK + r32) * ODD_IN + hi * 8, Kh, Vh, SB, (char*)smem, 0, 0.08838834764831845f, o, l);
    if (hi == 0) li_l[r32] = l; asm volatile("s_waitcnt lgkmcnt(0)" ::: "memory");
    float rli[16];
#pragma unroll
    for (int r = 0; r < 16; ++r) rli[r] = __builtin_amdgcn_rcpf(li_l[crow(r, hi)]);
    if (OUT1_FP8) store_tile_fp8(o, rli, p.ws + OFF_ACT8 + (size_t)(b * SB + NC + qb * 256 + wid * QBLK) * D + h * 128, D, r32, hi, (float)(1 << A_SHIFT));
    else store_tile_bf16(o, rli, att + (size_t)(b * SB + NC + qb * 256 + wid * QBLK) * D + h * 128, D, r32, hi);
  }
}

DEVI void phase_attn0(const Params& p, const PrepIn& pin, unsigned char* smem) {
  const bf16_t* proj = wsp<bf16_t>(p, OFF_PROJ); bf16_t* cat = wsp<bf16_t>(p, OFF_ACT);
  const int tid = ltid(), wid = tid >> 6, lane = tid & 63, r32 = lane & 31, hi = lane >> 5, mp = wid >> 2, w4 = wid & 3;
  const int vb_ = vbid(); const int xcd = vb_ & 7, slot = vb_ >> 3, nslot = gridDim.x >> 3;
  float* li_l = (float*)((char*)smem + 2 * SHM_V + 2 * SHM_K) + wid * 64;
  float* ex = (float*)smem + (size_t)w4 * 4096 + lane;
  const float lam = wsp<float>(p, OFF_LAM)[0];
  const float* subln = sm(p, SM_SUBLN);
  for (int it = slot; it < 8 * 18; it += nslot) {
    int g, qrow0, seq;
    if (it < 128) { g = xcd + 8 * (it >> 4); qrow0 = NC + (it & 15) * 128; seq = SB; }
    else { const int j = it - 128; g = xcd + 8 * (j >> 1); qrow0 = (j & 1) * 128; seq = NC; }
    const int b = g >> 2, h = g & 3;
    const bf16_t* Qw = proj + (size_t)(b * SB + qrow0 + w4 * QBLK + r32) * EVEN_IN + 1024 + h * 128 + mp * 64 + hi * 8;
    const bf16_t* Kh = proj + (size_t)(b * SB) * EVEN_IN + 1536 + h * 128; const bf16_t* Vh = Kh + 512;
    f32x16 o[4]; float l;
    __syncthreads();
    attn_loop<4, EVEN_IN>(Qw, Kh, Vh, seq, (char*)smem, mp * 128, 0.125f, o, l);
    if (hi == 0) li_l[r32] = l; asm volatile("s_waitcnt lgkmcnt(0)" ::: "memory");
    float rli[16];
#pragma unroll
    for (int r = 0; r < 16; ++r) rli[r] = __builtin_amdgcn_rcpf(li_l[crow(r, hi)]);
    __syncthreads();
    if (mp == 1) {
#pragma unroll
      for (int d0 = 0; d0 < 4; ++d0)
#pragma unroll
        for (int r = 0; r < 16; ++r) ex[(d0 * 16 + r) * 64] = o[d0][r] * rli[r];
    }
    __syncthreads();
    if (mp == 0) {
      float ss[16];
#pragma unroll
      for (int r = 0; r < 16; ++r) ss[r] = 0.f;
#pragma unroll
      for (int d0 = 0; d0 < 4; ++d0) { const float gcol = subln[d0 * 32 + r32];
#pragma unroll
        for (int r = 0; r < 16; ++r) { const float dv = o[d0][r] * rli[r] - lam * ex[(d0 * 16 + r) * 64]; ss[r] += dv * dv; o[d0][r] = dv * gcol; } }
#pragma unroll
      for (int r = 0; r < 16; ++r) { float v = ss[r];
        v += shx<1>(v); v += shx<2>(v); v += shx<4>(v); v += shx<8>(v); v += shx<16>(v);
        ss[r] = rsqrtf(v * (1.0f / 128) + EPS) * 0.8f; }
      if (OUT0_FP8) store_tile_fp8(o, ss, p.ws + OFF_ACT8 + (size_t)(b * SB + qrow0 + w4 * QBLK) * D + 512 + h * 128, D, r32, hi, (float)(1 << A_SHIFT));
      else store_tile_bf16(o, ss, cat + (size_t)(b * SB + qrow0 + w4 * QBLK) * D + 512 + h * 128, D, r32, hi);
    }
  }
}

DEVI void phase_gmlp(const Params& p, unsigned char* smem) {
  const bf16_t* proj = wsp<bf16_t>(p, OFF_PROJ); bf16_t* cat = wsp<bf16_t>(p, OFF_ACT); const bf16_t* wsa = wsp<bf16_t>(p, OFF_WSA);
  const float* lng = sm(p, SM_ALNG); const float* lnb = sm(p, SM_ALNB); const float* abs_ = sm(p, SM_ABS);
  for (int it = blockIdx.x; it < (T / 128 + 1) / 2; it += gridDim.x) {
    const int tid = ltid(), hf = tid >> 8, ht = tid & 255, wl = ht >> 6, lane = tid & 63, fr = lane & 15, fq = lane >> 4;
    bf16_t* Tl = (bf16_t*)(smem + hf * 36864);
    const int ch = it * 2 + hf; const bool live = ch < T / 128; const int t0 = (live ? ch : 0) * 128;
    const int q = ht >> 1, part = ht & 1;
    float mu, rstd;
    { const bf16_t* vr = proj + (size_t)(t0 + q) * EVEN_IN + 512 + part * 256;
      float s = 0.f, s2 = 0.f;
#pragma unroll
      for (int i = 0; i < 32; ++i) { const u32x4 x = *(const u32x4*)(vr + i * 8);
#pragma unroll
        for (int e = 0; e < 4; ++e) { const float f0 = __uint_as_float(x[e] << 16), f1 = __uint_as_float(x[e] & 0xffff0000u); s += f0 + f1; s2 += f0 * f0 + f1 * f1; } }
      s += shx<1>(s); s2 += shx<1>(s2);
      mu = s * (1.0f / 512); rstd = rsqrtf(fmaxf(s2 * (1.0f / 512) - mu * mu, 0.f) + EPS); }
    for (int g = 0; g < 4; ++g) {
      __syncthreads();
      { const bf16_t* vg = proj + (size_t)(t0 + q) * EVEN_IN + 512 + g * 128 + part * 64;
#pragma unroll
        for (int i = 0; i < 8; ++i) { const u32x4 x = *(const u32x4*)(vg + i * 8); const int d0 = part * 64 + i * 8;
          const f32x4 ga = *(const f32x4*)(lng + g * 128 + d0), gb = *(const f32x4*)(lng + g * 128 + d0 + 4), ba = *(const f32x4*)(lnb + g * 128 + d0), bb = *(const f32x4*)(lnb + g * 128 + d0 + 4);
#pragma unroll
          for (int e = 0; e < 4; ++e) { const float f0 = __uint_as_float(x[e] << 16), f1 = __uint_as_float(x[e] & 0xffff0000u);
            const float gg0 = e < 2 ? ga[2 * e] : gb[2 * e - 4], gg1 = e < 2 ? ga[2 * e + 1] : gb[2 * e - 3], bb0 = e < 2 ? ba[2 * e] : bb[2 * e - 4], bb1 = e < 2 ? ba[2 * e + 1] : bb[2 * e - 3];
            const unsigned w = cvtpk((f0 - mu) * rstd * gg0 + bb0, (f1 - mu) * rstd * gg1 + bb1);
            Tl[(d0 + 2 * e) * 136 + q] = (bf16_t)(w & 0xffff); Tl[(d0 + 2 * e + 1) * 136 + q] = (bf16_t)(w >> 16); } }
      }
      __syncthreads();
      bf16x8 af[2][4];
#pragma unroll
      for (int m = 0; m < 2; ++m)
#pragma unroll
        for (int k = 0; k < 4; ++k) af[m][k] = *(const bf16x8*)(wsa + (size_t)(g * 128 + wl * 32 + m * 16 + fr) * 128 + k * 32 + fq * 8);
      f32x4 acc[2][8];
#pragma unroll
      for (int m = 0; m < 2; ++m)
#pragma unroll
        for (int n = 0; n < 8; ++n) acc[m][n] = (f32x4){0.f, 0.f, 0.f, 0.f};
#pragma unroll
      for (int k = 0; k < 4; ++k)
#pragma unroll
        for (int n = 0; n < 8; ++n) { const bf16x8 bfr = *(const bf16x8*)(Tl + (16 * n + fr) * 136 + k * 32 + fq * 8);
          acc[0][n] = __builtin_amdgcn_mfma_f32_16x16x32_bf16(bfr, af[0][k], acc[0][n], 0, 0, 0);
          acc[1][n] = __builtin_amdgcn_mfma_f32_16x16x32_bf16(bfr, af[1][k], acc[1][n], 0, 0, 0); }
      if (live) {
#pragma unroll
        for (int m = 0; m < 2; ++m) { const int pp = wl * 32 + m * 16 + fr; const size_t t = (size_t)t0 + pp; const float bias = abs_[g * 128 + pp];
#pragma unroll
          for (int n = 0; n < 8; ++n) { const int c = g * 128 + 16 * n + 4 * fq;
            const u32x2 uu = *(const u32x2*)(proj + t * EVEN_IN + c);
            const float o0 = __uint_as_float(uu.x << 16) * (acc[m][n][0] + bias), o1 = __uint_as_float(uu.x & 0xffff0000u) * (acc[m][n][1] + bias);
            const float o2 = __uint_as_float(uu.y << 16) * (acc[m][n][2] + bias), o3 = __uint_as_float(uu.y & 0xffff0000u) * (acc[m][n][3] + bias);
            if (OUT0_FP8) { const float xs = (float)(1 << A_SHIFT); int w8 = 0;
              w8 = __builtin_amdgcn_cvt_pk_fp8_f32(__builtin_amdgcn_fmed3f(o0 * xs, -440.f, 440.f), __builtin_amdgcn_fmed3f(o1 * xs, -440.f, 440.f), w8, false);
              w8 = __builtin_amdgcn_cvt_pk_fp8_f32(__builtin_amdgcn_fmed3f(o2 * xs, -440.f, 440.f), __builtin_amdgcn_fmed3f(o3 * xs, -440.f, 440.f), w8, true);
              *(int*)(p.ws + OFF_ACT8 + t * D + c) = w8; }
            else { u32x2 w; w.x = cvtpk(o0, o1); w.y = cvtpk(o2, o3);
              *(u32x2*)(cat + t * D + c) = w; } } }
      }
    }
  }
}
#undef KSWZ
#undef SBAR
}
#define REP_PREP 1
#define REP_NORM1 1
#define REP_IN0 1
#define REP_ATT0 1
#define REP_GMLP 1
#define REP_OUT0 1
#define REP_GU 1
#define REP_IN1 1
#define REP_ATT1 1
#define REP_SYNC 0
#define DRY_IN0 0
#define DRY_DOWN 0
#define DRY_GU 0
#define REP_ROUTER 1
#define REP_DOWN 1
#define REP_COMB 1
#define REPEAT(n, stmt) { int _n = (n); if ((n) > 1) asm volatile("" : "+s"(_n)); for (int _r = 0; _r < _n; ++_r) { stmt; if (_r + 1 < _n) GSYNC(); } }
__global__ __launch_bounds__(512) void mega(Params p0, PrepIn pin) {
  cg::grid_group grid = cg::this_grid();
  LAS unsigned char* lds = (LAS unsigned char*)smem;
  volatile LAS unsigned* xst = (volatile LAS unsigned*)(lds + SMEM_BYTES - 16);
  if (threadIdx.x == 0) { xst[0] = 0u; xst[1] = 0u; }
  ltid_init();
  XcdBarrier xb = xcd_barrier_post((unsigned*)(p0.ws + OFF_ZERO), xst);
  if (threadIdx.x == 0) { volatile LAS int* vbp = (volatile LAS int*)(lds + LDS_VBID); vbp[0] = (int)blockIdx.x;
    vbp[1] = (int)xb_add((unsigned*)(p0.ws + OFF_XRANK) + xb.x, 1u); }
#define GSYNC() xcd_barrier(xb)
#define ROUTER(c) { int _n = REP_ROUTER; if (REP_ROUTER > 1) asm volatile("" : "+s"(_n)); for (int _r = 0; _r < _n; ++_r) { \
      if (_r > 0) { if (blockIdx.x == 0 && threadIdx.x < 128) ((int*)(p0.ws + OFF_CNT))[c.l * 128 + threadIdx.x] = 0; GSYNC(); } \
      stage_router(launder(p0), c, smem); if (_r + 1 < _n) GSYNC(); } }
#define MOE_HALF(c, half, FUSE) do { \
    REPEAT(REP_GU, { const Params pl = launder(p0); fg::moe_tables(pl, c, half, 2, lds); int dry = (DRY_GU && _r > 0) ? DRY_GU : 0; if (DRY_GU) { asm volatile("" : "+v"(dry)); dry = __builtin_amdgcn_readfirstlane(dry); } fg::JobGU J(pl, c, half, lds, dry); fg::gemm_phase(lds, J); }) \
    GSYNC(); \
    { int _n = REP_DOWN; if (REP_DOWN > 1) asm volatile("" : "+s"(_n)); for (int _r = 0; _r < _n; ++_r) { float ds = _r == 0 ? 1.0f : (DRY_DOWN ? -1.0f : 0.0f); if (REP_DOWN > 1) { asm volatile("" : "+v"(ds)); ds = __int_as_float(__builtin_amdgcn_readfirstlane(__float_as_int(ds))); } \
        const Params pl = launder(p0); fg::moe_tables(pl, c, half, 4, lds); fg::JobDown J(pl, c, half, lds, ds); fg::gemm_phase(lds, J); if (_r + 1 < _n) GSYNC(); } } \
    GSYNC(); \
    { int _n = REP_COMB; if (REP_COMB > 1) asm volatile("" : "+s"(_n)); for (int _r = 0; _r < _n; ++_r) { float ds = _r == 0 ? 1.0f : 0.0f; if (REP_COMB > 1) asm volatile("" : "+v"(ds)); \
        stage_combine<FUSE>(launder(p0), c, half, smem, ds); if (_r + 1 < _n) GSYNC(); } } \
    } while (0)
  for (int _r = 0; _r < REP_PREP; ++_r) { stage_prep(p0, pin, smem); if (_r + 1 < REP_PREP) __syncthreads(); }
  grid.sync();
  if (threadIdx.x == 0) {
    bool ok = true; const unsigned per = gridDim.x >> 3;
    for (int j = 0; j < 16; ++j) { const unsigned c = xb_ld((unsigned*)(p0.ws + OFF_XRANK) + j); ok = ok && (c == (j < 8 ? per : 0u)); }
    volatile LAS int* vbp = (volatile LAS int*)(lds + LDS_VBID);
    if (ok && (gridDim.x & 7) == 0) vbp[0] = (int)xb.x + 8 * vbp[1]; }
  __syncthreads();
  REPEAT(REP_NORM1, stage_norm1<0>(launder(p0))) GSYNC();
  REPEAT(REP_IN0, { const Params pl = launder(p0); fg::load_rope_lds(pl, OFF_TAB64, 512, SM_BQN, SM_BKN, 64, lds); int dry = (DRY_IN0 && _r > 0) ? DRY_IN0 : 0; if (DRY_IN0) { asm volatile("" : "+v"(dry)); dry = __builtin_amdgcn_readfirstlane(dry); } fg::JobIn0 J(pl, dry); fg::gemm_phase(lds, J); })
  GSYNC();
  REPEAT(REP_ATT0, fa::phase_attn0(launder(p0), pin, smem))
  REPEAT(REP_GMLP, fa::phase_gmlp(launder(p0), smem))
  GSYNC();
  REPEAT(REP_OUT0, { const Params pl = launder(p0); fg::JobOut<0> J(pl); fg::gemm_phase(lds, J); })
  expert_prep_steal(launder(p0), pin, smem, 0);
  GSYNC();
  { const LCfg c{0, SB, 0, 16 * SB};
    ROUTER(c); GSYNC();
    MOE_HALF(c, 0, true); GSYNC(); }
  { int _n = REP_SYNC; if (REP_SYNC > 0) asm volatile("" : "+s"(_n)); for (int _r = 0; _r < _n; ++_r) GSYNC(); }
  REPEAT(REP_IN1, { const Params pl = launder(p0); fg::load_rope_lds(pl, OFF_TAB128, 1024, SM_CQN, SM_CKN, 128, lds); fg::JobIn1 J(pl); fg::gemm_phase(lds, J); })
  expert_prep_steal(launder(p0), pin, smem, 1);
  GSYNC();
  REPEAT(REP_ATT1, fa::phase_attn1(launder(p0), pin, smem))
  GSYNC();
  { const Params pl = launder(p0); fg::JobOut<1> J(pl); fg::gemm_phase(lds, J); }
  GSYNC();
  { const LCfg c{1, S, NC, 16 * S};
    ROUTER(c); GSYNC();
    MOE_HALF(c, 0, false); }
}

extern "C" void kernel_launch(void* const* d_in, const int* in_sizes, int n_in, void* d_out, int out_size, void* d_ws, size_t ws_size, hipStream_t stream) {
  static int grid_blocks = 0;
  if (!grid_blocks) {
    if (n_in != 33 || ws_size < WS_TOTAL) { fprintf(stderr, "kernel_launch: bad n_in %d or ws %zu < %zu\n", n_in, ws_size, (size_t)WS_TOTAL); return; }
    if (hipFuncSetAttribute((const void*)mega, hipFuncAttributeMaxDynamicSharedMemorySize, SMEM_BYTES) != hipSuccess) { fprintf(stderr, "set attr failed\n"); return; }
    int dev = 0, cus = 0, per_cu = 0;
    hipGetDevice(&dev); hipDeviceGetAttribute(&cus, hipDeviceAttributeMultiprocessorCount, dev);
    hipOccupancyMaxActiveBlocksPerMultiprocessor(&per_cu, mega, 512, SMEM_BYTES);
    if (per_cu < 1) { fprintf(stderr, "occupancy 0\n"); return; }
    grid_blocks = cus;
  }
  Params p; memset(&p, 0, sizeof(p)); PrepIn pin; memset(&pin, 0, sizeof(pin));
  for (int i = 0; i < 33; ++i) pin.in[i] = (const float*)d_in[i];
  p.out = (float*)d_out; p.ws = (unsigned char*)d_ws;
  p.x = pin.in[I_X]; p.ctx = pin.in[I_CTX];
  hipMemsetAsync(d_ws, 0, ZERO_BYTES, stream);
  void* args[] = {&p, &pin};
  hipError_t e = hipLaunchCooperativeKernel((void*)mega, dim3(grid_blocks), dim3(512), args, SMEM_BYTES, stream);
  if (e != hipSuccess) fprintf(stderr, "cooperative launch failed: %s (grid %d)\n", hipGetErrorString(e), grid_blocks);
}
```

```cpp
#include <hip/hip_runtime.h>
#include <hip/hip_cooperative_groups.h>
#include <cstdio>
#include <cstdint>
#include <cstring>
namespace cg = cooperative_groups;

#define DEVI __device__ __forceinline__
#define LAS __attribute__((address_space(3)))
typedef unsigned short bf16_t;
typedef short bf16x8 __attribute__((ext_vector_type(8)));
typedef float f32x4 __attribute__((ext_vector_type(4)));
typedef unsigned u32x4 __attribute__((ext_vector_type(4)));
typedef unsigned u32x2 __attribute__((ext_vector_type(2)));

constexpr int D = 1024, NB = 16, S = 2048, NC = 256, SB = 2304, T = NB * SB, TX = NB * S;
constexpr int NE = 64, TOPK = 6, DE = 256;
constexpr int EVEN_IN = 2560, ODD_IN = 1536;
constexpr float EPS = 1e-6f;

constexpr size_t al256(size_t x) { return (x + 255) & ~(size_t)255; }
constexpr size_t OFF_ZERO = 0, ZERO_BYTES = 65536;
constexpr size_t OFF_CNT = 16384;
constexpr size_t OFF_XRANK = 20608;
constexpr size_t OFF_STEAL = 20480;
constexpr size_t OFF_TAB64 = OFF_ZERO + ZERO_BYTES;
constexpr size_t OFF_TAB128 = OFF_TAB64 + 64 * 16 * 8;
constexpr size_t OFF_LAM = OFF_TAB128 + 64 * 32 * 8;
constexpr size_t OFF_MODV = al256(OFF_LAM + 256);
constexpr size_t OFF_SMALL = al256(OFF_MODV + (size_t)2 * 17 * 6144 * 4);
enum { SM_N1G = 0, SM_N2G = 2048, SM_ALNG = 4096, SM_ALNB = 4608, SM_ABS = 5120, SM_BQN = 5632, SM_BKN = 5696, SM_SUBLN = 5760, SM_CQN = 5888, SM_CKN = 6016, SM_MBIAS = 6144,
       SM_AWSF = 8192, SM_ROUTER = 73728, SM_END = 204800 };
constexpr size_t OFF_WIN0T = al256(OFF_SMALL + (size_t)SM_END * 4);
constexpr size_t OFF_WOUT0T = OFF_WIN0T + (size_t)EVEN_IN * D * 2;
constexpr size_t OFF_WQKV1T = OFF_WOUT0T + (size_t)D * D * 2;
constexpr size_t OFF_WOUT1T = OFF_WQKV1T + (size_t)ODD_IN * D * 2;
constexpr size_t OFF_WSA = OFF_WOUT1T + (size_t)D * D * 2;
constexpr size_t OFF_WRT = OFF_WSA + (size_t)4 * 128 * 128 * 2;
constexpr size_t OFF_SHGU = OFF_WRT + (size_t)2 * NE * D * 2;
constexpr size_t OFF_SHD = OFF_SHGU + (size_t)2 * 512 * D * 2;
constexpr size_t OFF_EGU = OFF_SHD + (size_t)2 * D * DE * 2;
constexpr size_t OFF_ED = OFF_EGU + (size_t)NE * 512 * D;
constexpr size_t OFF_HB = OFF_ED + (size_t)NE * D * DE;
constexpr size_t OFF_HC = OFF_HB;
constexpr size_t OFF_ACT = OFF_HB + (size_t)T * D * 2;
constexpr size_t OFF_TOPW = OFF_ACT + (size_t)T * D * 2;
constexpr size_t OFF_TOPP = al256(OFF_TOPW + (size_t)T * 6 * 4);
constexpr size_t OFF_LIST = al256(OFF_TOPP + (size_t)T * 6 * 4);
constexpr int LCAP = 36864;
constexpr size_t OFF_R = al256(OFF_LIST + (size_t)NE * LCAP * 4);
constexpr size_t OFF_PROJ = OFF_R;
constexpr size_t OFF_SLOT = OFF_R;
constexpr size_t OFF_QK8 = al256(OFF_R + (size_t)120000000);
constexpr size_t OFF_HID = al256(OFF_SLOT + (size_t)258048 * D);
constexpr size_t OFF_ACT8 = al256(OFF_HID + (size_t)(258048 + 256) * DE);
constexpr size_t WS_TOTAL = OFF_ACT8 + (size_t)T * D;
static_assert(OFF_HID >= OFF_R + (size_t)0, "layout");
static_assert(OFF_R + (size_t)T * EVEN_IN * 2 <= WS_TOTAL, "proj fits");
static_assert(WS_TOTAL <= 636368384ull, "workspace budget");
static_assert((size_t)T * ODD_IN * 2 <= 120000000ull && OFF_QK8 + (size_t)T * 1280 <= OFF_SLOT + (size_t)258048 * D, "QK8 placement");

struct Params {
  float* out;
  unsigned char* ws;
  const float* x; const float* ctx;
};
struct PrepIn { const float* in[33]; };
typedef __attribute__((address_space(1))) unsigned char* gptr_t;
__device__ __forceinline__ Params launder(const Params& p) {
  unsigned long long a = (unsigned long long)p.out, b = (unsigned long long)p.ws, c = (unsigned long long)p.x, d = (unsigned long long)p.ctx;
  asm volatile("" : "+s"(a), "+s"(b), "+s"(c), "+s"(d));
  Params q; q.out = (float*)(gptr_t)a; q.ws = (unsigned char*)(gptr_t)b; q.x = (const float*)(gptr_t)c; q.ctx = (const float*)(gptr_t)d; return q; }
enum { I_X = 0, I_C, I_CTX, I_CCTX, I_MODW, I_MODB, I_N1G, I_N2G, I_EVWIN, I_EVWOUT, I_ALNG, I_ALNB, I_AWS, I_ABS, I_BQN, I_BKN,
       I_LQ1, I_LK1, I_LQ2, I_LK2, I_SUBLN, I_ODQKV, I_ODOUT, I_CQN, I_CKN, I_ROUTER, I_MBIAS, I_WG, I_WU, I_WD, I_SG, I_SU, I_SD };

extern __shared__ __attribute__((aligned(16))) unsigned char smem[];
constexpr int SMEM_BYTES = 152 * 1024;
constexpr int LDS_WTAB = SMEM_BYTES - 512;
DEVI int ltid() {
  const unsigned slot = (unsigned)__builtin_amdgcn_s_getreg(63492) & 0x3fu;
  const int wv = __builtin_amdgcn_readfirstlane(*(volatile LAS int*)((LAS unsigned char*)smem + LDS_WTAB + slot * 4));
  int l; asm volatile("v_mbcnt_lo_u32_b32 %0, -1, 0\n\tv_mbcnt_hi_u32_b32 %0, -1, %0" : "=v"(l));
  return wv * 64 + l;
}
constexpr int LDS_VBID = LDS_WTAB + 256;
DEVI int vbid() { return __builtin_amdgcn_readfirstlane(*(volatile LAS int*)((LAS unsigned char*)smem + LDS_VBID)); }
DEVI void ltid_init() {
  const unsigned slot = (unsigned)__builtin_amdgcn_s_getreg(63492) & 0x3fu;
  if ((threadIdx.x & 63) == 0) *(volatile LAS int*)((LAS unsigned char*)smem + LDS_WTAB + slot * 4) = (int)(threadIdx.x >> 6);
  __syncthreads();
}
template <int M> DEVI float shx(float v) { static_assert(M == 1 || M == 2 || M == 4 || M == 8 || M == 16, "xor mask");
  return __int_as_float(__builtin_amdgcn_ds_swizzle(__float_as_int(v), (M << 10) | 0x1f)); }
template <int CTRL> DEVI float dppf(float v) { return __int_as_float(__builtin_amdgcn_update_dpp(0, __float_as_int(v), CTRL, 0xf, 0xf, true)); }
DEVI float rlane(float v, int l) { return __int_as_float(__builtin_amdgcn_readlane(__float_as_int(v), l)); }
DEVI float wsum_dpp(float v) { v += dppf<0xB1>(v); v += dppf<0x4E>(v); v += dppf<0x141>(v); v += dppf<0x140>(v); return (rlane(v, 0) + rlane(v, 16)) + (rlane(v, 32) + rlane(v, 48)); }
DEVI float wmax_dpp(float v) { v = fmaxf(v, dppf<0xB1>(v)); v = fmaxf(v, dppf<0x4E>(v)); v = fmaxf(v, dppf<0x141>(v)); v = fmaxf(v, dppf<0x140>(v)); return fmaxf(fmaxf(rlane(v, 0), rlane(v, 16)), fmaxf(rlane(v, 32), rlane(v, 48))); }
DEVI float max8_dpp(float v) { v = fmaxf(v, dppf<0xB1>(v)); v = fmaxf(v, dppf<0x4E>(v)); return fmaxf(v, dppf<0x141>(v)); }
DEVI float sum32x(float v) { auto r = __builtin_amdgcn_permlane32_swap(__float_as_uint(v), __float_as_uint(v), false, false); return __uint_as_float(r[0]) + __uint_as_float(r[1]); }
DEVI float max32x(float v) { auto r = __builtin_amdgcn_permlane32_swap(__float_as_uint(v), __float_as_uint(v), false, false); return fmaxf(__uint_as_float(r[0]), __uint_as_float(r[1])); }
DEVI bf16_t f2bf(float f) { unsigned u = __float_as_uint(f); u += 0x7FFFu + ((u >> 16) & 1u); return (bf16_t)(u >> 16); }
DEVI float bf2f(bf16_t b) { return __uint_as_float(((unsigned)b) << 16); }
DEVI unsigned pack2(float lo, float hi) { return (unsigned)f2bf(lo) | ((unsigned)f2bf(hi) << 16); }
DEVI float wsum(float v) { v += shx<1>(v); v += shx<2>(v); v += shx<4>(v); v += shx<8>(v); v += shx<16>(v); return sum32x(v); }
DEVI float wmax(float v) { v = fmaxf(v, shx<1>(v)); v = fmaxf(v, shx<2>(v)); v = fmaxf(v, shx<4>(v)); v = fmaxf(v, shx<8>(v)); v = fmaxf(v, shx<16>(v)); return max32x(v); }
DEVI float gelu_exact(float v) { return 0.5f * v * (1.0f + erff(v * 0.70710678118654752f)); }
DEVI float silu(float v) { return v / (1.0f + __expf(-v)); }

template <class Tp> DEVI Tp* wsp(const Params& p, size_t off) { return (Tp*)(p.ws + off); }
DEVI const float* sm(const Params& p, int off) { return (const float*)(p.ws + OFF_SMALL) + off; }
DEVI const float* in_row(const Params& p, int t) { int b = t / SB, j = t - b * SB;
  unsigned long long xa = (unsigned long long)p.x, ca = (unsigned long long)p.ctx; asm volatile("" : "+s"(xa), "+s"(ca));
  const float* xp = (const float*)(gptr_t)xa; const float* cp = (const float*)(gptr_t)ca;
  return j < NC ? cp + ((size_t)(b * NC + j)) * D : xp + ((size_t)(b * S + j - NC)) * D; }
DEVI f32x4 bf4(u32x2 r) { return (f32x4){__uint_as_float(r.x << 16), __uint_as_float(r.x & 0xffff0000u), __uint_as_float(r.y << 16), __uint_as_float(r.y & 0xffff0000u)}; }
DEVI float* hid_row(const Params& p, int t) { int b = t / SB, j = t - b * SB;
  return j < NC ? wsp<float>(p, OFF_HC) + ((size_t)(b * NC + j)) * D : p.out + ((size_t)(b * S + j - NC)) * D; }
DEVI const float* modv(const Params& p, int l, int t, int which) { int b = t / SB, j = t - b * SB; int r = j < NC ? 16 : b;
  return wsp<float>(p, OFF_MODV) + ((size_t)(l * 17 + r)) * 6144 + which * D; }

#define XB_TMO      128
#define XB_XCNT(j)  (256  + 64 * (j))
#define XB_XSUB(j)  (1280 + 64 * (j))
#define XB_XGEN(j)  (2304 + 64 * (j))
#define XB_TOP      3328
#define XB_TOPGEN   3392
#define XCD_BAR_WORDS 3456
#define XB_SPIN_CAP (1u << 22)
DEVI unsigned xb_ld(unsigned* p) { return __hip_atomic_load(p, __ATOMIC_RELAXED, __HIP_MEMORY_SCOPE_AGENT); }
DEVI unsigned xb_add(unsigned* p, unsigned v) { return __hip_atomic_fetch_add(p, v, __ATOMIC_RELAXED, __HIP_MEMORY_SCOPE_AGENT); }
DEVI unsigned xb_xcc_id() { return (unsigned)__builtin_amdgcn_s_getreg((3 << 11) | 20) & 0xFu; }
#define XB_SPIN(cond, bar) do { unsigned _sp = 0; while (cond) { __builtin_amdgcn_s_sleep(1); \
    if ((++_sp & 255u) == 0u) { if (xb_ld(&(bar)[XB_TMO])) break; if (_sp > XB_SPIN_CAP) { atomicAdd(&(bar)[XB_TMO], 1u); break; } } } } while (0)
struct XcdBarrier { unsigned* bar; unsigned x; volatile LAS unsigned* st; };
DEVI XcdBarrier xcd_barrier_post(unsigned* bar, volatile LAS unsigned* st) {
  XcdBarrier b; b.bar = bar; b.x = xb_xcc_id(); b.st = st;
  if (ltid() == 0) (void)xb_add(&bar[XB_XCNT(b.x)], 1u);
  return b;
}
DEVI void xcd_barrier_complete(unsigned* bar, unsigned x, unsigned& nloc, unsigned& nx) {
  const unsigned G = gridDim.x * gridDim.y * gridDim.z;
  unsigned sum, cnt, mine, sp = 0u;
  for (;;) {
    sum = 0u; cnt = 0u; mine = 0u;
#pragma unroll
    for (unsigned j = 0; j < 16; ++j) { const unsigned c = xb_ld(&bar[XB_XCNT(j)]); sum += c; cnt += (c > 0u) ? 1u : 0u; mine = (j == x) ? c : mine; }
    if (sum == G) break;
    __builtin_amdgcn_s_sleep(1);
    if ((++sp & 255u) == 0u) { if (xb_ld(&bar[XB_TMO])) break; if (sp > XB_SPIN_CAP) { atomicAdd(&bar[XB_TMO], 1u); break; } }
  }
  nloc = mine > 0u ? mine : 1u; nx = cnt > 0u ? cnt : 1u;
}
DEVI void xcd_barrier(const XcdBarrier& b) {
  asm volatile("s_waitcnt vmcnt(0)" ::: "memory");
  __syncthreads();
  if (ltid() == 0) {
    unsigned* bar = b.bar;
    __builtin_amdgcn_s_waitcnt(0);
    unsigned nloc = b.st[0], nx = b.st[1];
    if (nloc == 0u) { xcd_barrier_complete(bar, b.x, nloc, nx); b.st[0] = nloc; b.st[1] = nx; }
    const unsigned old = xb_add(&bar[XB_XSUB(b.x)], 1u);
    const unsigned gen = old / nloc;
    if (old + 1u == (gen + 1u) * nloc) {
      __builtin_amdgcn_fence(__ATOMIC_RELEASE, "agent");
      asm volatile("s_waitcnt vmcnt(0)" ::: "memory");
      const unsigned og = xb_add(&bar[XB_TOP], 1u);
      const unsigned tg = og / nx;
      if (og + 1u == (tg + 1u) * nx) xb_add(&bar[XB_TOPGEN], 1u);
      else XB_SPIN(xb_ld(&bar[XB_TOPGEN]) == tg, bar);
      __builtin_amdgcn_fence(__ATOMIC_ACQUIRE, "agent");
      xb_add(&bar[XB_XGEN(b.x)], 1u);
      asm volatile("s_waitcnt vmcnt(0)" ::: "memory");
    } else {
      XB_SPIN(xb_ld(&bar[XB_XGEN(b.x)]) == gen, bar);
      __builtin_amdgcn_fence(__ATOMIC_ACQUIRE, "agent");
      asm volatile("s_waitcnt vmcnt(0)" ::: "memory");
    }
  }
  __syncthreads();
}

DEVI void transpose_tiles(const float* srcb, unsigned char* dstb, int K, int N, int nb, size_t sstride, size_t dstride, unsigned char* smem, int& goff) {
  const int G = gridDim.x, tk = K / 128, tn = N / 256, per = tk * tn, total = per * nb, tid = ltid();
  const int first = (((int)blockIdx.x - goff) % G + G) % G;
  const int n4 = tid & 63, kp0 = tid >> 6;
  f32x4 va[8], vb[8];
  auto issue = [&](int ti) { const int m = ti / per, r = ti - m * per, kb = r / tn, nb_ = r - kb * tn;
    const float* src = srcb + (size_t)m * sstride + (size_t)(kb * 128) * N + nb_ * 256 + n4 * 4;
#pragma unroll
    for (int i = 0; i < 8; ++i) { const int kp = kp0 + 8 * i; va[i] = __builtin_nontemporal_load((const f32x4*)(src + (size_t)(2 * kp) * N)); vb[i] = __builtin_nontemporal_load((const f32x4*)(src + (size_t)(2 * kp + 1) * N)); } };
  if (first < total) issue(first);
  int par = 0;
  for (int ti = first; ti < total; ti += G, par ^= 1) {
    unsigned* Tb = (unsigned*)smem + par * 16384;
#pragma unroll
    for (int i = 0; i < 8; ++i) { const int kp = kp0 + 8 * i;
#pragma unroll
      for (int j = 0; j < 4; ++j) { const int n = n4 * 4 + j; Tb[n * 64 + (kp ^ (((n >> 2) & 7) << 2))] = pack2(va[i][j], vb[i][j]); } }
    if (ti + G < total) issue(ti + G);
    __syncthreads();
    const int m = ti / per, r = ti - m * per, kb = r / tn, nb_ = r - kb * tn;
    bf16_t* dst = (bf16_t*)dstb + (size_t)m * dstride + (size_t)(nb_ * 256) * K + kb * 128;
#pragma unroll
    for (int i = 0; i < 8; ++i) { const int pc = tid + 512 * i, n = pc >> 4, q = pc & 15;
      const u32x4 w = *(const u32x4*)(Tb + n * 64 + ((4 * q) ^ (((n >> 2) & 7) << 2)));
      *(u32x4*)(dst + (size_t)n * K + 8 * q) = w; }
  }
  __syncthreads();
  goff = (goff + total) % G;
}

constexpr int WD_SHIFT = 4, H_SHIFT = 2, WG_SHIFT = 5, X_SHIFT = 3, WQ_SHIFT = 5;
constexpr bool IN1_FP8 = true, IN0_FP8 = true, OUT0_FP8 = true, OUT1_FP8 = true;
constexpr bool ATT1_QK8 = true;
constexpr int QS_SHIFT = 2;
constexpr int A_SHIFT = 3;
DEVI void transpose_panel8(const float* src0, unsigned char* dst0, int K, int N, int kb, int nb_, unsigned char* smem, int shift = WD_SHIFT) {
  const int tid = ltid(), n4 = tid & 63, kq0 = tid >> 6; unsigned* Tb = (unsigned*)smem;
  const float* src = src0 + (size_t)(kb * 128) * N + nb_ * 256 + n4 * 4; unsigned char* dst = dst0 + (size_t)(nb_ * 256) * K + kb * 128;
  f32x4 v[4][4];
#pragma unroll
  for (int i = 0; i < 4; ++i)
#pragma unroll
    for (int r = 0; r < 4; ++r) v[i][r] = __builtin_nontemporal_load((const f32x4*)(src + (size_t)(4 * (kq0 + 8 * i) + r) * N));
  const float sc = (float)(1 << shift);
#pragma unroll
  for (int i = 0; i < 4; ++i) { const int kq = kq0 + 8 * i;
#pragma unroll
    for (int j = 0; j < 4; ++j) { const int n = n4 * 4 + j; int w = 0;
      w = __builtin_amdgcn_cvt_pk_fp8_f32(v[i][0][j] * sc, v[i][1][j] * sc, w, false); w = __builtin_amdgcn_cvt_pk_fp8_f32(v[i][2][j] * sc, v[i][3][j] * sc, w, true);
      Tb[n * 32 + (kq ^ (((n >> 2) & 7) << 2))] = (unsigned)w; } }
  __syncthreads();
#pragma unroll
  for (int i = 0; i < 4; ++i) { const int pc = tid + 512 * i, n = pc >> 3, q = pc & 7;
    const u32x4 w = *(const u32x4*)(Tb + n * 32 + ((4 * q) ^ (((n >> 2) & 7) << 2)));
    *(u32x4*)(dst + (size_t)n * K + 16 * q) = w; }
}
DEVI void transpose_all8(const float* src, unsigned char* dst, int K, int N, int shift, unsigned char* smem, int& goff) {
  const int G = gridDim.x, tk = K / 128, tn = N / 256, total = tk * tn;
  const int first = (((int)blockIdx.x - goff) % G + G) % G;
  for (int ti = first; ti < total; ti += G) { __syncthreads(); const int kb = ti / tn, nb_ = ti - kb * tn; transpose_panel8(src, dst, K, N, kb, nb_, smem, shift); }
  __syncthreads();
  goff = (goff + total) % G;
}
DEVI void stage_prep(const Params& p, const PrepIn& pin, unsigned char* smem) {
  const int tid = ltid(), bid = blockIdx.x, G = gridDim.x;
  {
    float* sl = (float*)smem;
    for (int i = tid; i < 17 * 1024; i += 512) { int r = i >> 10, k = i & 1023; float v; if (r < 16) v = pin.in[I_C][r * 1024 + k]; else v = pin.in[I_CCTX][k]; sl[i] = silu(v); }
    __syncthreads();
    float* part = (float*)(smem + 17 * 1024 * 4);
    for (int cb = bid; cb < 256; cb += G) {
      const int col0 = cb * 48;
      if (tid < 384) {
        const int kc = tid / 48, c = tid - kc * 48, gc = col0 + c, l = gc / 6144, n = gc - l * 6144;
        const float* w = pin.in[I_MODW] + (size_t)l * 1024 * 6144 + n;
        float acc[17];
#pragma unroll
        for (int r = 0; r < 17; ++r) acc[r] = 0.f;
        for (int k = kc * 128; k < kc * 128 + 128; ++k) { float wv = w[(size_t)k * 6144];
#pragma unroll
          for (int r = 0; r < 17; ++r) acc[r] += sl[r * 1024 + k] * wv; }
#pragma unroll
        for (int r = 0; r < 17; ++r) part[(kc * 17 + r) * 48 + c] = acc[r];
      }
      __syncthreads();
      for (int i = tid; i < 17 * 48; i += 512) { int r = i / 48, c = i - r * 48, gc = col0 + c, l = gc / 6144, n = gc - l * 6144;
        float s = pin.in[I_MODB][l * 6144 + n];
        for (int kc = 0; kc < 8; ++kc) s += part[(kc * 17 + r) * 48 + c];
        wsp<float>(p, OFF_MODV)[((size_t)(l * 17 + r)) * 6144 + n] = s; }
      __syncthreads();
    }
  }
  if (bid == 0) {
    float2* t64 = wsp<float2>(p, OFF_TAB64); float2* t128 = wsp<float2>(p, OFF_TAB128);
    for (int i = tid; i < 64 * 16; i += 512) { int pos = i >> 4, f = i & 15; float inv = exp2f(-(float)f * (13.287712379549449f / 16.0f)); float a = (float)pos * inv; t64[i] = make_float2(__cosf(a), __sinf(a)); }
    for (int i = tid; i < 64 * 32; i += 512) { int pos = i >> 5, f = i & 31; float inv = exp2f(-(float)f * (13.287712379549449f / 32.0f)); float a = (float)pos * inv; t128[i] = make_float2(__cosf(a), __sinf(a)); }
    if (tid < 64) { float a = pin.in[I_LQ1][tid] * pin.in[I_LK1][tid], b = pin.in[I_LQ2][tid] * pin.in[I_LK2][tid]; a = wsum(a); b = wsum(b);
      if (tid == 0) wsp<float>(p, OFF_LAM)[0] = expf(a) - expf(b) + 0.2f; }
  }
  { float* smw = wsp<float>(p, OFF_SMALL); const int gt = bid * 512 + tid, gs = G * 512;
#define CPY(idx, off, n) for (int i = gt; i < (n); i += gs) smw[(off) + i] = pin.in[idx][i];
    CPY(I_N1G, SM_N1G, 2048) CPY(I_N2G, SM_N2G, 2048) CPY(I_ALNG, SM_ALNG, 512) CPY(I_ALNB, SM_ALNB, 512) CPY(I_ABS, SM_ABS, 512) CPY(I_BQN, SM_BQN, 64) CPY(I_BKN, SM_BKN, 64)
    CPY(I_SUBLN, SM_SUBLN, 128) CPY(I_CQN, SM_CQN, 128) CPY(I_CKN, SM_CKN, 128) CPY(I_MBIAS, SM_MBIAS, 128) CPY(I_AWS, SM_AWSF, 65536) CPY(I_ROUTER, SM_ROUTER, 131072)
#undef CPY
  }
  for (int i = bid * 512 + tid; i < 2 * NE * D; i += G * 512) { const int l = i >> 16, e = (i >> 10) & 63, kk = i & 1023; wsp<bf16_t>(p, OFF_WRT)[i] = f2bf(pin.in[I_ROUTER][((size_t)l * D + kk) * NE + e]); }
  for (int i = bid * 512 + tid; i < 4 * 128 * 128; i += G * 512) wsp<bf16_t>(p, OFF_WSA)[i] = f2bf(pin.in[I_AWS][i]);
  int goff = 0;
  const size_t EW = (size_t)D * DE;
  __syncthreads();
  if (IN0_FP8) transpose_all8(pin.in[I_EVWIN], p.ws + OFF_WIN0T, D, EVEN_IN, WQ_SHIFT, smem, goff);
  else transpose_tiles(pin.in[I_EVWIN], p.ws + OFF_WIN0T, D, EVEN_IN, 1, 0, 0, smem, goff);
  if (OUT0_FP8) transpose_all8(pin.in[I_EVWOUT], p.ws + OFF_WOUT0T, D, D, WQ_SHIFT, smem, goff);
  else transpose_tiles(pin.in[I_EVWOUT], p.ws + OFF_WOUT0T, D, D, 1, 0, 0, smem, goff);
  if (IN1_FP8) transpose_all8(pin.in[I_ODQKV], p.ws + OFF_WQKV1T, D, ODD_IN, WQ_SHIFT, smem, goff);
  else transpose_tiles(pin.in[I_ODQKV], p.ws + OFF_WQKV1T, D, ODD_IN, 1, 0, 0, smem, goff);
  if (OUT1_FP8) transpose_all8(pin.in[I_ODOUT], p.ws + OFF_WOUT1T, D, D, WQ_SHIFT, smem, goff);
  else transpose_tiles(pin.in[I_ODOUT], p.ws + OFF_WOUT1T, D, D, 1, 0, 0, smem, goff);
  for (int pi = bid; pi < 32; pi += G) { __syncthreads(); const int l = pi >> 4, up = (pi >> 3) & 1, kb = pi & 7;
    const float* sgu; if (up) sgu = pin.in[I_SU]; else sgu = pin.in[I_SG]; asm volatile("" : "+s"(sgu));
    transpose_panel8(sgu + (size_t)l * EW, p.ws + OFF_SHGU + (size_t)l * 512 * D + (size_t)up * 256 * D, D, DE, kb, 0, smem, WG_SHIFT); }
  __syncthreads();
  for (int pi = bid; pi < 16; pi += G) { __syncthreads(); const int l = pi >> 3, rr = pi & 7; transpose_panel8(pin.in[I_SD] + (size_t)l * EW, p.ws + OFF_SHD + (size_t)l * EW, DE, D, rr >> 2, rr & 3, smem); }
  __syncthreads();
}
DEVI void transpose_panel(const float* src0, bf16_t* dst0, int K, int N, int kb, int nb_, unsigned char* smem) {
  const int tid = ltid(), n4 = tid & 63, kp0 = tid >> 6; unsigned* Tb = (unsigned*)smem;
  const float* src = src0 + (size_t)(kb * 128) * N + nb_ * 256 + n4 * 4; bf16_t* dst = dst0 + (size_t)(nb_ * 256) * K + kb * 128;
  f32x4 va[8], vb[8];
#pragma unroll
  for (int i = 0; i < 8; ++i) { const int kp = kp0 + 8 * i; va[i] = __builtin_nontemporal_load((const f32x4*)(src + (size_t)(2 * kp) * N)); vb[i] = __builtin_nontemporal_load((const f32x4*)(src + (size_t)(2 * kp + 1) * N)); }
#pragma unroll
  for (int i = 0; i < 8; ++i) { const int kp = kp0 + 8 * i;
#pragma unroll
    for (int j = 0; j < 4; ++j) { const int n = n4 * 4 + j; Tb[n * 64 + (kp ^ (((n >> 2) & 7) << 2))] = pack2(va[i][j], vb[i][j]); } }
  __syncthreads();
#pragma unroll
  for (int i = 0; i < 8; ++i) { const int pc = tid + 512 * i, n = pc >> 4, q = pc & 15;
    const u32x4 w = *(const u32x4*)(Tb + n * 64 + ((4 * q) ^ (((n >> 2) & 7) << 2)));
    *(u32x4*)(dst + (size_t)n * K + 8 * q) = w; }
}
DEVI void expert_prep_steal(const Params& p, const PrepIn& pin, unsigned char* smem, int layer) {
  const size_t EW = (size_t)D * DE, lo = (size_t)layer * NE * EW; int* ctr = (int*)(p.ws + OFF_STEAL) + layer; int* bc = (int*)(smem + 65536);
  for (;;) {
    __syncthreads();
    if (ltid() == 0) bc[0] = atomicAdd(ctr, 1);
    __syncthreads();
    const int idx = bc[0]; if (idx >= 3 * 512) break;
    const int j = idx >> 9, r = idx & 511, m = r >> 3, rr = r & 7;
    if (j == 0) transpose_panel8(pin.in[I_WG] + lo + (size_t)m * EW, p.ws + OFF_EGU + (size_t)m * 512 * D, D, DE, rr, 0, smem, WG_SHIFT);
    else if (j == 1) transpose_panel8(pin.in[I_WU] + lo + (size_t)m * EW, p.ws + OFF_EGU + (size_t)m * 512 * D + (size_t)256 * D, D, DE, rr, 0, smem, WG_SHIFT);
    else transpose_panel8(pin.in[I_WD] + lo + (size_t)m * EW, p.ws + OFF_ED + (size_t)m * EW, DE, D, rr >> 2, rr & 3, smem);
  }
}
DEVI void stage_prep_experts(const Params& p, const PrepIn& pin, unsigned char* smem, int layer) {
  int goff = 0; const size_t EW = (size_t)D * DE, lo = (size_t)layer * NE * EW;
  __syncthreads();
  transpose_tiles(pin.in[I_WG] + lo, p.ws + OFF_EGU, D, DE, 64, EW, (size_t)512 * D, smem, goff);
  transpose_tiles(pin.in[I_WU] + lo, p.ws + OFF_EGU + (size_t)256 * D * 2, D, DE, 64, EW, (size_t)512 * D, smem, goff);
  transpose_tiles(pin.in[I_WD] + lo, p.ws + OFF_ED, DE, D, 64, EW, EW, smem, goff);
  __syncthreads();
}

template <int LAYER> DEVI void stage_norm1(const Params& p) {
  const int wid = ltid() >> 6, lane = ltid() & 63;
  const float* g = sm(p, SM_N1G + LAYER * D);
  bf16_t* act = wsp<bf16_t>(p, OFF_ACT);
  for (int t = blockIdx.x * 8 + wid; t < T; t += gridDim.x * 8) {
    const float* row = LAYER == 0 ? in_row(p, t) : (const float*)hid_row(p, t);
    const float* sh = modv(p, LAYER, t, 0); const float* sc = modv(p, LAYER, t, 1);
    f32x4 v[4]; float ss = 0.f;
#pragma unroll
    for (int i = 0; i < 4; ++i) { v[i] = *(const f32x4*)(row + (i * 64 + lane) * 4); ss += v[i][0] * v[i][0] + v[i][1] * v[i][1] + v[i][2] * v[i][2] + v[i][3] * v[i][3]; }
    ss = wsum(ss); const float rstd = rsqrtf(ss * (1.0f / D) + EPS);
#pragma unroll
    for (int i = 0; i < 4; ++i) { const int c = (i * 64 + lane) * 4; const f32x4 gg = *(const f32x4*)(g + c), s1 = *(const f32x4*)(sc + c), s0 = *(const f32x4*)(sh + c);
      float y[4];
#pragma unroll
      for (int q = 0; q < 4; ++q) y[q] = v[i][q] * rstd * gg[q] * (1.0f + s1[q]) + s0[q];
      if ((LAYER == 0 && IN0_FP8) || (LAYER == 1 && IN1_FP8)) { const float xs = (float)(1 << X_SHIFT); int w8 = 0;
        w8 = __builtin_amdgcn_cvt_pk_fp8_f32(__builtin_amdgcn_fmed3f(y[0] * xs, -440.f, 440.f), __builtin_amdgcn_fmed3f(y[1] * xs, -440.f, 440.f), w8, false);
        w8 = __builtin_amdgcn_cvt_pk_fp8_f32(__builtin_amdgcn_fmed3f(y[2] * xs, -440.f, 440.f), __builtin_amdgcn_fmed3f(y[3] * xs, -440.f, 440.f), w8, true);
        *(int*)(p.ws + OFF_ACT8 + (size_t)t * D + c) = w8; }
      else { u32x2 w; w.x = pack2(y[0], y[1]); w.y = pack2(y[2], y[3]);
        *(u32x2*)(act + (size_t)t * D + c) = w; } }
  }
}

template <class GA, class GB, class ST>
DEVI void ngemm(int MT, int NT, int K, GA getA, GB getB, ST store) {
  const int wid = ltid() >> 6, lane = ltid() & 63, fr = lane & 15, fq = lane >> 4;
  const long nw = (long)gridDim.x * 8;
  for (long tile = (long)blockIdx.x * 8 + wid; tile < (long)MT * NT; tile += nw) {
    const int tm = (int)(tile / NT), tn = (int)(tile - (long)tm * NT);
    const bf16_t* a0 = getA(tm * 32 + fr); const bf16_t* a1 = getA(tm * 32 + 16 + fr);
    const bf16_t* b0 = getB(tn * 32 + fr); const bf16_t* b1 = getB(tn * 32 + 16 + fr);
    f32x4 c00 = {0.f, 0.f, 0.f, 0.f}, c01 = c00, c10 = c00, c11 = c00;
    const bf16x8 z = {0, 0, 0, 0, 0, 0, 0, 0};
    for (int k = 0; k < K; k += 32) {
      const bf16x8 A0 = a0 ? *(const bf16x8*)(a0 + k + fq * 8) : z, A1 = a1 ? *(const bf16x8*)(a1 + k + fq * 8) : z;
      const bf16x8 B0 = *(const bf16x8*)(b0 + k + fq * 8), B1 = *(const bf16x8*)(b1 + k + fq * 8);
      c00 = __builtin_amdgcn_mfma_f32_16x16x32_bf16(A0, B0, c00, 0, 0, 0);
      c01 = __builtin_amdgcn_mfma_f32_16x16x32_bf16(A0, B1, c01, 0, 0, 0);
      c10 = __builtin_amdgcn_mfma_f32_16x16x32_bf16(A1, B0, c10, 0, 0, 0);
      c11 = __builtin_amdgcn_mfma_f32_16x16x32_bf16(A1, B1, c11, 0, 0, 0);
    }
#pragma unroll
    for (int j = 0; j < 4; ++j) {
      store(tm * 32 + fq * 4 + j, tn * 32 + fr, tn * 32 + 16 + fr, c00[j], c01[j]);
      store(tm * 32 + 16 + fq * 4 + j, tn * 32 + fr, tn * 32 + 16 + fr, c10[j], c11[j]);
    }
  }
}

DEVI void n_inproj0(const Params& p) {
  const bf16_t* act = wsp<bf16_t>(p, OFF_ACT); const bf16_t* w = wsp<bf16_t>(p, OFF_WIN0T); bf16_t* proj = wsp<bf16_t>(p, OFF_PROJ);
  ngemm(T / 32, EVEN_IN / 32, D,
        [&](int r) { return act + (size_t)r * D; }, [&](int n) { return w + (size_t)n * D; },
        [&](int r, int n0, int n1, float v0, float v1) { proj[(size_t)r * EVEN_IN + n0] = f2bf(v0); proj[(size_t)r * EVEN_IN + n1] = f2bf(v1); });
}
DEVI void n_post0(const Params& p) {
  const int wid = ltid() >> 6, lane = ltid() & 63;
  bf16_t* proj = wsp<bf16_t>(p, OFF_PROJ); const float2* t64 = wsp<float2>(p, OFF_TAB64);
  for (int t = blockIdx.x * 8 + wid; t < T; t += gridDim.x * 8) {
    bf16_t* row = proj + (size_t)t * EVEN_IN; const int b = t / SB, j = t - b * SB;
    for (int i = 0; i < 16; ++i) { int c = i * 64 + lane; row[c] = f2bf(gelu_exact(bf2f(row[c]))); }
    for (int hh = 0; hh < 16; ++hh) {
      const int c = 1024 + hh * 64 + lane; float v = bf2f(row[c]);
      float ss = wsum(v * v); float g = sm(p, hh < 8 ? SM_BQN : SM_BKN)[lane];
      float y = v * rsqrtf(ss * (1.0f / 64) + EPS) * g;
      y = bf2f(f2bf(y));
      if (j >= NC) { const int pos = j - NC, pr = lane >> 1; const int ps = pr < 16 ? (pos >> 6) : (pos & 63); const float2 cs = t64[ps * 16 + (pr & 15)];
        const float other = shx<1>(y);
        y = (lane & 1) ? (other * cs.y + y * cs.x) : (y * cs.x - other * cs.y); }
      row[c] = f2bf(y);
    }
  }
}

DEVI void attn_row(const bf16_t* q, int dq, const bf16_t* kb, int ldk, const bf16_t* vb, int ldv, int nkeys, float scale,
                   volatile float* sc, volatile float* qs, float& o0, float& o1) {
  const int lane = ltid() & 63;
  for (int d = lane; d < dq; d += 64) qs[d] = bf2f(q[d]);
  float mx = -1e30f;
  for (int key = lane; key < nkeys; key += 64) { const bf16_t* kr = kb + (size_t)key * ldk; float dot = 0.f;
    for (int d = 0; d < dq; d += 8) { const bf16x8 kv = *(const bf16x8*)(kr + d);
#pragma unroll
      for (int e = 0; e < 8; ++e) dot += qs[d + e] * bf2f((bf16_t)kv[e]); }
    dot *= scale; sc[key] = dot; mx = fmaxf(mx, dot); }
  mx = wmax(mx); float sum = 0.f;
  for (int key = lane; key < nkeys; key += 64) { float pv = __expf(sc[key] - mx); sc[key] = pv; sum += pv; }
  sum = wsum(sum); float a0 = 0.f, a1 = 0.f;
  for (int key = 0; key < nkeys; ++key) { const float pv = sc[key]; const unsigned vv = *(const unsigned*)(vb + (size_t)key * ldv + 2 * lane);
    a0 += pv * bf2f((bf16_t)(vv & 0xffff)); a1 += pv * bf2f((bf16_t)(vv >> 16)); }
  const float inv = 1.0f / sum; o0 = a0 * inv; o1 = a1 * inv;
}
DEVI void n_attn0(const Params& p, unsigned char* smem) {
  const int wid = ltid() >> 6, lane = ltid() & 63;
  volatile float* sc = (volatile float*)(smem + wid * (2304 * 4 + 512)); volatile float* qs = sc + 2304;
  const bf16_t* proj = wsp<bf16_t>(p, OFF_PROJ); bf16_t* cat = wsp<bf16_t>(p, OFF_ACT);
  const float lam = wsp<float>(p, OFF_LAM)[0];
  for (int task = blockIdx.x * 8 + wid; task < T * 4; task += gridDim.x * 8) {
    const int t = task >> 2, h = task & 3, b = t / SB, j = t - b * SB; const int nkeys = j < NC ? NC : SB;
    const bf16_t* kbase = proj + (size_t)(b * SB) * EVEN_IN + 1536 + h * 128; const bf16_t* vbase = proj + (size_t)(b * SB) * EVEN_IN + 2048 + h * 128;
    const bf16_t* q = proj + (size_t)t * EVEN_IN + 1024 + h * 128;
    float a0, a1, b0, b1;
    attn_row(q, 64, kbase, EVEN_IN, vbase, EVEN_IN, nkeys, 0.125f, sc, qs, a0, a1);
    attn_row(q + 64, 64, kbase + 64, EVEN_IN, vbase, EVEN_IN, nkeys, 0.125f, sc, qs, b0, b1);
    float o0 = a0 - lam * b0, o1 = a1 - lam * b1;
    float ss = wsum(o0 * o0 + o1 * o1); const float r = rsqrtf(ss * (1.0f / 128) + EPS) * 0.8f;
    o0 = o0 * r * sm(p, SM_SUBLN)[2 * lane]; o1 = o1 * r * sm(p, SM_SUBLN)[2 * lane + 1];
    *(unsigned*)(cat + (size_t)t * D + 512 + h * 128 + 2 * lane) = pack2(o0, o1);
  }
}
DEVI void n_gmlp(const Params& p, unsigned char* smem) {
  const int tid = ltid(), wid = tid >> 6, lane = tid & 63;
  bf16_t* lv = (bf16_t*)smem;
  const bf16_t* proj = wsp<bf16_t>(p, OFF_PROJ); bf16_t* cat = wsp<bf16_t>(p, OFF_ACT);
  for (int ch = blockIdx.x; ch < T / 128; ch += gridDim.x) {
    __syncthreads();
    for (int r = wid; r < 128; r += 8) { const bf16_t* vr = proj + (size_t)(ch * 128 + r) * EVEN_IN + 512;
      float v[8]; float s = 0.f;
#pragma unroll
      for (int i = 0; i < 8; ++i) { v[i] = bf2f(vr[i * 64 + lane]); s += v[i]; }
      s = wsum(s); const float mu = s * (1.0f / 512); float q = 0.f;
#pragma unroll
      for (int i = 0; i < 8; ++i) { const float d = v[i] - mu; q += d * d; }
      q = wsum(q); const float rstd = rsqrtf(q * (1.0f / 512) + EPS);
#pragma unroll
      for (int i = 0; i < 8; ++i) { const int c = i * 64 + lane; lv[r * 512 + c] = f2bf((v[i] - mu) * rstd * sm(p, SM_ALNG)[c] + sm(p, SM_ALNB)[c]); } }
    __syncthreads();
    const int c = tid, g = c >> 7;
    const float* wsg = sm(p, SM_AWSF) + (size_t)g * 128 * 128;
    for (int pp = 0; pp < 128; ++pp) { float acc = 0.f; const float* wr = wsg + pp * 128;
      for (int q = 0; q < 128; ++q) acc += wr[q] * bf2f(lv[q * 512 + c]);
      acc += sm(p, SM_ABS)[g * 128 + pp];
      const size_t t = (size_t)ch * 128 + pp; const float u = bf2f(proj[t * EVEN_IN + c]);
      cat[t * D + c] = f2bf(u * acc); }
  }
}
template <int LAYER> DEVI void n_outproj(const Params& p) {
  const bf16_t* cat = wsp<bf16_t>(p, OFF_ACT); const bf16_t* w = wsp<bf16_t>(p, LAYER == 0 ? OFF_WOUT0T : OFF_WOUT1T);
  auto st1 = [&](int r, int n, float v) { const int b = r / SB, j = r - b * SB; if (LAYER == 1 && j < NC) return;
    const float* res = LAYER == 0 ? in_row(p, r) : (const float*)hid_row(p, r); float* dst = hid_row(p, r);
    dst[n] = res[n] + modv(p, LAYER, r, 2)[n] * v; };
  ngemm(T / 32, D / 32, D, [&](int r) { return cat + (size_t)r * D; }, [&](int n) { return w + (size_t)n * D; },
        [&](int r, int n0, int n1, float v0, float v1) { st1(r, n0, v0); st1(r, n1, v1); });
}

struct LCfg { int l, npb, j0, nph; };
DEVI int act_tok(const LCfg& c, int half, int tl) { const int bl = tl / c.npb, jj = tl - bl * c.npb; return (half * 8 + bl) * SB + c.j0 + jj; }
DEVI void stage_router(const Params& p, const LCfg c, unsigned char* smem) {
  const int wid = ltid() >> 6, lane = ltid() & 63, fr = lane & 15, fq = lane >> 4;
  float* lgs = (float*)smem + wid * 4096;
  int* ksl = (int*)lgs + 2048;
  const float* g = sm(p, SM_N2G + c.l * D); bf16_t* act = wsp<bf16_t>(p, OFF_ACT);
  const bf16_t* wrt = wsp<bf16_t>(p, OFF_WRT) + (size_t)c.l * NE * D; const float bias = sm(p, SM_MBIAS)[c.l * NE + lane];
  int* cnt = (int*)(p.ws + OFF_CNT) + c.l * 128; int* list = wsp<int>(p, OFF_LIST); float* topw = wsp<float>(p, OFF_TOPW);
  const int nact = c.nph, nwv = gridDim.x * 8, chunk0 = (nact + nwv - 1) / nwv, chunk = chunk0 < 32 ? chunk0 : 32;
  const bool agg = (nact == nwv * chunk);
  LAS int* blk = (LAS int*)((LAS unsigned char*)smem + 131072); LAS int* blkb = blk + 64;
  if (agg) {
    if (ltid() < 64) blk[ltid()] = 0;
    const u32x4* src = (const u32x4*)wrt;
    for (int i = ltid(); i < NE * 128; i += 512) { const int row = i >> 7, ch = i & 127; *(LAS u32x4*)((LAS unsigned char*)smem + row * 2048 + ((ch ^ (row & 7)) << 4)) = src[i]; }
    __syncthreads(); }
  for (int ga0 = (blockIdx.x * 8 + wid) * chunk; ga0 < nact; ga0 += nwv * chunk) {
    const int ntk = (nact - ga0) < chunk ? (nact - ga0) : chunk;
    f32x4 gg[4], s1v[4], s0v[4]; int curb = -1;
#pragma unroll
    for (int i = 0; i < 4; ++i) gg[i] = *(const f32x4*)(g + (i * 64 + lane) * 4);
    for (int j0 = 0; j0 < ntk; j0 += 3) {
      f32x4 v[3][4]; int tt[3];
#pragma unroll
      for (int u = 0; u < 3; ++u) { int j = j0 + u; j = j < ntk ? j : ntk - 1; const int ga = ga0 + j, half = ga / c.nph, tl = ga - half * c.nph; tt[u] = act_tok(c, half, tl);
        const bf16_t* row = wsp<bf16_t>(p, OFF_HB) + (size_t)tt[u] * D;
#pragma unroll
        for (int i = 0; i < 4; ++i) v[u][i] = bf4(*(const u32x2*)(row + (i * 64 + lane) * 4)); }
#pragma unroll
      for (int u = 0; u < 3; ++u) { float ss = 0.f;
#pragma unroll
        for (int i = 0; i < 4; ++i) ss += v[u][i][0] * v[u][i][0] + v[u][i][1] * v[u][i][1] + v[u][i][2] * v[u][i][2] + v[u][i][3] * v[u][i][3];
        const float rstd = rsqrtf(wsum_dpp(ss) * (1.0f / D) + EPS);
        const int bt = tt[u] / SB, jt = tt[u] - bt * SB, mrow = jt < NC ? 16 : bt;
        if (mrow != curb) { curb = mrow; const float* sh = modv(p, c.l, tt[u], 3); const float* sc = modv(p, c.l, tt[u], 4);
#pragma unroll
          for (int i = 0; i < 4; ++i) { s0v[i] = *(const f32x4*)(sh + (i * 64 + lane) * 4); s1v[i] = *(const f32x4*)(sc + (i * 64 + lane) * 4); } }
        if (j0 + u < ntk) {
#pragma unroll
          for (int i = 0; i < 4; ++i) { const int cc = (i * 64 + lane) * 4;
            float y[4];
#pragma unroll
            for (int q = 0; q < 4; ++q) y[q] = v[u][i][q] * rstd * gg[i][q] * (1.0f + s1v[i][q]) + s0v[i][q];
            u32x2 w; w.x = pack2(y[0], y[1]); w.y = pack2(y[2], y[3]);
            *(u32x2*)(act + (size_t)tt[u] * D + cc) = w;
            const float xs = (float)(1 << X_SHIFT); int w8 = 0;
            w8 = __builtin_amdgcn_cvt_pk_fp8_f32(__builtin_amdgcn_fmed3f(y[0] * xs, -440.f, 440.f), __builtin_amdgcn_fmed3f(y[1] * xs, -440.f, 440.f), w8, false);
            w8 = __builtin_amdgcn_cvt_pk_fp8_f32(__builtin_amdgcn_fmed3f(y[2] * xs, -440.f, 440.f), __builtin_amdgcn_fmed3f(y[3] * xs, -440.f, 440.f), w8, true);
            *(int*)(p.ws + OFF_ACT8 + (size_t)tt[u] * D + cc) = w8; } }
      }
    }
    asm volatile("s_waitcnt vmcnt(0)" ::: "memory");
    const bf16_t* ar[2];
#pragma unroll
    for (int m = 0; m < 2; ++m) { int jj = m * 16 + fr; jj = jj < ntk ? jj : 0; const int ga = ga0 + jj, half = ga / c.nph, tl = ga - half * c.nph; ar[m] = act + (size_t)act_tok(c, half, tl) * D + fq * 8; }
    const bf16_t* br = wrt + (size_t)fr * D + fq * 8;
    f32x4 acc[2][4];
#pragma unroll
    for (int m = 0; m < 2; ++m)
#pragma unroll
      for (int n = 0; n < 4; ++n) acc[m][n] = (f32x4){0.f, 0.f, 0.f, 0.f};
    if (agg) {
      const LAS unsigned char* bl = (const LAS unsigned char*)smem + fr * 2048; const int sw = fr & 7;
#pragma unroll 8
      for (int k0 = 0; k0 < D; k0 += 32) {
        bf16x8 af[2], bfr[4];
#pragma unroll
        for (int m = 0; m < 2; ++m) af[m] = *(const bf16x8*)(ar[m] + k0);
#pragma unroll
        for (int n = 0; n < 4; ++n) bfr[n] = *(const LAS bf16x8*)(bl + n * 32768 + ((((k0 >> 3) + fq) ^ sw) << 4));
#pragma unroll
        for (int m = 0; m < 2; ++m)
#pragma unroll
          for (int n = 0; n < 4; ++n) acc[m][n] = __builtin_amdgcn_mfma_f32_16x16x32_bf16(af[m], bfr[n], acc[m][n], 0, 0, 0);
      }
      __syncthreads();
    } else {
#pragma unroll 4
    for (int k0 = 0; k0 < D; k0 += 32) {
      bf16x8 af[2], bfr[4];
#pragma unroll
      for (int m = 0; m < 2; ++m) af[m] = *(const bf16x8*)(ar[m] + k0);
#pragma unroll
      for (int n = 0; n < 4; ++n) bfr[n] = *(const bf16x8*)(br + (size_t)(16 * n) * D + k0);
#pragma unroll
      for (int m = 0; m < 2; ++m)
#pragma unroll
        for (int n = 0; n < 4; ++n) acc[m][n] = __builtin_amdgcn_mfma_f32_16x16x32_bf16(af[m], bfr[n], acc[m][n], 0, 0, 0);
    }
    }
    __builtin_amdgcn_wave_barrier();
#pragma unroll
    for (int m = 0; m < 2; ++m)
#pragma unroll
      for (int n = 0; n < 4; ++n)
#pragma unroll
        for (int r = 0; r < 4; ++r) lgs[(m * 16 + 4 * fq + r) * 64 + 16 * n + fr] = acc[m][n][r];
    __builtin_amdgcn_fence(__ATOMIC_RELEASE, "wavefront"); __builtin_amdgcn_wave_barrier();
    const int half0 = ga0 / c.nph, half1 = (ga0 + ntk - 1) / c.nph;
    unsigned cm0 = 0u, cm1 = 0u;
    for (int j0 = 0; j0 < ntk; j0 += 3) {
      float wq[3]; int kq[3];
#pragma unroll
      for (int u = 0; u < 3; ++u) { const int j = (j0 + u) < ntk ? (j0 + u) : j0;
        const float lg = ((volatile float*)lgs)[j * 64 + lane];
        const float score = __builtin_amdgcn_rcpf(1.0f + __expf(-lg)); const float sel = score + bias;
        const float m1 = max8_dpp(sel);
        const unsigned long long isb = __ballot(sel == m1); const int gbase = lane & ~7; const unsigned gm = (unsigned)((isb >> gbase) & 0xffull);
        const int first = gbase + __builtin_ctz(gm);
        const float m2 = max8_dpp((lane == first) ? -INFINITY : sel);
        const float gs = m1 + m2; const int gi = lane >> 3; int grank = 0;
#pragma unroll
        for (int g2 = 0; g2 < 8; ++g2) { const float og = rlane(gs, g2 * 8); grank += (og > gs || (og == gs && g2 < gi)) ? 1 : 0; }
        float cur = grank < 4 ? sel : -INFINITY;
        int myk = -1; float wsumv = 0.f;
#pragma unroll
        for (int kk = 0; kk < TOPK; ++kk) { const float mxv = wmax_dpp(cur); const unsigned long long bm = __ballot(cur == mxv); const int win = __builtin_ctzll(bm);
          if (lane == win) { myk = kk; cur = -INFINITY; } wsumv += rlane(score, win); }
        wq[u] = score * __builtin_amdgcn_rcpf(wsumv) * 2.5f; kq[u] = myk; }
#pragma unroll
      for (int u = 0; u < 3; ++u) { const int j = j0 + u;
        if (j < ntk) { ((volatile float*)lgs)[j * 64 + lane] = wq[u]; ((volatile int*)ksl)[j * 64 + lane] = kq[u];
          const bool inh0 = (ga0 + j) / c.nph == half0;
          if (kq[u] >= 0) { if (inh0) cm0 |= 1u << j; else cm1 |= 1u << j; } } }
    }
    int base0 = 0, base1 = 0;
    if (agg) {
      const int n0 = __builtin_popcount(cm0); int wb = 0;
      if (n0) wb = __atomic_fetch_add(&blk[lane], n0, __ATOMIC_RELAXED);
      __syncthreads();
      if (wid == 0) { const int tot = blk[lane]; int gb = 0; if (tot) gb = atomicAdd(&cnt[half0 * 64 + lane], tot); blkb[lane] = gb; }
      __syncthreads();
      base0 = blkb[lane] + wb;
    } else {
      if (cm0) base0 = atomicAdd(&cnt[half0 * 64 + lane], __builtin_popcount(cm0));
      if (cm1) base1 = atomicAdd(&cnt[half1 * 64 + lane], __builtin_popcount(cm1));
    }
    for (int j = 0; j < ntk; ++j) {
      const int myk = ((volatile int*)ksl)[j * 64 + lane];
      if (myk >= 0) { const int ga = ga0 + j, half = ga / c.nph, tl = ga - half * c.nph; const unsigned below = (1u << j) - 1u;
        const int pos = half == half0 ? base0 + __builtin_popcount(cm0 & below) : base1 + __builtin_popcount(cm1 & below);
        list[((size_t)(half * 64 + lane)) * LCAP + pos] = tl * 6 + myk; topw[(size_t)ga * 6 + myk] = ((volatile float*)lgs)[j * 64 + lane]; wsp<int>(p, OFF_TOPP)[(size_t)ga * 6 + myk] = (lane << 24) | pos; }
    }
    __builtin_amdgcn_wave_barrier();
  }
}

DEVI void n_moe_gu(const Params& p, const LCfg c, int half) {
  const bf16_t* act = wsp<bf16_t>(p, OFF_ACT); bf16_t* hid = wsp<bf16_t>(p, OFF_HID);
  const int* cnt = (const int*)(p.ws + OFF_CNT) + c.l * 128 + half * 64; const int* list = wsp<int>(p, OFF_LIST) + (size_t)half * 64 * LCAP;
  int off = 0;
  for (int e = 0; e <= NE; ++e) {
    const int n = e < NE ? cnt[e] : c.nph;
    const bf16_t* w = e < NE ? wsp<bf16_t>(p, OFF_EGU) + (size_t)e * 512 * D : wsp<bf16_t>(p, OFF_SHGU) + (size_t)c.l * 512 * D;
    const int* le = list + (size_t)e * LCAP;
    ngemm((n + 31) / 32, DE / 16, D,
          [&](int r) -> const bf16_t* { if (r >= n) return nullptr; const int tl = e < NE ? le[r] / 6 : r; return act + (size_t)act_tok(c, half, tl) * D; },
          [&](int nn) { const int tn = nn >> 5, i = (nn >> 4) & 1, fr = nn & 15; return w + (size_t)(i * 256 + tn * 16 + fr) * D; },
          [&](int r, int n0, int n1, float v0, float v1) { if (r < n) hid[(size_t)(off + r) * DE + (n0 >> 5) * 16 + (n0 & 15)] = f2bf(silu(v0) * v1); });
    off += n;
  }
}
DEVI void n_moe_down(const Params& p, const LCfg c, int half) {
  const bf16_t* hid = wsp<bf16_t>(p, OFF_HID); bf16_t* slot = wsp<bf16_t>(p, OFF_SLOT);
  const int* cnt = (const int*)(p.ws + OFF_CNT) + c.l * 128 + half * 64; const int* list = wsp<int>(p, OFF_LIST) + (size_t)half * 64 * LCAP;
  int off = 0;
  for (int e = 0; e <= NE; ++e) {
    const int n = e < NE ? cnt[e] : c.nph;
    const bf16_t* w = e < NE ? wsp<bf16_t>(p, OFF_ED) + (size_t)e * D * DE : wsp<bf16_t>(p, OFF_SHD) + (size_t)c.l * D * DE;
    const int* le = list + (size_t)e * LCAP;
    auto st1 = [&](int r, int nn, float v) { if (r >= n) return;
      if (e < NE) slot[(size_t)le[r] * D + nn] = f2bf(v);
      else { const int t = act_tok(c, half, r); float* h = hid_row(p, t); h[nn] += modv(p, c.l, t, 5)[nn] * v; } };
    ngemm((n + 31) / 32, D / 32, DE,
          [&](int r) -> const bf16_t* { return r < n ? hid + (size_t)(off + r) * DE : nullptr; },
          [&](int nn) { return w + (size_t)nn * DE; },
          [&](int r, int n0, int n1, float v0, float v1) { st1(r, n0, v0); st1(r, n1, v1); });
    off += n;
  }
}
template <bool FUSE_NORM1> DEVI void stage_combine(const Params& p, const LCfg c, int half, unsigned char* smem, float dscale = 1.0f) {
  const int wid = ltid() >> 6, lane = ltid() & 63;
  int* off = (int*)smem;
  __syncthreads();
  if (ltid() == 0) { const int* cnt = (const int*)(p.ws + OFF_CNT) + c.l * 128 + half * 64; int o = 0; for (int e = 0; e < NE; ++e) { off[e] = o; o += cnt[e]; } off[NE] = o; }
  __syncthreads();
  const unsigned char* slot = p.ws + OFF_SLOT; const float* topw = wsp<float>(p, OFF_TOPW); const int* topp = wsp<int>(p, OFF_TOPP);
  for (int tl = blockIdx.x * 8 + wid; tl < c.nph; tl += gridDim.x * 8) {
    const int t = act_tok(c, half, tl); bf16_t* h = wsp<bf16_t>(p, OFF_HB) + (size_t)t * D; const float* g5 = modv(p, c.l, t, 5);
    float* orow = p.out + ((size_t)((t / SB) * S + (t % SB) - NC)) * D;
    const float* w = topw + ((size_t)(half * c.nph + tl)) * 6; const int* pp = topp + ((size_t)(half * c.nph + tl)) * 6;
    float wk[7]; size_t ro[7];
#pragma unroll
    for (int k = 0; k < 6; ++k) { wk[k] = w[k]; const int q = pp[k]; ro[k] = (size_t)(off[q >> 24] + (q & 0xffffff)) * D; }
    wk[6] = 1.0f; ro[6] = (size_t)(off[NE] + tl) * D;
    unsigned sv[4][7]; f32x4 hv[4];
#pragma unroll
    for (int i = 0; i < 4; ++i) { const int cc = (i * 64 + lane) * 4; hv[i] = bf4(*(const u32x2*)(h + cc));
#pragma unroll
      for (int k = 0; k < 7; ++k) sv[i][k] = *(const unsigned*)(slot + ro[k] + cc); }
#pragma unroll
    for (int i = 0; i < 4; ++i) { const int cc = (i * 64 + lane) * 4; f32x4 acc = {0.f, 0.f, 0.f, 0.f};
#pragma unroll
      for (int k = 0; k < 7; ++k) { const auto lo = __builtin_amdgcn_cvt_pk_f32_fp8((int)sv[i][k], false); const auto hi = __builtin_amdgcn_cvt_pk_f32_fp8((int)sv[i][k], true);
        acc[0] += wk[k] * lo[0]; acc[1] += wk[k] * lo[1]; acc[2] += wk[k] * hi[0]; acc[3] += wk[k] * hi[1]; }
      const f32x4 gg = *(const f32x4*)(g5 + cc);
#pragma unroll
      for (int q = 0; q < 4; ++q) hv[i][q] += gg[q] * acc[q] * dscale;
      if (FUSE_NORM1) { u32x2 w; w.x = pack2(hv[i][0], hv[i][1]); w.y = pack2(hv[i][2], hv[i][3]); *(u32x2*)(h + cc) = w; }
      else *(f32x4*)(orow + cc) = hv[i]; }
    if (FUSE_NORM1) {
      float ss = 0.f;
#pragma unroll
      for (int i = 0; i < 4; ++i) ss += hv[i][0] * hv[i][0] + hv[i][1] * hv[i][1] + hv[i][2] * hv[i][2] + hv[i][3] * hv[i][3];
      const float rstd = rsqrtf(wsum_dpp(ss) * (1.0f / D) + EPS);
      const float* g1 = sm(p, SM_N1G + (c.l + 1) * D); const float* sh = modv(p, c.l + 1, t, 0); const float* sc = modv(p, c.l + 1, t, 1);
      bf16_t* act = wsp<bf16_t>(p, OFF_ACT);
#pragma unroll
      for (int i = 0; i < 4; ++i) { const int cc = (i * 64 + lane) * 4; const f32x4 gg = *(const f32x4*)(g1 + cc), s1 = *(const f32x4*)(sc + cc), s0 = *(const f32x4*)(sh + cc);
        float y[4];
#pragma unroll
        for (int q = 0; q < 4; ++q) y[q] = hv[i][q] * rstd * gg[q] * (1.0f + s1[q]) + s0[q];
        if (IN1_FP8) { const float xs = (float)(1 << X_SHIFT); int w8 = 0;
          w8 = __builtin_amdgcn_cvt_pk_fp8_f32(__builtin_amdgcn_fmed3f(y[0] * xs, -440.f, 440.f), __builtin_amdgcn_fmed3f(y[1] * xs, -440.f, 440.f), w8, false);
          w8 = __builtin_amdgcn_cvt_pk_fp8_f32(__builtin_amdgcn_fmed3f(y[2] * xs, -440.f, 440.f), __builtin_amdgcn_fmed3f(y[3] * xs, -440.f, 440.f), w8, true);
          *(int*)(p.ws + OFF_ACT8 + (size_t)t * D + cc) = w8; }
        else { u32x2 w; w.x = pack2(y[0], y[1]); w.y = pack2(y[2], y[3]);
          *(u32x2*)(act + (size_t)t * D + cc) = w; } }
    }
  }
}

DEVI void n_inproj1(const Params& p) {
  const bf16_t* act = wsp<bf16_t>(p, OFF_ACT); const bf16_t* w = wsp<bf16_t>(p, OFF_WQKV1T); bf16_t* proj = wsp<bf16_t>(p, OFF_PROJ);
  ngemm(T / 32, ODD_IN / 32, D, [&](int r) { return act + (size_t)r * D; }, [&](int n) { return w + (size_t)n * D; },
        [&](int r, int n0, int n1, float v0, float v1) { proj[(size_t)r * ODD_IN + n0] = f2bf(v0); proj[(size_t)r * ODD_IN + n1] = f2bf(v1); });
}
DEVI void n_post1(const Params& p) {
  const int wid = ltid() >> 6, lane = ltid() & 63;
  bf16_t* proj = wsp<bf16_t>(p, OFF_PROJ); const float2* t128 = wsp<float2>(p, OFF_TAB128);
  for (int t = blockIdx.x * 8 + wid; t < T; t += gridDim.x * 8) {
    bf16_t* row = proj + (size_t)t * ODD_IN; const int b = t / SB, j = t - b * SB;
    for (int hh = 0; hh < 10; ++hh) {
      unsigned* pp = (unsigned*)(row + hh * 128 + 2 * lane); const unsigned u = *pp;
      float x1 = __uint_as_float(u << 16), x2 = __uint_as_float(u & 0xffff0000u);
      const float ss = wsum(x1 * x1 + x2 * x2); const float r = rsqrtf(ss * (1.0f / 128) + EPS);
      const float* g = sm(p, hh < 8 ? SM_CQN : SM_CKN);
      x1 = x1 * r * g[2 * lane]; x2 = x2 * r * g[2 * lane + 1];
      if (j >= NC) { const int pos = j - NC; const int ps = lane < 32 ? (pos >> 6) : (pos & 63); const float2 cs = t128[ps * 32 + (lane & 31)];
        const float y1 = x1 * cs.x - x2 * cs.y, y2 = x1 * cs.y + x2 * cs.x; x1 = y1; x2 = y2; }
      *pp = pack2(x1, x2);
    }
  }
}
DEVI void n_attn1(const Params& p, unsigned char* smem) {
  const int wid = ltid() >> 6, lane = ltid() & 63;
  volatile float* sc = (volatile float*)(smem + wid * (2304 * 4 + 512)); volatile float* qs = sc + 2304;
  const bf16_t* proj = wsp<bf16_t>(p, OFF_PROJ); bf16_t* att = wsp<bf16_t>(p, OFF_ACT);
  for (int task = blockIdx.x * 8 + wid; task < TX * 8; task += gridDim.x * 8) {
    const int tx = task >> 3, h = task & 7, b = tx / S, i = tx - b * S, t = b * SB + NC + i, kvh = h >> 2;
    const bf16_t* kbase = proj + (size_t)(b * SB) * ODD_IN + 1024 + kvh * 128; const bf16_t* vbase = kbase + 256;
    float o0, o1;
    attn_row(proj + (size_t)t * ODD_IN + h * 128, 128, kbase, ODD_IN, vbase, ODD_IN, SB, 0.08838834764831845f, sc, qs, o0, o1);
    *(unsigned*)(att + (size_t)t * D + h * 128 + 2 * lane) = pack2(o0, o1);
  }
}

namespace fg {
constexpr int BM = 256, BK = 64, HALF = 128, HTB = HALF * BK * 2, STAGE_BYTES = 8 * HTB;
constexpr int LDS_XCH = STAGE_BYTES, LDS_TAB = STAGE_BYTES + 4096, LDS_ROPE = STAGE_BYTES + 6144, LDS_GAIN = LDS_ROPE + 16384;
DEVI int lds_byte(int r, int c) { const int st = (r >> 4) * 2 + (c >> 5), rr = r & 15, cc = c & 31, ob = rr * 64 + cc * 2; return st * 1024 + (ob ^ (((ob >> 9) & 1) << 5)); }
DEVI void stage_rc(int b, int& R, int& C) { const int st = b / 1024, sb = b % 1024, swz = sb ^ (((sb >> 9) & 1) << 5); R = (st >> 1) * 16 + swz / 64; C = (st & 1) * 32 + (swz % 64) / 2; }
DEVI int perm32(int rho) { const int n = rho >> 4, i = rho & 15; return 8 * (i >> 2) + 4 * n + (i & 3); }
DEVI unsigned cvt_pk_bf16(float lo, float hi) { unsigned r; asm volatile("v_cvt_pk_bf16_f32 %0, %1, %2" : "=v"(r) : "v"(lo), "v"(hi)); return r; }
typedef float f32x2 __attribute__((ext_vector_type(2)));
DEVI f32x2 gelu_pk(f32x2 v) {
  const f32x2 av = __builtin_elementwise_abs(v), d = av * 0.2316418882f + 1.0f;
  f32x2 t; t.x = __builtin_amdgcn_rcpf(d.x); t.y = __builtin_amdgcn_rcpf(d.y);
  f32x2 q = t * 0.5307027145f + (-0.7265760135f); q = q * t + 0.7107068705f; q = q * t + (-0.142248368f); q = q * t + 0.127414796f; q = q * t;
  const f32x2 s = (v * v) * (-0.72134752044f);
  f32x2 e; e.x = __builtin_amdgcn_exp2f(s.x); e.y = __builtin_amdgcn_exp2f(s.y);
  const f32x2 m = v * (q * e), r = v - m;
  f32x2 o; o.x = v.x < 0.f ? m.x : r.x; o.y = v.y < 0.f ? m.y : r.y; return o;
}
struct Unit { const char* A; const char* B0; const char* B1; int pm, pn, e, cnt, off; };
typedef f32x4 Acc[2][2][4][2];
typedef int v8i_t __attribute__((ext_vector_type(8)));
template <int K> DEVI unsigned boff_m1(int R, int C) { return (unsigned)((64 * (R >> 5) + perm32(R & 31)) * K + C) * 2u; }
template <int K> DEVI unsigned boff_m2(int R, int C) { return (unsigned)(((R & ~31) + perm32(R & 31)) * K + C) * 2u; }

template <class Job>
DEVI void gemm_phase(LAS unsigned char* lds, Job& J) {
  constexpr int K = Job::K, nt = K / BK;
  const int tid = ltid(), wid = __builtin_amdgcn_readfirstlane(tid >> 6), lane = tid & 63, wr = wid >> 2, wc = wid & 3, fr = lane & 15, fq = lane >> 4;
  int Rr[2], Cc[2];
#pragma unroll
  for (int i = 0; i < 2; ++i) stage_rc(tid * 16 + i * 8192, Rr[i], Cc[i]);
  unsigned voffB[2];
#pragma unroll
  for (int i = 0; i < 2; ++i) voffB[i] = J.boff(Rr[i], Cc[i]);
  unsigned cv[2][2]; unsigned nv[2][2];
  constexpr size_t AH = Job::GATHER ? 0 : (size_t)HALF * K * 2;
#define CV1 cv[Job::GATHER ? 1 : 0]
  constexpr size_t kstep = (size_t)(BK * 2);
  const unsigned ldsw = (unsigned)wid * 1024u;
  const int aoff = lds_byte(wr * 64 + fr, fq * 8), boff = lds_byte(wc * 32 + fr, fq * 8);
  LAS unsigned char* abase = lds + aoff; LAS unsigned char* bbase = lds + 4 * HTB + boff;
  asm volatile("" : "+v"(abase), "+v"(bbase));
#define FG_SA(b, h) (((b) * 2 + (h)) * HTB)
#define FG_SB(b, h) ((4 + (b) * 2 + (h)) * HTB)
#define FG_STAGE(bufoff, gbase, voff) do { _Pragma("unroll") for (int _i = 0; _i < 2; ++_i) { \
    const unsigned _la = (unsigned)(uintptr_t)(lds + ldsw) + (unsigned)((bufoff) + _i * 8192); const char* _gb = (const char*)(gbase); \
    asm volatile("s_mov_b32 m0, %0\n\ts_nop 0\n\tglobal_load_lds_dwordx4 %1, %2" :: "s"(_la), "v"((voff)[_i]), "s"(_gb) : "memory", "m0"); } } while (0)
#define FG_LDA(dst, b, h) do { _Pragma("unroll") for (int m = 0; m < 4; ++m) _Pragma("unroll") for (int k = 0; k < 2; ++k) dst[m][k] = *(const LAS bf16x8*)(abase + (FG_SA(b, h) + m * 2048 + k * 1024)); } while (0)
#define FG_LDB(dst, b, h) do { _Pragma("unroll") for (int n = 0; n < 2; ++n) _Pragma("unroll") for (int k = 0; k < 2; ++k) dst[n][k] = *(const LAS bf16x8*)(bbase + (FG_SB(b, h) - 4 * HTB + n * 2048 + k * 1024)); } while (0)
#define FG_MMA(ai, bj, At, Bt) do { __builtin_amdgcn_s_setprio(1); _Pragma("unroll") for (int m = 0; m < 4; ++m) _Pragma("unroll") for (int n = 0; n < 2; ++n) _Pragma("unroll") for (int k = 0; k < 2; ++k) \
    acc[ai][bj][m][n] = __builtin_amdgcn_mfma_f32_16x16x32_bf16(Bt[n][k], At[m][k], acc[ai][bj][m][n], 0, 0, 0); __builtin_amdgcn_s_setprio(0); } while (0)
#define FG_MMA8(ai, bj, At, Bt) do { __builtin_amdgcn_s_setprio(1); _Pragma("unroll") for (int m = 0; m < 4; ++m) _Pragma("unroll") for (int n = 0; n < 2; ++n) { \
      v8i_t _b, _a; { const u32x4 b0 = *(const u32x4*)&Bt[n][0], b1 = *(const u32x4*)&Bt[n][1], a0 = *(const u32x4*)&At[m][0], a1 = *(const u32x4*)&At[m][1]; \
        _b = (v8i_t){(int)b0[0], (int)b0[1], (int)b0[2], (int)b0[3], (int)b1[0], (int)b1[1], (int)b1[2], (int)b1[3]}; _a = (v8i_t){(int)a0[0], (int)a0[1], (int)a0[2], (int)a0[3], (int)a1[0], (int)a1[1], (int)a1[2], (int)a1[3]}; } \
      acc[ai][bj][m][n] = __builtin_amdgcn_mfma_scale_f32_16x16x128_f8f6f4(_b, _a, acc[ai][bj][m][n], 0, 0, 0, Job::SCALE, 0, Job::SCALE); } __builtin_amdgcn_s_setprio(0); } while (0)
#define FG_WAIT_V(n) asm volatile("s_waitcnt vmcnt(" #n ")" ::: "memory")
#define FG_WAIT_L(n) asm volatile("s_waitcnt lgkmcnt(" #n ")" ::: "memory")
#define FG_MM(ai, bj, At, Bt) do { if constexpr (Job::FP8) FG_MMA8(ai, bj, At, Bt); else FG_MMA(ai, bj, At, Bt); } while (0)
#define FG_BAR __builtin_amdgcn_s_barrier()
#define FG_SCHED __builtin_amdgcn_sched_barrier(0)
  Unit cur, nxt;
  if (!J.next(cur)) return;
  Acc acc;
#pragma unroll
  for (int a = 0; a < 2; ++a)
#pragma unroll
    for (int b = 0; b < 2; ++b)
#pragma unroll
      for (int m = 0; m < 4; ++m)
#pragma unroll
        for (int n = 0; n < 2; ++n) acc[a][b][m][n] = (f32x4){0.f, 0.f, 0.f, 0.f};
  bf16x8 At[4][2], B0[2][2], B1[2][2];
  J.aoffs(cur, Rr, Cc, cv);
  asm volatile("s_waitcnt vmcnt(0)" ::: "memory");
  FG_STAGE(FG_SB(0, 0), cur.B0, voffB); FG_STAGE(FG_SA(0, 0), cur.A, cv[0]); FG_STAGE(FG_SB(0, 1), cur.B1, voffB); FG_STAGE(FG_SA(0, 1), cur.A + AH, CV1);
  if (wr == 1) FG_BAR;
  FG_WAIT_V(4); FG_BAR;
  FG_STAGE(FG_SB(1, 0), cur.B0 + kstep, voffB); FG_STAGE(FG_SA(1, 0), cur.A + kstep, cv[0]); FG_STAGE(FG_SB(1, 1), cur.B1 + kstep, voffB);
  FG_WAIT_V(6); FG_BAR;
  for (;;) {
    const bool has_next = J.next(nxt);
    const char* nA = has_next ? nxt.A : cur.A; const char* nB0 = has_next ? nxt.B0 : cur.B0; const char* nB1 = has_next ? nxt.B1 : cur.B1;
    for (int t = 0; t < nt; t += 2) {
      const bool last = (t == nt - 2);
      const char* a1 = cur.A + (size_t)(t + 1) * kstep;
      const char* a2 = last ? nA : cur.A + (size_t)(t + 2) * kstep;
      const char* b20 = last ? nB0 : cur.B0 + (size_t)(t + 2) * kstep; const char* b21 = last ? nB1 : cur.B1 + (size_t)(t + 2) * kstep;
      const char* a3 = a2 + kstep; const char* b30 = b20 + kstep; const char* b31 = b21 + kstep;
      asm volatile("" : "+s"(a1), "+s"(a2), "+s"(a3), "+s"(b20), "+s"(b21), "+s"(b30), "+s"(b31));
      if constexpr (Job::GATHER) { if (last && has_next) { J.aoffs(nxt, Rr, Cc, nv); asm volatile("s_waitcnt vmcnt(0)" ::: "memory"); } }
      FG_LDB(B0, 0, 0); FG_SCHED; FG_LDA(At, 0, 0); FG_STAGE(FG_SA(1, 1), a1 + AH, CV1);
      if constexpr (Job::GATHER) { if (last && has_next) { cv[0][0] = nv[0][0]; cv[0][1] = nv[0][1]; cv[1][0] = nv[1][0]; cv[1][1] = nv[1][1]; } }
      FG_WAIT_L(8); FG_BAR; FG_WAIT_L(0); FG_MM(0, 0, At, B0); FG_BAR; FG_SCHED;
      FG_LDB(B1, 0, 1); FG_STAGE(FG_SB(0, 0), b20, voffB);
      FG_BAR; FG_WAIT_L(0); FG_MM(0, 1, At, B1); FG_BAR;
      FG_LDA(At, 0, 1); FG_STAGE(FG_SA(0, 0), a2, cv[0]);
      FG_BAR; FG_WAIT_L(0); FG_MM(1, 0, At, B0); FG_BAR; FG_SCHED;
      FG_STAGE(FG_SB(0, 1), b21, voffB);
      FG_WAIT_V(6); FG_BAR; FG_MM(1, 1, At, B1); FG_BAR;
      FG_LDB(B0, 1, 0); FG_SCHED; FG_LDA(At, 1, 0); FG_STAGE(FG_SA(0, 1), a2 + AH, CV1);
      FG_WAIT_L(8); FG_BAR; FG_WAIT_L(0); FG_MM(0, 0, At, B0); FG_BAR; FG_SCHED;
      FG_LDB(B1, 1, 1); FG_STAGE(FG_SB(1, 0), b30, voffB);
      FG_BAR; FG_WAIT_L(0); FG_MM(0, 1, At, B1); FG_BAR;
      FG_LDA(At, 1, 1); FG_STAGE(FG_SA(1, 0), a3, cv[0]);
      FG_BAR; FG_WAIT_L(0); FG_MM(1, 0, At, B0); FG_BAR; FG_SCHED;
      FG_STAGE(FG_SB(1, 1), b31, voffB);
      FG_WAIT_V(6); FG_BAR; FG_MM(1, 1, At, B1); FG_BAR;
    }
    if (wr == 0) FG_BAR;
    { int l2; asm volatile("v_mbcnt_lo_u32_b32 %0, -1, 0\n\tv_mbcnt_hi_u32_b32 %0, -1, %0" : "=v"(l2));
      J.epilogue(acc, cur, wr, wc, l2 & 15, l2 >> 4, lds); }
    if (!has_next) break;
#pragma unroll
    for (int a = 0; a < 2; ++a)
#pragma unroll
      for (int b = 0; b < 2; ++b)
#pragma unroll
        for (int m = 0; m < 4; ++m)
#pragma unroll
          for (int n = 0; n < 2; ++n) acc[a][b][m][n] = (f32x4){0.f, 0.f, 0.f, 0.f};
    cur = nxt;
    if (wr == 1) FG_BAR;
  }
  FG_WAIT_V(0);
  FG_BAR;
#undef CV1
#undef FG_SA
#undef FG_SB
#undef FG_STAGE
#undef FG_LDA
#undef FG_LDB
#undef FG_MMA
#undef FG_MMA8
#undef FG_MM
#undef FG_WAIT_V
#undef FG_WAIT_L
#undef FG_BAR
#undef FG_SCHED
}

DEVI bool dense_decode(long L, int nM, int nN, int& pm, int& pn) {
  const int nwg = nM * nN; if (L >= nwg) return false;
  int wgid = (int)L; { const int q = nwg / 8, r = nwg % 8, xcd = wgid % 8, off = wgid / 8; wgid = (xcd < r ? xcd * (q + 1) : r * (q + 1) + (xcd - r) * q) + off; }
  const int nig = 8 * nN, gid = wgid / nig, fm = gid * 8, gsz = (nM - fm) < 8 ? (nM - fm) : 8;
  pm = fm + ((wgid % nig) % gsz); pn = (wgid % nig) / gsz; return true;
}
template <int K> DEVI void dense_aoffs(const int (&Rr)[2], const int (&Cc)[2], unsigned (&v)[2][2]) {
#pragma unroll
  for (int i = 0; i < 2; ++i) { v[0][i] = (unsigned)(Rr[i] * K + Cc[i]) * 2u; v[1][i] = 0u; }
}


struct Slab { LAS unsigned char* w0; LAS unsigned char* wf; LAS unsigned char* r0; };
DEVI Slab slab_init(LAS unsigned char* lds, int wid, int fr, int fq) {
  Slab s; LAS unsigned char* b = lds + 3 * HTB + wid * 1024;
  s.w0 = b + fr * 64 + fq * 16; s.wf = b + (fq >> 1) * 8192 + fr * 64 + (fq & 1) * 32; s.r0 = b + (fq * 16 + fr) * 16; return s; }
DEVI void slab_x16(const Slab& s, u32x4 a, u32x4 b, u32x4& ra, u32x4& rb) { *(LAS u32x4*)s.w0 = a; *(LAS u32x4*)(s.w0 + 8192) = b; ra = *(LAS u32x4*)s.r0; rb = *(LAS u32x4*)(s.r0 + 8192); }
DEVI void slab_x16(const Slab& s, u32x4 a, u32x4& ra) { *(LAS u32x4*)s.w0 = a; ra = *(LAS u32x4*)s.r0; }
DEVI void slab_x32(const Slab& s, f32x4 a, f32x4 b, f32x4& ra, f32x4& rb) { *(LAS f32x4*)s.wf = a; *(LAS f32x4*)(s.wf + 16) = b; ra = *(LAS f32x4*)s.r0; rb = *(LAS f32x4*)(s.r0 + 8192); }

template <int LAYER> struct JobOut {
  static constexpr bool FP8 = LAYER == 0 ? OUT0_FP8 : OUT1_FP8;
  static constexpr int K = FP8 ? D / 2 : D; static constexpr bool GATHER = false;
  static constexpr int SCALE = 0x01010101 * (127 - (WQ_SHIFT + A_SHIFT) / 2); static_assert((WQ_SHIFT + A_SHIFT) % 2 == 0, "");
  const Params& p; int i, c, G;
  DEVI JobOut(const Params& p_) : p(p_), i(0), c(vbid()), G(gridDim.x) {}
  DEVI unsigned boff(int R, int C) const { return boff_m2<K>(R, C); }
  DEVI bool next(Unit& u) {
    for (;;) { int pm, pn; if (!dense_decode((long)i * G + c, T / 256, D / 256, pm, pn)) return false; ++i;
      if (LAYER == 1 && pm % 9 == 0) continue;
      u.pm = pm; u.pn = pn; u.A = (const char*)(p.ws + (FP8 ? OFF_ACT8 : OFF_ACT)) + (size_t)pm * 256 * K * 2;
      u.B0 = (const char*)wsp<bf16_t>(p, LAYER == 0 ? OFF_WOUT0T : OFF_WOUT1T) + (size_t)(256 * pn) * K * 2; u.B1 = u.B0 + (size_t)128 * K * 2; return true; }
  }
  DEVI void aoffs(const Unit&, const int (&Rr)[2], const int (&Cc)[2], unsigned (&v)[2][2]) const { dense_aoffs<K>(Rr, Cc, v); }
  DEVI void epilogue(const Acc& acc, const Unit& u, int wr, int wc, int fr, int fq, LAS unsigned char* lds) const {
    asm volatile("" : "+v"(fr), "+v"(fq));
    const int t0 = u.pm * 256;
    const float* res = in_row(p, t0); bf16_t* dst = wsp<bf16_t>(p, OFF_HB) + (size_t)t0 * D;
    const float* gate = modv(p, LAYER, t0, 2);
    const int col0 = u.pn * 256 + wc * 32 + 8 * fq, lane = fq * 16 + fr;
    const Slab sl = slab_init(lds, wr * 4 + wc, fr, fq);
    const size_t rb = (size_t)(wr * 64 + (lane >> 2)) * D + u.pn * 256 + wc * 32 + 4 * (lane & 3);
    res += rb; dst += rb;
    asm volatile("" : "+v"(res), "+v"(dst));
    f32x4 gv[2][2];
#pragma unroll
    for (int bj = 0; bj < 2; ++bj)
#pragma unroll
      for (int n = 0; n < 2; ++n) gv[bj][n] = *(const f32x4*)(gate + col0 + bj * 128 + 4 * n);
#pragma unroll
    for (int ai = 0; ai < 2; ++ai) {
      f32x4 r4[4][2][2];
#pragma unroll
      for (int m = 0; m < 4; ++m) { const size_t ro = (size_t)(ai * 128 + m * 16) * D;
#pragma unroll
        for (int bj = 0; bj < 2; ++bj) {
          if (LAYER == 0) { r4[m][bj][0] = *(const f32x4*)(res + ro + bj * 128); r4[m][bj][1] = *(const f32x4*)(res + ro + bj * 128 + 16); }
          else { r4[m][bj][0] = bf4(*(const u32x2*)(dst + ro + bj * 128)); r4[m][bj][1] = bf4(*(const u32x2*)(dst + ro + bj * 128 + 16)); } } }
#pragma unroll
      for (int m = 0; m < 4; ++m) { const size_t ro = (size_t)(ai * 128 + m * 16) * D;
#pragma unroll
        for (int bj = 0; bj < 2; ++bj) { f32x4 x0, x1; slab_x32(sl, gv[bj][0] * acc[ai][bj][m][0], gv[bj][1] * acc[ai][bj][m][1], x0, x1);
          x0 += r4[m][bj][0]; x1 += r4[m][bj][1];
          u32x2 w0, w1; w0.x = pack2(x0[0], x0[1]); w0.y = pack2(x0[2], x0[3]); w1.x = pack2(x1[0], x1[1]); w1.y = pack2(x1[2], x1[3]);
          *(u32x2*)(dst + ro + bj * 128) = w0; *(u32x2*)(dst + ro + bj * 128 + 16) = w1; } }
      asm volatile("" ::: "memory"); }
  }
};

DEVI void load_rope_lds(const Params& p, size_t tab_off, int nrope, int gq, int gk, int ng, LAS unsigned char* lds) {
  const int tid = ltid(); __syncthreads();
  const f32x4* src = (const f32x4*)(p.ws + tab_off); LAS f32x4* dst = (LAS f32x4*)(lds + LDS_ROPE);
  for (int i = tid; i < nrope; i += 512) dst[i] = src[i];
  LAS float* g = (LAS float*)(lds + LDS_GAIN);
  if (tid < 2 * ng) g[tid] = tid < ng ? sm(p, gq)[tid] : sm(p, gk)[tid - ng];
  __syncthreads();
}
struct JobIn0 {
  static constexpr int K = IN0_FP8 ? D / 2 : D; static constexpr bool GATHER = false, FP8 = IN0_FP8;
  static constexpr int SCALE = 0x01010101 * (127 - (WQ_SHIFT + X_SHIFT) / 2);
  const Params& p; int i, c, G; int dry;
  DEVI JobIn0(const Params& p_, int dry_ = 0) : p(p_), i(0), c(vbid()), G(gridDim.x), dry(dry_) {}
  DEVI unsigned boff(int R, int C) const { return boff_m1<K>(R, C); }
  DEVI bool next(Unit& u) {
    int pm, pn; if (!dense_decode((long)i * G + c, T / 256, EVEN_IN / 256, pm, pn)) return false; ++i;
    u.pm = pm; u.pn = pn; u.A = (const char*)(p.ws + (IN0_FP8 ? OFF_ACT8 : OFF_ACT)) + (size_t)pm * 256 * K * 2;
    u.B0 = (const char*)wsp<bf16_t>(p, OFF_WIN0T) + (size_t)(256 * pn) * K * 2; u.B1 = u.B0 + (size_t)32 * K * 2; return true;
  }
  DEVI void aoffs(const Unit&, const int (&Rr)[2], const int (&Cc)[2], unsigned (&v)[2][2]) const { dense_aoffs<K>(Rr, Cc, v); }
  DEVI void epilogue(const Acc& acc, const Unit& u, int wr, int wc, int fr, int fq, LAS unsigned char* lds) const {
    asm volatile("" : "+v"(fr), "+v"(fq));
    if (dry == 1) {
#pragma unroll
      for (int ai = 0; ai < 2; ++ai)
#pragma unroll
        for (int bj = 0; bj < 2; ++bj)
#pragma unroll
          for (int m = 0; m < 4; ++m)
#pragma unroll
            for (int n = 0; n < 2; ++n) asm volatile("" :: "v"(acc[ai][bj][m][n]));
      return; }
    const int lane = fq * 16 + fr; const Slab sl = slab_init(lds, wr * 4 + wc, fr, fq);
    bf16_t* outp = wsp<bf16_t>(p, OFF_PROJ) + (size_t)(u.pm * 256 + wr * 64 + (lane >> 2)) * EVEN_IN + u.pn * 256 + wc * 64 + 8 * (lane & 3);
    asm volatile("" : "+v"(outp));
    const int pn = u.pn;
    if (pn < 4) {
#pragma unroll
      for (int ai = 0; ai < 2; ++ai)
#pragma unroll
        for (int m = 0; m < 4; ++m) {
          u32x4 wq[2];
#pragma unroll
          for (int bj = 0; bj < 2; ++bj) { const f32x4 v0 = acc[ai][bj][m][0], v1 = acc[ai][bj][m][1];
            const f32x2 a = gelu_pk((f32x2){v0[0], v0[1]}), b = gelu_pk((f32x2){v0[2], v0[3]}), c2 = gelu_pk((f32x2){v1[0], v1[1]}), d = gelu_pk((f32x2){v1[2], v1[3]});
            u32x4 w; w.x = cvt_pk_bf16(a.x, a.y); w.y = cvt_pk_bf16(b.x, b.y); w.z = cvt_pk_bf16(c2.x, c2.y); w.w = cvt_pk_bf16(d.x, d.y);
            wq[bj] = w; }
          { u32x4 ra, rb; slab_x16(sl, wq[0], wq[1], ra, rb); *(u32x4*)(outp + (size_t)(ai * 128 + m * 16) * EVEN_IN) = ra; *(u32x4*)(outp + (size_t)(ai * 128 + m * 16) * EVEN_IN + 32) = rb; } }
    } else if (pn >= 8) {
#pragma unroll
      for (int ai = 0; ai < 2; ++ai)
#pragma unroll
        for (int m = 0; m < 4; ++m) {
          u32x4 wq[2];
#pragma unroll
          for (int bj = 0; bj < 2; ++bj) { const f32x4 v0 = acc[ai][bj][m][0], v1 = acc[ai][bj][m][1];
            u32x4 w; w.x = cvt_pk_bf16(v0[0], v0[1]); w.y = cvt_pk_bf16(v0[2], v0[3]); w.z = cvt_pk_bf16(v1[0], v1[1]); w.w = cvt_pk_bf16(v1[2], v1[3]);
            wq[bj] = w; }
          { u32x4 ra, rb; slab_x16(sl, wq[0], wq[1], ra, rb); *(u32x4*)(outp + (size_t)(ai * 128 + m * 16) * EVEN_IN) = ra; *(u32x4*)(outp + (size_t)(ai * 128 + m * 16) * EVEN_IN + 32) = rb; } }
    } else {
      LAS const float* gn = (LAS const float*)(lds + LDS_GAIN) + (pn < 6 ? 0 : 64) + 8 * fq;
      f32x4 g4[2][2];
#pragma unroll
      for (int bj = 0; bj < 2; ++bj)
#pragma unroll
        for (int n = 0; n < 2; ++n) g4[bj][n] = *(LAS const f32x4*)(gn + bj * 32 + 4 * n);
      const int jt = u.pm % 9; const bool lat = jt != 0;
      LAS const f32x4* t64 = (LAS const f32x4*)(lds + LDS_ROPE);
#pragma unroll
      for (int ai = 0; ai < 2; ++ai)
#pragma unroll
        for (int m = 0; m < 4; ++m) {
          f32x4 cs[2][2];
          if (lat) { const int il = (jt - 1) * 256 + ai * 128 + wr * 64 + m * 16 + fr; const int prow = il >> 6, pcol = il & 63;
#pragma unroll
            for (int bj = 0; bj < 2; ++bj)
#pragma unroll
              for (int n = 0; n < 2; ++n) cs[bj][n] = t64[(bj ? pcol : prow) * 8 + 2 * fq + n]; }
          float ss = 0.f;
#pragma unroll
          for (int bj = 0; bj < 2; ++bj)
#pragma unroll
            for (int n = 0; n < 2; ++n) { const f32x4 x = acc[ai][bj][m][n]; ss += (x[0] * x[0] + x[1] * x[1]) + (x[2] * x[2] + x[3] * x[3]); }
          ss += shx<16>(ss); ss = sum32x(ss);
          const float rstd = rsqrtf(ss * (1.0f / 64) + EPS);
          u32x4 wq[2];
#pragma unroll
          for (int bj = 0; bj < 2; ++bj) { f32x4 y[2];
#pragma unroll
            for (int n = 0; n < 2; ++n) { f32x4 x = acc[ai][bj][m][n] * rstd * g4[bj][n];
              if (lat) { const f32x4 c4 = cs[bj][n]; x = (f32x4){x[0] * c4[0] - x[1] * c4[1], x[0] * c4[1] + x[1] * c4[0], x[2] * c4[2] - x[3] * c4[3], x[2] * c4[3] + x[3] * c4[2]}; }
              y[n] = x; }
            u32x4 w; w.x = cvt_pk_bf16(y[0][0], y[0][1]); w.y = cvt_pk_bf16(y[0][2], y[0][3]); w.z = cvt_pk_bf16(y[1][0], y[1][1]); w.w = cvt_pk_bf16(y[1][2], y[1][3]);
            wq[bj] = w; }
          { u32x4 ra, rb; slab_x16(sl, wq[0], wq[1], ra, rb); *(u32x4*)(outp + (size_t)(ai * 128 + m * 16) * EVEN_IN) = ra; *(u32x4*)(outp + (size_t)(ai * 128 + m * 16) * EVEN_IN + 32) = rb; }
          asm volatile("" ::: "memory");
        }
    }
  }
};

struct JobIn1 {
  static constexpr int K = IN1_FP8 ? D / 2 : D; static constexpr bool GATHER = false, FP8 = IN1_FP8;
  static constexpr int SCALE = 0x01010101 * (127 - (WQ_SHIFT + X_SHIFT) / 2); static_assert((WQ_SHIFT + X_SHIFT) % 2 == 0, "");
  const Params& p; int i, c, G;
  DEVI JobIn1(const Params& p_) : p(p_), i(0), c(vbid()), G(gridDim.x) {}
  DEVI unsigned boff(int R, int C) const { return boff_m1<K>(R, C); }
  DEVI bool next(Unit& u) {
    for (;;) { int pm, pn; if (!dense_decode((long)i * G + c, T / 256, ODD_IN / 256, pm, pn)) return false; ++i;
      if (pm % 9 == 0 && pn < 4) continue;
      u.pm = pm; u.pn = pn; u.A = (const char*)(p.ws + (IN1_FP8 ? OFF_ACT8 : OFF_ACT)) + (size_t)pm * 256 * K * 2;
      u.B0 = (const char*)wsp<bf16_t>(p, OFF_WQKV1T) + (size_t)(256 * pn) * K * 2; u.B1 = u.B0 + (size_t)32 * K * 2; return true; }
  }
  DEVI void aoffs(const Unit&, const int (&Rr)[2], const int (&Cc)[2], unsigned (&v)[2][2]) const { dense_aoffs<K>(Rr, Cc, v); }
  DEVI void epilogue(const Acc& acc, const Unit& u, int wr, int wc, int fr, int fq, LAS unsigned char* lds) const {
    asm volatile("" : "+v"(fr), "+v"(fq));
    const int lane = fq * 16 + fr; const Slab sl = slab_init(lds, wr * 4 + wc, fr, fq);
    int ooff = (u.pm * 256 + wr * 64 + (lane >> 2)) * ODD_IN + u.pn * 256 + wc * 64 + 8 * (lane & 3);
    asm volatile("" : "+v"(ooff));
    bf16_t* outp = wsp<bf16_t>(p, OFF_PROJ) + ooff;
    asm volatile("" : "+v"(outp));
    const int pn = u.pn;
    if (pn == 5) {
#pragma unroll
      for (int ai = 0; ai < 2; ++ai)
#pragma unroll
        for (int m = 0; m < 4; ++m) {
          u32x4 wq[2];
#pragma unroll
          for (int bj = 0; bj < 2; ++bj) { const f32x4 v0 = acc[ai][bj][m][0], v1 = acc[ai][bj][m][1];
            u32x4 w; w.x = cvt_pk_bf16(v0[0], v0[1]); w.y = cvt_pk_bf16(v0[2], v0[3]); w.z = cvt_pk_bf16(v1[0], v1[1]); w.w = cvt_pk_bf16(v1[2], v1[3]);
            wq[bj] = w; }
          { u32x4 ra, rb; slab_x16(sl, wq[0], wq[1], ra, rb); *(u32x4*)(outp + (size_t)(ai * 128 + m * 16) * ODD_IN) = ra; *(u32x4*)(outp + (size_t)(ai * 128 + m * 16) * ODD_IN + 32) = rb; } }
    } else {
      const int wid = wr * 4 + wc;
      LAS float* xw = (LAS float*)(lds + LDS_XCH) + wid * 128 + fr; LAS float* xr = (LAS float*)(lds + LDS_XCH) + (wid ^ 1) * 128 + fr;
      asm volatile("" : "+v"(xw), "+v"(xr));
      float ssr[2][4];
#pragma unroll
      for (int ai = 0; ai < 2; ++ai)
#pragma unroll
        for (int m = 0; m < 4; ++m) { float ss = 0.f;
#pragma unroll
          for (int bj = 0; bj < 2; ++bj)
#pragma unroll
            for (int n = 0; n < 2; ++n) { const f32x4 x = acc[ai][bj][m][n]; ss += (x[0] * x[0] + x[1] * x[1]) + (x[2] * x[2] + x[3] * x[3]); }
          ss += shx<16>(ss); ss = sum32x(ss); ssr[ai][m] = ss;
          if (fq == 0) xw[ai * 64 + m * 16] = ss; }
      asm volatile("s_waitcnt lgkmcnt(0)" ::: "memory"); __builtin_amdgcn_s_barrier(); asm volatile("" ::: "memory");
#pragma unroll
      for (int ai = 0; ai < 2; ++ai)
#pragma unroll
        for (int m = 0; m < 4; ++m) ssr[ai][m] += xr[ai * 64 + m * 16];
      const int hh = wc & 1;
      LAS const float* gn = (LAS const float*)(lds + LDS_GAIN) + (pn < 4 ? 0 : 128) + 64 * hh + 8 * fq;
      asm volatile("" : "+v"(gn));
      const int jt = u.pm % 9; const bool lat = jt != 0;
      LAS const f32x4* t128 = (LAS const f32x4*)(lds + LDS_ROPE);
#pragma unroll
      for (int ai = 0; ai < 2; ++ai)
#pragma unroll
        for (int m = 0; m < 4; ++m) {
          f32x4 g4[2][2];
#pragma unroll
          for (int bj = 0; bj < 2; ++bj)
#pragma unroll
            for (int n = 0; n < 2; ++n) g4[bj][n] = *(LAS const f32x4*)(gn + bj * 32 + 4 * n);
          f32x4 cs[2][2];
          if (lat) { const int il = (jt - 1) * 256 + ai * 128 + wr * 64 + m * 16 + fr; const int pos = hh ? (il & 63) : (il >> 6);
#pragma unroll
            for (int bj = 0; bj < 2; ++bj)
#pragma unroll
              for (int n = 0; n < 2; ++n) cs[bj][n] = t128[pos * 16 + 8 * bj + 2 * fq + n]; }
          const float rstd = rsqrtf(ssr[ai][m] * (1.0f / 128) + EPS);
          u32x4 wq[2];
#pragma unroll
          for (int bj = 0; bj < 2; ++bj) { f32x4 y[2];
#pragma unroll
            for (int n = 0; n < 2; ++n) { f32x4 x = acc[ai][bj][m][n] * rstd * g4[bj][n];
              if (lat) { const f32x4 c4 = cs[bj][n]; x = (f32x4){x[0] * c4[0] - x[1] * c4[1], x[0] * c4[1] + x[1] * c4[0], x[2] * c4[2] - x[3] * c4[3], x[2] * c4[3] + x[3] * c4[2]}; }
              y[n] = x; }
            if (ATT1_QK8) { const float qs = (float)(1 << QS_SHIFT); int lo = 0, hi8 = 0;
#pragma unroll
              for (int n = 0; n < 2; ++n)
#pragma unroll
                for (int j = 0; j < 4; ++j) y[n][j] = __builtin_amdgcn_fmed3f(y[n][j] * qs, -440.f, 440.f);
              lo = __builtin_amdgcn_cvt_pk_fp8_f32(y[0][0], y[0][1], lo, false); lo = __builtin_amdgcn_cvt_pk_fp8_f32(y[0][2], y[0][3], lo, true);
              hi8 = __builtin_amdgcn_cvt_pk_fp8_f32(y[1][0], y[1][1], hi8, false); hi8 = __builtin_amdgcn_cvt_pk_fp8_f32(y[1][2], y[1][3], hi8, true);
              *(LAS u32x2*)(lds + 3 * HTB + (wr * 4 + wc) * 1024 + fr * 64 + bj * 32 + fq * 8) = (u32x2){(unsigned)lo, (unsigned)hi8}; }
            else {
            u32x4 w; w.x = cvt_pk_bf16(y[0][0], y[0][1]); w.y = cvt_pk_bf16(y[0][2], y[0][3]); w.z = cvt_pk_bf16(y[1][0], y[1][1]); w.w = cvt_pk_bf16(y[1][2], y[1][3]);
            wq[bj] = w; } }
          if (ATT1_QK8) { const u32x4 rw = *(LAS u32x4*)(lds + 3 * HTB + (wr * 4 + wc) * 1024 + lane * 16);
            *(u32x4*)(p.ws + OFF_QK8 + (size_t)(u.pm * 256 + wr * 64 + (lane >> 2) + ai * 128 + m * 16) * 1280 + pn * 256 + wc * 64 + 16 * (lane & 3)) = rw; }
          else { u32x4 ra, rb; slab_x16(sl, wq[0], wq[1], ra, rb); *(u32x4*)(outp + (size_t)(ai * 128 + m * 16) * ODD_IN) = ra; *(u32x4*)(outp + (size_t)(ai * 128 + m * 16) * ODD_IN + 32) = rb; }
          asm volatile("" ::: "memory");
        }
    }
  }
};

DEVI void moe_tables(const Params& p, const LCfg c, int half, int nN, LAS unsigned char* lds) {
  LAS int* tb = (LAS int*)(lds + LDS_TAB);
  const int tid = ltid();
  __syncthreads();
  if (tid <= NE) tb[tid] = tid < NE ? ((const int*)(p.ws + OFF_CNT))[c.l * 128 + half * 64 + tid] : c.nph;
  __syncthreads();
  if (tid == 0) { int up = 0, off = 0; for (int e = 0; e <= NE; ++e) { const int n = tb[e]; tb[72 + e] = up; tb[144 + e] = off; up += ((n + 255) >> 8) * nN; off += n; } tb[72 + 65] = up; tb[144 + 65] = off; }
  __syncthreads();
}
struct MoeIter {
  int g, gend, step, e;
  DEVI void init(LAS const int* tb) { const int vb = vbid(); const int U = __builtin_amdgcn_readfirstlane(tb[72 + 65]), chunk = (U + 7) >> 3, x = vb & 7; g = x * chunk + (vb >> 3); gend = (x + 1) * chunk < U ? (x + 1) * chunk : U; step = gridDim.x >> 3; e = 0; }
  DEVI bool next(LAS const int* tb, int nN, int& ee, int& mt, int& pn) { if (g >= gend) return false; while (__builtin_amdgcn_readfirstlane(tb[72 + e + 1]) <= g) ++e; const int r = g - __builtin_amdgcn_readfirstlane(tb[72 + e]); mt = r / nN; pn = r - mt * nN; ee = e; g += step; return true; }
};
struct JobGU {
  static constexpr int K = D / 2; static constexpr bool GATHER = true, FP8 = true;
  static constexpr int SCALE = 0x01010101 * (127 - (WG_SHIFT + X_SHIFT) / 2); static_assert((WG_SHIFT + X_SHIFT) % 2 == 0, "");
  const Params& p; const LCfg c; int half; LAS const int* tb; MoeIter it; int dry;
  DEVI JobGU(const Params& p_, const LCfg c_, int half_, LAS unsigned char* lds, int dry_ = 0) : p(p_), c(c_), half(half_), tb((LAS const int*)(lds + LDS_TAB)), dry(dry_) { it.init(tb); }
  DEVI unsigned boff(int R, int C) const { return boff_m2<K>(R, C); }
  DEVI bool next(Unit& u) {
    int e, mt, pn; if (!it.next(tb, 2, e, mt, pn)) return false;
    u.e = e; u.pm = mt; u.pn = pn; u.cnt = __builtin_amdgcn_readfirstlane(tb[e]); u.off = __builtin_amdgcn_readfirstlane(tb[144 + e]); u.A = (const char*)(p.ws + OFF_ACT8);
    const char* w = e < NE ? (const char*)wsp<bf16_t>(p, OFF_EGU) + (size_t)e * 512 * K * 2 : (const char*)wsp<bf16_t>(p, OFF_SHGU) + (size_t)c.l * 512 * K * 2;
    u.B0 = w + (size_t)(128 * pn) * K * 2; u.B1 = w + (size_t)(256 + 128 * pn) * K * 2; return true;
  }
  DEVI void aoffs(const Unit& u, const int (&Rr)[2], const int (&Cc)[2], unsigned (&v)[2][2]) const {
    const int* le = wsp<int>(p, OFF_LIST) + ((size_t)(half * 64 + (u.e < NE ? u.e : 0))) * LCAP;
#pragma unroll
    for (int h = 0; h < 2; ++h)
#pragma unroll
      for (int i = 0; i < 2; ++i) { int r = u.pm * 256 + h * 128 + Rr[i]; r = r < u.cnt ? r : 0;
        int tl = r; if (u.e < NE) tl = le[r] / 6;
        v[h][i] = (unsigned)(act_tok(c, half, tl) * K + Cc[i]) * 2u; }
  }
  DEVI void epilogue(const Acc& acc, const Unit& u, int wr, int wc, int fr, int fq, LAS unsigned char* lds) const {
    asm volatile("" : "+v"(fr), "+v"(fq));
    if (dry == 1) {
#pragma unroll
      for (int ai = 0; ai < 2; ++ai)
#pragma unroll
        for (int bj = 0; bj < 2; ++bj)
#pragma unroll
          for (int m = 0; m < 4; ++m)
#pragma unroll
            for (int n = 0; n < 2; ++n) asm volatile("" :: "v"(acc[ai][bj][m][n]));
      return; }
    const int lane = fq * 16 + fr;
    LAS unsigned char* sb = lds + 3 * HTB + (wr * 4 + wc) * 1024;
    const int r0 = u.pm * 256 + wr * 64 + (lane >> 2);
    unsigned char* hid = p.ws + OFF_HID + ((size_t)u.off + r0) * DE + u.pn * 128 + wc * 32 + 8 * (lane & 3);
    asm volatile("" : "+v"(hid));
    const float hs = (float)(1 << H_SHIFT);
#pragma unroll
    for (int ai = 0; ai < 2; ++ai)
#pragma unroll
      for (int m = 0; m < 4; ++m) { const int r = r0 + ai * 128 + m * 16;
        float h[8];
#pragma unroll
        for (int n = 0; n < 2; ++n)
#pragma unroll
          for (int j = 0; j < 4; ++j) { const float gg = acc[ai][0][m][n][j]; h[n * 4 + j] = __builtin_amdgcn_fmed3f(gg * __builtin_amdgcn_rcpf(1.0f + __expf(-gg)) * acc[ai][1][m][n][j] * hs, -440.f, 440.f); }
        int lo = 0, hi = 0;
        lo = __builtin_amdgcn_cvt_pk_fp8_f32(h[0], h[1], lo, false); lo = __builtin_amdgcn_cvt_pk_fp8_f32(h[2], h[3], lo, true);
        hi = __builtin_amdgcn_cvt_pk_fp8_f32(h[4], h[5], hi, false); hi = __builtin_amdgcn_cvt_pk_fp8_f32(h[6], h[7], hi, true);
        *(LAS u32x2*)(sb + fr * 32 + fq * 8) = (u32x2){(unsigned)lo, (unsigned)hi};
        const u32x2 rw = *(LAS u32x2*)(sb + lane * 8);
        if (r < u.cnt) *(u32x2*)(hid + (size_t)(ai * 128 + m * 16) * DE) = rw; }
  }
};
struct JobDown {
  static constexpr int K = DE / 2; static constexpr bool GATHER = false, FP8 = true;
  static constexpr int SCALE = 0x01010101 * (127 - (WD_SHIFT + H_SHIFT) / 2); static_assert((WD_SHIFT + H_SHIFT) % 2 == 0, "");
  const Params& p; const LCfg c; int half; LAS const int* tb; MoeIter it; float dscale;
  DEVI JobDown(const Params& p_, const LCfg c_, int half_, LAS unsigned char* lds, float ds = 1.0f) : p(p_), c(c_), half(half_), tb((LAS const int*)(lds + LDS_TAB)), dscale(ds) { it.init(tb); }
  DEVI unsigned boff(int R, int C) const { return boff_m1<K>(R, C); }
  DEVI bool next(Unit& u) {
    int e, mt, pn; if (!it.next(tb, 4, e, mt, pn)) return false;
    u.e = e; u.pm = mt; u.pn = pn; u.cnt = __builtin_amdgcn_readfirstlane(tb[e]); u.off = __builtin_amdgcn_readfirstlane(tb[144 + e]);
    u.A = (const char*)wsp<bf16_t>(p, OFF_HID) + ((size_t)(u.off + mt * 256)) * K * 2;
    const char* w = e < NE ? (const char*)wsp<bf16_t>(p, OFF_ED) + (size_t)e * D * K * 2 : (const char*)wsp<bf16_t>(p, OFF_SHD) + (size_t)c.l * D * K * 2;
    u.B0 = w + (size_t)(256 * pn) * K * 2; u.B1 = u.B0 + (size_t)32 * K * 2; return true;
  }
  DEVI void aoffs(const Unit&, const int (&Rr)[2], const int (&Cc)[2], unsigned (&v)[2][2]) const { dense_aoffs<K>(Rr, Cc, v); }
  DEVI void epilogue(const Acc& acc, const Unit& u, int wr, int wc, int fr, int fq, LAS unsigned char* lds) const {
    asm volatile("" : "+v"(fr), "+v"(fq));
    const int lane = fq * 16 + fr;
    if (dscale < 0.f) {
#pragma unroll
      for (int ai = 0; ai < 2; ++ai)
#pragma unroll
        for (int bj = 0; bj < 2; ++bj)
#pragma unroll
          for (int m = 0; m < 4; ++m)
#pragma unroll
            for (int n = 0; n < 2; ++n) asm volatile("" :: "v"(acc[ai][bj][m][n]));
      return; }
    LAS unsigned char* sb = lds + 3 * HTB + (wr * 4 + wc) * 1024;
    const int r0 = u.pm * 256 + wr * 64 + (lane >> 2);
    unsigned char* slot = p.ws + OFF_SLOT + ((size_t)u.off + r0) * D + u.pn * 256 + wc * 64 + 16 * (lane & 3);
    asm volatile("" : "+v"(slot));
#pragma unroll
    for (int ai = 0; ai < 2; ++ai)
#pragma unroll
      for (int m = 0; m < 4; ++m) {
#pragma unroll
        for (int bj = 0; bj < 2; ++bj) { f32x4 v0 = acc[ai][bj][m][0], v1 = acc[ai][bj][m][1]; int lo = 0, hi = 0;
#pragma unroll
          for (int j = 0; j < 4; ++j) { v0[j] = __builtin_amdgcn_fmed3f(v0[j], -440.f, 440.f); v1[j] = __builtin_amdgcn_fmed3f(v1[j], -440.f, 440.f); }
          lo = __builtin_amdgcn_cvt_pk_fp8_f32(v0[0], v0[1], lo, false); lo = __builtin_amdgcn_cvt_pk_fp8_f32(v0[2], v0[3], lo, true);
          hi = __builtin_amdgcn_cvt_pk_fp8_f32(v1[0], v1[1], hi, false); hi = __builtin_amdgcn_cvt_pk_fp8_f32(v1[2], v1[3], hi, true);
          *(LAS u32x2*)(sb + fr * 64 + bj * 32 + fq * 8) = (u32x2){(unsigned)lo, (unsigned)hi}; }
        const u32x4 rw = *(LAS u32x4*)(sb + lane * 16);
        if (r0 + ai * 128 + m * 16 < u.cnt) *(u32x4*)(slot + (size_t)(ai * 128 + m * 16) * D) = rw; }
  }
};
}
namespace fa {
constexpr int NW = 8, QBLK = 32, KVBLK = 64;
constexpr float THR = 8.f;
constexpr size_t SHM_V = KVBLK * 128 * 2, SHM_K = KVBLK * 128 * 2, SHM_ATTN = 2 * SHM_V + 2 * SHM_K + NW * 64 * 4;
using s16x4 = __attribute__((ext_vector_type(4))) short;
using f32x16 = __attribute__((ext_vector_type(16))) float;
#define KSWZ(row, colB) ((row) * 256 + ((colB) ^ (((row) & 7) << 4)))
#define SBAR() __builtin_amdgcn_sched_barrier(0)
DEVI int crow(int r, int hi) { return (r & 3) + 8 * (r >> 2) + 4 * hi; }
DEVI unsigned cvtpk(float lo, float hi) { unsigned r; asm volatile("v_cvt_pk_bf16_f32 %0, %1, %2" : "=v"(r) : "v"(lo), "v"(hi)); return r; }

template <int SCALE_NUM> struct ScaleC;
DEVI void partialSM(f32x16& p0, f32x16& p1, float& m_reg, float& mn, float& alpha, const float SCALE) {
  const float C = SCALE * 1.4426950408889634f;
  float pmax = p0[0];
#pragma unroll
  for (int r = 1; r < 16; ++r) pmax = fmaxf(pmax, p0[r]);
#pragma unroll
  for (int r = 0; r < 16; ++r) pmax = fmaxf(pmax, p1[r]);
  { auto rr = __builtin_amdgcn_permlane32_swap(__float_as_uint(pmax), __float_as_uint(pmax), false, false);
    pmax = fmaxf(__uint_as_float(rr[0]), __uint_as_float(rr[1])); }
  if (__builtin_expect(__all(pmax - m_reg <= THR / SCALE), 1)) { mn = m_reg; alpha = 1.f; }
  else { mn = fmaxf(m_reg, pmax); alpha = __builtin_amdgcn_exp2f((m_reg - mn) * C); m_reg = mn; }
  float mnC = -mn * C;
#pragma unroll
  for (int r = 0; r < 16; ++r) p0[r] = fmaf(p0[r], C, mnC);
#pragma unroll
  for (int r = 0; r < 16; ++r) p1[r] = fmaf(p1[r], C, mnC);
#pragma unroll
  for (int r = 0; r < 16; ++r) p0[r] = __builtin_amdgcn_exp2f(p0[r]);
}
DEVI void finishSM(f32x16& p0, f32x16& p1, float alpha, float& l_reg, bf16x8& pa0, bf16x8& pa1, bf16x8& pa2, bf16x8& pa3) {
#pragma unroll
  for (int r = 0; r < 16; ++r) p1[r] = __builtin_amdgcn_exp2f(p1[r]);
  float ps = 0;
#pragma unroll
  for (int r = 0; r < 16; ++r) ps += p0[r];
#pragma unroll
  for (int r = 0; r < 16; ++r) ps += p1[r];
  { auto rr = __builtin_amdgcn_permlane32_swap(__float_as_uint(ps), __float_as_uint(ps), false, false);
    ps = __uint_as_float(rr[0]) + __uint_as_float(rr[1]); }
  l_reg = l_reg * alpha + ps;
#define PK4(P, BASE, OUT) do { unsigned a0 = cvtpk(P[BASE + 0], P[BASE + 1]), a1 = cvtpk(P[BASE + 2], P[BASE + 3]);   \
    unsigned b0 = cvtpk(P[BASE + 4], P[BASE + 5]), b1 = cvtpk(P[BASE + 6], P[BASE + 7]);                              \
    auto r0 = __builtin_amdgcn_permlane32_swap(a0, b0, false, false); auto r1 = __builtin_amdgcn_permlane32_swap(a1, b1, false, false); \
    u32x4 w = {r0[0], r1[0], r0[1], r1[1]}; OUT = *reinterpret_cast<bf16x8*>(&w); } while (0)
  PK4(p0, 0, pa0); PK4(p0, 8, pa1); PK4(p1, 0, pa2); PK4(p1, 8, pa3);
#undef PK4
}
template <int ND0> DEVI void qkt(f32x16& p0, f32x16& p1, const char* Ks, const bf16x8* qr, int r32, int hi, int cbase) {
  p0 = f32x16{}; p1 = f32x16{};
#pragma unroll
  for (int d0 = 0; d0 < ND0; ++d0) { int cb = cbase + (d0 * 16 + hi * 8) * 2;
    bf16x8 b0 = *reinterpret_cast<const bf16x8*>(Ks + KSWZ(r32, cb));
    bf16x8 b1 = *reinterpret_cast<const bf16x8*>(Ks + KSWZ(32 + r32, cb));
    p0 = __builtin_amdgcn_mfma_f32_32x32x16_bf16(b0, qr[d0], p0, 0, 0, 0);
    p1 = __builtin_amdgcn_mfma_f32_32x32x16_bf16(b1, qr[d0], p1, 0, 0, 0); }
}
using fg::v8i_t;
#define K8SWZ(row, chunk) ((row) * 128 + ((((chunk)) ^ ((row) & 7)) << 4))
DEVI void qkt8(f32x16& p0, f32x16& p1, const char* Ks, const v8i_t* q8, int r32, int hi) {
  p0 = f32x16{}; p1 = f32x16{};
  constexpr int SC = 0x01010101 * (127 - QS_SHIFT);
#pragma unroll
  for (int ks = 0; ks < 2; ++ks) { const int c0 = ks * 4 + hi * 2;
    const u32x4 a0 = *reinterpret_cast<const u32x4*>(Ks + K8SWZ(r32, c0)), a1 = *reinterpret_cast<const u32x4*>(Ks + K8SWZ(r32, c0 + 1));
    const u32x4 b0 = *reinterpret_cast<const u32x4*>(Ks + K8SWZ(32 + r32, c0)), b1 = *reinterpret_cast<const u32x4*>(Ks + K8SWZ(32 + r32, c0 + 1));
    const v8i_t ka = {(int)a0[0], (int)a0[1], (int)a0[2], (int)a0[3], (int)a1[0], (int)a1[1], (int)a1[2], (int)a1[3]};
    const v8i_t kb = {(int)b0[0], (int)b0[1], (int)b0[2], (int)b0[3], (int)b1[0], (int)b1[1], (int)b1[2], (int)b1[3]};
    p0 = __builtin_amdgcn_mfma_scale_f32_32x32x64_f8f6f4(ka, q8[ks], p0, 0, 0, 0, SC, 0, SC);
    p1 = __builtin_amdgcn_mfma_scale_f32_32x32x64_f8f6f4(kb, q8[ks], p1, 0, 0, 0, SC, 0, SC); }
}
DEVI int v_st(int k, int c) { const int kk = (k & ~0xC) | ((k & 4) << 1) | ((k & 8) >> 1); return ((kk >> 3) * 4 + (c >> 5)) * 512 + ((kk & 7) * 32 + (c & 31)) * 2; }
DEVI int v_rd_base(int lane) { return ((lane & 3) << 3) | (((lane >> 2) & 3) << 6) | (((lane >> 4) & 1) << 5) | (((lane >> 5) & 1) << 8); }
constexpr int v_rd_off(int d0, int ks, int half) { return d0 * 512 + ks * 4096 + half * 2048; }
template <int OFF> DEVI s16x4 tr_read(int vb) { s16x4 r; asm volatile("ds_read_b64_tr_b16 %0, %1 offset:%2" : "=&v"(r) : "v"(vb), "i"(OFF) : "memory"); return r; }
template <int D0> DEVI void pv_one(f32x16& od, int vb, bf16x8 pa0, bf16x8 pa1, bf16x8 pa2, bf16x8 pa3) {
  const s16x4 l0 = tr_read<v_rd_off(D0, 0, 0)>(vb), h0 = tr_read<v_rd_off(D0, 0, 1)>(vb), l1 = tr_read<v_rd_off(D0, 1, 0)>(vb), h1 = tr_read<v_rd_off(D0, 1, 1)>(vb);
  const s16x4 l2 = tr_read<v_rd_off(D0, 2, 0)>(vb), h2 = tr_read<v_rd_off(D0, 2, 1)>(vb), l3 = tr_read<v_rd_off(D0, 3, 0)>(vb), h3 = tr_read<v_rd_off(D0, 3, 1)>(vb);
  asm volatile("s_waitcnt lgkmcnt(0)" ::: "memory"); SBAR();
#define PK(L, H) (bf16x8){L[0], L[1], L[2], L[3], H[0], H[1], H[2], H[3]}
  od = __builtin_amdgcn_mfma_f32_32x32x16_bf16(pa0, PK(l0, h0), od, 0, 0, 0);
  od = __builtin_amdgcn_mfma_f32_32x32x16_bf16(pa1, PK(l1, h1), od, 0, 0, 0);
  od = __builtin_amdgcn_mfma_f32_32x32x16_bf16(pa2, PK(l2, h2), od, 0, 0, 0);
  od = __builtin_amdgcn_mfma_f32_32x32x16_bf16(pa3, PK(l3, h3), od, 0, 0, 0);
#undef PK
}
DEVI void pv_d0(f32x16* o, int vb, bf16x8 pa0, bf16x8 pa1, bf16x8 pa2, bf16x8 pa3) {
  pv_one<0>(o[0], vb, pa0, pa1, pa2, pa3); pv_one<1>(o[1], vb, pa0, pa1, pa2, pa3); pv_one<2>(o[2], vb, pa0, pa1, pa2, pa3); pv_one<3>(o[3], vb, pa0, pa1, pa2, pa3);
}

template <int ND0, int LD, bool KF8 = false>
DEVI void attn_loop(const bf16_t* __restrict__ Qw, const bf16_t* __restrict__ Kh, const bf16_t* __restrict__ Vh, int seq, char* lds, int kcol_bytes, const float SCALE,
                    f32x16 (&o)[4], float& l_out) {
  const int tid = ltid(), wid = tid >> 6, lane = tid & 63, r32 = lane & 31, hi = lane >> 5;
  char* V_lds = lds; char* K_lds = lds + 2 * SHM_V;
  float* ws = (float*)(lds + 2 * SHM_V + 2 * SHM_K) + wid * 64; float* al_l = ws + 32;
  float m_reg = -1e30f, l_reg = 0; bf16x8 qr[ND0]; v8i_t q8[2];
#pragma unroll
  for (int d = 0; d < 4; ++d) o[d] = f32x16{};
  if constexpr (KF8) {
#pragma unroll
    for (int ks = 0; ks < 2; ++ks) q8[ks] = *reinterpret_cast<const v8i_t*>((const unsigned char*)Qw + ks * 64);
  } else {
#pragma unroll
  for (int d0 = 0; d0 < ND0; ++d0) qr[d0] = *reinterpret_cast<const bf16x8*>(Qw + d0 * 16);
  }
  const int sr = tid >> 4, sc = (tid & 15) * 8, vst0 = v_st(sr, sc), vst1 = v_st(32 + sr, sc);
  const int vb0 = (int)(uintptr_t)V_lds + v_rd_base(lane);
  struct { bf16x8 vs0, vs1, ks0, ks1; } sr_[2];
#define SLOAD(i, k0) do { sr_[i].vs0 = *reinterpret_cast<const bf16x8*>(&Vh[(long)((k0) + sr) * LD + sc]); sr_[i].vs1 = *reinterpret_cast<const bf16x8*>(&Vh[(long)((k0) + 32 + sr) * LD + sc]); \
    if constexpr (KF8) { sr_[i].ks0 = *reinterpret_cast<const bf16x8*>((const unsigned char*)Kh + (long)((k0) + (tid >> 3)) * 1280 + (tid & 7) * 16); } else { \
    sr_[i].ks0 = *reinterpret_cast<const bf16x8*>(&Kh[(long)((k0) + sr) * LD + sc]); sr_[i].ks1 = *reinterpret_cast<const bf16x8*>(&Kh[(long)((k0) + 32 + sr) * LD + sc]); } } while (0)
#define SWRITE(b, i) do { *(bf16x8*)(V_lds + (b) * SHM_V + vst0) = sr_[i].vs0;          \
    *(bf16x8*)(V_lds + (b) * SHM_V + vst1) = sr_[i].vs1; int kc = sc * 2;               \
    if constexpr (KF8) { *(bf16x8*)(K_lds + (b) * SHM_K + K8SWZ(tid >> 3, tid & 7)) = sr_[i].ks0; } else { \
    *(bf16x8*)(K_lds + (b) * SHM_K + KSWZ(sr, kc)) = sr_[i].ks0;                       \
    *(bf16x8*)(K_lds + (b) * SHM_K + KSWZ(32 + sr, kc)) = sr_[i].ks1; } } while (0)
#define SWAIT() do { if constexpr (KF8) asm volatile("s_waitcnt vmcnt(3)" ::: "memory"); else asm volatile("s_waitcnt vmcnt(4)" ::: "memory"); } while (0)
#define QKT(P0, P1, KS) do { if constexpr (KF8) qkt8(P0, P1, KS, q8, r32, hi); else qkt<ND0>(P0, P1, KS, qr, r32, hi, kcol_bytes); } while (0)
#define RESC(a) do { if (__any((a) < 1.f)) { if (hi == 0) al_l[r32] = (a); asm volatile("s_waitcnt lgkmcnt(0)" ::: "memory"); \
    _Pragma("unroll") for (int d = 0; d < 4; ++d) _Pragma("unroll") for (int r = 0; r < 16; ++r) o[d][r] *= al_l[crow(r, hi)]; } } while (0)
  f32x16 pA0, pA1, pB0, pB1; float mnA, mnB, alA, alB; bf16x8 pa0, pa1, pa2, pa3; const int NT = seq / KVBLK;
  constexpr int SE = 0, SO = 1;
  SLOAD(SE, 0); asm volatile("s_waitcnt vmcnt(0)" ::: "memory"); SWRITE(0, SE); __syncthreads();
  QKT(pA0, pA1, K_lds); partialSM(pA0, pA1, m_reg, mnA, alA, SCALE);
  SLOAD(SO, KVBLK); if (2 < NT) SLOAD(SE, 2 * KVBLK);
  SWAIT(); SWRITE(1, SO); __syncthreads();
  for (int j = 1; j + 1 < NT; j += 2) {
    SBAR(); QKT(pB0, pB1, K_lds + SHM_K);
    finishSM(pA0, pA1, alA, l_reg, pa0, pa1, pa2, pa3); SBAR();
    SLOAD(SO, (j + 2) * KVBLK); SBAR();
    pv_d0(o, vb0, pa0, pa1, pa2, pa3); partialSM(pB0, pB1, m_reg, mnB, alB, SCALE);
    __syncthreads(); SWAIT(); SWRITE(0, SE);
    RESC(alB); __syncthreads();
    SBAR(); QKT(pA0, pA1, K_lds);
    finishSM(pB0, pB1, alB, l_reg, pa0, pa1, pa2, pa3); SBAR();
    if (j + 3 < NT) SLOAD(SE, (j + 3) * KVBLK); SBAR();
    pv_d0(o, vb0 + (int)SHM_V, pa0, pa1, pa2, pa3); partialSM(pA0, pA1, m_reg, mnA, alA, SCALE);
    __syncthreads(); SWAIT(); SWRITE(1, SO);
    RESC(alA); __syncthreads();
  }
  SBAR(); QKT(pB0, pB1, K_lds + SHM_K);
  finishSM(pA0, pA1, alA, l_reg, pa0, pa1, pa2, pa3); SBAR();
  pv_d0(o, vb0, pa0, pa1, pa2, pa3); partialSM(pB0, pB1, m_reg, mnB, alB, SCALE);
  __syncthreads(); RESC(alB);
  finishSM(pB0, pB1, alB, l_reg, pa0, pa1, pa2, pa3); SBAR();
  pv_d0(o, vb0 + (int)SHM_V, pa0, pa1, pa2, pa3);
  asm volatile("s_waitcnt vmcnt(0)" ::: "memory");
  l_out = l_reg;
#undef QKT
#undef SLOAD
#undef SWRITE
#undef SWAIT
#undef RESC
}

DEVI void store_tile_bf16(const f32x16 (&o)[4], const float (&scl)[16], bf16_t* Ow, int ldo, int r32, int hi) {
#pragma unroll
  for (int d0 = 0; d0 < 4; ++d0)
#pragma unroll
    for (int r = 0; r < 16; r += 2) {
      const float va = o[d0][r] * scl[r], vb = o[d0][r + 1] * scl[r + 1];
      const float snd = (r32 & 1) ? va : vb; const float got = shx<1>(snd);
      const int row = (r32 & 1) ? crow(r + 1, hi) : crow(r, hi); const int col = d0 * 32 + (r32 & ~1);
      const unsigned w = (r32 & 1) ? cvtpk(got, vb) : cvtpk(va, got);
      *(unsigned*)(Ow + (long)row * ldo + col) = w; }
}

DEVI void store_tile_fp8(const f32x16 (&o)[4], const float (&scl)[16], unsigned char* Ow, int ldo, int r32, int hi, const float xs) {
  const int q = r32 & 3; const bool b0 = q & 1, b1 = q & 2;
#pragma unroll
  for (int d0 = 0; d0 < 4; ++d0)
#pragma unroll
    for (int r4 = 0; r4 < 16; r4 += 4) {
      float v[4];
#pragma unroll
      for (int kk = 0; kk < 4; ++kk) v[kk] = __builtin_amdgcn_fmed3f(o[d0][r4 + kk] * scl[r4 + kk] * xs, -440.f, 440.f);
      const float gA = shx<1>(b0 ? v[0] : v[1]), gB = shx<1>(b0 ? v[2] : v[3]);
      const float aLo = b0 ? gA : v[0], aHi = b0 ? v[1] : gA;
      const float bLo = b0 ? gB : v[2], bHi = b0 ? v[3] : gB;
      const int pA = __builtin_amdgcn_cvt_pk_fp8_f32(aLo, aHi, 0, false) & 0xffff, pB = __builtin_amdgcn_cvt_pk_fp8_f32(bLo, bHi, 0, false) & 0xffff;
      const int got = __float_as_int(shx<2>(__int_as_float(b1 ? pA : pB))) & 0xffff;
      const unsigned w = b1 ? ((unsigned)got | ((unsigned)pB << 16)) : ((unsigned)pA | ((unsigned)got << 16));
      *(unsigned*)(Ow + (long)crow(r4 + q, hi) * ldo + d0 * 32 + (r32 & ~3)) = w; }
}

DEVI void phase_attn1(const Params& p, const PrepIn& pin, unsigned char* smem) {
  const bf16_t* qkv = wsp<bf16_t>(p, OFF_PROJ); bf16_t* att = wsp<bf16_t>(p, OFF_ACT);
  const int tid = ltid(), wid = tid >> 6, lane = tid & 63, r32 = lane & 31, hi = lane >> 5;
  const int vb_ = vbid(); const int xcd = vb_ & 7, slot = vb_ >> 3, nslot = gridDim.x >> 3;
  float* li_l = (float*)((char*)smem + 2 * SHM_V + 2 * SHM_K) + wid * 64;
  for (int it = slot; it < 4 * 32; it += nslot) {
    const int g = xcd + 8 * (it >> 5), item = it & 31, b = g >> 1, kvh = g & 1, h = kvh * 4 + (item >> 3), qb = item & 7;
    const bf16_t* Qb = qkv + (size_t)(b * SB + NC + qb * 256) * ODD_IN + h * 128;
    const bf16_t* Kh = qkv + (size_t)(b * SB) * ODD_IN + 1024 + kvh * 128; const bf16_t* Vh = Kh + 256;
    const unsigned char* Q8 = p.ws + OFF_QK8 + (size_t)(b * SB + NC + qb * 256) * 1280 + h * 128; const unsigned char* K8 = p.ws + OFF_QK8 + (size_t)(b * SB) * 1280 + 1024 + kvh * 128;
    f32x16 o[4]; float l;
    __syncthreads();
    if constexpr (ATT1_QK8) attn_loop<8, ODD_IN, true>((const bf16_t*)(Q8 + (long)(wid * QBLK + r32) * 1280 + hi * 32), (const bf16_t*)K8, Vh, SB, (char*)smem, 0, 0.08838834764831845f, o, l);
    else attn_loop<8, ODD_IN>(Qb + (long)(wid * QBLK + r32) * ODD_IN + hi * 8, Kh, Vh, SB, (char*)smem, 0, 0.08838834764831845f, o, l);
    if (hi == 0) li_l[r32] = l; asm volatile("s_waitcnt lgkmcnt(0)" ::: "memory");
    float rli[16];
#pragma unroll
    for (int r = 0; r < 16; ++r) rli[r] = __builtin_amdgcn_rcpf(li_l[crow(r, hi)]);
    if (OUT1_FP8) store_tile_fp8(o, rli, p.ws + OFF_ACT8 + (size_t)(b * SB + NC + qb * 256 + wid * QBLK) * D + h * 128, D, r32, hi, (float)(1 << A_SHIFT));
    else store_tile_bf16(o, rli, att + (size_t)(b * SB + NC + qb * 256 + wid * QBLK) * D + h * 128, D, r32, hi);
  }
}

DEVI void phase_attn0(const Params& p, const PrepIn& pin, unsigned char* smem) {
  const bf16_t* proj = wsp<bf16_t>(p, OFF_PROJ); bf16_t* cat = wsp<bf16_t>(p, OFF_ACT);
  const int tid = ltid(), wid = tid >> 6, lane = tid & 63, r32 = lane & 31, hi = lane >> 5, mp = wid >> 2, w4 = wid & 3;
  const int vb_ = vbid(); const int xcd = vb_ & 7, slot = vb_ >> 3, nslot = gridDim.x >> 3;
  float* li_l = (float*)((char*)smem + 2 * SHM_V + 2 * SHM_K) + wid * 64;
  float* ex = (float*)smem + (size_t)w4 * 4096 + lane;
  const float lam = wsp<float>(p, OFF_LAM)[0];
  const float* subln = sm(p, SM_SUBLN);
  for (int it = slot; it < 8 * 18; it += nslot) {
    int g, qrow0, seq;
    if (it < 128) { g = xcd + 8 * (it >> 4); qrow0 = NC + (it & 15) * 128; seq = SB; }
    else { const int j = it - 128; g = xcd + 8 * (j >> 1); qrow0 = (j & 1) * 128; seq = NC; }
    const int b = g >> 2, h = g & 3;
    const bf16_t* Qw = proj + (size_t)(b * SB + qrow0 + w4 * QBLK + r32) * EVEN_IN + 1024 + h * 128 + mp * 64 + hi * 8;
    const bf16_t* Kh = proj + (size_t)(b * SB) * EVEN_IN + 1536 + h * 128; const bf16_t* Vh = Kh + 512;
    f32x16 o[4]; float l;
    __syncthreads();
    attn_loop<4, EVEN_IN>(Qw, Kh, Vh, seq, (char*)smem, mp * 128, 0.125f, o, l);
    if (hi == 0) li_l[r32] = l; asm volatile("s_waitcnt lgkmcnt(0)" ::: "memory");
    float rli[16];
#pragma unroll
    for (int r = 0; r < 16; ++r) rli[r] = __builtin_amdgcn_rcpf(li_l[crow(r, hi)]);
    __syncthreads();
    if (mp == 1) {
#pragma unroll
      for (int d0 = 0; d0 < 4; ++d0)
#pragma unroll
        for (int r = 0; r < 16; ++r) ex[(d0 * 16 + r) * 64] = o[d0][r] * rli[r];
    }
    __syncthreads();
    if (mp == 0) {
      float ss[16];
#pragma unroll
      for (int r = 0; r < 16; ++r) ss[r] = 0.f;
#pragma unroll
      for (int d0 = 0; d0 < 4; ++d0) { const float gcol = subln[d0 * 32 + r32];
#pragma unroll
        for (int r = 0; r < 16; ++r) { const float dv = o[d0][r] * rli[r] - lam * ex[(d0 * 16 + r) * 64]; ss[r] += dv * dv; o[d0][r] = dv * gcol; } }
#pragma unroll
      for (int r = 0; r < 16; ++r) { float v = ss[r];
        v += shx<1>(v); v += shx<2>(v); v += shx<4>(v); v += shx<8>(v); v += shx<16>(v);
        ss[r] = rsqrtf(v * (1.0f / 128) + EPS) * 0.8f; }
      if (OUT0_FP8) store_tile_fp8(o, ss, p.ws + OFF_ACT8 + (size_t)(b * SB + qrow0 + w4 * QBLK) * D + 512 + h * 128, D, r32, hi, (float)(1 << A_SHIFT));
      else store_tile_bf16(o, ss, cat + (size_t)(b * SB + qrow0 + w4 * QBLK) * D + 512 + h * 128, D, r32, hi);
    }
  }
}

DEVI void phase_gmlp(const Params& p, unsigned char* smem) {
  const bf16_t* proj = wsp<bf16_t>(p, OFF_PROJ); bf16_t* cat = wsp<bf16_t>(p, OFF_ACT); const bf16_t* wsa = wsp<bf16_t>(p, OFF_WSA);
  const float* lng = sm(p, SM_ALNG); const float* lnb = sm(p, SM_ALNB); const float* abs_ = sm(p, SM_ABS);
  for (int it = blockIdx.x; it < (T / 128 + 1) / 2; it += gridDim.x) {
    const int tid = ltid(), hf = tid >> 8, ht = tid & 255, wl = ht >> 6, lane = tid & 63, fr = lane & 15, fq = lane >> 4;
    bf16_t* Tl = (bf16_t*)(smem + hf * 36864);
    const int ch = it * 2 + hf; const bool live = ch < T / 128; const int t0 = (live ? ch : 0) * 128;
    const int q = ht >> 1, part = ht & 1;
    float mu, rstd;
    { const bf16_t* vr = proj + (size_t)(t0 + q) * EVEN_IN + 512 + part * 256;
      float s = 0.f, s2 = 0.f;
#pragma unroll
      for (int i = 0; i < 32; ++i) { const u32x4 x = *(const u32x4*)(vr + i * 8);
#pragma unroll
        for (int e = 0; e < 4; ++e) { const float f0 = __uint_as_float(x[e] << 16), f1 = __uint_as_float(x[e] & 0xffff0000u); s += f0 + f1; s2 += f0 * f0 + f1 * f1; } }
      s += shx<1>(s); s2 += shx<1>(s2);
      mu = s * (1.0f / 512); rstd = rsqrtf(fmaxf(s2 * (1.0f / 512) - mu * mu, 0.f) + EPS); }
    for (int g = 0; g < 4; ++g) {
      __syncthreads();
      { const bf16_t* vg = proj + (size_t)(t0 + q) * EVEN_IN + 512 + g * 128 + part * 64;
#pragma unroll
        for (int i = 0; i < 8; ++i) { const u32x4 x = *(const u32x4*)(vg + i * 8); const int d0 = part * 64 + i * 8;
          const f32x4 ga = *(const f32x4*)(lng + g * 128 + d0), gb = *(const f32x4*)(lng + g * 128 + d0 + 4), ba = *(const f32x4*)(lnb + g * 128 + d0), bb = *(const f32x4*)(lnb + g * 128 + d0 + 4);
#pragma unroll
          for (int e = 0; e < 4; ++e) { const float f0 = __uint_as_float(x[e] << 16), f1 = __uint_as_float(x[e] & 0xffff0000u);
            const float gg0 = e < 2 ? ga[2 * e] : gb[2 * e - 4], gg1 = e < 2 ? ga[2 * e + 1] : gb[2 * e - 3], bb0 = e < 2 ? ba[2 * e] : bb[2 * e - 4], bb1 = e < 2 ? ba[2 * e + 1] : bb[2 * e - 3];
            const unsigned w = cvtpk((f0 - mu) * rstd * gg0 + bb0, (f1 - mu) * rstd * gg1 + bb1);
            Tl[(d0 + 2 * e) * 136 + q] = (bf16_t)(w & 0xffff); Tl[(d0 + 2 * e + 1) * 136 + q] = (bf16_t)(w >> 16); } }
      }
      __syncthreads();
      bf16x8 af[2][4];
#pragma unroll
      for (int m = 0; m < 2; ++m)
#pragma unroll
        for (int k = 0; k < 4; ++k) af[m][k] = *(const bf16x8*)(wsa + (size_t)(g * 128 + wl * 32 + m * 16 + fr) * 128 + k * 32 + fq * 8);
      f32x4 acc[2][8];
#pragma unroll
      for (int m = 0; m < 2; ++m)
#pragma unroll
        for (int n = 0; n < 8; ++n) acc[m][n] = (f32x4){0.f, 0.f, 0.f, 0.f};
#pragma unroll
      for (int k = 0; k < 4; ++k)
#pragma unroll
        for (int n = 0; n < 8; ++n) { const bf16x8 bfr = *(const bf16x8*)(Tl + (16 * n + fr) * 136 + k * 32 + fq * 8);
          acc[0][n] = __builtin_amdgcn_mfma_f32_16x16x32_bf16(bfr, af[0][k], acc[0][n], 0, 0, 0);
          acc[1][n] = __builtin_amdgcn_mfma_f32_16x16x32_bf16(bfr, af[1][k], acc[1][n], 0, 0, 0); }
      if (live) {
#pragma unroll
        for (int m = 0; m < 2; ++m) { const int pp = wl * 32 + m * 16 + fr; const size_t t = (size_t)t0 + pp; const float bias = abs_[g * 128 + pp];
#pragma unroll
          for (int n = 0; n < 8; ++n) { const int c = g * 128 + 16 * n + 4 * fq;
            const u32x2 uu = *(const u32x2*)(proj + t * EVEN_IN + c);
            const float o0 = __uint_as_float(uu.x << 16) * (acc[m][n][0] + bias), o1 = __uint_as_float(uu.x & 0xffff0000u) * (acc[m][n][1] + bias);
            const float o2 = __uint_as_float(uu.y << 16) * (acc[m][n][2] + bias), o3 = __uint_as_float(uu.y & 0xffff0000u) * (acc[m][n][3] + bias);
            if (OUT0_FP8) { const float xs = (float)(1 << A_SHIFT); int w8 = 0;
              w8 = __builtin_amdgcn_cvt_pk_fp8_f32(__builtin_amdgcn_fmed3f(o0 * xs, -440.f, 440.f), __builtin_amdgcn_fmed3f(o1 * xs, -440.f, 440.f), w8, false);
              w8 = __builtin_amdgcn_cvt_pk_fp8_f32(__builtin_amdgcn_fmed3f(o2 * xs, -440.f, 440.f), __builtin_amdgcn_fmed3f(o3 * xs, -440.f, 440.f), w8, true);
              *(int*)(p.ws + OFF_ACT8 + t * D + c) = w8; }
            else { u32x2 w; w.x = cvtpk(o0, o1); w.y = cvtpk(o2, o3);
              *(u32x2*)(cat + t * D + c) = w; } } }
      }
    }
  }
}
#undef KSWZ
#undef SBAR
}
#define REP_PREP 1
#define REP_NORM1 1
#define REP_IN0 1
#define REP_ATT0 1
#define REP_GMLP 1
#define REP_OUT0 1
#define REP_GU 1
#define REP_IN1 1
#define REP_ATT1 1
#define REP_SYNC 0
#define DRY_IN0 0
#define DRY_DOWN 0
#define DRY_GU 0
#define REP_ROUTER 1
#define REP_DOWN 1
#define REP_COMB 1
#define REPEAT(n, stmt) { int _n = (n); if ((n) > 1) asm volatile("" : "+s"(_n)); for (int _r = 0; _r < _n; ++_r) { stmt; if (_r + 1 < _n) GSYNC(); } }
__global__ __launch_bounds__(512) void mega(Params p0, PrepIn pin) {
  cg::grid_group grid = cg::this_grid();
  LAS unsigned char* lds = (LAS unsigned char*)smem;
  volatile LAS unsigned* xst = (volatile LAS unsigned*)(lds + SMEM_BYTES - 16);
  if (threadIdx.x == 0) { xst[0] = 0u; xst[1] = 0u; }
  ltid_init();
  XcdBarrier xb = xcd_barrier_post((unsigned*)(p0.ws + OFF_ZERO), xst);
  if (threadIdx.x == 0) { volatile LAS int* vbp = (volatile LAS int*)(lds + LDS_VBID); vbp[0] = (int)blockIdx.x;
    vbp[1] = (int)xb_add((unsigned*)(p0.ws + OFF_XRANK) + xb.x, 1u); }
#define GSYNC() xcd_barrier(xb)
#define ROUTER(c) { int _n = REP_ROUTER; if (REP_ROUTER > 1) asm volatile("" : "+s"(_n)); for (int _r = 0; _r < _n; ++_r) { \
      if (_r > 0) { if (blockIdx.x == 0 && threadIdx.x < 128) ((int*)(p0.ws + OFF_CNT))[c.l * 128 + threadIdx.x] = 0; GSYNC(); } \
      stage_router(launder(p0), c, smem); if (_r + 1 < _n) GSYNC(); } }
#define MOE_HALF(c, half, FUSE) do { \
    REPEAT(REP_GU, { const Params pl = launder(p0); fg::moe_tables(pl, c, half, 2, lds); int dry = (DRY_GU && _r > 0) ? DRY_GU : 0; if (DRY_GU) { asm volatile("" : "+v"(dry)); dry = __builtin_amdgcn_readfirstlane(dry); } fg::JobGU J(pl, c, half, lds, dry); fg::gemm_phase(lds, J); }) \
    GSYNC(); \
    { int _n = REP_DOWN; if (REP_DOWN > 1) asm volatile("" : "+s"(_n)); for (int _r = 0; _r < _n; ++_r) { float ds = _r == 0 ? 1.0f : (DRY_DOWN ? -1.0f : 0.0f); if (REP_DOWN > 1) { asm volatile("" : "+v"(ds)); ds = __int_as_float(__builtin_amdgcn_readfirstlane(__float_as_int(ds))); } \
        const Params pl = launder(p0); fg::moe_tables(pl, c, half, 4, lds); fg::JobDown J(pl, c, half, lds, ds); fg::gemm_phase(lds, J); if (_r + 1 < _n) GSYNC(); } } \
    GSYNC(); \
    { int _n = REP_COMB; if (REP_COMB > 1) asm volatile("" : "+s"(_n)); for (int _r = 0; _r < _n; ++_r) { float ds = _r == 0 ? 1.0f : 0.0f; if (REP_COMB > 1) asm volatile("" : "+v"(ds)); \
        stage_combine<FUSE>(launder(p0), c, half, smem, ds); if (_r + 1 < _n) GSYNC(); } } \
    } while (0)
  for (int _r = 0; _r < REP_PREP; ++_r) { stage_prep(p0, pin, smem); if (_r + 1 < REP_PREP) __syncthreads(); }
  grid.sync();
  if (threadIdx.x == 0) {
    bool ok = true; const unsigned per = gridDim.x >> 3;
    for (int j = 0; j < 16; ++j) { const unsigned c = xb_ld((unsigned*)(p0.ws + OFF_XRANK) + j); ok = ok && (c == (j < 8 ? per : 0u)); }
    volatile LAS int* vbp = (volatile LAS int*)(lds + LDS_VBID);
    if (ok && (gridDim.x & 7) == 0) vbp[0] = (int)xb.x + 8 * vbp[1]; }
  __syncthreads();
  REPEAT(REP_NORM1, stage_norm1<0>(launder(p0))) GSYNC();
  REPEAT(REP_IN0, { const Params pl = launder(p0); fg::load_rope_lds(pl, OFF_TAB64, 512, SM_BQN, SM_BKN, 64, lds); int dry = (DRY_IN0 && _r > 0) ? DRY_IN0 : 0; if (DRY_IN0) { asm volatile("" : "+v"(dry)); dry = __builtin_amdgcn_readfirstlane(dry); } fg::JobIn0 J(pl, dry); fg::gemm_phase(lds, J); })
  GSYNC();
  REPEAT(REP_ATT0, fa::phase_attn0(launder(p0), pin, smem))
  REPEAT(REP_GMLP, fa::phase_gmlp(launder(p0), smem))
  GSYNC();
  REPEAT(REP_OUT0, { const Params pl = launder(p0); fg::JobOut<0> J(pl); fg::gemm_phase(lds, J); })
  expert_prep_steal(launder(p0), pin, smem, 0);
  GSYNC();
  { const LCfg c{0, SB, 0, 16 * SB};
    ROUTER(c); GSYNC();
    MOE_HALF(c, 0, true); GSYNC(); }
  { int _n = REP_SYNC; if (REP_SYNC > 0) asm volatile("" : "+s"(_n)); for (int _r = 0; _r < _n; ++_r) GSYNC(); }
  REPEAT(REP_IN1, { const Params pl = launder(p0); fg::load_rope_lds(pl, OFF_TAB128, 1024, SM_CQN, SM_CKN, 128, lds); fg::JobIn1 J(pl); fg::gemm_phase(lds, J); })
  expert_prep_steal(launder(p0), pin, smem, 1);
  GSYNC();
  REPEAT(REP_ATT1, fa::phase_attn1(launder(p0), pin, smem))
  GSYNC();
  { const Params pl = launder(p0); fg::JobOut<1> J(pl); fg::gemm_phase(lds, J); }
  GSYNC();
  { const LCfg c{1, S, NC, 16 * S};
    ROUTER(c); GSYNC();
    MOE_HALF(c, 0, false); }
}

extern "C" void kernel_launch(void* const* d_in, const int* in_sizes, int n_in, void* d_out, int out_size, void* d_ws, size_t ws_size, hipStream_t stream) {
  static int grid_blocks = 0;
  if (!grid_blocks) {
    if (n_in != 33 || ws_size < WS_TOTAL) { fprintf(stderr, "kernel_launch: bad n_in %d or ws %zu < %zu\n", n_in, ws_size, (size_t)WS_TOTAL); return; }
    if (hipFuncSetAttribute((const void*)mega, hipFuncAttributeMaxDynamicSharedMemorySize, SMEM_BYTES) != hipSuccess) { fprintf(stderr, "set attr failed\n"); return; }
    int dev = 0, cus = 0, per_cu = 0;
    hipGetDevice(&dev); hipDeviceGetAttribute(&cus, hipDeviceAttributeMultiprocessorCount, dev);
    hipOccupancyMaxActiveBlocksPerMultiprocessor(&per_cu, mega, 512, SMEM_BYTES);
    if (per_cu < 1) { fprintf(stderr, "occupancy 0\n"); return; }
    grid_blocks = cus;
  }
  Params p; memset(&p, 0, sizeof(p)); PrepIn pin; memset(&pin, 0, sizeof(pin));
  for (int i = 0; i < 33; ++i) pin.in[i] = (const float*)d_in[i];
  p.out = (float*)d_out; p.ws = (unsigned char*)d_ws;
  p.x = pin.in[I_X]; p.ctx = pin.in[I_CTX];
  hipMemsetAsync(d_ws, 0, ZERO_BYTES, stream);
  void* args[] = {&p, &pin};
  hipError_t e = hipLaunchCooperativeKernel((void*)mega, dim3(grid_blocks), dim3(512), args, SMEM_BYTES, stream);
  if (e != hipSuccess) fprintf(stderr, "cooperative launch failed: %s (grid %d)\n", hipGetErrorString(e), grid_blocks);
}
```

```cpp
#include <hip/hip_runtime.h>
#include <hip/hip_cooperative_groups.h>
#include <cstdio>
#include <cstdint>
#include <cstring>
namespace cg = cooperative_groups;

#define DEVI __device__ __forceinline__
#define LAS __attribute__((address_space(3)))
typedef unsigned short bf16_t;
typedef short bf16x8 __attribute__((ext_vector_type(8)));
typedef float f32x4 __attribute__((ext_vector_type(4)));
typedef unsigned u32x4 __attribute__((ext_vector_type(4)));
typedef unsigned u32x2 __attribute__((ext_vector_type(2)));

constexpr int D = 1024, NB = 16, S = 2048, NC = 256, SB = 2304, T = NB * SB, TX = NB * S;
constexpr int NE = 64, TOPK = 6, DE = 256;
constexpr int EVEN_IN = 2560, ODD_IN = 1536;
constexpr float EPS = 1e-6f;

constexpr size_t al256(size_t x) { return (x + 255) & ~(size_t)255; }
constexpr size_t OFF_ZERO = 0, ZERO_BYTES = 65536;
constexpr size_t OFF_CNT = 16384;
constexpr size_t OFF_XRANK = 20608;
constexpr size_t OFF_STEAL = 20480;
constexpr size_t OFF_TAB64 = OFF_ZERO + ZERO_BYTES;
constexpr size_t OFF_TAB128 = OFF_TAB64 + 64 * 16 * 8;
constexpr size_t OFF_LAM = OFF_TAB128 + 64 * 32 * 8;
constexpr size_t OFF_MODV = al256(OFF_LAM + 256);
constexpr size_t OFF_SMALL = al256(OFF_MODV + (size_t)2 * 17 * 6144 * 4);
enum { SM_N1G = 0, SM_N2G = 2048, SM_ALNG = 4096, SM_ALNB = 4608, SM_ABS = 5120, SM_BQN = 5632, SM_BKN = 5696, SM_SUBLN = 5760, SM_CQN = 5888, SM_CKN = 6016, SM_MBIAS = 6144,
       SM_AWSF = 8192, SM_ROUTER = 73728, SM_END = 204800 };
constexpr size_t OFF_WIN0T = al256(OFF_SMALL + (size_t)SM_END * 4);
constexpr size_t OFF_WOUT0T = OFF_WIN0T + (size_t)EVEN_IN * D * 2;
constexpr size_t OFF_WQKV1T = OFF_WOUT0T + (size_t)D * D * 2;
constexpr size_t OFF_WOUT1T = OFF_WQKV1T + (size_t)ODD_IN * D * 2;
constexpr size_t OFF_WSA = OFF_WOUT1T + (size_t)D * D * 2;
constexpr size_t OFF_WRT = OFF_WSA + (size_t)4 * 128 * 128 * 2;
constexpr size_t OFF_SHGU = OFF_WRT + (size_t)2 * NE * D * 2;
constexpr size_t OFF_SHD = OFF_SHGU + (size_t)2 * 512 * D * 2;
constexpr size_t OFF_EGU = OFF_SHD + (size_t)2 * D * DE * 2;
constexpr size_t OFF_ED = OFF_EGU + (size_t)NE * 512 * D;
constexpr size_t OFF_HB = OFF_ED + (size_t)NE * D * DE;
constexpr size_t OFF_HC = OFF_HB;
constexpr size_t OFF_ACT = OFF_HB + (size_t)T * D * 2;
constexpr size_t OFF_TOPW = OFF_ACT + (size_t)T * D * 2;
constexpr size_t OFF_TOPP = al256(OFF_TOPW + (size_t)T * 6 * 4);
constexpr size_t OFF_LIST = al256(OFF_TOPP + (size_t)T * 6 * 4);
constexpr int LCAP = 36864;
constexpr size_t OFF_R = al256(OFF_LIST + (size_t)NE * LCAP * 4);
constexpr size_t OFF_PROJ = OFF_R;
constexpr size_t OFF_SLOT = OFF_R;
constexpr size_t OFF_QK8 = al256(OFF_R + (size_t)120000000);
constexpr size_t OFF_VT8 = al256(OFF_QK8 + (size_t)T * 1280);
constexpr size_t OFF_HID = al256(OFF_SLOT + (size_t)258048 * D);
constexpr size_t OFF_ACT8 = al256(OFF_HID + (size_t)(258048 + 256) * DE);
constexpr size_t WS_TOTAL = OFF_ACT8 + (size_t)T * D;
static_assert(OFF_HID >= OFF_R + (size_t)0, "layout");
static_assert(OFF_R + (size_t)T * EVEN_IN * 2 <= WS_TOTAL, "proj fits");
static_assert(WS_TOTAL <= 636368384ull, "workspace budget");
static_assert((size_t)T * ODD_IN * 2 <= 120000000ull && OFF_VT8 + (size_t)NB * 2 * 128 * SB <= OFF_SLOT + (size_t)258048 * D, "QK8 / VT8 placement");

struct Params {
  float* out;
  unsigned char* ws;
  const float* x; const float* ctx;
};
struct PrepIn { const float* in[33]; };
typedef __attribute__((address_space(1))) unsigned char* gptr_t;
__device__ __forceinline__ Params launder(const Params& p) {
  unsigned long long a = (unsigned long long)p.out, b = (unsigned long long)p.ws, c = (unsigned long long)p.x, d = (unsigned long long)p.ctx;
  asm volatile("" : "+s"(a), "+s"(b), "+s"(c), "+s"(d));
  Params q; q.out = (float*)(gptr_t)a; q.ws = (unsigned char*)(gptr_t)b; q.x = (const float*)(gptr_t)c; q.ctx = (const float*)(gptr_t)d; return q; }
enum { I_X = 0, I_C, I_CTX, I_CCTX, I_MODW, I_MODB, I_N1G, I_N2G, I_EVWIN, I_EVWOUT, I_ALNG, I_ALNB, I_AWS, I_ABS, I_BQN, I_BKN,
       I_LQ1, I_LK1, I_LQ2, I_LK2, I_SUBLN, I_ODQKV, I_ODOUT, I_CQN, I_CKN, I_ROUTER, I_MBIAS, I_WG, I_WU, I_WD, I_SG, I_SU, I_SD };

extern __shared__ __attribute__((aligned(16))) unsigned char smem[];
constexpr int SMEM_BYTES = 152 * 1024;
constexpr int LDS_WTAB = SMEM_BYTES - 512;
DEVI int ltid() {
  const unsigned slot = (unsigned)__builtin_amdgcn_s_getreg(63492) & 0x3fu;
  const int wv = __builtin_amdgcn_readfirstlane(*(volatile LAS int*)((LAS unsigned char*)smem + LDS_WTAB + slot * 4));
  int l; asm volatile("v_mbcnt_lo_u32_b32 %0, -1, 0\n\tv_mbcnt_hi_u32_b32 %0, -1, %0" : "=v"(l));
  return wv * 64 + l;
}
constexpr int LDS_VBID = LDS_WTAB + 256;
DEVI int vbid() { return __builtin_amdgcn_readfirstlane(*(volatile LAS int*)((LAS unsigned char*)smem + LDS_VBID)); }
DEVI void ltid_init() {
  const unsigned slot = (unsigned)__builtin_amdgcn_s_getreg(63492) & 0x3fu;
  if ((threadIdx.x & 63) == 0) *(volatile LAS int*)((LAS unsigned char*)smem + LDS_WTAB + slot * 4) = (int)(threadIdx.x >> 6);
  __syncthreads();
}
template <int M> DEVI float shx(float v) { static_assert(M == 1 || M == 2 || M == 4 || M == 8 || M == 16, "xor mask");
  return __int_as_float(__builtin_amdgcn_ds_swizzle(__float_as_int(v), (M << 10) | 0x1f)); }
template <int CTRL> DEVI float dppf(float v) { return __int_as_float(__builtin_amdgcn_update_dpp(0, __float_as_int(v), CTRL, 0xf, 0xf, true)); }
DEVI float rlane(float v, int l) { return __int_as_float(__builtin_amdgcn_readlane(__float_as_int(v), l)); }
DEVI float wsum_dpp(float v) { v += dppf<0xB1>(v); v += dppf<0x4E>(v); v += dppf<0x141>(v); v += dppf<0x140>(v); return (rlane(v, 0) + rlane(v, 16)) + (rlane(v, 32) + rlane(v, 48)); }
DEVI float wmax_dpp(float v) { v = fmaxf(v, dppf<0xB1>(v)); v = fmaxf(v, dppf<0x4E>(v)); v = fmaxf(v, dppf<0x141>(v)); v = fmaxf(v, dppf<0x140>(v)); return fmaxf(fmaxf(rlane(v, 0), rlane(v, 16)), fmaxf(rlane(v, 32), rlane(v, 48))); }
DEVI float max8_dpp(float v) { v = fmaxf(v, dppf<0xB1>(v)); v = fmaxf(v, dppf<0x4E>(v)); return fmaxf(v, dppf<0x141>(v)); }
DEVI float sum32x(float v) { auto r = __builtin_amdgcn_permlane32_swap(__float_as_uint(v), __float_as_uint(v), false, false); return __uint_as_float(r[0]) + __uint_as_float(r[1]); }
DEVI float max32x(float v) { auto r = __builtin_amdgcn_permlane32_swap(__float_as_uint(v), __float_as_uint(v), false, false); return fmaxf(__uint_as_float(r[0]), __uint_as_float(r[1])); }
DEVI bf16_t f2bf(float f) { unsigned u = __float_as_uint(f); u += 0x7FFFu + ((u >> 16) & 1u); return (bf16_t)(u >> 16); }
DEVI float bf2f(bf16_t b) { return __uint_as_float(((unsigned)b) << 16); }
DEVI unsigned pack2(float lo, float hi) { return (unsigned)f2bf(lo) | ((unsigned)f2bf(hi) << 16); }
DEVI float wsum(float v) { v += shx<1>(v); v += shx<2>(v); v += shx<4>(v); v += shx<8>(v); v += shx<16>(v); return sum32x(v); }
DEVI float wmax(float v) { v = fmaxf(v, shx<1>(v)); v = fmaxf(v, shx<2>(v)); v = fmaxf(v, shx<4>(v)); v = fmaxf(v, shx<8>(v)); v = fmaxf(v, shx<16>(v)); return max32x(v); }
DEVI float gelu_exact(float v) { return 0.5f * v * (1.0f + erff(v * 0.70710678118654752f)); }
DEVI float silu(float v) { return v / (1.0f + __expf(-v)); }

template <class Tp> DEVI Tp* wsp(const Params& p, size_t off) { return (Tp*)(p.ws + off); }
DEVI const float* sm(const Params& p, int off) { return (const float*)(p.ws + OFF_SMALL) + off; }
DEVI const float* in_row(const Params& p, int t) { int b = t / SB, j = t - b * SB;
  unsigned long long xa = (unsigned long long)p.x, ca = (unsigned long long)p.ctx; asm volatile("" : "+s"(xa), "+s"(ca));
  const float* xp = (const float*)(gptr_t)xa; const float* cp = (const float*)(gptr_t)ca;
  return j < NC ? cp + ((size_t)(b * NC + j)) * D : xp + ((size_t)(b * S + j - NC)) * D; }
DEVI f32x4 bf4(u32x2 r) { return (f32x4){__uint_as_float(r.x << 16), __uint_as_float(r.x & 0xffff0000u), __uint_as_float(r.y << 16), __uint_as_float(r.y & 0xffff0000u)}; }
DEVI float* hid_row(const Params& p, int t) { int b = t / SB, j = t - b * SB;
  return j < NC ? wsp<float>(p, OFF_HC) + ((size_t)(b * NC + j)) * D : p.out + ((size_t)(b * S + j - NC)) * D; }
DEVI const float* modv(const Params& p, int l, int t, int which) { int b = t / SB, j = t - b * SB; int r = j < NC ? 16 : b;
  return wsp<float>(p, OFF_MODV) + ((size_t)(l * 17 + r)) * 6144 + which * D; }

#define XB_TMO      128
#define XB_XCNT(j)  (256  + 64 * (j))
#define XB_XSUB(j)  (1280 + 64 * (j))
#define XB_XGEN(j)  (2304 + 64 * (j))
#define XB_TOP      3328
#define XB_TOPGEN   3392
#define XCD_BAR_WORDS 3456
#define XB_SPIN_CAP (1u << 22)
DEVI unsigned xb_ld(unsigned* p) { return __hip_atomic_load(p, __ATOMIC_RELAXED, __HIP_MEMORY_SCOPE_AGENT); }
DEVI unsigned xb_add(unsigned* p, unsigned v) { return __hip_atomic_fetch_add(p, v, __ATOMIC_RELAXED, __HIP_MEMORY_SCOPE_AGENT); }
DEVI unsigned xb_xcc_id() { return (unsigned)__builtin_amdgcn_s_getreg((3 << 11) | 20) & 0xFu; }
#define XB_SPIN(cond, bar) do { unsigned _sp = 0; while (cond) { __builtin_amdgcn_s_sleep(1); \
    if ((++_sp & 255u) == 0u) { if (xb_ld(&(bar)[XB_TMO])) break; if (_sp > XB_SPIN_CAP) { atomicAdd(&(bar)[XB_TMO], 1u); break; } } } } while (0)
struct XcdBarrier { unsigned* bar; unsigned x; volatile LAS unsigned* st; };
DEVI XcdBarrier xcd_barrier_post(unsigned* bar, volatile LAS unsigned* st) {
  XcdBarrier b; b.bar = bar; b.x = xb_xcc_id(); b.st = st;
  if (ltid() == 0) (void)xb_add(&bar[XB_XCNT(b.x)], 1u);
  return b;
}
DEVI void xcd_barrier_complete(unsigned* bar, unsigned x, unsigned& nloc, unsigned& nx) {
  const unsigned G = gridDim.x * gridDim.y * gridDim.z;
  unsigned sum, cnt, mine, sp = 0u;
  for (;;) {
    sum = 0u; cnt = 0u; mine = 0u;
#pragma unroll
    for (unsigned j = 0; j < 16; ++j) { const unsigned c = xb_ld(&bar[XB_XCNT(j)]); sum += c; cnt += (c > 0u) ? 1u : 0u; mine = (j == x) ? c : mine; }
    if (sum == G) break;
    __builtin_amdgcn_s_sleep(1);
    if ((++sp & 255u) == 0u) { if (xb_ld(&bar[XB_TMO])) break; if (sp > XB_SPIN_CAP) { atomicAdd(&bar[XB_TMO], 1u); break; } }
  }
  nloc = mine > 0u ? mine : 1u; nx = cnt > 0u ? cnt : 1u;
}
DEVI void xcd_barrier(const XcdBarrier& b) {
  asm volatile("s_waitcnt vmcnt(0)" ::: "memory");
  __syncthreads();
  if (ltid() == 0) {
    unsigned* bar = b.bar;
    __builtin_amdgcn_s_waitcnt(0);
    unsigned nloc = b.st[0], nx = b.st[1];
    if (nloc == 0u) { xcd_barrier_complete(bar, b.x, nloc, nx); b.st[0] = nloc; b.st[1] = nx; }
    const unsigned old = xb_add(&bar[XB_XSUB(b.x)], 1u);
    const unsigned gen = old / nloc;
    if (old + 1u == (gen + 1u) * nloc) {
      __builtin_amdgcn_fence(__ATOMIC_RELEASE, "agent");
      asm volatile("s_waitcnt vmcnt(0)" ::: "memory");
      const unsigned og = xb_add(&bar[XB_TOP], 1u);
      const unsigned tg = og / nx;
      if (og + 1u == (tg + 1u) * nx) xb_add(&bar[XB_TOPGEN], 1u);
      else XB_SPIN(xb_ld(&bar[XB_TOPGEN]) == tg, bar);
      __builtin_amdgcn_fence(__ATOMIC_ACQUIRE, "agent");
      xb_add(&bar[XB_XGEN(b.x)], 1u);
      asm volatile("s_waitcnt vmcnt(0)" ::: "memory");
    } else {
      XB_SPIN(xb_ld(&bar[XB_XGEN(b.x)]) == gen, bar);
      __builtin_amdgcn_fence(__ATOMIC_ACQUIRE, "agent");
      asm volatile("s_waitcnt vmcnt(0)" ::: "memory");
    }
  }
  __syncthreads();
}

DEVI void transpose_tiles(const float* srcb, unsigned char* dstb, int K, int N, int nb, size_t sstride, size_t dstride, unsigned char* smem, int& goff) {
  const int G = gridDim.x, tk = K / 128, tn = N / 256, per = tk * tn, total = per * nb, tid = ltid();
  const int first = (((int)blockIdx.x - goff) % G + G) % G;
  const int n4 = tid & 63, kp0 = tid >> 6;
  f32x4 va[8], vb[8];
  auto issue = [&](int ti) { const int m = ti / per, r = ti - m * per, kb = r / tn, nb_ = r - kb * tn;
    const float* src = srcb + (size_t)m * sstride + (size_t)(kb * 128) * N + nb_ * 256 + n4 * 4;
#pragma unroll
    for (int i = 0; i < 8; ++i) { const int kp = kp0 + 8 * i; va[i] = __builtin_nontemporal_load((const f32x4*)(src + (size_t)(2 * kp) * N)); vb[i] = __builtin_nontemporal_load((const f32x4*)(src + (size_t)(2 * kp + 1) * N)); } };
  if (first < total) issue(first);
  int par = 0;
  for (int ti = first; ti < total; ti += G, par ^= 1) {
    unsigned* Tb = (unsigned*)smem + par * 16384;
#pragma unroll
    for (int i = 0; i < 8; ++i) { const int kp = kp0 + 8 * i;
#pragma unroll
      for (int j = 0; j < 4; ++j) { const int n = n4 * 4 + j; Tb[n * 64 + (kp ^ (((n >> 2) & 7) << 2))] = pack2(va[i][j], vb[i][j]); } }
    if (ti + G < total) issue(ti + G);
    __syncthreads();
    const int m = ti / per, r = ti - m * per, kb = r / tn, nb_ = r - kb * tn;
    bf16_t* dst = (bf16_t*)dstb + (size_t)m * dstride + (size_t)(nb_ * 256) * K + kb * 128;
#pragma unroll
    for (int i = 0; i < 8; ++i) { const int pc = tid + 512 * i, n = pc >> 4, q = pc & 15;
      const u32x4 w = *(const u32x4*)(Tb + n * 64 + ((4 * q) ^ (((n >> 2) & 7) << 2)));
      *(u32x4*)(dst + (size_t)n * K + 8 * q) = w; }
  }
  __syncthreads();
  goff = (goff + total) % G;
}

constexpr int WD_SHIFT = 4, H_SHIFT = 2, WG_SHIFT = 5, X_SHIFT = 3, WQ_SHIFT = 5;
constexpr bool IN1_FP8 = true, IN0_FP8 = true, OUT0_FP8 = true, OUT1_FP8 = true;
constexpr bool ATT1_QK8 = true;
constexpr bool ATT1_PV8 = true;
constexpr int VS_SHIFT = 2, PS_SHIFT = 4;
constexpr int QS_SHIFT = 2;
constexpr int A_SHIFT = 3;
DEVI void transpose_panel8(const float* src0, unsigned char* dst0, int K, int N, int kb, int nb_, unsigned char* smem, int shift = WD_SHIFT) {
  const int tid = ltid(), n4 = tid & 63, kq0 = tid >> 6; unsigned* Tb = (unsigned*)smem;
  const float* src = src0 + (size_t)(kb * 128) * N + nb_ * 256 + n4 * 4; unsigned char* dst = dst0 + (size_t)(nb_ * 256) * K + kb * 128;
  f32x4 v[4][4];
#pragma unroll
  for (int i = 0; i < 4; ++i)
#pragma unroll
    for (int r = 0; r < 4; ++r) v[i][r] = __builtin_nontemporal_load((const f32x4*)(src + (size_t)(4 * (kq0 + 8 * i) + r) * N));
  const float sc = (float)(1 << shift);
#pragma unroll
  for (int i = 0; i < 4; ++i) { const int kq = kq0 + 8 * i;
#pragma unroll
    for (int j = 0; j < 4; ++j) { const int n = n4 * 4 + j; int w = 0;
      w = __builtin_amdgcn_cvt_pk_fp8_f32(v[i][0][j] * sc, v[i][1][j] * sc, w, false); w = __builtin_amdgcn_cvt_pk_fp8_f32(v[i][2][j] * sc, v[i][3][j] * sc, w, true);
      Tb[n * 32 + (kq ^ (((n >> 2) & 7) << 2))] = (unsigned)w; } }
  __syncthreads();
#pragma unroll
  for (int i = 0; i < 4; ++i) { const int pc = tid + 512 * i, n = pc >> 3, q = pc & 7;
    const u32x4 w = *(const u32x4*)(Tb + n * 32 + ((4 * q) ^ (((n >> 2) & 7) << 2)));
    *(u32x4*)(dst + (size_t)n * K + 16 * q) = w; }
}
DEVI void transpose_all8(const float* src, unsigned char* dst, int K, int N, int shift, unsigned char* smem, int& goff) {
  const int G = gridDim.x, tk = K / 128, tn = N / 256, total = tk * tn;
  const int first = (((int)blockIdx.x - goff) % G + G) % G;
  for (int ti = first; ti < total; ti += G) { __syncthreads(); const int kb = ti / tn, nb_ = ti - kb * tn; transpose_panel8(src, dst, K, N, kb, nb_, smem, shift); }
  __syncthreads();
  goff = (goff + total) % G;
}
DEVI void stage_prep(const Params& p, const PrepIn& pin, unsigned char* smem) {
  const int tid = ltid(), bid = blockIdx.x, G = gridDim.x;
  {
    float* sl = (float*)smem;
    for (int i = tid; i < 17 * 1024; i += 512) { int r = i >> 10, k = i & 1023; float v; if (r < 16) v = pin.in[I_C][r * 1024 + k]; else v = pin.in[I_CCTX][k]; sl[i] = silu(v); }
    __syncthreads();
    float* part = (float*)(smem + 17 * 1024 * 4);
    for (int cb = bid; cb < 256; cb += G) {
      const int col0 = cb * 48;
      if (tid < 384) {
        const int kc = tid / 48, c = tid - kc * 48, gc = col0 + c, l = gc / 6144, n = gc - l * 6144;
        const float* w = pin.in[I_MODW] + (size_t)l * 1024 * 6144 + n;
        float acc[17];
#pragma unroll
        for (int r = 0; r < 17; ++r) acc[r] = 0.f;
        for (int k = kc * 128; k < kc * 128 + 128; ++k) { float wv = w[(size_t)k * 6144];
#pragma unroll
          for (int r = 0; r < 17; ++r) acc[r] += sl[r * 1024 + k] * wv; }
#pragma unroll
        for (int r = 0; r < 17; ++r) part[(kc * 17 + r) * 48 + c] = acc[r];
      }
      __syncthreads();
      for (int i = tid; i < 17 * 48; i += 512) { int r = i / 48, c = i - r * 48, gc = col0 + c, l = gc / 6144, n = gc - l * 6144;
        float s = pin.in[I_MODB][l * 6144 + n];
        for (int kc = 0; kc < 8; ++kc) s += part[(kc * 17 + r) * 48 + c];
        wsp<float>(p, OFF_MODV)[((size_t)(l * 17 + r)) * 6144 + n] = s; }
      __syncthreads();
    }
  }
  if (bid == 0) {
    float2* t64 = wsp<float2>(p, OFF_TAB64); float2* t128 = wsp<float2>(p, OFF_TAB128);
    for (int i = tid; i < 64 * 16; i += 512) { int pos = i >> 4, f = i & 15; float inv = exp2f(-(float)f * (13.287712379549449f / 16.0f)); float a = (float)pos * inv; t64[i] = make_float2(__cosf(a), __sinf(a)); }
    for (int i = tid; i < 64 * 32; i += 512) { int pos = i >> 5, f = i & 31; float inv = exp2f(-(float)f * (13.287712379549449f / 32.0f)); float a = (float)pos * inv; t128[i] = make_float2(__cosf(a), __sinf(a)); }
    if (tid < 64) { float a = pin.in[I_LQ1][tid] * pin.in[I_LK1][tid], b = pin.in[I_LQ2][tid] * pin.in[I_LK2][tid]; a = wsum(a); b = wsum(b);
      if (tid == 0) wsp<float>(p, OFF_LAM)[0] = expf(a) - expf(b) + 0.2f; }
  }
  { float* smw = wsp<float>(p, OFF_SMALL); const int gt = bid * 512 + tid, gs = G * 512;
#define CPY(idx, off, n) for (int i = gt; i < (n); i += gs) smw[(off) + i] = pin.in[idx][i];
    CPY(I_N1G, SM_N1G, 2048) CPY(I_N2G, SM_N2G, 2048) CPY(I_ALNG, SM_ALNG, 512) CPY(I_ALNB, SM_ALNB, 512) CPY(I_ABS, SM_ABS, 512) CPY(I_BQN, SM_BQN, 64) CPY(I_BKN, SM_BKN, 64)
    CPY(I_SUBLN, SM_SUBLN, 128) CPY(I_CQN, SM_CQN, 128) CPY(I_CKN, SM_CKN, 128) CPY(I_MBIAS, SM_MBIAS, 128) CPY(I_AWS, SM_AWSF, 65536) CPY(I_ROUTER, SM_ROUTER, 131072)
#undef CPY
  }
  for (int i = bid * 512 + tid; i < 2 * NE * D; i += G * 512) { const int l = i >> 16, e = (i >> 10) & 63, kk = i & 1023; wsp<bf16_t>(p, OFF_WRT)[i] = f2bf(pin.in[I_ROUTER][((size_t)l * D + kk) * NE + e]); }
  for (int i = bid * 512 + tid; i < 4 * 128 * 128; i += G * 512) wsp<bf16_t>(p, OFF_WSA)[i] = f2bf(pin.in[I_AWS][i]);
  int goff = 0;
  const size_t EW = (size_t)D * DE;
  __syncthreads();
  if (IN0_FP8) transpose_all8(pin.in[I_EVWIN], p.ws + OFF_WIN0T, D, EVEN_IN, WQ_SHIFT, smem, goff);
  else transpose_tiles(pin.in[I_EVWIN], p.ws + OFF_WIN0T, D, EVEN_IN, 1, 0, 0, smem, goff);
  if (OUT0_FP8) transpose_all8(pin.in[I_EVWOUT], p.ws + OFF_WOUT0T, D, D, WQ_SHIFT, smem, goff);
  else transpose_tiles(pin.in[I_EVWOUT], p.ws + OFF_WOUT0T, D, D, 1, 0, 0, smem, goff);
  if (IN1_FP8) transpose_all8(pin.in[I_ODQKV], p.ws + OFF_WQKV1T, D, ODD_IN, WQ_SHIFT, smem, goff);
  else transpose_tiles(pin.in[I_ODQKV], p.ws + OFF_WQKV1T, D, ODD_IN, 1, 0, 0, smem, goff);
  if (OUT1_FP8) transpose_all8(pin.in[I_ODOUT], p.ws + OFF_WOUT1T, D, D, WQ_SHIFT, smem, goff);
  else transpose_tiles(pin.in[I_ODOUT], p.ws + OFF_WOUT1T, D, D, 1, 0, 0, smem, goff);
  for (int pi = bid; pi < 32; pi += G) { __syncthreads(); const int l = pi >> 4, up = (pi >> 3) & 1, kb = pi & 7;
    const float* sgu; if (up) sgu = pin.in[I_SU]; else sgu = pin.in[I_SG]; asm volatile("" : "+s"(sgu));
    transpose_panel8(sgu + (size_t)l * EW, p.ws + OFF_SHGU + (size_t)l * 512 * D + (size_t)up * 256 * D, D, DE, kb, 0, smem, WG_SHIFT); }
  __syncthreads();
  for (int pi = bid; pi < 16; pi += G) { __syncthreads(); const int l = pi >> 3, rr = pi & 7; transpose_panel8(pin.in[I_SD] + (size_t)l * EW, p.ws + OFF_SHD + (size_t)l * EW, DE, D, rr >> 2, rr & 3, smem); }
  __syncthreads();
}
DEVI void transpose_panel(const float* src0, bf16_t* dst0, int K, int N, int kb, int nb_, unsigned char* smem) {
  const int tid = ltid(), n4 = tid & 63, kp0 = tid >> 6; unsigned* Tb = (unsigned*)smem;
  const float* src = src0 + (size_t)(kb * 128) * N + nb_ * 256 + n4 * 4; bf16_t* dst = dst0 + (size_t)(nb_ * 256) * K + kb * 128;
  f32x4 va[8], vb[8];
#pragma unroll
  for (int i = 0; i < 8; ++i) { const int kp = kp0 + 8 * i; va[i] = __builtin_nontemporal_load((const f32x4*)(src + (size_t)(2 * kp) * N)); vb[i] = __builtin_nontemporal_load((const f32x4*)(src + (size_t)(2 * kp + 1) * N)); }
#pragma unroll
  for (int i = 0; i < 8; ++i) { const int kp = kp0 + 8 * i;
#pragma unroll
    for (int j = 0; j < 4; ++j) { const int n = n4 * 4 + j; Tb[n * 64 + (kp ^ (((n >> 2) & 7) << 2))] = pack2(va[i][j], vb[i][j]); } }
  __syncthreads();
#pragma unroll
  for (int i = 0; i < 8; ++i) { const int pc = tid + 512 * i, n = pc >> 4, q = pc & 15;
    const u32x4 w = *(const u32x4*)(Tb + n * 64 + ((4 * q) ^ (((n >> 2) & 7) << 2)));
    *(u32x4*)(dst + (size_t)n * K + 8 * q) = w; }
}
DEVI void expert_prep_steal(const Params& p, const PrepIn& pin, unsigned char* smem, int layer) {
  const size_t EW = (size_t)D * DE, lo = (size_t)layer * NE * EW; int* ctr = (int*)(p.ws + OFF_STEAL) + layer; int* bc = (int*)(smem + 65536);
  for (;;) {
    __syncthreads();
    if (ltid() == 0) bc[0] = atomicAdd(ctr, 1);
    __syncthreads();
    const int idx = bc[0]; if (idx >= 3 * 512) break;
    const int j = idx >> 9, r = idx & 511, m = r >> 3, rr = r & 7;
    if (j == 0) transpose_panel8(pin.in[I_WG] + lo + (size_t)m * EW, p.ws + OFF_EGU + (size_t)m * 512 * D, D, DE, rr, 0, smem, WG_SHIFT);
    else if (j == 1) transpose_panel8(pin.in[I_WU] + lo + (size_t)m * EW, p.ws + OFF_EGU + (size_t)m * 512 * D + (size_t)256 * D, D, DE, rr, 0, smem, WG_SHIFT);
    else transpose_panel8(pin.in[I_WD] + lo + (size_t)m * EW, p.ws + OFF_ED + (size_t)m * EW, DE, D, rr >> 2, rr & 3, smem);
  }
}
DEVI void stage_prep_experts(const Params& p, const PrepIn& pin, unsigned char* smem, int layer) {
  int goff = 0; const size_t EW = (size_t)D * DE, lo = (size_t)layer * NE * EW;
  __syncthreads();
  transpose_tiles(pin.in[I_WG] + lo, p.ws + OFF_EGU, D, DE, 64, EW, (size_t)512 * D, smem, goff);
  transpose_tiles(pin.in[I_WU] + lo, p.ws + OFF_EGU + (size_t)256 * D * 2, D, DE, 64, EW, (size_t)512 * D, smem, goff);
  transpose_tiles(pin.in[I_WD] + lo, p.ws + OFF_ED, DE, D, 64, EW, EW, smem, goff);
  __syncthreads();
}

template <int LAYER> DEVI void stage_norm1(const Params& p) {
  const int wid = ltid() >> 6, lane = ltid() & 63;
  const float* g = sm(p, SM_N1G + LAYER * D);
  bf16_t* act = wsp<bf16_t>(p, OFF_ACT);
  for (int t = blockIdx.x * 8 + wid; t < T; t += gridDim.x * 8) {
    const float* row = LAYER == 0 ? in_row(p, t) : (const float*)hid_row(p, t);
    const float* sh = modv(p, LAYER, t, 0); const float* sc = modv(p, LAYER, t, 1);
    f32x4 v[4]; float ss = 0.f;
#pragma unroll
    for (int i = 0; i < 4; ++i) { v[i] = *(const f32x4*)(row + (i * 64 + lane) * 4); ss += v[i][0] * v[i][0] + v[i][1] * v[i][1] + v[i][2] * v[i][2] + v[i][3] * v[i][3]; }
    ss = wsum(ss); const float rstd = rsqrtf(ss * (1.0f / D) + EPS);
#pragma unroll
    for (int i = 0; i < 4; ++i) { const int c = (i * 64 + lane) * 4; const f32x4 gg = *(const f32x4*)(g + c), s1 = *(const f32x4*)(sc + c), s0 = *(const f32x4*)(sh + c);
      float y[4];
#pragma unroll
      for (int q = 0; q < 4; ++q) y[q] = v[i][q] * rstd * gg[q] * (1.0f + s1[q]) + s0[q];
      if ((LAYER == 0 && IN0_FP8) || (LAYER == 1 && IN1_FP8)) { const float xs = (float)(1 << X_SHIFT); int w8 = 0;
        w8 = __builtin_amdgcn_cvt_pk_fp8_f32(__builtin_amdgcn_fmed3f(y[0] * xs, -440.f, 440.f), __builtin_amdgcn_fmed3f(y[1] * xs, -440.f, 440.f), w8, false);
        w8 = __builtin_amdgcn_cvt_pk_fp8_f32(__builtin_amdgcn_fmed3f(y[2] * xs, -440.f, 440.f), __builtin_amdgcn_fmed3f(y[3] * xs, -440.f, 440.f), w8, true);
        *(int*)(p.ws + OFF_ACT8 + (size_t)t * D + c) = w8; }
      else { u32x2 w; w.x = pack2(y[0], y[1]); w.y = pack2(y[2], y[3]);
        *(u32x2*)(act + (size_t)t * D + c) = w; } }
  }
}

template <class GA, class GB, class ST>
DEVI void ngemm(int MT, int NT, int K, GA getA, GB getB, ST store) {
  const int wid = ltid() >> 6, lane = ltid() & 63, fr = lane & 15, fq = lane >> 4;
  const long nw = (long)gridDim.x * 8;
  for (long tile = (long)blockIdx.x * 8 + wid; tile < (long)MT * NT; tile += nw) {
    const int tm = (int)(tile / NT), tn = (int)(tile - (long)tm * NT);
    const bf16_t* a0 = getA(tm * 32 + fr); const bf16_t* a1 = getA(tm * 32 + 16 + fr);
    const bf16_t* b0 = getB(tn * 32 + fr); const bf16_t* b1 = getB(tn * 32 + 16 + fr);
    f32x4 c00 = {0.f, 0.f, 0.f, 0.f}, c01 = c00, c10 = c00, c11 = c00;
    const bf16x8 z = {0, 0, 0, 0, 0, 0, 0, 0};
    for (int k = 0; k < K; k += 32) {
      const bf16x8 A0 = a0 ? *(const bf16x8*)(a0 + k + fq * 8) : z, A1 = a1 ? *(const bf16x8*)(a1 + k + fq * 8) : z;
      const bf16x8 B0 = *(const bf16x8*)(b0 + k + fq * 8), B1 = *(const bf16x8*)(b1 + k + fq * 8);
      c00 = __builtin_amdgcn_mfma_f32_16x16x32_bf16(A0, B0, c00, 0, 0, 0);
      c01 = __builtin_amdgcn_mfma_f32_16x16x32_bf16(A0, B1, c01, 0, 0, 0);
      c10 = __builtin_amdgcn_mfma_f32_16x16x32_bf16(A1, B0, c10, 0, 0, 0);
      c11 = __builtin_amdgcn_mfma_f32_16x16x32_bf16(A1, B1, c11, 0, 0, 0);
    }
#pragma unroll
    for (int j = 0; j < 4; ++j) {
      store(tm * 32 + fq * 4 + j, tn * 32 + fr, tn * 32 + 16 + fr, c00[j], c01[j]);
      store(tm * 32 + 16 + fq * 4 + j, tn * 32 + fr, tn * 32 + 16 + fr, c10[j], c11[j]);
    }
  }
}

DEVI void n_inproj0(const Params& p) {
  const bf16_t* act = wsp<bf16_t>(p, OFF_ACT); const bf16_t* w = wsp<bf16_t>(p, OFF_WIN0T); bf16_t* proj = wsp<bf16_t>(p, OFF_PROJ);
  ngemm(T / 32, EVEN_IN / 32, D,
        [&](int r) { return act + (size_t)r * D; }, [&](int n) { return w + (size_t)n * D; },
        [&](int r, int n0, int n1, float v0, float v1) { proj[(size_t)r * EVEN_IN + n0] = f2bf(v0); proj[(size_t)r * EVEN_IN + n1] = f2bf(v1); });
}
DEVI void n_post0(const Params& p) {
  const int wid = ltid() >> 6, lane = ltid() & 63;
  bf16_t* proj = wsp<bf16_t>(p, OFF_PROJ); const float2* t64 = wsp<float2>(p, OFF_TAB64);
  for (int t = blockIdx.x * 8 + wid; t < T; t += gridDim.x * 8) {
    bf16_t* row = proj + (size_t)t * EVEN_IN; const int b = t / SB, j = t - b * SB;
    for (int i = 0; i < 16; ++i) { int c = i * 64 + lane; row[c] = f2bf(gelu_exact(bf2f(row[c]))); }
    for (int hh = 0; hh < 16; ++hh) {
      const int c = 1024 + hh * 64 + lane; float v = bf2f(row[c]);
      float ss = wsum(v * v); float g = sm(p, hh < 8 ? SM_BQN : SM_BKN)[lane];
      float y = v * rsqrtf(ss * (1.0f / 64) + EPS) * g;
      y = bf2f(f2bf(y));
      if (j >= NC) { const int pos = j - NC, pr = lane >> 1; const int ps = pr < 16 ? (pos >> 6) : (pos & 63); const float2 cs = t64[ps * 16 + (pr & 15)];
        const float other = shx<1>(y);
        y = (lane & 1) ? (other * cs.y + y * cs.x) : (y * cs.x - other * cs.y); }
      row[c] = f2bf(y);
    }
  }
}

DEVI void attn_row(const bf16_t* q, int dq, const bf16_t* kb, int ldk, const bf16_t* vb, int ldv, int nkeys, float scale,
                   volatile float* sc, volatile float* qs, float& o0, float& o1) {
  const int lane = ltid() & 63;
  for (int d = lane; d < dq; d += 64) qs[d] = bf2f(q[d]);
  float mx = -1e30f;
  for (int key = lane; key < nkeys; key += 64) { const bf16_t* kr = kb + (size_t)key * ldk; float dot = 0.f;
    for (int d = 0; d < dq; d += 8) { const bf16x8 kv = *(const bf16x8*)(kr + d);
#pragma unroll
      for (int e = 0; e < 8; ++e) dot += qs[d + e] * bf2f((bf16_t)kv[e]); }
    dot *= scale; sc[key] = dot; mx = fmaxf(mx, dot); }
  mx = wmax(mx); float sum = 0.f;
  for (int key = lane; key < nkeys; key += 64) { float pv = __expf(sc[key] - mx); sc[key] = pv; sum += pv; }
  sum = wsum(sum); float a0 = 0.f, a1 = 0.f;
  for (int key = 0; key < nkeys; ++key) { const float pv = sc[key]; const unsigned vv = *(const unsigned*)(vb + (size_t)key * ldv + 2 * lane);
    a0 += pv * bf2f((bf16_t)(vv & 0xffff)); a1 += pv * bf2f((bf16_t)(vv >> 16)); }
  const float inv = 1.0f / sum; o0 = a0 * inv; o1 = a1 * inv;
}
DEVI void n_attn0(const Params& p, unsigned char* smem) {
  const int wid = ltid() >> 6, lane = ltid() & 63;
  volatile float* sc = (volatile float*)(smem + wid * (2304 * 4 + 512)); volatile float* qs = sc + 2304;
  const bf16_t* proj = wsp<bf16_t>(p, OFF_PROJ); bf16_t* cat = wsp<bf16_t>(p, OFF_ACT);
  const float lam = wsp<float>(p, OFF_LAM)[0];
  for (int task = blockIdx.x * 8 + wid; task < T * 4; task += gridDim.x * 8) {
    const int t = task >> 2, h = task & 3, b = t / SB, j = t - b * SB; const int nkeys = j < NC ? NC : SB;
    const bf16_t* kbase = proj + (size_t)(b * SB) * EVEN_IN + 1536 + h * 128; const bf16_t* vbase = proj + (size_t)(b * SB) * EVEN_IN + 2048 + h * 128;
    const bf16_t* q = proj + (size_t)t * EVEN_IN + 1024 + h * 128;
    float a0, a1, b0, b1;
    attn_row(q, 64, kbase, EVEN_IN, vbase, EVEN_IN, nkeys, 0.125f, sc, qs, a0, a1);
    attn_row(q + 64, 64, kbase + 64, EVEN_IN, vbase, EVEN_IN, nkeys, 0.125f, sc, qs, b0, b1);
    float o0 = a0 - lam * b0, o1 = a1 - lam * b1;
    float ss = wsum(o0 * o0 + o1 * o1); const float r = rsqrtf(ss * (1.0f / 128) + EPS) * 0.8f;
    o0 = o0 * r * sm(p, SM_SUBLN)[2 * lane]; o1 = o1 * r * sm(p, SM_SUBLN)[2 * lane + 1];
    *(unsigned*)(cat + (size_t)t * D + 512 + h * 128 + 2 * lane) = pack2(o0, o1);
  }
}
DEVI void n_gmlp(const Params& p, unsigned char* smem) {
  const int tid = ltid(), wid = tid >> 6, lane = tid & 63;
  bf16_t* lv = (bf16_t*)smem;
  const bf16_t* proj = wsp<bf16_t>(p, OFF_PROJ); bf16_t* cat = wsp<bf16_t>(p, OFF_ACT);
  for (int ch = blockIdx.x; ch < T / 128; ch += gridDim.x) {
    __syncthreads();
    for (int r = wid; r < 128; r += 8) { const bf16_t* vr = proj + (size_t)(ch * 128 + r) * EVEN_IN + 512;
      float v[8]; float s = 0.f;
#pragma unroll
      for (int i = 0; i < 8; ++i) { v[i] = bf2f(vr[i * 64 + lane]); s += v[i]; }
      s = wsum(s); const float mu = s * (1.0f / 512); float q = 0.f;
#pragma unroll
      for (int i = 0; i < 8; ++i) { const float d = v[i] - mu; q += d * d; }
      q = wsum(q); const float rstd = rsqrtf(q * (1.0f / 512) + EPS);
#pragma unroll
      for (int i = 0; i < 8; ++i) { const int c = i * 64 + lane; lv[r * 512 + c] = f2bf((v[i] - mu) * rstd * sm(p, SM_ALNG)[c] + sm(p, SM_ALNB)[c]); } }
    __syncthreads();
    const int c = tid, g = c >> 7;
    const float* wsg = sm(p, SM_AWSF) + (size_t)g * 128 * 128;
    for (int pp = 0; pp < 128; ++pp) { float acc = 0.f; const float* wr = wsg + pp * 128;
      for (int q = 0; q < 128; ++q) acc += wr[q] * bf2f(lv[q * 512 + c]);
      acc += sm(p, SM_ABS)[g * 128 + pp];
      const size_t t = (size_t)ch * 128 + pp; const float u = bf2f(proj[t * EVEN_IN + c]);
      cat[t * D + c] = f2bf(u * acc); }
  }
}
template <int LAYER> DEVI void n_outproj(const Params& p) {
  const bf16_t* cat = wsp<bf16_t>(p, OFF_ACT); const bf16_t* w = wsp<bf16_t>(p, LAYER == 0 ? OFF_WOUT0T : OFF_WOUT1T);
  auto st1 = [&](int r, int n, float v) { const int b = r / SB, j = r - b * SB; if (LAYER == 1 && j < NC) return;
    const float* res = LAYER == 0 ? in_row(p, r) : (const float*)hid_row(p, r); float* dst = hid_row(p, r);
    dst[n] = res[n] + modv(p, LAYER, r, 2)[n] * v; };
  ngemm(T / 32, D / 32, D, [&](int r) { return cat + (size_t)r * D; }, [&](int n) { return w + (size_t)n * D; },
        [&](int r, int n0, int n1, float v0, float v1) { st1(r, n0, v0); st1(r, n1, v1); });
}

struct LCfg { int l, npb, j0, nph; };
DEVI int act_tok(const LCfg& c, int half, int tl) { const int bl = tl / c.npb, jj = tl - bl * c.npb; return (half * 8 + bl) * SB + c.j0 + jj; }
DEVI void stage_router(const Params& p, const LCfg c, unsigned char* smem) {
  const int wid = ltid() >> 6, lane = ltid() & 63, fr = lane & 15, fq = lane >> 4;
  float* lgs = (float*)smem + wid * 4096;
  int* ksl = (int*)lgs + 2048;
  const float* g = sm(p, SM_N2G + c.l * D); bf16_t* act = wsp<bf16_t>(p, OFF_ACT);
  const bf16_t* wrt = wsp<bf16_t>(p, OFF_WRT) + (size_t)c.l * NE * D; const float bias = sm(p, SM_MBIAS)[c.l * NE + lane];
  int* cnt = (int*)(p.ws + OFF_CNT) + c.l * 128; int* list = wsp<int>(p, OFF_LIST); float* topw = wsp<float>(p, OFF_TOPW);
  const int nact = c.nph, nwv = gridDim.x * 8, chunk0 = (nact + nwv - 1) / nwv, chunk = chunk0 < 32 ? chunk0 : 32;
  const bool agg = (nact == nwv * chunk);
  LAS int* blk = (LAS int*)((LAS unsigned char*)smem + 131072); LAS int* blkb = blk + 64;
  if (agg) {
    if (ltid() < 64) blk[ltid()] = 0;
    const u32x4* src = (const u32x4*)wrt;
    for (int i = ltid(); i < NE * 128; i += 512) { const int row = i >> 7, ch = i & 127; *(LAS u32x4*)((LAS unsigned char*)smem + row * 2048 + ((ch ^ (row & 7)) << 4)) = src[i]; }
    __syncthreads(); }
  for (int ga0 = (blockIdx.x * 8 + wid) * chunk; ga0 < nact; ga0 += nwv * chunk) {
    const int ntk = (nact - ga0) < chunk ? (nact - ga0) : chunk;
    f32x4 gg[4], s1v[4], s0v[4]; int curb = -1;
#pragma unroll
    for (int i = 0; i < 4; ++i) gg[i] = *(const f32x4*)(g + (i * 64 + lane) * 4);
    for (int j0 = 0; j0 < ntk; j0 += 3) {
      f32x4 v[3][4]; int tt[3];
#pragma unroll
      for (int u = 0; u < 3; ++u) { int j = j0 + u; j = j < ntk ? j : ntk - 1; const int ga = ga0 + j, half = ga / c.nph, tl = ga - half * c.nph; tt[u] = act_tok(c, half, tl);
        const bf16_t* row = wsp<bf16_t>(p, OFF_HB) + (size_t)tt[u] * D;
#pragma unroll
        for (int i = 0; i < 4; ++i) v[u][i] = bf4(*(const u32x2*)(row + (i * 64 + lane) * 4)); }
#pragma unroll
      for (int u = 0; u < 3; ++u) { float ss = 0.f;
#pragma unroll
        for (int i = 0; i < 4; ++i) ss += v[u][i][0] * v[u][i][0] + v[u][i][1] * v[u][i][1] + v[u][i][2] * v[u][i][2] + v[u][i][3] * v[u][i][3];
        const float rstd = rsqrtf(wsum_dpp(ss) * (1.0f / D) + EPS);
        const int bt = tt[u] / SB, jt = tt[u] - bt * SB, mrow = jt < NC ? 16 : bt;
        if (mrow != curb) { curb = mrow; const float* sh = modv(p, c.l, tt[u], 3); const float* sc = modv(p, c.l, tt[u], 4);
#pragma unroll
          for (int i = 0; i < 4; ++i) { s0v[i] = *(const f32x4*)(sh + (i * 64 + lane) * 4); s1v[i] = *(const f32x4*)(sc + (i * 64 + lane) * 4); } }
        if (j0 + u < ntk) {
#pragma unroll
          for (int i = 0; i < 4; ++i) { const int cc = (i * 64 + lane) * 4;
            float y[4];
#pragma unroll
            for (int q = 0; q < 4; ++q) y[q] = v[u][i][q] * rstd * gg[i][q] * (1.0f + s1v[i][q]) + s0v[i][q];
            u32x2 w; w.x = pack2(y[0], y[1]); w.y = pack2(y[2], y[3]);
            *(u32x2*)(act + (size_t)tt[u] * D + cc) = w;
            const float xs = (float)(1 << X_SHIFT); int w8 = 0;
            w8 = __builtin_amdgcn_cvt_pk_fp8_f32(__builtin_amdgcn_fmed3f(y[0] * xs, -440.f, 440.f), __builtin_amdgcn_fmed3f(y[1] * xs, -440.f, 440.f), w8, false);
            w8 = __builtin_amdgcn_cvt_pk_fp8_f32(__builtin_amdgcn_fmed3f(y[2] * xs, -440.f, 440.f), __builtin_amdgcn_fmed3f(y[3] * xs, -440.f, 440.f), w8, true);
            *(int*)(p.ws + OFF_ACT8 + (size_t)tt[u] * D + cc) = w8; } }
      }
    }
    asm volatile("s_waitcnt vmcnt(0)" ::: "memory");
    const bf16_t* ar[2];
#pragma unroll
    for (int m = 0; m < 2; ++m) { int jj = m * 16 + fr; jj = jj < ntk ? jj : 0; const int ga = ga0 + jj, half = ga / c.nph, tl = ga - half * c.nph; ar[m] = act + (size_t)act_tok(c, half, tl) * D + fq * 8; }
    const bf16_t* br = wrt + (size_t)fr * D + fq * 8;
    f32x4 acc[2][4];
#pragma unroll
    for (int m = 0; m < 2; ++m)
#pragma unroll
      for (int n = 0; n < 4; ++n) acc[m][n] = (f32x4){0.f, 0.f, 0.f, 0.f};
    if (agg) {
      const LAS unsigned char* bl = (const LAS unsigned char*)smem + fr * 2048; const int sw = fr & 7;
#pragma unroll 8
      for (int k0 = 0; k0 < D; k0 += 32) {
        bf16x8 af[2], bfr[4];
#pragma unroll
        for (int m = 0; m < 2; ++m) af[m] = *(const bf16x8*)(ar[m] + k0);
#pragma unroll
        for (int n = 0; n < 4; ++n) bfr[n] = *(const LAS bf16x8*)(bl + n * 32768 + ((((k0 >> 3) + fq) ^ sw) << 4));
#pragma unroll
        for (int m = 0; m < 2; ++m)
#pragma unroll
          for (int n = 0; n < 4; ++n) acc[m][n] = __builtin_amdgcn_mfma_f32_16x16x32_bf16(af[m], bfr[n], acc[m][n], 0, 0, 0);
      }
      __syncthreads();
    } else {
#pragma unroll 4
    for (int k0 = 0; k0 < D; k0 += 32) {
      bf16x8 af[2], bfr[4];
#pragma unroll
      for (int m = 0; m < 2; ++m) af[m] = *(const bf16x8*)(ar[m] + k0);
#pragma unroll
      for (int n = 0; n < 4; ++n) bfr[n] = *(const bf16x8*)(br + (size_t)(16 * n) * D + k0);
#pragma unroll
      for (int m = 0; m < 2; ++m)
#pragma unroll
        for (int n = 0; n < 4; ++n) acc[m][n] = __builtin_amdgcn_mfma_f32_16x16x32_bf16(af[m], bfr[n], acc[m][n], 0, 0, 0);
    }
    }
    __builtin_amdgcn_wave_barrier();
#pragma unroll
    for (int m = 0; m < 2; ++m)
#pragma unroll
      for (int n = 0; n < 4; ++n)
#pragma unroll
        for (int r = 0; r < 4; ++r) lgs[(m * 16 + 4 * fq + r) * 64 + 16 * n + fr] = acc[m][n][r];
    __builtin_amdgcn_fence(__ATOMIC_RELEASE, "wavefront"); __builtin_amdgcn_wave_barrier();
    const int half0 = ga0 / c.nph, half1 = (ga0 + ntk - 1) / c.nph;
    unsigned cm0 = 0u, cm1 = 0u;
    for (int j0 = 0; j0 < ntk; j0 += 3) {
      float wq[3]; int kq[3];
#pragma unroll
      for (int u = 0; u < 3; ++u) { const int j = (j0 + u) < ntk ? (j0 + u) : j0;
        const float lg = ((volatile float*)lgs)[j * 64 + lane];
        const float score = __builtin_amdgcn_rcpf(1.0f + __expf(-lg)); const float sel = score + bias;
        const float m1 = max8_dpp(sel);
        const unsigned long long isb = __ballot(sel == m1); const int gbase = lane & ~7; const unsigned gm = (unsigned)((isb >> gbase) & 0xffull);
        const int first = gbase + __builtin_ctz(gm);
        const float m2 = max8_dpp((lane == first) ? -INFINITY : sel);
        const float gs = m1 + m2; const int gi = lane >> 3; int grank = 0;
#pragma unroll
        for (int g2 = 0; g2 < 8; ++g2) { const float og = rlane(gs, g2 * 8); grank += (og > gs || (og == gs && g2 < gi)) ? 1 : 0; }
        float cur = grank < 4 ? sel : -INFINITY;
        int myk = -1; float wsumv = 0.f;
#pragma unroll
        for (int kk = 0; kk < TOPK; ++kk) { const float mxv = wmax_dpp(cur); const unsigned long long bm = __ballot(cur == mxv); const int win = __builtin_ctzll(bm);
          if (lane == win) { myk = kk; cur = -INFINITY; } wsumv += rlane(score, win); }
        wq[u] = score * __builtin_amdgcn_rcpf(wsumv) * 2.5f; kq[u] = myk; }
#pragma unroll
      for (int u = 0; u < 3; ++u) { const int j = j0 + u;
        if (j < ntk) { ((volatile float*)lgs)[j * 64 + lane] = wq[u]; ((volatile int*)ksl)[j * 64 + lane] = kq[u];
          const bool inh0 = (ga0 + j) / c.nph == half0;
          if (kq[u] >= 0) { if (inh0) cm0 |= 1u << j; else cm1 |= 1u << j; } } }
    }
    int base0 = 0, base1 = 0;
    if (agg) {
      const int n0 = __builtin_popcount(cm0); int wb = 0;
      if (n0) wb = __atomic_fetch_add(&blk[lane], n0, __ATOMIC_RELAXED);
      __syncthreads();
      if (wid == 0) { const int tot = blk[lane]; int gb = 0; if (tot) gb = atomicAdd(&cnt[half0 * 64 + lane], tot); blkb[lane] = gb; }
      __syncthreads();
      base0 = blkb[lane] + wb;
    } else {
      if (cm0) base0 = atomicAdd(&cnt[half0 * 64 + lane], __builtin_popcount(cm0));
      if (cm1) base1 = atomicAdd(&cnt[half1 * 64 + lane], __builtin_popcount(cm1));
    }
    for (int j = 0; j < ntk; ++j) {
      const int myk = ((volatile int*)ksl)[j * 64 + lane];
      if (myk >= 0) { const int ga = ga0 + j, half = ga / c.nph, tl = ga - half * c.nph; const unsigned below = (1u << j) - 1u;
        const int pos = half == half0 ? base0 + __builtin_popcount(cm0 & below) : base1 + __builtin_popcount(cm1 & below);
        list[((size_t)(half * 64 + lane)) * LCAP + pos] = tl * 6 + myk; topw[(size_t)ga * 6 + myk] = ((volatile float*)lgs)[j * 64 + lane]; wsp<int>(p, OFF_TOPP)[(size_t)ga * 6 + myk] = (lane << 24) | pos; }
    }
    __builtin_amdgcn_wave_barrier();
  }
}

DEVI void n_moe_gu(const Params& p, const LCfg c, int half) {
  const bf16_t* act = wsp<bf16_t>(p, OFF_ACT); bf16_t* hid = wsp<bf16_t>(p, OFF_HID);
  const int* cnt = (const int*)(p.ws + OFF_CNT) + c.l * 128 + half * 64; const int* list = wsp<int>(p, OFF_LIST) + (size_t)half * 64 * LCAP;
  int off = 0;
  for (int e = 0; e <= NE; ++e) {
    const int n = e < NE ? cnt[e] : c.nph;
    const bf16_t* w = e < NE ? wsp<bf16_t>(p, OFF_EGU) + (size_t)e * 512 * D : wsp<bf16_t>(p, OFF_SHGU) + (size_t)c.l * 512 * D;
    const int* le = list + (size_t)e * LCAP;
    ngemm((n + 31) / 32, DE / 16, D,
          [&](int r) -> const bf16_t* { if (r >= n) return nullptr; const int tl = e < NE ? le[r] / 6 : r; return act + (size_t)act_tok(c, half, tl) * D; },
          [&](int nn) { const int tn = nn >> 5, i = (nn >> 4) & 1, fr = nn & 15; return w + (size_t)(i * 256 + tn * 16 + fr) * D; },
          [&](int r, int n0, int n1, float v0, float v1) { if (r < n) hid[(size_t)(off + r) * DE + (n0 >> 5) * 16 + (n0 & 15)] = f2bf(silu(v0) * v1); });
    off += n;
  }
}
DEVI void n_moe_down(const Params& p, const LCfg c, int half) {
  const bf16_t* hid = wsp<bf16_t>(p, OFF_HID); bf16_t* slot = wsp<bf16_t>(p, OFF_SLOT);
  const int* cnt = (const int*)(p.ws + OFF_CNT) + c.l * 128 + half * 64; const int* list = wsp<int>(p, OFF_LIST) + (size_t)half * 64 * LCAP;
  int off = 0;
  for (int e = 0; e <= NE; ++e) {
    const int n = e < NE ? cnt[e] : c.nph;
    const bf16_t* w = e < NE ? wsp<bf16_t>(p, OFF_ED) + (size_t)e * D * DE : wsp<bf16_t>(p, OFF_SHD) + (size_t)c.l * D * DE;
    const int* le = list + (size_t)e * LCAP;
    auto st1 = [&](int r, int nn, float v) { if (r >= n) return;
      if (e < NE) slot[(size_t)le[r] * D + nn] = f2bf(v);
      else { const int t = act_tok(c, half, r); float* h = hid_row(p, t); h[nn] += modv(p, c.l, t, 5)[nn] * v; } };
    ngemm((n + 31) / 32, D / 32, DE,
          [&](int r) -> const bf16_t* { return r < n ? hid + (size_t)(off + r) * DE : nullptr; },
          [&](int nn) { return w + (size_t)nn * DE; },
          [&](int r, int n0, int n1, float v0, float v1) { st1(r, n0, v0); st1(r, n1, v1); });
    off += n;
  }
}
template <bool FUSE_NORM1> DEVI void stage_combine(const Params& p, const LCfg c, int half, unsigned char* smem, float dscale = 1.0f) {
  const int wid = ltid() >> 6, lane = ltid() & 63;
  int* off = (int*)smem;
  __syncthreads();
  if (ltid() == 0) { const int* cnt = (const int*)(p.ws + OFF_CNT) + c.l * 128 + half * 64; int o = 0; for (int e = 0; e < NE; ++e) { off[e] = o; o += cnt[e]; } off[NE] = o; }
  __syncthreads();
  const unsigned char* slot = p.ws + OFF_SLOT; const float* topw = wsp<float>(p, OFF_TOPW); const int* topp = wsp<int>(p, OFF_TOPP);
  for (int tl = blockIdx.x * 8 + wid; tl < c.nph; tl += gridDim.x * 8) {
    const int t = act_tok(c, half, tl); bf16_t* h = wsp<bf16_t>(p, OFF_HB) + (size_t)t * D; const float* g5 = modv(p, c.l, t, 5);
    float* orow = p.out + ((size_t)((t / SB) * S + (t % SB) - NC)) * D;
    const float* w = topw + ((size_t)(half * c.nph + tl)) * 6; const int* pp = topp + ((size_t)(half * c.nph + tl)) * 6;
    float wk[7]; size_t ro[7];
#pragma unroll
    for (int k = 0; k < 6; ++k) { wk[k] = w[k]; const int q = pp[k]; ro[k] = (size_t)(off[q >> 24] + (q & 0xffffff)) * D; }
    wk[6] = 1.0f; ro[6] = (size_t)(off[NE] + tl) * D;
    unsigned sv[4][7]; f32x4 hv[4];
#pragma unroll
    for (int i = 0; i < 4; ++i) { const int cc = (i * 64 + lane) * 4; hv[i] = bf4(*(const u32x2*)(h + cc));
#pragma unroll
      for (int k = 0; k < 7; ++k) sv[i][k] = *(const unsigned*)(slot + ro[k] + cc); }
#pragma unroll
    for (int i = 0; i < 4; ++i) { const int cc = (i * 64 + lane) * 4; f32x4 acc = {0.f, 0.f, 0.f, 0.f};
#pragma unroll
      for (int k = 0; k < 7; ++k) { const auto lo = __builtin_amdgcn_cvt_pk_f32_fp8((int)sv[i][k], false); const auto hi = __builtin_amdgcn_cvt_pk_f32_fp8((int)sv[i][k], true);
        acc[0] += wk[k] * lo[0]; acc[1] += wk[k] * lo[1]; acc[2] += wk[k] * hi[0]; acc[3] += wk[k] * hi[1]; }
      const f32x4 gg = *(const f32x4*)(g5 + cc);
#pragma unroll
      for (int q = 0; q < 4; ++q) hv[i][q] += gg[q] * acc[q] * dscale;
      if (FUSE_NORM1) { u32x2 w; w.x = pack2(hv[i][0], hv[i][1]); w.y = pack2(hv[i][2], hv[i][3]); *(u32x2*)(h + cc) = w; }
      else *(f32x4*)(orow + cc) = hv[i]; }
    if (FUSE_NORM1) {
      float ss = 0.f;
#pragma unroll
      for (int i = 0; i < 4; ++i) ss += hv[i][0] * hv[i][0] + hv[i][1] * hv[i][1] + hv[i][2] * hv[i][2] + hv[i][3] * hv[i][3];
      const float rstd = rsqrtf(wsum_dpp(ss) * (1.0f / D) + EPS);
      const float* g1 = sm(p, SM_N1G + (c.l + 1) * D); const float* sh = modv(p, c.l + 1, t, 0); const float* sc = modv(p, c.l + 1, t, 1);
      bf16_t* act = wsp<bf16_t>(p, OFF_ACT);
#pragma unroll
      for (int i = 0; i < 4; ++i) { const int cc = (i * 64 + lane) * 4; const f32x4 gg = *(const f32x4*)(g1 + cc), s1 = *(const f32x4*)(sc + cc), s0 = *(const f32x4*)(sh + cc);
        float y[4];
#pragma unroll
        for (int q = 0; q < 4; ++q) y[q] = hv[i][q] * rstd * gg[q] * (1.0f + s1[q]) + s0[q];
        if (IN1_FP8) { const float xs = (float)(1 << X_SHIFT); int w8 = 0;
          w8 = __builtin_amdgcn_cvt_pk_fp8_f32(__builtin_amdgcn_fmed3f(y[0] * xs, -440.f, 440.f), __builtin_amdgcn_fmed3f(y[1] * xs, -440.f, 440.f), w8, false);
          w8 = __builtin_amdgcn_cvt_pk_fp8_f32(__builtin_amdgcn_fmed3f(y[2] * xs, -440.f, 440.f), __builtin_amdgcn_fmed3f(y[3] * xs, -440.f, 440.f), w8, true);
          *(int*)(p.ws + OFF_ACT8 + (size_t)t * D + cc) = w8; }
        else { u32x2 w; w.x = pack2(y[0], y[1]); w.y = pack2(y[2], y[3]);
          *(u32x2*)(act + (size_t)t * D + cc) = w; } }
    }
  }
}

DEVI void n_inproj1(const Params& p) {
  const bf16_t* act = wsp<bf16_t>(p, OFF_ACT); const bf16_t* w = wsp<bf16_t>(p, OFF_WQKV1T); bf16_t* proj = wsp<bf16_t>(p, OFF_PROJ);
  ngemm(T / 32, ODD_IN / 32, D, [&](int r) { return act + (size_t)r * D; }, [&](int n) { return w + (size_t)n * D; },
        [&](int r, int n0, int n1, float v0, float v1) { proj[(size_t)r * ODD_IN + n0] = f2bf(v0); proj[(size_t)r * ODD_IN + n1] = f2bf(v1); });
}
DEVI void n_post1(const Params& p) {
  const int wid = ltid() >> 6, lane = ltid() & 63;
  bf16_t* proj = wsp<bf16_t>(p, OFF_PROJ); const float2* t128 = wsp<float2>(p, OFF_TAB128);
  for (int t = blockIdx.x * 8 + wid; t < T; t += gridDim.x * 8) {
    bf16_t* row = proj + (size_t)t * ODD_IN; const int b = t / SB, j = t - b * SB;
    for (int hh = 0; hh < 10; ++hh) {
      unsigned* pp = (unsigned*)(row + hh * 128 + 2 * lane); const unsigned u = *pp;
      float x1 = __uint_as_float(u << 16), x2 = __uint_as_float(u & 0xffff0000u);
      const float ss = wsum(x1 * x1 + x2 * x2); const float r = rsqrtf(ss * (1.0f / 128) + EPS);
      const float* g = sm(p, hh < 8 ? SM_CQN : SM_CKN);
      x1 = x1 * r * g[2 * lane]; x2 = x2 * r * g[2 * lane + 1];
      if (j >= NC) { const int pos = j - NC; const int ps = lane < 32 ? (pos >> 6) : (pos & 63); const float2 cs = t128[ps * 32 + (lane & 31)];
        const float y1 = x1 * cs.x - x2 * cs.y, y2 = x1 * cs.y + x2 * cs.x; x1 = y1; x2 = y2; }
      *pp = pack2(x1, x2);
    }
  }
}
DEVI void n_attn1(const Params& p, unsigned char* smem) {
  const int wid = ltid() >> 6, lane = ltid() & 63;
  volatile float* sc = (volatile float*)(smem + wid * (2304 * 4 + 512)); volatile float* qs = sc + 2304;
  const bf16_t* proj = wsp<bf16_t>(p, OFF_PROJ); bf16_t* att = wsp<bf16_t>(p, OFF_ACT);
  for (int task = blockIdx.x * 8 + wid; task < TX * 8; task += gridDim.x * 8) {
    const int tx = task >> 3, h = task & 7, b = tx / S, i = tx - b * S, t = b * SB + NC + i, kvh = h >> 2;
    const bf16_t* kbase = proj + (size_t)(b * SB) * ODD_IN + 1024 + kvh * 128; const bf16_t* vbase = kbase + 256;
    float o0, o1;
    attn_row(proj + (size_t)t * ODD_IN + h * 128, 128, kbase, ODD_IN, vbase, ODD_IN, SB, 0.08838834764831845f, sc, qs, o0, o1);
    *(unsigned*)(att + (size_t)t * D + h * 128 + 2 * lane) = pack2(o0, o1);
  }
}

namespace fg {
constexpr int BM = 256, BK = 64, HALF = 128, HTB = HALF * BK * 2, STAGE_BYTES = 8 * HTB;
constexpr int LDS_XCH = STAGE_BYTES, LDS_TAB = STAGE_BYTES + 4096, LDS_ROPE = STAGE_BYTES + 6144, LDS_GAIN = LDS_ROPE + 16384;
DEVI int lds_byte(int r, int c) { const int st = (r >> 4) * 2 + (c >> 5), rr = r & 15, cc = c & 31, ob = rr * 64 + cc * 2; return st * 1024 + (ob ^ (((ob >> 9) & 1) << 5)); }
DEVI void stage_rc(int b, int& R, int& C) { const int st = b / 1024, sb = b % 1024, swz = sb ^ (((sb >> 9) & 1) << 5); R = (st >> 1) * 16 + swz / 64; C = (st & 1) * 32 + (swz % 64) / 2; }
DEVI int perm32(int rho) { const int n = rho >> 4, i = rho & 15; return 8 * (i >> 2) + 4 * n + (i & 3); }
DEVI unsigned cvt_pk_bf16(float lo, float hi) { unsigned r; asm volatile("v_cvt_pk_bf16_f32 %0, %1, %2" : "=v"(r) : "v"(lo), "v"(hi)); return r; }
typedef float f32x2 __attribute__((ext_vector_type(2)));
DEVI f32x2 gelu_pk(f32x2 v) {
  const f32x2 av = __builtin_elementwise_abs(v), d = av * 0.2316418882f + 1.0f;
  f32x2 t; t.x = __builtin_amdgcn_rcpf(d.x); t.y = __builtin_amdgcn_rcpf(d.y);
  f32x2 q = t * 0.5307027145f + (-0.7265760135f); q = q * t + 0.7107068705f; q = q * t + (-0.142248368f); q = q * t + 0.127414796f; q = q * t;
  const f32x2 s = (v * v) * (-0.72134752044f);
  f32x2 e; e.x = __builtin_amdgcn_exp2f(s.x); e.y = __builtin_amdgcn_exp2f(s.y);
  const f32x2 m = v * (q * e), r = v - m;
  f32x2 o; o.x = v.x < 0.f ? m.x : r.x; o.y = v.y < 0.f ? m.y : r.y; return o;
}
struct Unit { const char* A; const char* B0; const char* B1; int pm, pn, e, cnt, off; };
typedef f32x4 Acc[2][2][4][2];
typedef int v8i_t __attribute__((ext_vector_type(8)));
template <int K> DEVI unsigned boff_m1(int R, int C) { return (unsigned)((64 * (R >> 5) + perm32(R & 31)) * K + C) * 2u; }
template <int K> DEVI unsigned boff_m2(int R, int C) { return (unsigned)(((R & ~31) + perm32(R & 31)) * K + C) * 2u; }

template <class Job>
DEVI void gemm_phase(LAS unsigned char* lds, Job& J) {
  constexpr int K = Job::K, nt = K / BK;
  const int tid = ltid(), wid = __builtin_amdgcn_readfirstlane(tid >> 6), lane = tid & 63, wr = wid >> 2, wc = wid & 3, fr = lane & 15, fq = lane >> 4;
  int Rr[2], Cc[2];
#pragma unroll
  for (int i = 0; i < 2; ++i) stage_rc(tid * 16 + i * 8192, Rr[i], Cc[i]);
  unsigned voffB[2];
#pragma unroll
  for (int i = 0; i < 2; ++i) voffB[i] = J.boff(Rr[i], Cc[i]);
  unsigned cv[2][2]; unsigned nv[2][2];
  constexpr size_t AH = Job::GATHER ? 0 : (size_t)HALF * K * 2;
#define CV1 cv[Job::GATHER ? 1 : 0]
  constexpr size_t kstep = (size_t)(BK * 2);
  const unsigned ldsw = (unsigned)wid * 1024u;
  const int aoff = lds_byte(wr * 64 + fr, fq * 8), boff = lds_byte(wc * 32 + fr, fq * 8);
  LAS unsigned char* abase = lds + aoff; LAS unsigned char* bbase = lds + 4 * HTB + boff;
  asm volatile("" : "+v"(abase), "+v"(bbase));
#define FG_SA(b, h) (((b) * 2 + (h)) * HTB)
#define FG_SB(b, h) ((4 + (b) * 2 + (h)) * HTB)
#define FG_STAGE(bufoff, gbase, voff) do { _Pragma("unroll") for (int _i = 0; _i < 2; ++_i) { \
    const unsigned _la = (unsigned)(uintptr_t)(lds + ldsw) + (unsigned)((bufoff) + _i * 8192); const char* _gb = (const char*)(gbase); \
    asm volatile("s_mov_b32 m0, %0\n\ts_nop 0\n\tglobal_load_lds_dwordx4 %1, %2" :: "s"(_la), "v"((voff)[_i]), "s"(_gb) : "memory", "m0"); } } while (0)
#define FG_LDA(dst, b, h) do { _Pragma("unroll") for (int m = 0; m < 4; ++m) _Pragma("unroll") for (int k = 0; k < 2; ++k) dst[m][k] = *(const LAS bf16x8*)(abase + (FG_SA(b, h) + m * 2048 + k * 1024)); } while (0)
#define FG_LDB(dst, b, h) do { _Pragma("unroll") for (int n = 0; n < 2; ++n) _Pragma("unroll") for (int k = 0; k < 2; ++k) dst[n][k] = *(const LAS bf16x8*)(bbase + (FG_SB(b, h) - 4 * HTB + n * 2048 + k * 1024)); } while (0)
#define FG_MMA(ai, bj, At, Bt) do { __builtin_amdgcn_s_setprio(1); _Pragma("unroll") for (int m = 0; m < 4; ++m) _Pragma("unroll") for (int n = 0; n < 2; ++n) _Pragma("unroll") for (int k = 0; k < 2; ++k) \
    acc[ai][bj][m][n] = __builtin_amdgcn_mfma_f32_16x16x32_bf16(Bt[n][k], At[m][k], acc[ai][bj][m][n], 0, 0, 0); __builtin_amdgcn_s_setprio(0); } while (0)
#define FG_MMA8(ai, bj, At, Bt) do { __builtin_amdgcn_s_setprio(1); _Pragma("unroll") for (int m = 0; m < 4; ++m) _Pragma("unroll") for (int n = 0; n < 2; ++n) { \
      v8i_t _b, _a; { const u32x4 b0 = *(const u32x4*)&Bt[n][0], b1 = *(const u32x4*)&Bt[n][1], a0 = *(const u32x4*)&At[m][0], a1 = *(const u32x4*)&At[m][1]; \
        _b = (v8i_t){(int)b0[0], (int)b0[1], (int)b0[2], (int)b0[3], (int)b1[0], (int)b1[1], (int)b1[2], (int)b1[3]}; _a = (v8i_t){(int)a0[0], (int)a0[1], (int)a0[2], (int)a0[3], (int)a1[0], (int)a1[1], (int)a1[2], (int)a1[3]}; } \
      acc[ai][bj][m][n] = __builtin_amdgcn_mfma_scale_f32_16x16x128_f8f6f4(_b, _a, acc[ai][bj][m][n], 0, 0, 0, Job::SCALE, 0, Job::SCALE); } __builtin_amdgcn_s_setprio(0); } while (0)
#define FG_WAIT_V(n) asm volatile("s_waitcnt vmcnt(" #n ")" ::: "memory")
#define FG_WAIT_L(n) asm volatile("s_waitcnt lgkmcnt(" #n ")" ::: "memory")
#define FG_MM(ai, bj, At, Bt) do { if constexpr (Job::FP8) FG_MMA8(ai, bj, At, Bt); else FG_MMA(ai, bj, At, Bt); } while (0)
#define FG_BAR __builtin_amdgcn_s_barrier()
#define FG_SCHED __builtin_amdgcn_sched_barrier(0)
  Unit cur, nxt;
  if (!J.next(cur)) return;
  Acc acc;
#pragma unroll
  for (int a = 0; a < 2; ++a)
#pragma unroll
    for (int b = 0; b < 2; ++b)
#pragma unroll
      for (int m = 0; m < 4; ++m)
#pragma unroll
        for (int n = 0; n < 2; ++n) acc[a][b][m][n] = (f32x4){0.f, 0.f, 0.f, 0.f};
  bf16x8 At[4][2], B0[2][2], B1[2][2];
  J.aoffs(cur, Rr, Cc, cv);
  asm volatile("s_waitcnt vmcnt(0)" ::: "memory");
  FG_STAGE(FG_SB(0, 0), cur.B0, voffB); FG_STAGE(FG_SA(0, 0), cur.A, cv[0]); FG_STAGE(FG_SB(0, 1), cur.B1, voffB); FG_STAGE(FG_SA(0, 1), cur.A + AH, CV1);
  if (wr == 1) FG_BAR;
  FG_WAIT_V(4); FG_BAR;
  FG_STAGE(FG_SB(1, 0), cur.B0 + kstep, voffB); FG_STAGE(FG_SA(1, 0), cur.A + kstep, cv[0]); FG_STAGE(FG_SB(1, 1), cur.B1 + kstep, voffB);
  FG_WAIT_V(6); FG_BAR;
  for (;;) {
    const bool has_next = J.next(nxt);
    const char* nA = has_next ? nxt.A : cur.A; const char* nB0 = has_next ? nxt.B0 : cur.B0; const char* nB1 = has_next ? nxt.B1 : cur.B1;
    for (int t = 0; t < nt; t += 2) {
      const bool last = (t == nt - 2);
      const char* a1 = cur.A + (size_t)(t + 1) * kstep;
      const char* a2 = last ? nA : cur.A + (size_t)(t + 2) * kstep;
      const char* b20 = last ? nB0 : cur.B0 + (size_t)(t + 2) * kstep; const char* b21 = last ? nB1 : cur.B1 + (size_t)(t + 2) * kstep;
      const char* a3 = a2 + kstep; const char* b30 = b20 + kstep; const char* b31 = b21 + kstep;
      asm volatile("" : "+s"(a1), "+s"(a2), "+s"(a3), "+s"(b20), "+s"(b21), "+s"(b30), "+s"(b31));
      if constexpr (Job::GATHER) { if (last && has_next) { J.aoffs(nxt, Rr, Cc, nv); asm volatile("s_waitcnt vmcnt(0)" ::: "memory"); } }
      FG_LDB(B0, 0, 0); FG_SCHED; FG_LDA(At, 0, 0); FG_STAGE(FG_SA(1, 1), a1 + AH, CV1);
      if constexpr (Job::GATHER) { if (last && has_next) { cv[0][0] = nv[0][0]; cv[0][1] = nv[0][1]; cv[1][0] = nv[1][0]; cv[1][1] = nv[1][1]; } }
      FG_WAIT_L(8); FG_BAR; FG_WAIT_L(0); FG_MM(0, 0, At, B0); FG_BAR; FG_SCHED;
      FG_LDB(B1, 0, 1); FG_STAGE(FG_SB(0, 0), b20, voffB);
      FG_BAR; FG_WAIT_L(0); FG_MM(0, 1, At, B1); FG_BAR;
      FG_LDA(At, 0, 1); FG_STAGE(FG_SA(0, 0), a2, cv[0]);
      FG_BAR; FG_WAIT_L(0); FG_MM(1, 0, At, B0); FG_BAR; FG_SCHED;
      FG_STAGE(FG_SB(0, 1), b21, voffB);
      FG_WAIT_V(6); FG_BAR; FG_MM(1, 1, At, B1); FG_BAR;
      FG_LDB(B0, 1, 0); FG_SCHED; FG_LDA(At, 1, 0); FG_STAGE(FG_SA(0, 1), a2 + AH, CV1);
      FG_WAIT_L(8); FG_BAR; FG_WAIT_L(0); FG_MM(0, 0, At, B0); FG_BAR; FG_SCHED;
      FG_LDB(B1, 1, 1); FG_STAGE(FG_SB(1, 0), b30, voffB);
      FG_BAR; FG_WAIT_L(0); FG_MM(0, 1, At, B1); FG_BAR;
      FG_LDA(At, 1, 1); FG_STAGE(FG_SA(1, 0), a3, cv[0]);
      FG_BAR; FG_WAIT_L(0); FG_MM(1, 0, At, B0); FG_BAR; FG_SCHED;
      FG_STAGE(FG_SB(1, 1), b31, voffB);
      FG_WAIT_V(6); FG_BAR; FG_MM(1, 1, At, B1); FG_BAR;
    }
    if (wr == 0) FG_BAR;
    { int l2; asm volatile("v_mbcnt_lo_u32_b32 %0, -1, 0\n\tv_mbcnt_hi_u32_b32 %0, -1, %0" : "=v"(l2));
      J.epilogue(acc, cur, wr, wc, l2 & 15, l2 >> 4, lds); }
    if (!has_next) break;
#pragma unroll
    for (int a = 0; a < 2; ++a)
#pragma unroll
      for (int b = 0; b < 2; ++b)
#pragma unroll
        for (int m = 0; m < 4; ++m)
#pragma unroll
          for (int n = 0; n < 2; ++n) acc[a][b][m][n] = (f32x4){0.f, 0.f, 0.f, 0.f};
    cur = nxt;
    if (wr == 1) FG_BAR;
  }
  FG_WAIT_V(0);
  FG_BAR;
#undef CV1
#undef FG_SA
#undef FG_SB
#undef FG_STAGE
#undef FG_LDA
#undef FG_LDB
#undef FG_MMA
#undef FG_MMA8
#undef FG_MM
#undef FG_WAIT_V
#undef FG_WAIT_L
#undef FG_BAR
#undef FG_SCHED
}

DEVI bool dense_decode(long L, int nM, int nN, int& pm, int& pn) {
  const int nwg = nM * nN; if (L >= nwg) return false;
  int wgid = (int)L; { const int q = nwg / 8, r = nwg % 8, xcd = wgid % 8, off = wgid / 8; wgid = (xcd < r ? xcd * (q + 1) : r * (q + 1) + (xcd - r) * q) + off; }
  const int nig = 8 * nN, gid = wgid / nig, fm = gid * 8, gsz = (nM - fm) < 8 ? (nM - fm) : 8;
  pm = fm + ((wgid % nig) % gsz); pn = (wgid % nig) / gsz; return true;
}
template <int K> DEVI void dense_aoffs(const int (&Rr)[2], const int (&Cc)[2], unsigned (&v)[2][2]) {
#pragma unroll
  for (int i = 0; i < 2; ++i) { v[0][i] = (unsigned)(Rr[i] * K + Cc[i]) * 2u; v[1][i] = 0u; }
}


struct Slab { LAS unsigned char* w0; LAS unsigned char* wf; LAS unsigned char* r0; };
DEVI Slab slab_init(LAS unsigned char* lds, int wid, int fr, int fq) {
  Slab s; LAS unsigned char* b = lds + 3 * HTB + wid * 1024;
  s.w0 = b + fr * 64 + fq * 16; s.wf = b + (fq >> 1) * 8192 + fr * 64 + (fq & 1) * 32; s.r0 = b + (fq * 16 + fr) * 16; return s; }
DEVI void slab_x16(const Slab& s, u32x4 a, u32x4 b, u32x4& ra, u32x4& rb) { *(LAS u32x4*)s.w0 = a; *(LAS u32x4*)(s.w0 + 8192) = b; ra = *(LAS u32x4*)s.r0; rb = *(LAS u32x4*)(s.r0 + 8192); }
DEVI void slab_x16(const Slab& s, u32x4 a, u32x4& ra) { *(LAS u32x4*)s.w0 = a; ra = *(LAS u32x4*)s.r0; }
DEVI void slab_x32(const Slab& s, f32x4 a, f32x4 b, f32x4& ra, f32x4& rb) { *(LAS f32x4*)s.wf = a; *(LAS f32x4*)(s.wf + 16) = b; ra = *(LAS f32x4*)s.r0; rb = *(LAS f32x4*)(s.r0 + 8192); }

template <int LAYER> struct JobOut {
  static constexpr bool FP8 = LAYER == 0 ? OUT0_FP8 : OUT1_FP8;
  static constexpr int K = FP8 ? D / 2 : D; static constexpr bool GATHER = false;
  static constexpr int SCALE = 0x01010101 * (127 - (WQ_SHIFT + A_SHIFT) / 2); static_assert((WQ_SHIFT + A_SHIFT) % 2 == 0, "");
  const Params& p; int i, c, G;
  DEVI JobOut(const Params& p_) : p(p_), i(0), c(vbid()), G(gridDim.x) {}
  DEVI unsigned boff(int R, int C) const { return boff_m2<K>(R, C); }
  DEVI bool next(Unit& u) {
    for (;;) { int pm, pn; if (!dense_decode((long)i * G + c, T / 256, D / 256, pm, pn)) return false; ++i;
      if (LAYER == 1 && pm % 9 == 0) continue;
      u.pm = pm; u.pn = pn; u.A = (const char*)(p.ws + (FP8 ? OFF_ACT8 : OFF_ACT)) + (size_t)pm * 256 * K * 2;
      u.B0 = (const char*)wsp<bf16_t>(p, LAYER == 0 ? OFF_WOUT0T : OFF_WOUT1T) + (size_t)(256 * pn) * K * 2; u.B1 = u.B0 + (size_t)128 * K * 2; return true; }
  }
  DEVI void aoffs(const Unit&, const int (&Rr)[2], const int (&Cc)[2], unsigned (&v)[2][2]) const { dense_aoffs<K>(Rr, Cc, v); }
  DEVI void epilogue(const Acc& acc, const Unit& u, int wr, int wc, int fr, int fq, LAS unsigned char* lds) const {
    asm volatile("" : "+v"(fr), "+v"(fq));
    const int t0 = u.pm * 256;
    const float* res = in_row(p, t0); bf16_t* dst = wsp<bf16_t>(p, OFF_HB) + (size_t)t0 * D;
    const float* gate = modv(p, LAYER, t0, 2);
    const int col0 = u.pn * 256 + wc * 32 + 8 * fq, lane = fq * 16 + fr;
    const Slab sl = slab_init(lds, wr * 4 + wc, fr, fq);
    const size_t rb = (size_t)(wr * 64 + (lane >> 2)) * D + u.pn * 256 + wc * 32 + 4 * (lane & 3);
    res += rb; dst += rb;
    asm volatile("" : "+v"(res), "+v"(dst));
    f32x4 gv[2][2];
#pragma unroll
    for (int bj = 0; bj < 2; ++bj)
#pragma unroll
      for (int n = 0; n < 2; ++n) gv[bj][n] = *(const f32x4*)(gate + col0 + bj * 128 + 4 * n);
#pragma unroll
    for (int ai = 0; ai < 2; ++ai) {
      f32x4 r4[4][2][2];
#pragma unroll
      for (int m = 0; m < 4; ++m) { const size_t ro = (size_t)(ai * 128 + m * 16) * D;
#pragma unroll
        for (int bj = 0; bj < 2; ++bj) {
          if (LAYER == 0) { r4[m][bj][0] = *(const f32x4*)(res + ro + bj * 128); r4[m][bj][1] = *(const f32x4*)(res + ro + bj * 128 + 16); }
          else { r4[m][bj][0] = bf4(*(const u32x2*)(dst + ro + bj * 128)); r4[m][bj][1] = bf4(*(const u32x2*)(dst + ro + bj * 128 + 16)); } } }
#pragma unroll
      for (int m = 0; m < 4; ++m) { const size_t ro = (size_t)(ai * 128 + m * 16) * D;
#pragma unroll
        for (int bj = 0; bj < 2; ++bj) { f32x4 x0, x1; slab_x32(sl, gv[bj][0] * acc[ai][bj][m][0], gv[bj][1] * acc[ai][bj][m][1], x0, x1);
          x0 += r4[m][bj][0]; x1 += r4[m][bj][1];
          u32x2 w0, w1; w0.x = pack2(x0[0], x0[1]); w0.y = pack2(x0[2], x0[3]); w1.x = pack2(x1[0], x1[1]); w1.y = pack2(x1[2], x1[3]);
          *(u32x2*)(dst + ro + bj * 128) = w0; *(u32x2*)(dst + ro + bj * 128 + 16) = w1; } }
      asm volatile("" ::: "memory"); }
  }
};

DEVI void load_rope_lds(const Params& p, size_t tab_off, int nrope, int gq, int gk, int ng, LAS unsigned char* lds) {
  const int tid = ltid(); __syncthreads();
  const f32x4* src = (const f32x4*)(p.ws + tab_off); LAS f32x4* dst = (LAS f32x4*)(lds + LDS_ROPE);
  for (int i = tid; i < nrope; i += 512) dst[i] = src[i];
  LAS float* g = (LAS float*)(lds + LDS_GAIN);
  if (tid < 2 * ng) g[tid] = tid < ng ? sm(p, gq)[tid] : sm(p, gk)[tid - ng];
  __syncthreads();
}
struct JobIn0 {
  static constexpr int K = IN0_FP8 ? D / 2 : D; static constexpr bool GATHER = false, FP8 = IN0_FP8;
  static constexpr int SCALE = 0x01010101 * (127 - (WQ_SHIFT + X_SHIFT) / 2);
  const Params& p; int i, c, G; int dry;
  DEVI JobIn0(const Params& p_, int dry_ = 0) : p(p_), i(0), c(vbid()), G(gridDim.x), dry(dry_) {}
  DEVI unsigned boff(int R, int C) const { return boff_m1<K>(R, C); }
  DEVI bool next(Unit& u) {
    int pm, pn; if (!dense_decode((long)i * G + c, T / 256, EVEN_IN / 256, pm, pn)) return false; ++i;
    u.pm = pm; u.pn = pn; u.A = (const char*)(p.ws + (IN0_FP8 ? OFF_ACT8 : OFF_ACT)) + (size_t)pm * 256 * K * 2;
    u.B0 = (const char*)wsp<bf16_t>(p, OFF_WIN0T) + (size_t)(256 * pn) * K * 2; u.B1 = u.B0 + (size_t)32 * K * 2; return true;
  }
  DEVI void aoffs(const Unit&, const int (&Rr)[2], const int (&Cc)[2], unsigned (&v)[2][2]) const { dense_aoffs<K>(Rr, Cc, v); }
  DEVI void epilogue(const Acc& acc, const Unit& u, int wr, int wc, int fr, int fq, LAS unsigned char* lds) const {
    asm volatile("" : "+v"(fr), "+v"(fq));
    if (dry == 1) {
#pragma unroll
      for (int ai = 0; ai < 2; ++ai)
#pragma unroll
        for (int bj = 0; bj < 2; ++bj)
#pragma unroll
          for (int m = 0; m < 4; ++m)
#pragma unroll
            for (int n = 0; n < 2; ++n) asm volatile("" :: "v"(acc[ai][bj][m][n]));
      return; }
    const int lane = fq * 16 + fr; const Slab sl = slab_init(lds, wr * 4 + wc, fr, fq);
    bf16_t* outp = wsp<bf16_t>(p, OFF_PROJ) + (size_t)(u.pm * 256 + wr * 64 + (lane >> 2)) * EVEN_IN + u.pn * 256 + wc * 64 + 8 * (lane & 3);
    asm volatile("" : "+v"(outp));
    const int pn = u.pn;
    if (pn < 4) {
#pragma unroll
      for (int ai = 0; ai < 2; ++ai)
#pragma unroll
        for (int m = 0; m < 4; ++m) {
          u32x4 wq[2];
#pragma unroll
          for (int bj = 0; bj < 2; ++bj) { const f32x4 v0 = acc[ai][bj][m][0], v1 = acc[ai][bj][m][1];
            const f32x2 a = gelu_pk((f32x2){v0[0], v0[1]}), b = gelu_pk((f32x2){v0[2], v0[3]}), c2 = gelu_pk((f32x2){v1[0], v1[1]}), d = gelu_pk((f32x2){v1[2], v1[3]});
            u32x4 w; w.x = cvt_pk_bf16(a.x, a.y); w.y = cvt_pk_bf16(b.x, b.y); w.z = cvt_pk_bf16(c2.x, c2.y); w.w = cvt_pk_bf16(d.x, d.y);
            wq[bj] = w; }
          { u32x4 ra, rb; slab_x16(sl, wq[0], wq[1], ra, rb); *(u32x4*)(outp + (size_t)(ai * 128 + m * 16) * EVEN_IN) = ra; *(u32x4*)(outp + (size_t)(ai * 128 + m * 16) * EVEN_IN + 32) = rb; } }
    } else if (pn >= 8) {
#pragma unroll
      for (int ai = 0; ai < 2; ++ai)
#pragma unroll
        for (int m = 0; m < 4; ++m) {
          u32x4 wq[2];
#pragma unroll
          for (int bj = 0; bj < 2; ++bj) { const f32x4 v0 = acc[ai][bj][m][0], v1 = acc[ai][bj][m][1];
            u32x4 w; w.x = cvt_pk_bf16(v0[0], v0[1]); w.y = cvt_pk_bf16(v0[2], v0[3]); w.z = cvt_pk_bf16(v1[0], v1[1]); w.w = cvt_pk_bf16(v1[2], v1[3]);
            wq[bj] = w; }
          { u32x4 ra, rb; slab_x16(sl, wq[0], wq[1], ra, rb); *(u32x4*)(outp + (size_t)(ai * 128 + m * 16) * EVEN_IN) = ra; *(u32x4*)(outp + (size_t)(ai * 128 + m * 16) * EVEN_IN + 32) = rb; } }
    } else {
      LAS const float* gn = (LAS const float*)(lds + LDS_GAIN) + (pn < 6 ? 0 : 64) + 8 * fq;
      f32x4 g4[2][2];
#pragma unroll
      for (int bj = 0; bj < 2; ++bj)
#pragma unroll
        for (int n = 0; n < 2; ++n) g4[bj][n] = *(LAS const f32x4*)(gn + bj * 32 + 4 * n);
      const int jt = u.pm % 9; const bool lat = jt != 0;
      LAS const f32x4* t64 = (LAS const f32x4*)(lds + LDS_ROPE);
#pragma unroll
      for (int ai = 0; ai < 2; ++ai)
#pragma unroll
        for (int m = 0; m < 4; ++m) {
          f32x4 cs[2][2];
          if (lat) { const int il = (jt - 1) * 256 + ai * 128 + wr * 64 + m * 16 + fr; const int prow = il >> 6, pcol = il & 63;
#pragma unroll
            for (int bj = 0; bj < 2; ++bj)
#pragma unroll
              for (int n = 0; n < 2; ++n) cs[bj][n] = t64[(bj ? pcol : prow) * 8 + 2 * fq + n]; }
          float ss = 0.f;
#pragma unroll
          for (int bj = 0; bj < 2; ++bj)
#pragma unroll
            for (int n = 0; n < 2; ++n) { const f32x4 x = acc[ai][bj][m][n]; ss += (x[0] * x[0] + x[1] * x[1]) + (x[2] * x[2] + x[3] * x[3]); }
          ss += shx<16>(ss); ss = sum32x(ss);
          const float rstd = rsqrtf(ss * (1.0f / 64) + EPS);
          u32x4 wq[2];
#pragma unroll
          for (int bj = 0; bj < 2; ++bj) { f32x4 y[2];
#pragma unroll
            for (int n = 0; n < 2; ++n) { f32x4 x = acc[ai][bj][m][n] * rstd * g4[bj][n];
              if (lat) { const f32x4 c4 = cs[bj][n]; x = (f32x4){x[0] * c4[0] - x[1] * c4[1], x[0] * c4[1] + x[1] * c4[0], x[2] * c4[2] - x[3] * c4[3], x[2] * c4[3] + x[3] * c4[2]}; }
              y[n] = x; }
            u32x4 w; w.x = cvt_pk_bf16(y[0][0], y[0][1]); w.y = cvt_pk_bf16(y[0][2], y[0][3]); w.z = cvt_pk_bf16(y[1][0], y[1][1]); w.w = cvt_pk_bf16(y[1][2], y[1][3]);
            wq[bj] = w; }
          { u32x4 ra, rb; slab_x16(sl, wq[0], wq[1], ra, rb); *(u32x4*)(outp + (size_t)(ai * 128 + m * 16) * EVEN_IN) = ra; *(u32x4*)(outp + (size_t)(ai * 128 + m * 16) * EVEN_IN + 32) = rb; }
          asm volatile("" ::: "memory");
        }
    }
  }
};

struct JobIn1 {
  static constexpr int K = IN1_FP8 ? D / 2 : D; static constexpr bool GATHER = false, FP8 = IN1_FP8;
  static constexpr int SCALE = 0x01010101 * (127 - (WQ_SHIFT + X_SHIFT) / 2); static_assert((WQ_SHIFT + X_SHIFT) % 2 == 0, "");
  const Params& p; int i, c, G;
  DEVI JobIn1(const Params& p_) : p(p_), i(0), c(vbid()), G(gridDim.x) {}
  DEVI unsigned boff(int R, int C) const { return boff_m1<K>(R, C); }
  DEVI bool next(Unit& u) {
    for (;;) { int pm, pn; if (!dense_decode((long)i * G + c, T / 256, ODD_IN / 256, pm, pn)) return false; ++i;
      if (pm % 9 == 0 && pn < 4) continue;
      u.pm = pm; u.pn = pn; u.A = (const char*)(p.ws + (IN1_FP8 ? OFF_ACT8 : OFF_ACT)) + (size_t)pm * 256 * K * 2;
      u.B0 = (const char*)wsp<bf16_t>(p, OFF_WQKV1T) + (size_t)(256 * pn) * K * 2; u.B1 = u.B0 + (size_t)32 * K * 2; return true; }
  }
  DEVI void aoffs(const Unit&, const int (&Rr)[2], const int (&Cc)[2], unsigned (&v)[2][2]) const { dense_aoffs<K>(Rr, Cc, v); }
  DEVI void epilogue(const Acc& acc, const Unit& u, int wr, int wc, int fr, int fq, LAS unsigned char* lds) const {
    asm volatile("" : "+v"(fr), "+v"(fq));
    const int lane = fq * 16 + fr; const Slab sl = slab_init(lds, wr * 4 + wc, fr, fq);
    int ooff = (u.pm * 256 + wr * 64 + (lane >> 2)) * ODD_IN + u.pn * 256 + wc * 64 + 8 * (lane & 3);
    asm volatile("" : "+v"(ooff));
    bf16_t* outp = wsp<bf16_t>(p, OFF_PROJ) + ooff;
    asm volatile("" : "+v"(outp));
    const int pn = u.pn;
    if (pn == 5 && ATT1_PV8) {
      LAS unsigned char* sb = lds + 3 * HTB + (wr * 4 + wc) * 1024;
      const int bb = u.pm / 9, kvh = wc >> 1; const float vs = (float)(1 << VS_SHIFT);
      unsigned char* vt = p.ws + OFF_VT8 + ((size_t)((bb * 2 + kvh) * 128 + (wc & 1) * 64 + lane)) * SB + (size_t)((u.pm % 9) * 4 + wr) * 64;
      asm volatile("" : "+v"(vt));
#pragma unroll
      for (int ai = 0; ai < 2; ++ai)
#pragma unroll
        for (int m = 0; m < 4; ++m) {
#pragma unroll
          for (int bj = 0; bj < 2; ++bj)
#pragma unroll
            for (int n = 0; n < 2; ++n) { const f32x4 x = acc[ai][bj][m][n];
              const int w01 = __builtin_amdgcn_cvt_pk_fp8_f32(__builtin_amdgcn_fmed3f(x[0] * vs, -440.f, 440.f), __builtin_amdgcn_fmed3f(x[1] * vs, -440.f, 440.f), 0, false);
              const int w23 = __builtin_amdgcn_cvt_pk_fp8_f32(__builtin_amdgcn_fmed3f(x[2] * vs, -440.f, 440.f), __builtin_amdgcn_fmed3f(x[3] * vs, -440.f, 440.f), 0, false);
              LAS unsigned char* d = sb + (32 * bj + 8 * fq + 4 * n) * 16 + fr;
              d[0] = (unsigned char)(w01 & 0xff); d[16] = (unsigned char)((w01 >> 8) & 0xff); d[32] = (unsigned char)(w23 & 0xff); d[48] = (unsigned char)((w23 >> 8) & 0xff); }
          const u32x4 rw = *(LAS u32x4*)(sb + lane * 16);
          unsigned char* dst = vt + ai * 128 + 16 * (m >> 1) + 8 * (m & 1);
          *(u32x2*)dst = (u32x2){rw.x, rw.z}; *(u32x2*)(dst + 32) = (u32x2){rw.y, rw.w};
          asm volatile("" ::: "memory"); }
    } else if (pn == 5) {
#pragma unroll
      for (int ai = 0; ai < 2; ++ai)
#pragma unroll
        for (int m = 0; m < 4; ++m) {
          u32x4 wq[2];
#pragma unroll
          for (int bj = 0; bj < 2; ++bj) { const f32x4 v0 = acc[ai][bj][m][0], v1 = acc[ai][bj][m][1];
            u32x4 w; w.x = cvt_pk_bf16(v0[0], v0[1]); w.y = cvt_pk_bf16(v0[2], v0[3]); w.z = cvt_pk_bf16(v1[0], v1[1]); w.w = cvt_pk_bf16(v1[2], v1[3]);
            wq[bj] = w; }
          { u32x4 ra, rb; slab_x16(sl, wq[0], wq[1], ra, rb); *(u32x4*)(outp + (size_t)(ai * 128 + m * 16) * ODD_IN) = ra; *(u32x4*)(outp + (size_t)(ai * 128 + m * 16) * ODD_IN + 32) = rb; } }
    } else {
      const int wid = wr * 4 + wc;
      LAS float* xw = (LAS float*)(lds + LDS_XCH) + wid * 128 + fr; LAS float* xr = (LAS float*)(lds + LDS_XCH) + (wid ^ 1) * 128 + fr;
      asm volatile("" : "+v"(xw), "+v"(xr));
      float ssr[2][4];
#pragma unroll
      for (int ai = 0; ai < 2; ++ai)
#pragma unroll
        for (int m = 0; m < 4; ++m) { float ss = 0.f;
#pragma unroll
          for (int bj = 0; bj < 2; ++bj)
#pragma unroll
            for (int n = 0; n < 2; ++n) { const f32x4 x = acc[ai][bj][m][n]; ss += (x[0] * x[0] + x[1] * x[1]) + (x[2] * x[2] + x[3] * x[3]); }
          ss += shx<16>(ss); ss = sum32x(ss); ssr[ai][m] = ss;
          if (fq == 0) xw[ai * 64 + m * 16] = ss; }
      asm volatile("s_waitcnt lgkmcnt(0)" ::: "memory"); __builtin_amdgcn_s_barrier(); asm volatile("" ::: "memory");
#pragma unroll
      for (int ai = 0; ai < 2; ++ai)
#pragma unroll
        for (int m = 0; m < 4; ++m) ssr[ai][m] += xr[ai * 64 + m * 16];
      const int hh = wc & 1;
      LAS const float* gn = (LAS const float*)(lds + LDS_GAIN) + (pn < 4 ? 0 : 128) + 64 * hh + 8 * fq;
      asm volatile("" : "+v"(gn));
      const int jt = u.pm % 9; const bool lat = jt != 0;
      LAS const f32x4* t128 = (LAS const f32x4*)(lds + LDS_ROPE);
#pragma unroll
      for (int ai = 0; ai < 2; ++ai)
#pragma unroll
        for (int m = 0; m < 4; ++m) {
          f32x4 g4[2][2];
#pragma unroll
          for (int bj = 0; bj < 2; ++bj)
#pragma unroll
            for (int n = 0; n < 2; ++n) g4[bj][n] = *(LAS const f32x4*)(gn + bj * 32 + 4 * n);
          f32x4 cs[2][2];
          if (lat) { const int il = (jt - 1) * 256 + ai * 128 + wr * 64 + m * 16 + fr; const int pos = hh ? (il & 63) : (il >> 6);
#pragma unroll
            for (int bj = 0; bj < 2; ++bj)
#pragma unroll
              for (int n = 0; n < 2; ++n) cs[bj][n] = t128[pos * 16 + 8 * bj + 2 * fq + n]; }
          const float rstd = rsqrtf(ssr[ai][m] * (1.0f / 128) + EPS);
          u32x4 wq[2];
#pragma unroll
          for (int bj = 0; bj < 2; ++bj) { f32x4 y[2];
#pragma unroll
            for (int n = 0; n < 2; ++n) { f32x4 x = acc[ai][bj][m][n] * rstd * g4[bj][n];
              if (lat) { const f32x4 c4 = cs[bj][n]; x = (f32x4){x[0] * c4[0] - x[1] * c4[1], x[0] * c4[1] + x[1] * c4[0], x[2] * c4[2] - x[3] * c4[3], x[2] * c4[3] + x[3] * c4[2]}; }
              y[n] = x; }
            if (ATT1_QK8) { const float qs = (float)(1 << QS_SHIFT); int lo = 0, hi8 = 0;
#pragma unroll
              for (int n = 0; n < 2; ++n)
#pragma unroll
                for (int j = 0; j < 4; ++j) y[n][j] = __builtin_amdgcn_fmed3f(y[n][j] * qs, -440.f, 440.f);
              lo = __builtin_amdgcn_cvt_pk_fp8_f32(y[0][0], y[0][1], lo, false); lo = __builtin_amdgcn_cvt_pk_fp8_f32(y[0][2], y[0][3], lo, true);
              hi8 = __builtin_amdgcn_cvt_pk_fp8_f32(y[1][0], y[1][1], hi8, false); hi8 = __builtin_amdgcn_cvt_pk_fp8_f32(y[1][2], y[1][3], hi8, true);
              *(LAS u32x2*)(lds + 3 * HTB + (wr * 4 + wc) * 1024 + fr * 64 + bj * 32 + fq * 8) = (u32x2){(unsigned)lo, (unsigned)hi8}; }
            else {
            u32x4 w; w.x = cvt_pk_bf16(y[0][0], y[0][1]); w.y = cvt_pk_bf16(y[0][2], y[0][3]); w.z = cvt_pk_bf16(y[1][0], y[1][1]); w.w = cvt_pk_bf16(y[1][2], y[1][3]);
            wq[bj] = w; } }
          if (ATT1_QK8) { const u32x4 rw = *(LAS u32x4*)(lds + 3 * HTB + (wr * 4 + wc) * 1024 + lane * 16);
            *(u32x4*)(p.ws + OFF_QK8 + (size_t)(u.pm * 256 + wr * 64 + (lane >> 2) + ai * 128 + m * 16) * 1280 + pn * 256 + wc * 64 + 16 * (lane & 3)) = rw; }
          else { u32x4 ra, rb; slab_x16(sl, wq[0], wq[1], ra, rb); *(u32x4*)(outp + (size_t)(ai * 128 + m * 16) * ODD_IN) = ra; *(u32x4*)(outp + (size_t)(ai * 128 + m * 16) * ODD_IN + 32) = rb; }
          asm volatile("" ::: "memory");
        }
    }
  }
};

DEVI void moe_tables(const Params& p, const LCfg c, int half, int nN, LAS unsigned char* lds) {
  LAS int* tb = (LAS int*)(lds + LDS_TAB);
  const int tid = ltid();
  __syncthreads();
  if (tid <= NE) tb[tid] = tid < NE ? ((const int*)(p.ws + OFF_CNT))[c.l * 128 + half * 64 + tid] : c.nph;
  __syncthreads();
  if (tid == 0) { int up = 0, off = 0; for (int e = 0; e <= NE; ++e) { const int n = tb[e]; tb[72 + e] = up; tb[144 + e] = off; up += ((n + 255) >> 8) * nN; off += n; } tb[72 + 65] = up; tb[144 + 65] = off; }
  __syncthreads();
}
struct MoeIter {
  int g, gend, step, e;
  DEVI void init(LAS const int* tb) { const int vb = vbid(); const int U = __builtin_amdgcn_readfirstlane(tb[72 + 65]), chunk = (U + 7) >> 3, x = vb & 7; g = x * chunk + (vb >> 3); gend = (x + 1) * chunk < U ? (x + 1) * chunk : U; step = gridDim.x >> 3; e = 0; }
  DEVI bool next(LAS const int* tb, int nN, int& ee, int& mt, int& pn) { if (g >= gend) return false; while (__builtin_amdgcn_readfirstlane(tb[72 + e + 1]) <= g) ++e; const int r = g - __builtin_amdgcn_readfirstlane(tb[72 + e]); mt = r / nN; pn = r - mt * nN; ee = e; g += step; return true; }
};
struct JobGU {
  static constexpr int K = D / 2; static constexpr bool GATHER = true, FP8 = true;
  static constexpr int SCALE = 0x01010101 * (127 - (WG_SHIFT + X_SHIFT) / 2); static_assert((WG_SHIFT + X_SHIFT) % 2 == 0, "");
  const Params& p; const LCfg c; int half; LAS const int* tb; MoeIter it; int dry;
  DEVI JobGU(const Params& p_, const LCfg c_, int half_, LAS unsigned char* lds, int dry_ = 0) : p(p_), c(c_), half(half_), tb((LAS const int*)(lds + LDS_TAB)), dry(dry_) { it.init(tb); }
  DEVI unsigned boff(int R, int C) const { return boff_m2<K>(R, C); }
  DEVI bool next(Unit& u) {
    int e, mt, pn; if (!it.next(tb, 2, e, mt, pn)) return false;
    u.e = e; u.pm = mt; u.pn = pn; u.cnt = __builtin_amdgcn_readfirstlane(tb[e]); u.off = __builtin_amdgcn_readfirstlane(tb[144 + e]); u.A = (const char*)(p.ws + OFF_ACT8);
    const char* w = e < NE ? (const char*)wsp<bf16_t>(p, OFF_EGU) + (size_t)e * 512 * K * 2 : (const char*)wsp<bf16_t>(p, OFF_SHGU) + (size_t)c.l * 512 * K * 2;
    u.B0 = w + (size_t)(128 * pn) * K * 2; u.B1 = w + (size_t)(256 + 128 * pn) * K * 2; return true;
  }
  DEVI void aoffs(const Unit& u, const int (&Rr)[2], const int (&Cc)[2], unsigned (&v)[2][2]) const {
    const int* le = wsp<int>(p, OFF_LIST) + ((size_t)(half * 64 + (u.e < NE ? u.e : 0))) * LCAP;
#pragma unroll
    for (int h = 0; h < 2; ++h)
#pragma unroll
      for (int i = 0; i < 2; ++i) { int r = u.pm * 256 + h * 128 + Rr[i]; r = r < u.cnt ? r : 0;
        int tl = r; if (u.e < NE) tl = le[r] / 6;
        v[h][i] = (unsigned)(act_tok(c, half, tl) * K + Cc[i]) * 2u; }
  }
  DEVI void epilogue(const Acc& acc, const Unit& u, int wr, int wc, int fr, int fq, LAS unsigned char* lds) const {
    asm volatile("" : "+v"(fr), "+v"(fq));
    if (dry == 1) {
#pragma unroll
      for (int ai = 0; ai < 2; ++ai)
#pragma unroll
        for (int bj = 0; bj < 2; ++bj)
#pragma unroll
          for (int m = 0; m < 4; ++m)
#pragma unroll
            for (int n = 0; n < 2; ++n) asm volatile("" :: "v"(acc[ai][bj][m][n]));
      return; }
    const int lane = fq * 16 + fr;
    LAS unsigned char* sb = lds + 3 * HTB + (wr * 4 + wc) * 1024;
    const int r0 = u.pm * 256 + wr * 64 + (lane >> 2);
    unsigned char* hid = p.ws + OFF_HID + ((size_t)u.off + r0) * DE + u.pn * 128 + wc * 32 + 8 * (lane & 3);
    asm volatile("" : "+v"(hid));
    const float hs = (float)(1 << H_SHIFT);
#pragma unroll
    for (int ai = 0; ai < 2; ++ai)
#pragma unroll
      for (int m = 0; m < 4; ++m) { const int r = r0 + ai * 128 + m * 16;
        float h[8];
#pragma unroll
        for (int n = 0; n < 2; ++n)
#pragma unroll
          for (int j = 0; j < 4; ++j) { const float gg = acc[ai][0][m][n][j]; h[n * 4 + j] = __builtin_amdgcn_fmed3f(gg * __builtin_amdgcn_rcpf(1.0f + __expf(-gg)) * acc[ai][1][m][n][j] * hs, -440.f, 440.f); }
        int lo = 0, hi = 0;
        lo = __builtin_amdgcn_cvt_pk_fp8_f32(h[0], h[1], lo, false); lo = __builtin_amdgcn_cvt_pk_fp8_f32(h[2], h[3], lo, true);
        hi = __builtin_amdgcn_cvt_pk_fp8_f32(h[4], h[5], hi, false); hi = __builtin_amdgcn_cvt_pk_fp8_f32(h[6], h[7], hi, true);
        *(LAS u32x2*)(sb + fr * 32 + fq * 8) = (u32x2){(unsigned)lo, (unsigned)hi};
        const u32x2 rw = *(LAS u32x2*)(sb + lane * 8);
        if (r < u.cnt) *(u32x2*)(hid + (size_t)(ai * 128 + m * 16) * DE) = rw; }
  }
};
struct JobDown {
  static constexpr int K = DE / 2; static constexpr bool GATHER = false, FP8 = true;
  static constexpr int SCALE = 0x01010101 * (127 - (WD_SHIFT + H_SHIFT) / 2); static_assert((WD_SHIFT + H_SHIFT) % 2 == 0, "");
  const Params& p; const LCfg c; int half; LAS const int* tb; MoeIter it; float dscale;
  DEVI JobDown(const Params& p_, const LCfg c_, int half_, LAS unsigned char* lds, float ds = 1.0f) : p(p_), c(c_), half(half_), tb((LAS const int*)(lds + LDS_TAB)), dscale(ds) { it.init(tb); }
  DEVI unsigned boff(int R, int C) const { return boff_m1<K>(R, C); }
  DEVI bool next(Unit& u) {
    int e, mt, pn; if (!it.next(tb, 4, e, mt, pn)) return false;
    u.e = e; u.pm = mt; u.pn = pn; u.cnt = __builtin_amdgcn_readfirstlane(tb[e]); u.off = __builtin_amdgcn_readfirstlane(tb[144 + e]);
    u.A = (const char*)wsp<bf16_t>(p, OFF_HID) + ((size_t)(u.off + mt * 256)) * K * 2;
    const char* w = e < NE ? (const char*)wsp<bf16_t>(p, OFF_ED) + (size_t)e * D * K * 2 : (const char*)wsp<bf16_t>(p, OFF_SHD) + (size_t)c.l * D * K * 2;
    u.B0 = w + (size_t)(256 * pn) * K * 2; u.B1 = u.B0 + (size_t)32 * K * 2; return true;
  }
  DEVI void aoffs(const Unit&, const int (&Rr)[2], const int (&Cc)[2], unsigned (&v)[2][2]) const { dense_aoffs<K>(Rr, Cc, v); }
  DEVI void epilogue(const Acc& acc, const Unit& u, int wr, int wc, int fr, int fq, LAS unsigned char* lds) const {
    asm volatile("" : "+v"(fr), "+v"(fq));
    const int lane = fq * 16 + fr;
    if (dscale < 0.f) {
#pragma unroll
      for (int ai = 0; ai < 2; ++ai)
#pragma unroll
        for (int bj = 0; bj < 2; ++bj)
#pragma unroll
          for (int m = 0; m < 4; ++m)
#pragma unroll
            for (int n = 0; n < 2; ++n) asm volatile("" :: "v"(acc[ai][bj][m][n]));
      return; }
    LAS unsigned char* sb = lds + 3 * HTB + (wr * 4 + wc) * 1024;
    const int r0 = u.pm * 256 + wr * 64 + (lane >> 2);
    unsigned char* slot = p.ws + OFF_SLOT + ((size_t)u.off + r0) * D + u.pn * 256 + wc * 64 + 16 * (lane & 3);
    asm volatile("" : "+v"(slot));
#pragma unroll
    for (int ai = 0; ai < 2; ++ai)
#pragma unroll
      for (int m = 0; m < 4; ++m) {
#pragma unroll
        for (int bj = 0; bj < 2; ++bj) { f32x4 v0 = acc[ai][bj][m][0], v1 = acc[ai][bj][m][1]; int lo = 0, hi = 0;
#pragma unroll
          for (int j = 0; j < 4; ++j) { v0[j] = __builtin_amdgcn_fmed3f(v0[j], -440.f, 440.f); v1[j] = __builtin_amdgcn_fmed3f(v1[j], -440.f, 440.f); }
          lo = __builtin_amdgcn_cvt_pk_fp8_f32(v0[0], v0[1], lo, false); lo = __builtin_amdgcn_cvt_pk_fp8_f32(v0[2], v0[3], lo, true);
          hi = __builtin_amdgcn_cvt_pk_fp8_f32(v1[0], v1[1], hi, false); hi = __builtin_amdgcn_cvt_pk_fp8_f32(v1[2], v1[3], hi, true);
          *(LAS u32x2*)(sb + fr * 64 + bj * 32 + fq * 8) = (u32x2){(unsigned)lo, (unsigned)hi}; }
        const u32x4 rw = *(LAS u32x4*)(sb + lane * 16);
        if (r0 + ai * 128 + m * 16 < u.cnt) *(u32x4*)(slot + (size_t)(ai * 128 + m * 16) * D) = rw; }
  }
};
}
namespace fa {
constexpr int NW = 8, QBLK = 32, KVBLK = 64;
constexpr float THR = 8.f;
constexpr size_t SHM_V = KVBLK * 128 * 2, SHM_K = KVBLK * 128 * 2, SHM_ATTN = 2 * SHM_V + 2 * SHM_K + NW * 64 * 4;
using s16x4 = __attribute__((ext_vector_type(4))) short;
using f32x16 = __attribute__((ext_vector_type(16))) float;
#define KSWZ(row, colB) ((row) * 256 + ((colB) ^ (((row) & 7) << 4)))
#define SBAR() __builtin_amdgcn_sched_barrier(0)
DEVI int crow(int r, int hi) { return (r & 3) + 8 * (r >> 2) + 4 * hi; }
DEVI unsigned cvtpk(float lo, float hi) { unsigned r; asm volatile("v_cvt_pk_bf16_f32 %0, %1, %2" : "=v"(r) : "v"(lo), "v"(hi)); return r; }

template <int SCALE_NUM> struct ScaleC;
DEVI void partialSM(f32x16& p0, f32x16& p1, float& m_reg, float& mn, float& alpha, const float SCALE, const float THRv = THR) {
  const float C = SCALE * 1.4426950408889634f;
  float pmax = p0[0];
#pragma unroll
  for (int r = 1; r < 16; ++r) pmax = fmaxf(pmax, p0[r]);
#pragma unroll
  for (int r = 0; r < 16; ++r) pmax = fmaxf(pmax, p1[r]);
  { auto rr = __builtin_amdgcn_permlane32_swap(__float_as_uint(pmax), __float_as_uint(pmax), false, false);
    pmax = fmaxf(__uint_as_float(rr[0]), __uint_as_float(rr[1])); }
  if (__builtin_expect(__all(pmax - m_reg <= THRv / SCALE), 1)) { mn = m_reg; alpha = 1.f; }
  else { mn = fmaxf(m_reg, pmax); alpha = __builtin_amdgcn_exp2f((m_reg - mn) * C); m_reg = mn; }
  float mnC = -mn * C;
#pragma unroll
  for (int r = 0; r < 16; ++r) p0[r] = fmaf(p0[r], C, mnC);
#pragma unroll
  for (int r = 0; r < 16; ++r) p1[r] = fmaf(p1[r], C, mnC);
#pragma unroll
  for (int r = 0; r < 16; ++r) p0[r] = __builtin_amdgcn_exp2f(p0[r]);
}
DEVI void finishSM(f32x16& p0, f32x16& p1, float alpha, float& l_reg, bf16x8& pa0, bf16x8& pa1, bf16x8& pa2, bf16x8& pa3) {
#pragma unroll
  for (int r = 0; r < 16; ++r) p1[r] = __builtin_amdgcn_exp2f(p1[r]);
  float ps = 0;
#pragma unroll
  for (int r = 0; r < 16; ++r) ps += p0[r];
#pragma unroll
  for (int r = 0; r < 16; ++r) ps += p1[r];
  { auto rr = __builtin_amdgcn_permlane32_swap(__float_as_uint(ps), __float_as_uint(ps), false, false);
    ps = __uint_as_float(rr[0]) + __uint_as_float(rr[1]); }
  l_reg = l_reg * alpha + ps;
#define PK4(P, BASE, OUT) do { unsigned a0 = cvtpk(P[BASE + 0], P[BASE + 1]), a1 = cvtpk(P[BASE + 2], P[BASE + 3]);   \
    unsigned b0 = cvtpk(P[BASE + 4], P[BASE + 5]), b1 = cvtpk(P[BASE + 6], P[BASE + 7]);                              \
    auto r0 = __builtin_amdgcn_permlane32_swap(a0, b0, false, false); auto r1 = __builtin_amdgcn_permlane32_swap(a1, b1, false, false); \
    u32x4 w = {r0[0], r1[0], r0[1], r1[1]}; OUT = *reinterpret_cast<bf16x8*>(&w); } while (0)
  PK4(p0, 0, pa0); PK4(p0, 8, pa1); PK4(p1, 0, pa2); PK4(p1, 8, pa3);
#undef PK4
}
template <int ND0> DEVI void qkt(f32x16& p0, f32x16& p1, const char* Ks, const bf16x8* qr, int r32, int hi, int cbase) {
  p0 = f32x16{}; p1 = f32x16{};
#pragma unroll
  for (int d0 = 0; d0 < ND0; ++d0) { int cb = cbase + (d0 * 16 + hi * 8) * 2;
    bf16x8 b0 = *reinterpret_cast<const bf16x8*>(Ks + KSWZ(r32, cb));
    bf16x8 b1 = *reinterpret_cast<const bf16x8*>(Ks + KSWZ(32 + r32, cb));
    p0 = __builtin_amdgcn_mfma_f32_32x32x16_bf16(b0, qr[d0], p0, 0, 0, 0);
    p1 = __builtin_amdgcn_mfma_f32_32x32x16_bf16(b1, qr[d0], p1, 0, 0, 0); }
}
using fg::v8i_t;
#define K8SWZ(row, chunk) ((row) * 128 + ((((chunk)) ^ ((row) & 7)) << 4))
DEVI void qkt8(f32x16& p0, f32x16& p1, const char* Ks, const v8i_t* q8, int r32, int hi) {
  p0 = f32x16{}; p1 = f32x16{};
  constexpr int SC = 0x01010101 * (127 - QS_SHIFT);
#pragma unroll
  for (int ks = 0; ks < 2; ++ks) { const int c0 = ks * 4 + hi * 2;
    const u32x4 a0 = *reinterpret_cast<const u32x4*>(Ks + K8SWZ(r32, c0)), a1 = *reinterpret_cast<const u32x4*>(Ks + K8SWZ(r32, c0 + 1));
    const u32x4 b0 = *reinterpret_cast<const u32x4*>(Ks + K8SWZ(32 + r32, c0)), b1 = *reinterpret_cast<const u32x4*>(Ks + K8SWZ(32 + r32, c0 + 1));
    const v8i_t ka = {(int)a0[0], (int)a0[1], (int)a0[2], (int)a0[3], (int)a1[0], (int)a1[1], (int)a1[2], (int)a1[3]};
    const v8i_t kb = {(int)b0[0], (int)b0[1], (int)b0[2], (int)b0[3], (int)b1[0], (int)b1[1], (int)b1[2], (int)b1[3]};
    p0 = __builtin_amdgcn_mfma_scale_f32_32x32x64_f8f6f4(ka, q8[ks], p0, 0, 0, 0, SC, 0, SC);
    p1 = __builtin_amdgcn_mfma_scale_f32_32x32x64_f8f6f4(kb, q8[ks], p1, 0, 0, 0, SC, 0, SC); }
}
constexpr float THR8 = 3.f;
#define VT8SWZ(d, c) ((d) * 64 + ((((c)) ^ (((d) >> 2) & 3)) << 4))
DEVI void finishSM8(f32x16& p0, f32x16& p1, float alpha, float& l_reg, v8i_t& pa) {
#pragma unroll
  for (int r = 0; r < 16; ++r) p1[r] = __builtin_amdgcn_exp2f(p1[r]);
  float ps = 0;
#pragma unroll
  for (int r = 0; r < 16; ++r) ps += p0[r];
#pragma unroll
  for (int r = 0; r < 16; ++r) ps += p1[r];
  { auto rr = __builtin_amdgcn_permlane32_swap(__float_as_uint(ps), __float_as_uint(ps), false, false);
    ps = __uint_as_float(rr[0]) + __uint_as_float(rr[1]); }
  l_reg = l_reg * alpha + ps;
  const float sc = (float)(1 << PS_SHIFT);
#pragma unroll
  for (int w = 0; w < 4; ++w) { int a = 0, b = 0;
    a = __builtin_amdgcn_cvt_pk_fp8_f32(p0[4 * w] * sc, p0[4 * w + 1] * sc, a, false); a = __builtin_amdgcn_cvt_pk_fp8_f32(p0[4 * w + 2] * sc, p0[4 * w + 3] * sc, a, true);
    b = __builtin_amdgcn_cvt_pk_fp8_f32(p1[4 * w] * sc, p1[4 * w + 1] * sc, b, false); b = __builtin_amdgcn_cvt_pk_fp8_f32(p1[4 * w + 2] * sc, p1[4 * w + 3] * sc, b, true);
    pa[w] = a; pa[4 + w] = b; }
}
DEVI void pv8(f32x16* o, const char* Vs, const v8i_t pa, int r32, int hi) {
  constexpr int SC = 0x01010101 * (127 - (PS_SHIFT + VS_SHIFT) / 2); static_assert((PS_SHIFT + VS_SHIFT) % 2 == 0, "");
  u32x4 lo[4], hh[4];
#pragma unroll
  for (int d0 = 0; d0 < 4; ++d0) { const int d = d0 * 32 + r32; lo[d0] = *reinterpret_cast<const u32x4*>(Vs + VT8SWZ(d, 2 * hi)); hh[d0] = *reinterpret_cast<const u32x4*>(Vs + VT8SWZ(d, 2 * hi + 1)); }
  asm volatile("s_waitcnt lgkmcnt(0)" ::: "memory"); SBAR();
#pragma unroll
  for (int d0 = 0; d0 < 4; ++d0) { const v8i_t vb = {(int)lo[d0][0], (int)lo[d0][1], (int)lo[d0][2], (int)lo[d0][3], (int)hh[d0][0], (int)hh[d0][1], (int)hh[d0][2], (int)hh[d0][3]};
    o[d0] = __builtin_amdgcn_mfma_scale_f32_32x32x64_f8f6f4(pa, vb, o[d0], 0, 0, 0, SC, 0, SC); }
}
DEVI int v_st(int k, int c) { const int kk = (k & ~0xC) | ((k & 4) << 1) | ((k & 8) >> 1); return ((kk >> 3) * 4 + (c >> 5)) * 512 + ((kk & 7) * 32 + (c & 31)) * 2; }
DEVI int v_rd_base(int lane) { return ((lane & 3) << 3) | (((lane >> 2) & 3) << 6) | (((lane >> 4) & 1) << 5) | (((lane >> 5) & 1) << 8); }
constexpr int v_rd_off(int d0, int ks, int half) { return d0 * 512 + ks * 4096 + half * 2048; }
template <int OFF> DEVI s16x4 tr_read(int vb) { s16x4 r; asm volatile("ds_read_b64_tr_b16 %0, %1 offset:%2" : "=&v"(r) : "v"(vb), "i"(OFF) : "memory"); return r; }
template <int D0> DEVI void pv_one(f32x16& od, int vb, bf16x8 pa0, bf16x8 pa1, bf16x8 pa2, bf16x8 pa3) {
  const s16x4 l0 = tr_read<v_rd_off(D0, 0, 0)>(vb), h0 = tr_read<v_rd_off(D0, 0, 1)>(vb), l1 = tr_read<v_rd_off(D0, 1, 0)>(vb), h1 = tr_read<v_rd_off(D0, 1, 1)>(vb);
  const s16x4 l2 = tr_read<v_rd_off(D0, 2, 0)>(vb), h2 = tr_read<v_rd_off(D0, 2, 1)>(vb), l3 = tr_read<v_rd_off(D0, 3, 0)>(vb), h3 = tr_read<v_rd_off(D0, 3, 1)>(vb);
  asm volatile("s_waitcnt lgkmcnt(0)" ::: "memory"); SBAR();
#define PK(L, H) (bf16x8){L[0], L[1], L[2], L[3], H[0], H[1], H[2], H[3]}
  od = __builtin_amdgcn_mfma_f32_32x32x16_bf16(pa0, PK(l0, h0), od, 0, 0, 0);
  od = __builtin_amdgcn_mfma_f32_32x32x16_bf16(pa1, PK(l1, h1), od, 0, 0, 0);
  od = __builtin_amdgcn_mfma_f32_32x32x16_bf16(pa2, PK(l2, h2), od, 0, 0, 0);
  od = __builtin_amdgcn_mfma_f32_32x32x16_bf16(pa3, PK(l3, h3), od, 0, 0, 0);
#undef PK
}
DEVI void pv_d0(f32x16* o, int vb, bf16x8 pa0, bf16x8 pa1, bf16x8 pa2, bf16x8 pa3) {
  pv_one<0>(o[0], vb, pa0, pa1, pa2, pa3); pv_one<1>(o[1], vb, pa0, pa1, pa2, pa3); pv_one<2>(o[2], vb, pa0, pa1, pa2, pa3); pv_one<3>(o[3], vb, pa0, pa1, pa2, pa3);
}

template <int ND0, int LD, bool KF8 = false, bool PV8 = false>
DEVI void attn_loop(const bf16_t* __restrict__ Qw, const bf16_t* __restrict__ Kh, const bf16_t* __restrict__ Vh, int seq, char* lds, int kcol_bytes, const float SCALE,
                    f32x16 (&o)[4], float& l_out) {
  const int tid = ltid(), wid = tid >> 6, lane = tid & 63, r32 = lane & 31, hi = lane >> 5;
  char* V_lds = lds; char* K_lds = lds + 2 * SHM_V;
  float* ws = (float*)(lds + 2 * SHM_V + 2 * SHM_K) + wid * 64; float* al_l = ws + 32;
  float m_reg = -1e30f, l_reg = 0; bf16x8 qr[ND0]; v8i_t q8[2];
#pragma unroll
  for (int d = 0; d < 4; ++d) o[d] = f32x16{};
  if constexpr (KF8) {
#pragma unroll
    for (int ks = 0; ks < 2; ++ks) q8[ks] = *reinterpret_cast<const v8i_t*>((const unsigned char*)Qw + ks * 64);
  } else {
#pragma unroll
  for (int d0 = 0; d0 < ND0; ++d0) qr[d0] = *reinterpret_cast<const bf16x8*>(Qw + d0 * 16);
  }
  const int sr = tid >> 4, sc = (tid & 15) * 8, vst0 = v_st(sr, sc), vst1 = v_st(32 + sr, sc);
  const int vb0 = (int)(uintptr_t)V_lds + v_rd_base(lane);
  struct { bf16x8 vs0, vs1, ks0, ks1; } sr_[2];
#define SLOAD(i, k0) do { if constexpr (PV8) { sr_[i].vs0 = *reinterpret_cast<const bf16x8*>((const unsigned char*)Vh + (long)(tid >> 2) * SB + (k0) + (tid & 3) * 16); } else { \
    sr_[i].vs0 = *reinterpret_cast<const bf16x8*>(&Vh[(long)((k0) + sr) * LD + sc]); sr_[i].vs1 = *reinterpret_cast<const bf16x8*>(&Vh[(long)((k0) + 32 + sr) * LD + sc]); } \
    if constexpr (KF8) { sr_[i].ks0 = *reinterpret_cast<const bf16x8*>((const unsigned char*)Kh + (long)((k0) + (tid >> 3)) * 1280 + (tid & 7) * 16); } else { \
    sr_[i].ks0 = *reinterpret_cast<const bf16x8*>(&Kh[(long)((k0) + sr) * LD + sc]); sr_[i].ks1 = *reinterpret_cast<const bf16x8*>(&Kh[(long)((k0) + 32 + sr) * LD + sc]); } } while (0)
#define SWRITE(b, i) do { if constexpr (PV8) { *(bf16x8*)(V_lds + (b) * SHM_V + VT8SWZ(tid >> 2, tid & 3)) = sr_[i].vs0; } else { *(bf16x8*)(V_lds + (b) * SHM_V + vst0) = sr_[i].vs0;          \
    *(bf16x8*)(V_lds + (b) * SHM_V + vst1) = sr_[i].vs1; } int kc = sc * 2;               \
    if constexpr (KF8) { *(bf16x8*)(K_lds + (b) * SHM_K + K8SWZ(tid >> 3, tid & 7)) = sr_[i].ks0; } else { \
    *(bf16x8*)(K_lds + (b) * SHM_K + KSWZ(sr, kc)) = sr_[i].ks0;                       \
    *(bf16x8*)(K_lds + (b) * SHM_K + KSWZ(32 + sr, kc)) = sr_[i].ks1; } } while (0)
#define SWAIT() do { if constexpr (KF8 && PV8) asm volatile("s_waitcnt vmcnt(2)" ::: "memory"); else if constexpr (KF8) asm volatile("s_waitcnt vmcnt(3)" ::: "memory"); else asm volatile("s_waitcnt vmcnt(4)" ::: "memory"); } while (0)
#define FINSM(P0, P1, al) do { if constexpr (PV8) finishSM8(P0, P1, al, l_reg, pa8); else finishSM(P0, P1, al, l_reg, pa0, pa1, pa2, pa3); } while (0)
#define PVD(vboff) do { if constexpr (PV8) pv8(o, V_lds + (vboff), pa8, r32, hi); else pv_d0(o, vb0 + (int)(vboff), pa0, pa1, pa2, pa3); } while (0)
#define PSM(P0, P1, mn, al) do { if constexpr (PV8) partialSM(P0, P1, m_reg, mn, al, SCALE, THR8); else partialSM(P0, P1, m_reg, mn, al, SCALE); } while (0)
#define QKT(P0, P1, KS) do { if constexpr (KF8) qkt8(P0, P1, KS, q8, r32, hi); else qkt<ND0>(P0, P1, KS, qr, r32, hi, kcol_bytes); } while (0)
#define RESC(a) do { if (__any((a) < 1.f)) { if (hi == 0) al_l[r32] = (a); asm volatile("s_waitcnt lgkmcnt(0)" ::: "memory"); \
    _Pragma("unroll") for (int d = 0; d < 4; ++d) _Pragma("unroll") for (int r = 0; r < 16; ++r) o[d][r] *= al_l[crow(r, hi)]; } } while (0)
  f32x16 pA0, pA1, pB0, pB1; float mnA, mnB, alA, alB; bf16x8 pa0, pa1, pa2, pa3; v8i_t pa8; const int NT = seq / KVBLK;
  constexpr int SE = 0, SO = 1;
  SLOAD(SE, 0); asm volatile("s_waitcnt vmcnt(0)" ::: "memory"); SWRITE(0, SE); __syncthreads();
  QKT(pA0, pA1, K_lds); PSM(pA0, pA1, mnA, alA);
  SLOAD(SO, KVBLK); if (2 < NT) SLOAD(SE, 2 * KVBLK);
  SWAIT(); SWRITE(1, SO); __syncthreads();
  for (int j = 1; j + 1 < NT; j += 2) {
    SBAR(); QKT(pB0, pB1, K_lds + SHM_K);
    FINSM(pA0, pA1, alA); SBAR();
    SLOAD(SO, (j + 2) * KVBLK); SBAR();
    PVD(0); PSM(pB0, pB1, mnB, alB);
    __syncthreads(); SWAIT(); SWRITE(0, SE);
    RESC(alB); __syncthreads();
    SBAR(); QKT(pA0, pA1, K_lds);
    FINSM(pB0, pB1, alB); SBAR();
    if (j + 3 < NT) SLOAD(SE, (j + 3) * KVBLK); SBAR();
    PVD(SHM_V); PSM(pA0, pA1, mnA, alA);
    __syncthreads(); SWAIT(); SWRITE(1, SO);
    RESC(alA); __syncthreads();
  }
  SBAR(); QKT(pB0, pB1, K_lds + SHM_K);
  FINSM(pA0, pA1, alA); SBAR();
  PVD(0); PSM(pB0, pB1, mnB, alB);
  __syncthreads(); RESC(alB);
  FINSM(pB0, pB1, alB); SBAR();
  PVD(SHM_V);
  asm volatile("s_waitcnt vmcnt(0)" ::: "memory");
  l_out = l_reg;
#undef QKT
#undef FINSM
#undef PVD
#undef PSM
#undef SLOAD
#undef SWRITE
#undef SWAIT
#undef RESC
}

DEVI void store_tile_bf16(const f32x16 (&o)[4], const float (&scl)[16], bf16_t* Ow, int ldo, int r32, int hi) {
#pragma unroll
  for (int d0 = 0; d0 < 4; ++d0)
#pragma unroll
    for (int r = 0; r < 16; r += 2) {
      const float va = o[d0][r] * scl[r], vb = o[d0][r + 1] * scl[r + 1];
      const float snd = (r32 & 1) ? va : vb; const float got = shx<1>(snd);
      const int row = (r32 & 1) ? crow(r + 1, hi) : crow(r, hi); const int col = d0 * 32 + (r32 & ~1);
      const unsigned w = (r32 & 1) ? cvtpk(got, vb) : cvtpk(va, got);
      *(unsigned*)(Ow + (long)row * ldo + col) = w; }
}

DEVI void store_tile_fp8(const f32x16 (&o)[4], const float (&scl)[16], unsigned char* Ow, int ldo, int r32, int hi, const float xs) {
  const int q = r32 & 3; const bool b0 = q & 1, b1 = q & 2;
#pragma unroll
  for (int d0 = 0; d0 < 4; ++d0)
#pragma unroll
    for (int r4 = 0; r4 < 16; r4 += 4) {
      float v[4];
#pragma unroll
      for (int kk = 0; kk < 4; ++kk) v[kk] = __builtin_amdgcn_fmed3f(o[d0][r4 + kk] * scl[r4 + kk] * xs, -440.f, 440.f);
      const float gA = shx<1>(b0 ? v[0] : v[1]), gB = shx<1>(b0 ? v[2] : v[3]);
      const float aLo = b0 ? gA : v[0], aHi = b0 ? v[1] : gA;
      const float bLo = b0 ? gB : v[2], bHi = b0 ? v[3] : gB;
      const int pA = __builtin_amdgcn_cvt_pk_fp8_f32(aLo, aHi, 0, false) & 0xffff, pB = __builtin_amdgcn_cvt_pk_fp8_f32(bLo, bHi, 0, false) & 0xffff;
      const int got = __float_as_int(shx<2>(__int_as_float(b1 ? pA : pB))) & 0xffff;
      const unsigned w = b1 ? ((unsigned)got | ((unsigned)pB << 16)) : ((unsigned)pA | ((unsigned)got << 16));
      *(unsigned*)(Ow + (long)crow(r4 + q, hi) * ldo + d0 * 32 + (r32 & ~3)) = w; }
}

DEVI void phase_attn1(const Params& p, const PrepIn& pin, unsigned char* smem) {
  const bf16_t* qkv = wsp<bf16_t>(p, OFF_PROJ); bf16_t* att = wsp<bf16_t>(p, OFF_ACT);
  const int tid = ltid(), wid = tid >> 6, lane = tid & 63, r32 = lane & 31, hi = lane >> 5;
  const int vb_ = vbid(); const int xcd = vb_ & 7, slot = vb_ >> 3, nslot = gridDim.x >> 3;
  float* li_l = (float*)((char*)smem + 2 * SHM_V + 2 * SHM_K) + wid * 64;
  for (int it = slot; it < 4 * 32; it += nslot) {
    const int g = xcd + 8 * (it >> 5), item = it & 31, b = g >> 1, kvh = g & 1, h = kvh * 4 + (item >> 3), qb = item & 7;
    const bf16_t* Qb = qkv + (size_t)(b * SB + NC + qb * 256) * ODD_IN + h * 128;
    const bf16_t* Kh = qkv + (size_t)(b * SB) * ODD_IN + 1024 + kvh * 128; const bf16_t* Vh = Kh + 256;
    const unsigned char* Q8 = p.ws + OFF_QK8 + (size_t)(b * SB + NC + qb * 256) * 1280 + h * 128; const unsigned char* K8 = p.ws + OFF_QK8 + (size_t)(b * SB) * 1280 + 1024 + kvh * 128;
    f32x16 o[4]; float l;
    __syncthreads();
    if constexpr (ATT1_QK8 && ATT1_PV8) attn_loop<8, ODD_IN, true, true>((const bf16_t*)(Q8 + (long)(wid * QBLK + r32) * 1280 + hi * 32), (const bf16_t*)K8, (const bf16_t*)(p.ws + OFF_VT8 + (size_t)((b * 2 + kvh) * 128) * SB), SB, (char*)smem, 0, 0.08838834764831845f, o, l);
    else if constexpr (ATT1_QK8) attn_loop<8, ODD_IN, true>((const bf16_t*)(Q8 + (long)(wid * QBLK + r32) * 1280 + hi * 32), (const bf16_t*)K8, Vh, SB, (char*)smem, 0, 0.08838834764831845f, o, l);
    else attn_loop<8, ODD_IN>(Qb + (long)(wid * QBLK + r32) * ODD_IN + hi * 8, Kh, Vh, SB, (char*)smem, 0, 0.08838834764831845f, o, l);
    if (hi == 0) li_l[r32] = l; asm volatile("s_waitcnt lgkmcnt(0)" ::: "memory");
    float rli[16];
#pragma unroll
    for (int r = 0; r < 16; ++r) rli[r] = __builtin_amdgcn_rcpf(li_l[crow(r, hi)]);
    if (OUT1_FP8) store_tile_fp8(o, rli, p.ws + OFF_ACT8 + (size_t)(b * SB + NC + qb * 256 + wid * QBLK) * D + h * 128, D, r32, hi, (float)(1 << A_SHIFT));
    else store_tile_bf16(o, rli, att + (size_t)(b * SB + NC + qb * 256 + wid * QBLK) * D + h * 128, D, r32, hi);
  }
}

DEVI void phase_attn0(const Params& p, const PrepIn& pin, unsigned char* smem) {
  const bf16_t* proj = wsp<bf16_t>(p, OFF_PROJ); bf16_t* cat = wsp<bf16_t>(p, OFF_ACT);
  const int tid = ltid(), wid = tid >> 6, lane = tid & 63, r32 = lane & 31, hi = lane >> 5, mp = wid >> 2, w4 = wid & 3;
  const int vb_ = vbid(); const int xcd = vb_ & 7, slot = vb_ >> 3, nslot = gridDim.x >> 3;
  float* li_l = (float*)((char*)smem + 2 * SHM_V + 2 * SHM_K) + wid * 64;
  float* ex = (float*)smem + (size_t)w4 * 4096 + lane;
  const float lam = wsp<float>(p, OFF_LAM)[0];
  const float* subln = sm(p, SM_SUBLN);
  for (int it = slot; it < 8 * 18; it += nslot) {
    int g, qrow0, seq;
    if (it < 128) { g = xcd + 8 * (it >> 4); qrow0 = NC + (it & 15) * 128; seq = SB; }
    else { const int j = it - 128; g = xcd + 8 * (j >> 1); qrow0 = (j & 1) * 128; seq = NC; }
    const int b = g >> 2, h = g & 3;
    const bf16_t* Qw = proj + (size_t)(b * SB + qrow0 + w4 * QBLK + r32) * EVEN_IN + 1024 + h * 128 + mp * 64 + hi * 8;
    const bf16_t* Kh = proj + (size_t)(b * SB) * EVEN_IN + 1536 + h * 128; const bf16_t* Vh = Kh + 512;
    f32x16 o[4]; float l;
    __syncthreads();
    attn_loop<4, EVEN_IN>(Qw, Kh, Vh, seq, (char*)smem, mp * 128, 0.125f, o, l);
    if (hi == 0) li_l[r32] = l; asm volatile("s_waitcnt lgkmcnt(0)" ::: "memory");
    float rli[16];
#pragma unroll
    for (int r = 0; r < 16; ++r) rli[r] = __builtin_amdgcn_rcpf(li_l[crow(r, hi)]);
    __syncthreads();
    if (mp == 1) {
#pragma unroll
      for (int d0 = 0; d0 < 4; ++d0)
#pragma unroll
        for (int r = 0; r < 16; ++r) ex[(d0 * 16 + r) * 64] = o[d0][r] * rli[r];
    }
    __syncthreads();
    if (mp == 0) {
      float ss[16];
#pragma unroll
      for (int r = 0; r < 16; ++r) ss[r] = 0.f;
#pragma unroll
      for (int d0 = 0; d0 < 4; ++d0) { const float gcol = subln[d0 * 32 + r32];
#pragma unroll
        for (int r = 0; r < 16; ++r) { const float dv = o[d0][r] * rli[r] - lam * ex[(d0 * 16 + r) * 64]; ss[r] += dv * dv; o[d0][r] = dv * gcol; } }
#pragma unroll
      for (int r = 0; r < 16; ++r) { float v = ss[r];
        v += shx<1>(v); v += shx<2>(v); v += shx<4>(v); v += shx<8>(v); v += shx<16>(v);
        ss[r] = rsqrtf(v * (1.0f / 128) + EPS) * 0.8f; }
      if (OUT0_FP8) store_tile_fp8(o, ss, p.ws + OFF_ACT8 + (size_t)(b * SB + qrow0 + w4 * QBLK) * D + 512 + h * 128, D, r32, hi, (float)(1 << A_SHIFT));
      else store_tile_bf16(o, ss, cat + (size_t)(b * SB + qrow0 + w4 * QBLK) * D + 512 + h * 128, D, r32, hi);
    }
  }
}

DEVI void phase_gmlp(const Params& p, unsigned char* smem) {
  const bf16_t* proj = wsp<bf16_t>(p, OFF_PROJ); bf16_t* cat = wsp<bf16_t>(p, OFF_ACT); const bf16_t* wsa = wsp<bf16_t>(p, OFF_WSA);
  const float* lng = sm(p, SM_ALNG); const float* lnb = sm(p, SM_ALNB); const float* abs_ = sm(p, SM_ABS);
  for (int it = blockIdx.x; it < (T / 128 + 1) / 2; it += gridDim.x) {
    const int tid = ltid(), hf = tid >> 8, ht = tid & 255, wl = ht >> 6, lane = tid & 63, fr = lane & 15, fq = lane >> 4;
    bf16_t* Tl = (bf16_t*)(smem + hf * 36864);
    const int ch = it * 2 + hf; const bool live = ch < T / 128; const int t0 = (live ? ch : 0) * 128;
    const int q = ht >> 1, part = ht & 1;
    float mu, rstd;
    { const bf16_t* vr = proj + (size_t)(t0 + q) * EVEN_IN + 512 + part * 256;
      float s = 0.f, s2 = 0.f;
#pragma unroll
      for (int i = 0; i < 32; ++i) { const u32x4 x = *(const u32x4*)(vr + i * 8);
#pragma unroll
        for (int e = 0; e < 4; ++e) { const float f0 = __uint_as_float(x[e] << 16), f1 = __uint_as_float(x[e] & 0xffff0000u); s += f0 + f1; s2 += f0 * f0 + f1 * f1; } }
      s += shx<1>(s); s2 += shx<1>(s2);
      mu = s * (1.0f / 512); rstd = rsqrtf(fmaxf(s2 * (1.0f / 512) - mu * mu, 0.f) + EPS); }
    for (int g = 0; g < 4; ++g) {
      __syncthreads();
      { const bf16_t* vg = proj + (size_t)(t0 + q) * EVEN_IN + 512 + g * 128 + part * 64;
#pragma unroll
        for (int i = 0; i < 8; ++i) { const u32x4 x = *(const u32x4*)(vg + i * 8); const int d0 = part * 64 + i * 8;
          const f32x4 ga = *(const f32x4*)(lng + g * 128 + d0), gb = *(const f32x4*)(lng + g * 128 + d0 + 4), ba = *(const f32x4*)(lnb + g * 128 + d0), bb = *(const f32x4*)(lnb + g * 128 + d0 + 4);
#pragma unroll
          for (int e = 0; e < 4; ++e) { const float f0 = __uint_as_float(x[e] << 16), f1 = __uint_as_float(x[e] & 0xffff0000u);
            const float gg0 = e < 2 ? ga[2 * e] : gb[2 * e - 4], gg1 = e < 2 ? ga[2 * e + 1] : gb[2 * e - 3], bb0 = e < 2 ? ba[2 * e] : bb[2 * e - 4], bb1 = e < 2 ? ba[2 * e + 1] : bb[2 * e - 3];
            const unsigned w = cvtpk((f0 - mu) * rstd * gg0 + bb0, (f1 - mu) * rstd * gg1 + bb1);
            Tl[(d0 + 2 * e) * 136 + q] = (bf16_t)(w & 0xffff); Tl[(d0 + 2 * e + 1) * 136 + q] = (bf16_t)(w >> 16); } }
      }
      __syncthreads();
      bf16x8 af[2][4];
#pragma unroll
      for (int m = 0; m < 2; ++m)
#pragma unroll
        for (int k = 0; k < 4; ++k) af[m][k] = *(const bf16x8*)(wsa + (size_t)(g * 128 + wl * 32 + m * 16 + fr) * 128 + k * 32 + fq * 8);
      f32x4 acc[2][8];
#pragma unroll
      for (int m = 0; m < 2; ++m)
#pragma unroll
        for (int n = 0; n < 8; ++n) acc[m][n] = (f32x4){0.f, 0.f, 0.f, 0.f};
#pragma unroll
      for (int k = 0; k < 4; ++k)
#pragma unroll
        for (int n = 0; n < 8; ++n) { const bf16x8 bfr = *(const bf16x8*)(Tl + (16 * n + fr) * 136 + k * 32 + fq * 8);
          acc[0][n] = __builtin_amdgcn_mfma_f32_16x16x32_bf16(bfr, af[0][k], acc[0][n], 0, 0, 0);
          acc[1][n] = __builtin_amdgcn_mfma_f32_16x16x32_bf16(bfr, af[1][k], acc[1][n], 0, 0, 0); }
      if (live) {
#pragma unroll
        for (int m = 0; m < 2; ++m) { const int pp = wl * 32 + m * 16 + fr; const size_t t = (size_t)t0 + pp; const float bias = abs_[g * 128 + pp];
#pragma unroll
          for (int n = 0; n < 8; ++n) { const int c = g * 128 + 16 * n + 4 * fq;
            const u32x2 uu = *(const u32x2*)(proj + t * EVEN_IN + c);
            const float o0 = __uint_as_float(uu.x << 16) * (acc[m][n][0] + bias), o1 = __uint_as_float(uu.x & 0xffff0000u) * (acc[m][n][1] + bias);
            const float o2 = __uint_as_float(uu.y << 16) * (acc[m][n][2] + bias), o3 = __uint_as_float(uu.y & 0xffff0000u) * (acc[m][n][3] + bias);
            if (OUT0_FP8) { const float xs = (float)(1 << A_SHIFT); int w8 = 0;
              w8 = __builtin_amdgcn_cvt_pk_fp8_f32(__builtin_amdgcn_fmed3f(o0 * xs, -440.f, 440.f), __builtin_amdgcn_fmed3f(o1 * xs, -440.f, 440.f), w8, false);
              w8 = __builtin_amdgcn_cvt_pk_fp8_f32(__builtin_amdgcn_fmed3f(o2 * xs, -440.f, 440.f), __builtin_amdgcn_fmed3f(o3 * xs, -440.f, 440.f), w8, true);
              *(int*)(p.ws + OFF_ACT8 + t * D + c) = w8; }
            else { u32x2 w; w.x = cvtpk(o0, o1); w.y = cvtpk(o2, o3);
              *(u32x2*)(cat + t * D + c) = w; } } }
      }
    }
  }
}
#undef KSWZ
#undef SBAR
}
#define REP_PREP 1
#define REP_NORM1 1
#define REP_IN0 1
#define REP_ATT0 1
#define REP_GMLP 1
#define REP_OUT0 1
#define REP_GU 1
#define REP_IN1 1
#define REP_ATT1 1
#define REP_SYNC 0
#define DRY_IN0 0
#define DRY_DOWN 0
#define DRY_GU 0
#define REP_ROUTER 1
#define REP_DOWN 1
#define REP_COMB 1
#define REPEAT(n, stmt) { int _n = (n); if ((n) > 1) asm volatile("" : "+s"(_n)); for (int _r = 0; _r < _n; ++_r) { stmt; if (_r + 1 < _n) GSYNC(); } }
__global__ __launch_bounds__(512) void mega(Params p0, PrepIn pin) {
  cg::grid_group grid = cg::this_grid();
  LAS unsigned char* lds = (LAS unsigned char*)smem;
  volatile LAS unsigned* xst = (volatile LAS unsigned*)(lds + SMEM_BYTES - 16);
  if (threadIdx.x == 0) { xst[0] = 0u; xst[1] = 0u; }
  ltid_init();
  XcdBarrier xb = xcd_barrier_post((unsigned*)(p0.ws + OFF_ZERO), xst);
  if (threadIdx.x == 0) { volatile LAS int* vbp = (volatile LAS int*)(lds + LDS_VBID); vbp[0] = (int)blockIdx.x;
    vbp[1] = (int)xb_add((unsigned*)(p0.ws + OFF_XRANK) + xb.x, 1u); }
#define GSYNC() xcd_barrier(xb)
#define ROUTER(c) { int _n = REP_ROUTER; if (REP_ROUTER > 1) asm volatile("" : "+s"(_n)); for (int _r = 0; _r < _n; ++_r) { \
      if (_r > 0) { if (blockIdx.x == 0 && threadIdx.x < 128) ((int*)(p0.ws + OFF_CNT))[c.l * 128 + threadIdx.x] = 0; GSYNC(); } \
      stage_router(launder(p0), c, smem); if (_r + 1 < _n) GSYNC(); } }
#define MOE_HALF(c, half, FUSE) do { \
    REPEAT(REP_GU, { const Params pl = launder(p0); fg::moe_tables(pl, c, half, 2, lds); int dry = (DRY_GU && _r > 0) ? DRY_GU : 0; if (DRY_GU) { asm volatile("" : "+v"(dry)); dry = __builtin_amdgcn_readfirstlane(dry); } fg::JobGU J(pl, c, half, lds, dry); fg::gemm_phase(lds, J); }) \
    GSYNC(); \
    { int _n = REP_DOWN; if (REP_DOWN > 1) asm volatile("" : "+s"(_n)); for (int _r = 0; _r < _n; ++_r) { float ds = _r == 0 ? 1.0f : (DRY_DOWN ? -1.0f : 0.0f); if (REP_DOWN > 1) { asm volatile("" : "+v"(ds)); ds = __int_as_float(__builtin_amdgcn_readfirstlane(__float_as_int(ds))); } \
        const Params pl = launder(p0); fg::moe_tables(pl, c, half, 4, lds); fg::JobDown J(pl, c, half, lds, ds); fg::gemm_phase(lds, J); if (_r + 1 < _n) GSYNC(); } } \
    GSYNC(); \
    { int _n = REP_COMB; if (REP_COMB > 1) asm volatile("" : "+s"(_n)); for (int _r = 0; _r < _n; ++_r) { float ds = _r == 0 ? 1.0f : 0.0f; if (REP_COMB > 1) asm volatile("" : "+v"(ds)); \
        stage_combine<FUSE>(launder(p0), c, half, smem, ds); if (_r + 1 < _n) GSYNC(); } } \
    } while (0)
  for (int _r = 0; _r < REP_PREP; ++_r) { stage_prep(p0, pin, smem); if (_r + 1 < REP_PREP) __syncthreads(); }
  grid.sync();
  if (threadIdx.x == 0) {
    bool ok = true; const unsigned per = gridDim.x >> 3;
    for (int j = 0; j < 16; ++j) { const unsigned c = xb_ld((unsigned*)(p0.ws + OFF_XRANK) + j); ok = ok && (c == (j < 8 ? per : 0u)); }
    volatile LAS int* vbp = (volatile LAS int*)(lds + LDS_VBID);
    if (ok && (gridDim.x & 7) == 0) vbp[0] = (int)xb.x + 8 * vbp[1]; }
  __syncthreads();
  REPEAT(REP_NORM1, stage_norm1<0>(launder(p0))) GSYNC();
  REPEAT(REP_IN0, { const Params pl = launder(p0); fg::load_rope_lds(pl, OFF_TAB64, 512, SM_BQN, SM_BKN, 64, lds); int dry = (DRY_IN0 && _r > 0) ? DRY_IN0 : 0; if (DRY_IN0) { asm volatile("" : "+v"(dry)); dry = __builtin_amdgcn_readfirstlane(dry); } fg::JobIn0 J(pl, dry); fg::gemm_phase(lds, J); })
  GSYNC();
  REPEAT(REP_ATT0, fa::phase_attn0(launder(p0), pin, smem))
  REPEAT(REP_GMLP, fa::phase_gmlp(launder(p0), smem))
  GSYNC();
  REPEAT(REP_OUT0, { const Params pl = launder(p0); fg::JobOut<0> J(pl); fg::gemm_phase(lds, J); })
  expert_prep_steal(launder(p0), pin, smem, 0);
  GSYNC();
  { const LCfg c{0, SB, 0, 16 * SB};
    ROUTER(c); GSYNC();
    MOE_HALF(c, 0, true); GSYNC(); }
  { int _n = REP_SYNC; if (REP_SYNC > 0) asm volatile("" : "+s"(_n)); for (int _r = 0; _r < _n; ++_r) GSYNC(); }
  REPEAT(REP_IN1, { const Params pl = launder(p0); fg::load_rope_lds(pl, OFF_TAB128, 1024, SM_CQN, SM_CKN, 128, lds); fg::JobIn1 J(pl); fg::gemm_phase(lds, J); })
  expert_prep_steal(launder(p0), pin, smem, 1);
  GSYNC();
  REPEAT(REP_ATT1, fa::phase_attn1(launder(p0), pin, smem))
  GSYNC();
  { const Params pl = launder(p0); fg::JobOut<1> J(pl); fg::gemm_phase(lds, J); }
  GSYNC();
  { const LCfg c{1, S, NC, 16 * S};
    ROUTER(c); GSYNC();
    MOE_HALF(c, 0, false); }
}

extern "C" void kernel_launch(void* const* d_in, const int* in_sizes, int n_in, void* d_out, int out_size, void* d_ws, size_t ws_size, hipStream_t stream) {
  static int grid_blocks = 0;
  if (!grid_blocks) {
    if (n_in != 33 || ws_size < WS_TOTAL) { fprintf(stderr, "kernel_launch: bad n_in %d or ws %zu < %zu\n", n_in, ws_size, (size_t)WS_TOTAL); return; }
    if (hipFuncSetAttribute((const void*)mega, hipFuncAttributeMaxDynamicSharedMemorySize, SMEM_BYTES) != hipSuccess) { fprintf(stderr, "set attr failed\n"); return; }
    int dev = 0, cus = 0, per_cu = 0;
    hipGetDevice(&dev); hipDeviceGetAttribute(&cus, hipDeviceAttributeMultiprocessorCount, dev);
    hipOccupancyMaxActiveBlocksPerMultiprocessor(&per_cu, mega, 512, SMEM_BYTES);
    if (per_cu < 1) { fprintf(stderr, "occupancy 0\n"); return; }
    grid_blocks = cus;
  }
  Params p; memset(&p, 0, sizeof(p)); PrepIn pin; memset(&pin, 0, sizeof(pin));
  for (int i = 0; i < 33; ++i) pin.in[i] = (const float*)d_in[i];
  p.out = (float*)d_out; p.ws = (unsigned char*)d_ws;
  p.x = pin.in[I_X]; p.ctx = pin.in[I_CTX];
  hipMemsetAsync(d_ws, 0, ZERO_BYTES, stream);
  void* args[] = {&p, &pin};
  hipError_t e = hipLaunchCooperativeKernel((void*)mega, dim3(grid_blocks), dim3(512), args, SMEM_BYTES, stream);
  if (e != hipSuccess) fprintf(stderr, "cooperative launch failed: %s (grid %d)\n", hipGetErrorString(e), grid_blocks);
}
```

```cpp
#include <hip/hip_runtime.h>
#include <hip/hip_cooperative_groups.h>
#include <cstdio>
#include <cstdint>
#include <cstring>
namespace cg = cooperative_groups;

#define DEVI __device__ __forceinline__
#define LAS __attribute__((address_space(3)))
typedef unsigned short bf16_t;
typedef short bf16x8 __attribute__((ext_vector_type(8)));
typedef float f32x4 __attribute__((ext_vector_type(4)));
typedef unsigned u32x4 __attribute__((ext_vector_type(4)));
typedef unsigned u32x2 __attribute__((ext_vector_type(2)));

constexpr int D = 1024, NB = 16, S = 2048, NC = 256, SB = 2304, T = NB * SB, TX = NB * S;
constexpr int NE = 64, TOPK = 6, DE = 256;
constexpr int EVEN_IN = 2560, ODD_IN = 1536;
constexpr float EPS = 1e-6f;

constexpr size_t al256(size_t x) { return (x + 255) & ~(size_t)255; }
constexpr size_t OFF_ZERO = 0, ZERO_BYTES = 65536;
constexpr size_t OFF_CNT = 16384;
constexpr size_t OFF_XRANK = 20608;
constexpr size_t OFF_STEAL = 20480;
constexpr size_t OFF_TAB64 = OFF_ZERO + ZERO_BYTES;
constexpr size_t OFF_TAB128 = OFF_TAB64 + 64 * 16 * 8;
constexpr size_t OFF_LAM = OFF_TAB128 + 64 * 32 * 8;
constexpr size_t OFF_MODV = al256(OFF_LAM + 256);
constexpr size_t OFF_SMALL = al256(OFF_MODV + (size_t)2 * 17 * 6144 * 4);
enum { SM_N1G = 0, SM_N2G = 2048, SM_ALNG = 4096, SM_ALNB = 4608, SM_ABS = 5120, SM_BQN = 5632, SM_BKN = 5696, SM_SUBLN = 5760, SM_CQN = 5888, SM_CKN = 6016, SM_MBIAS = 6144,
       SM_AWSF = 8192, SM_ROUTER = 73728, SM_END = 204800 };
constexpr size_t OFF_WIN0T = al256(OFF_SMALL + (size_t)SM_END * 4);
constexpr size_t OFF_WOUT0T = OFF_WIN0T + (size_t)EVEN_IN * D * 2;
constexpr size_t OFF_WQKV1T = OFF_WOUT0T + (size_t)D * D * 2;
constexpr size_t OFF_WOUT1T = OFF_WQKV1T + (size_t)ODD_IN * D * 2;
constexpr size_t OFF_WSA = OFF_WOUT1T + (size_t)D * D * 2;
constexpr size_t OFF_WRT = OFF_WSA + (size_t)4 * 128 * 128 * 2;
constexpr size_t OFF_SHGU = OFF_WRT + (size_t)2 * NE * D * 2;
constexpr size_t OFF_SHD = OFF_SHGU + (size_t)2 * 512 * D * 2;
constexpr size_t OFF_EGU = OFF_SHD + (size_t)2 * D * DE * 2;
constexpr size_t OFF_ED = OFF_EGU + (size_t)NE * 512 * D;
constexpr size_t OFF_HB = OFF_ED + (size_t)NE * D * DE;
constexpr size_t OFF_HC = OFF_HB;
constexpr size_t OFF_ACT = OFF_HB + (size_t)T * D * 2;
constexpr size_t OFF_TOPW = OFF_ACT + (size_t)T * D * 2;
constexpr size_t OFF_TOPP = al256(OFF_TOPW + (size_t)T * 6 * 4);
constexpr size_t OFF_LIST = al256(OFF_TOPP + (size_t)T * 6 * 4);
constexpr int LCAP = 36864;
constexpr size_t OFF_R = al256(OFF_LIST + (size_t)NE * LCAP * 4);
constexpr size_t OFF_PROJ = OFF_R;
constexpr size_t OFF_SLOT = OFF_R;
constexpr size_t OFF_QK8 = al256(OFF_R + (size_t)120000000);
constexpr size_t OFF_VT8 = al256(OFF_QK8 + (size_t)T * 1280);
constexpr size_t OFF_QK8_0 = al256(OFF_R + (size_t)192000000);
constexpr size_t OFF_VT8_0 = al256(OFF_QK8_0 + (size_t)T * 1024);
constexpr size_t OFF_HID = al256(OFF_SLOT + (size_t)258048 * D);
constexpr size_t OFF_ACT8 = al256(OFF_HID + (size_t)(258048 + 256) * DE);
constexpr size_t WS_TOTAL = OFF_ACT8 + (size_t)T * D;
static_assert(OFF_HID >= OFF_R + (size_t)0, "layout");
static_assert(OFF_R + (size_t)T * EVEN_IN * 2 <= WS_TOTAL, "proj fits");
static_assert(WS_TOTAL <= 636368384ull, "workspace budget");
static_assert((size_t)T * ODD_IN * 2 <= 120000000ull && OFF_VT8 + (size_t)NB * 2 * 128 * SB <= OFF_SLOT + (size_t)258048 * D, "QK8 / VT8 placement");
static_assert((size_t)T * EVEN_IN * 2 <= 192000000ull && OFF_VT8_0 + (size_t)NB * 4 * 128 * SB <= OFF_SLOT + (size_t)258048 * D, "layer-0 QK8 / VT8 placement");

struct Params {
  float* out;
  unsigned char* ws;
  const float* x; const float* ctx;
};
struct PrepIn { const float* in[33]; };
typedef __attribute__((address_space(1))) unsigned char* gptr_t;
__device__ __forceinline__ Params launder(const Params& p) {
  unsigned long long a = (unsigned long long)p.out, b = (unsigned long long)p.ws, c = (unsigned long long)p.x, d = (unsigned long long)p.ctx;
  asm volatile("" : "+s"(a), "+s"(b), "+s"(c), "+s"(d));
  Params q; q.out = (float*)(gptr_t)a; q.ws = (unsigned char*)(gptr_t)b; q.x = (const float*)(gptr_t)c; q.ctx = (const float*)(gptr_t)d; return q; }
enum { I_X = 0, I_C, I_CTX, I_CCTX, I_MODW, I_MODB, I_N1G, I_N2G, I_EVWIN, I_EVWOUT, I_ALNG, I_ALNB, I_AWS, I_ABS, I_BQN, I_BKN,
       I_LQ1, I_LK1, I_LQ2, I_LK2, I_SUBLN, I_ODQKV, I_ODOUT, I_CQN, I_CKN, I_ROUTER, I_MBIAS, I_WG, I_WU, I_WD, I_SG, I_SU, I_SD };

extern __shared__ __attribute__((aligned(16))) unsigned char smem[];
constexpr int SMEM_BYTES = 152 * 1024;
constexpr int LDS_WTAB = SMEM_BYTES - 512;
DEVI int ltid() {
  const unsigned slot = (unsigned)__builtin_amdgcn_s_getreg(63492) & 0x3fu;
  const int wv = __builtin_amdgcn_readfirstlane(*(volatile LAS int*)((LAS unsigned char*)smem + LDS_WTAB + slot * 4));
  int l; asm volatile("v_mbcnt_lo_u32_b32 %0, -1, 0\n\tv_mbcnt_hi_u32_b32 %0, -1, %0" : "=v"(l));
  return wv * 64 + l;
}
constexpr int LDS_VBID = LDS_WTAB + 256;
DEVI int vbid() { return __builtin_amdgcn_readfirstlane(*(volatile LAS int*)((LAS unsigned char*)smem + LDS_VBID)); }
DEVI void ltid_init() {
  const unsigned slot = (unsigned)__builtin_amdgcn_s_getreg(63492) & 0x3fu;
  if ((threadIdx.x & 63) == 0) *(volatile LAS int*)((LAS unsigned char*)smem + LDS_WTAB + slot * 4) = (int)(threadIdx.x >> 6);
  __syncthreads();
}
template <int M> DEVI float shx(float v) { static_assert(M == 1 || M == 2 || M == 4 || M == 8 || M == 16, "xor mask");
  return __int_as_float(__builtin_amdgcn_ds_swizzle(__float_as_int(v), (M << 10) | 0x1f)); }
template <int CTRL> DEVI float dppf(float v) { return __int_as_float(__builtin_amdgcn_update_dpp(0, __float_as_int(v), CTRL, 0xf, 0xf, true)); }
DEVI float rlane(float v, int l) { return __int_as_float(__builtin_amdgcn_readlane(__float_as_int(v), l)); }
DEVI float wsum_dpp(float v) { v += dppf<0xB1>(v); v += dppf<0x4E>(v); v += dppf<0x141>(v); v += dppf<0x140>(v); return (rlane(v, 0) + rlane(v, 16)) + (rlane(v, 32) + rlane(v, 48)); }
DEVI float wmax_dpp(float v) { v = fmaxf(v, dppf<0xB1>(v)); v = fmaxf(v, dppf<0x4E>(v)); v = fmaxf(v, dppf<0x141>(v)); v = fmaxf(v, dppf<0x140>(v)); return fmaxf(fmaxf(rlane(v, 0), rlane(v, 16)), fmaxf(rlane(v, 32), rlane(v, 48))); }
DEVI float max8_dpp(float v) { v = fmaxf(v, dppf<0xB1>(v)); v = fmaxf(v, dppf<0x4E>(v)); return fmaxf(v, dppf<0x141>(v)); }
DEVI float sum32x(float v) { auto r = __builtin_amdgcn_permlane32_swap(__float_as_uint(v), __float_as_uint(v), false, false); return __uint_as_float(r[0]) + __uint_as_float(r[1]); }
DEVI float max32x(float v) { auto r = __builtin_amdgcn_permlane32_swap(__float_as_uint(v), __float_as_uint(v), false, false); return fmaxf(__uint_as_float(r[0]), __uint_as_float(r[1])); }
DEVI bf16_t f2bf(float f) { unsigned u = __float_as_uint(f); u += 0x7FFFu + ((u >> 16) & 1u); return (bf16_t)(u >> 16); }
DEVI float bf2f(bf16_t b) { return __uint_as_float(((unsigned)b) << 16); }
DEVI unsigned pack2(float lo, float hi) { return (unsigned)f2bf(lo) | ((unsigned)f2bf(hi) << 16); }
DEVI float wsum(float v) { v += shx<1>(v); v += shx<2>(v); v += shx<4>(v); v += shx<8>(v); v += shx<16>(v); return sum32x(v); }
DEVI float wmax(float v) { v = fmaxf(v, shx<1>(v)); v = fmaxf(v, shx<2>(v)); v = fmaxf(v, shx<4>(v)); v = fmaxf(v, shx<8>(v)); v = fmaxf(v, shx<16>(v)); return max32x(v); }
DEVI float gelu_exact(float v) { return 0.5f * v * (1.0f + erff(v * 0.70710678118654752f)); }
DEVI float silu(float v) { return v / (1.0f + __expf(-v)); }

template <class Tp> DEVI Tp* wsp(const Params& p, size_t off) { return (Tp*)(p.ws + off); }
DEVI const float* sm(const Params& p, int off) { return (const float*)(p.ws + OFF_SMALL) + off; }
DEVI const float* in_row(const Params& p, int t) { int b = t / SB, j = t - b * SB;
  unsigned long long xa = (unsigned long long)p.x, ca = (unsigned long long)p.ctx; asm volatile("" : "+s"(xa), "+s"(ca));
  const float* xp = (const float*)(gptr_t)xa; const float* cp = (const float*)(gptr_t)ca;
  return j < NC ? cp + ((size_t)(b * NC + j)) * D : xp + ((size_t)(b * S + j - NC)) * D; }
DEVI f32x4 bf4(u32x2 r) { return (f32x4){__uint_as_float(r.x << 16), __uint_as_float(r.x & 0xffff0000u), __uint_as_float(r.y << 16), __uint_as_float(r.y & 0xffff0000u)}; }
DEVI float* hid_row(const Params& p, int t) { int b = t / SB, j = t - b * SB;
  return j < NC ? wsp<float>(p, OFF_HC) + ((size_t)(b * NC + j)) * D : p.out + ((size_t)(b * S + j - NC)) * D; }
DEVI const float* modv(const Params& p, int l, int t, int which) { int b = t / SB, j = t - b * SB; int r = j < NC ? 16 : b;
  return wsp<float>(p, OFF_MODV) + ((size_t)(l * 17 + r)) * 6144 + which * D; }

#define XB_TMO      128
#define XB_XCNT(j)  (256  + 64 * (j))
#define XB_XSUB(j)  (1280 + 64 * (j))
#define XB_XGEN(j)  (2304 + 64 * (j))
#define XB_TOP      3328
#define XB_TOPGEN   3392
#define XCD_BAR_WORDS 3456
#define XB_SPIN_CAP (1u << 22)
DEVI unsigned xb_ld(unsigned* p) { return __hip_atomic_load(p, __ATOMIC_RELAXED, __HIP_MEMORY_SCOPE_AGENT); }
DEVI unsigned xb_add(unsigned* p, unsigned v) { return __hip_atomic_fetch_add(p, v, __ATOMIC_RELAXED, __HIP_MEMORY_SCOPE_AGENT); }
DEVI unsigned xb_xcc_id() { return (unsigned)__builtin_amdgcn_s_getreg((3 << 11) | 20) & 0xFu; }
#define XB_SPIN(cond, bar) do { unsigned _sp = 0; while (cond) { __builtin_amdgcn_s_sleep(1); \
    if ((++_sp & 255u) == 0u) { if (xb_ld(&(bar)[XB_TMO])) break; if (_sp > XB_SPIN_CAP) { atomicAdd(&(bar)[XB_TMO], 1u); break; } } } } while (0)
struct XcdBarrier { unsigned* bar; unsigned x; volatile LAS unsigned* st; };
DEVI XcdBarrier xcd_barrier_post(unsigned* bar, volatile LAS unsigned* st) {
  XcdBarrier b; b.bar = bar; b.x = xb_xcc_id(); b.st = st;
  if (ltid() == 0) (void)xb_add(&bar[XB_XCNT(b.x)], 1u);
  return b;
}
DEVI void xcd_barrier_complete(unsigned* bar, unsigned x, unsigned& nloc, unsigned& nx) {
  const unsigned G = gridDim.x * gridDim.y * gridDim.z;
  unsigned sum, cnt, mine, sp = 0u;
  for (;;) {
    sum = 0u; cnt = 0u; mine = 0u;
#pragma unroll
    for (unsigned j = 0; j < 16; ++j) { const unsigned c = xb_ld(&bar[XB_XCNT(j)]); sum += c; cnt += (c > 0u) ? 1u : 0u; mine = (j == x) ? c : mine; }
    if (sum == G) break;
    __builtin_amdgcn_s_sleep(1);
    if ((++sp & 255u) == 0u) { if (xb_ld(&bar[XB_TMO])) break; if (sp > XB_SPIN_CAP) { atomicAdd(&bar[XB_TMO], 1u); break; } }
  }
  nloc = mine > 0u ? mine : 1u; nx = cnt > 0u ? cnt : 1u;
}
DEVI void xcd_barrier(const XcdBarrier& b) {
  asm volatile("s_waitcnt vmcnt(0)" ::: "memory");
  __syncthreads();
  if (ltid() == 0) {
    unsigned* bar = b.bar;
    __builtin_amdgcn_s_waitcnt(0);
    unsigned nloc = b.st[0], nx = b.st[1];
    if (nloc == 0u) { xcd_barrier_complete(bar, b.x, nloc, nx); b.st[0] = nloc; b.st[1] = nx; }
    const unsigned old = xb_add(&bar[XB_XSUB(b.x)], 1u);
    const unsigned gen = old / nloc;
    if (old + 1u == (gen + 1u) * nloc) {
      __builtin_amdgcn_fence(__ATOMIC_RELEASE, "agent");
      asm volatile("s_waitcnt vmcnt(0)" ::: "memory");
      const unsigned og = xb_add(&bar[XB_TOP], 1u);
      const unsigned tg = og / nx;
      if (og + 1u == (tg + 1u) * nx) xb_add(&bar[XB_TOPGEN], 1u);
      else XB_SPIN(xb_ld(&bar[XB_TOPGEN]) == tg, bar);
      __builtin_amdgcn_fence(__ATOMIC_ACQUIRE, "agent");
      xb_add(&bar[XB_XGEN(b.x)], 1u);
      asm volatile("s_waitcnt vmcnt(0)" ::: "memory");
    } else {
      XB_SPIN(xb_ld(&bar[XB_XGEN(b.x)]) == gen, bar);
      __builtin_amdgcn_fence(__ATOMIC_ACQUIRE, "agent");
      asm volatile("s_waitcnt vmcnt(0)" ::: "memory");
    }
  }
  __syncthreads();
}

DEVI void transpose_tiles(const float* srcb, unsigned char* dstb, int K, int N, int nb, size_t sstride, size_t dstride, unsigned char* smem, int& goff) {
  const int G = gridDim.x, tk = K / 128, tn = N / 256, per = tk * tn, total = per * nb, tid = ltid();
  const int first = (((int)blockIdx.x - goff) % G + G) % G;
  const int n4 = tid & 63, kp0 = tid >> 6;
  f32x4 va[8], vb[8];
  auto issue = [&](int ti) { const int m = ti / per, r = ti - m * per, kb = r / tn, nb_ = r - kb * tn;
    const float* src = srcb + (size_t)m * sstride + (size_t)(kb * 128) * N + nb_ * 256 + n4 * 4;
#pragma unroll
    for (int i = 0; i < 8; ++i) { const int kp = kp0 + 8 * i; va[i] = __builtin_nontemporal_load((const f32x4*)(src + (size_t)(2 * kp) * N)); vb[i] = __builtin_nontemporal_load((const f32x4*)(src + (size_t)(2 * kp + 1) * N)); } };
  if (first < total) issue(first);
  int par = 0;
  for (int ti = first; ti < total; ti += G, par ^= 1) {
    unsigned* Tb = (unsigned*)smem + par * 16384;
#pragma unroll
    for (int i = 0; i < 8; ++i) { const int kp = kp0 + 8 * i;
#pragma unroll
      for (int j = 0; j < 4; ++j) { const int n = n4 * 4 + j; Tb[n * 64 + (kp ^ (((n >> 2) & 7) << 2))] = pack2(va[i][j], vb[i][j]); } }
    if (ti + G < total) issue(ti + G);
    __syncthreads();
    const int m = ti / per, r = ti - m * per, kb = r / tn, nb_ = r - kb * tn;
    bf16_t* dst = (bf16_t*)dstb + (size_t)m * dstride + (size_t)(nb_ * 256) * K + kb * 128;
#pragma unroll
    for (int i = 0; i < 8; ++i) { const int pc = tid + 512 * i, n = pc >> 4, q = pc & 15;
      const u32x4 w = *(const u32x4*)(Tb + n * 64 + ((4 * q) ^ (((n >> 2) & 7) << 2)));
      *(u32x4*)(dst + (size_t)n * K + 8 * q) = w; }
  }
  __syncthreads();
  goff = (goff + total) % G;
}

constexpr int WD_SHIFT = 4, H_SHIFT = 2, WG_SHIFT = 5, X_SHIFT = 3, WQ_SHIFT = 5;
constexpr bool IN1_FP8 = true, IN0_FP8 = true, OUT0_FP8 = true, OUT1_FP8 = true;
constexpr bool ATT1_QK8 = true;
constexpr bool ATT0_F8 = true;
constexpr bool ATT1_PV8 = true;
constexpr int VS_SHIFT = 2, PS_SHIFT = 4;
constexpr int QS_SHIFT = 2;
constexpr int A_SHIFT = 3;
DEVI void transpose_panel8(const float* src0, unsigned char* dst0, int K, int N, int kb, int nb_, unsigned char* smem, int shift = WD_SHIFT) {
  const int tid = ltid(), n4 = tid & 63, kq0 = tid >> 6; unsigned* Tb = (unsigned*)smem;
  const float* src = src0 + (size_t)(kb * 128) * N + nb_ * 256 + n4 * 4; unsigned char* dst = dst0 + (size_t)(nb_ * 256) * K + kb * 128;
  f32x4 v[4][4];
#pragma unroll
  for (int i = 0; i < 4; ++i)
#pragma unroll
    for (int r = 0; r < 4; ++r) v[i][r] = __builtin_nontemporal_load((const f32x4*)(src + (size_t)(4 * (kq0 + 8 * i) + r) * N));
  const float sc = (float)(1 << shift);
#pragma unroll
  for (int i = 0; i < 4; ++i) { const int kq = kq0 + 8 * i;
#pragma unroll
    for (int j = 0; j < 4; ++j) { const int n = n4 * 4 + j; int w = 0;
      w = __builtin_amdgcn_cvt_pk_fp8_f32(v[i][0][j] * sc, v[i][1][j] * sc, w, false); w = __builtin_amdgcn_cvt_pk_fp8_f32(v[i][2][j] * sc, v[i][3][j] * sc, w, true);
      Tb[n * 32 + (kq ^ (((n >> 2) & 7) << 2))] = (unsigned)w; } }
  __syncthreads();
#pragma unroll
  for (int i = 0; i < 4; ++i) { const int pc = tid + 512 * i, n = pc >> 3, q = pc & 7;
    const u32x4 w = *(const u32x4*)(Tb + n * 32 + ((4 * q) ^ (((n >> 2) & 7) << 2)));
    *(u32x4*)(dst + (size_t)n * K + 16 * q) = w; }
}
DEVI void transpose_all8(const float* src, unsigned char* dst, int K, int N, int shift, unsigned char* smem, int& goff) {
  const int G = gridDim.x, tk = K / 128, tn = N / 256, total = tk * tn;
  const int first = (((int)blockIdx.x - goff) % G + G) % G;
  for (int ti = first; ti < total; ti += G) { __syncthreads(); const int kb = ti / tn, nb_ = ti - kb * tn; transpose_panel8(src, dst, K, N, kb, nb_, smem, shift); }
  __syncthreads();
  goff = (goff + total) % G;
}
DEVI void stage_prep(const Params& p, const PrepIn& pin, unsigned char* smem) {
  const int tid = ltid(), bid = blockIdx.x, G = gridDim.x;
  {
    float* sl = (float*)smem;
    for (int i = tid; i < 17 * 1024; i += 512) { int r = i >> 10, k = i & 1023; float v; if (r < 16) v = pin.in[I_C][r * 1024 + k]; else v = pin.in[I_CCTX][k]; sl[i] = silu(v); }
    __syncthreads();
    float* part = (float*)(smem + 17 * 1024 * 4);
    for (int cb = bid; cb < 256; cb += G) {
      const int col0 = cb * 48;
      if (tid < 384) {
        const int kc = tid / 48, c = tid - kc * 48, gc = col0 + c, l = gc / 6144, n = gc - l * 6144;
        const float* w = pin.in[I_MODW] + (size_t)l * 1024 * 6144 + n;
        float acc[17];
#pragma unroll
        for (int r = 0; r < 17; ++r) acc[r] = 0.f;
        for (int k = kc * 128; k < kc * 128 + 128; ++k) { float wv = w[(size_t)k * 6144];
#pragma unroll
          for (int r = 0; r < 17; ++r) acc[r] += sl[r * 1024 + k] * wv; }
#pragma unroll
        for (int r = 0; r < 17; ++r) part[(kc * 17 + r) * 48 + c] = acc[r];
      }
      __syncthreads();
      for (int i = tid; i < 17 * 48; i += 512) { int r = i / 48, c = i - r * 48, gc = col0 + c, l = gc / 6144, n = gc - l * 6144;
        float s = pin.in[I_MODB][l * 6144 + n];
        for (int kc = 0; kc < 8; ++kc) s += part[(kc * 17 + r) * 48 + c];
        wsp<float>(p, OFF_MODV)[((size_t)(l * 17 + r)) * 6144 + n] = s; }
      __syncthreads();
    }
  }
  if (bid == 0) {
    float2* t64 = wsp<float2>(p, OFF_TAB64); float2* t128 = wsp<float2>(p, OFF_TAB128);
    for (int i = tid; i < 64 * 16; i += 512) { int pos = i >> 4, f = i & 15; float inv = exp2f(-(float)f * (13.287712379549449f / 16.0f)); float a = (float)pos * inv; t64[i] = make_float2(__cosf(a), __sinf(a)); }
    for (int i = tid; i < 64 * 32; i += 512) { int pos = i >> 5, f = i & 31; float inv = exp2f(-(float)f * (13.287712379549449f / 32.0f)); float a = (float)pos * inv; t128[i] = make_float2(__cosf(a), __sinf(a)); }
    if (tid < 64) { float a = pin.in[I_LQ1][tid] * pin.in[I_LK1][tid], b = pin.in[I_LQ2][tid] * pin.in[I_LK2][tid]; a = wsum(a); b = wsum(b);
      if (tid == 0) wsp<float>(p, OFF_LAM)[0] = expf(a) - expf(b) + 0.2f; }
  }
  { float* smw = wsp<float>(p, OFF_SMALL); const int gt = bid * 512 + tid, gs = G * 512;
#define CPY(idx, off, n) for (int i = gt; i < (n); i += gs) smw[(off) + i] = pin.in[idx][i];
    CPY(I_N1G, SM_N1G, 2048) CPY(I_N2G, SM_N2G, 2048) CPY(I_ALNG, SM_ALNG, 512) CPY(I_ALNB, SM_ALNB, 512) CPY(I_ABS, SM_ABS, 512) CPY(I_BQN, SM_BQN, 64) CPY(I_BKN, SM_BKN, 64)
    CPY(I_SUBLN, SM_SUBLN, 128) CPY(I_CQN, SM_CQN, 128) CPY(I_CKN, SM_CKN, 128) CPY(I_MBIAS, SM_MBIAS, 128) CPY(I_AWS, SM_AWSF, 65536) CPY(I_ROUTER, SM_ROUTER, 131072)
#undef CPY
  }
  for (int i = bid * 512 + tid; i < 2 * NE * D; i += G * 512) { const int l = i >> 16, e = (i >> 10) & 63, kk = i & 1023; wsp<bf16_t>(p, OFF_WRT)[i] = f2bf(pin.in[I_ROUTER][((size_t)l * D + kk) * NE + e]); }
  for (int i = bid * 512 + tid; i < 4 * 128 * 128; i += G * 512) wsp<bf16_t>(p, OFF_WSA)[i] = f2bf(pin.in[I_AWS][i]);
  int goff = 0;
  const size_t EW = (size_t)D * DE;
  __syncthreads();
  if (IN0_FP8) transpose_all8(pin.in[I_EVWIN], p.ws + OFF_WIN0T, D, EVEN_IN, WQ_SHIFT, smem, goff);
  else transpose_tiles(pin.in[I_EVWIN], p.ws + OFF_WIN0T, D, EVEN_IN, 1, 0, 0, smem, goff);
  if (OUT0_FP8) transpose_all8(pin.in[I_EVWOUT], p.ws + OFF_WOUT0T, D, D, WQ_SHIFT, smem, goff);
  else transpose_tiles(pin.in[I_EVWOUT], p.ws + OFF_WOUT0T, D, D, 1, 0, 0, smem, goff);
  if (IN1_FP8) transpose_all8(pin.in[I_ODQKV], p.ws + OFF_WQKV1T, D, ODD_IN, WQ_SHIFT, smem, goff);
  else transpose_tiles(pin.in[I_ODQKV], p.ws + OFF_WQKV1T, D, ODD_IN, 1, 0, 0, smem, goff);
  if (OUT1_FP8) transpose_all8(pin.in[I_ODOUT], p.ws + OFF_WOUT1T, D, D, WQ_SHIFT, smem, goff);
  else transpose_tiles(pin.in[I_ODOUT], p.ws + OFF_WOUT1T, D, D, 1, 0, 0, smem, goff);
  for (int pi = bid; pi < 32; pi += G) { __syncthreads(); const int l = pi >> 4, up = (pi >> 3) & 1, kb = pi & 7;
    const float* sgu; if (up) sgu = pin.in[I_SU]; else sgu = pin.in[I_SG]; asm volatile("" : "+s"(sgu));
    transpose_panel8(sgu + (size_t)l * EW, p.ws + OFF_SHGU + (size_t)l * 512 * D + (size_t)up * 256 * D, D, DE, kb, 0, smem, WG_SHIFT); }
  __syncthreads();
  for (int pi = bid; pi < 16; pi += G) { __syncthreads(); const int l = pi >> 3, rr = pi & 7; transpose_panel8(pin.in[I_SD] + (size_t)l * EW, p.ws + OFF_SHD + (size_t)l * EW, DE, D, rr >> 2, rr & 3, smem); }
  __syncthreads();
}
DEVI void transpose_panel(const float* src0, bf16_t* dst0, int K, int N, int kb, int nb_, unsigned char* smem) {
  const int tid = ltid(), n4 = tid & 63, kp0 = tid >> 6; unsigned* Tb = (unsigned*)smem;
  const float* src = src0 + (size_t)(kb * 128) * N + nb_ * 256 + n4 * 4; bf16_t* dst = dst0 + (size_t)(nb_ * 256) * K + kb * 128;
  f32x4 va[8], vb[8];
#pragma unroll
  for (int i = 0; i < 8; ++i) { const int kp = kp0 + 8 * i; va[i] = __builtin_nontemporal_load((const f32x4*)(src + (size_t)(2 * kp) * N)); vb[i] = __builtin_nontemporal_load((const f32x4*)(src + (size_t)(2 * kp + 1) * N)); }
#pragma unroll
  for (int i = 0; i < 8; ++i) { const int kp = kp0 + 8 * i;
#pragma unroll
    for (int j = 0; j < 4; ++j) { const int n = n4 * 4 + j; Tb[n * 64 + (kp ^ (((n >> 2) & 7) << 2))] = pack2(va[i][j], vb[i][j]); } }
  __syncthreads();
#pragma unroll
  for (int i = 0; i < 8; ++i) { const int pc = tid + 512 * i, n = pc >> 4, q = pc & 15;
    const u32x4 w = *(const u32x4*)(Tb + n * 64 + ((4 * q) ^ (((n >> 2) & 7) << 2)));
    *(u32x4*)(dst + (size_t)n * K + 8 * q) = w; }
}
DEVI void expert_prep_steal(const Params& p, const PrepIn& pin, unsigned char* smem, int layer) {
  const size_t EW = (size_t)D * DE, lo = (size_t)layer * NE * EW; int* ctr = (int*)(p.ws + OFF_STEAL) + layer; int* bc = (int*)(smem + 65536);
  for (;;) {
    __syncthreads();
    if (ltid() == 0) bc[0] = atomicAdd(ctr, 1);
    __syncthreads();
    const int idx = bc[0]; if (idx >= 3 * 512) break;
    const int j = idx >> 9, r = idx & 511, m = r >> 3, rr = r & 7;
    if (j == 0) transpose_panel8(pin.in[I_WG] + lo + (size_t)m * EW, p.ws + OFF_EGU + (size_t)m * 512 * D, D, DE, rr, 0, smem, WG_SHIFT);
    else if (j == 1) transpose_panel8(pin.in[I_WU] + lo + (size_t)m * EW, p.ws + OFF_EGU + (size_t)m * 512 * D + (size_t)256 * D, D, DE, rr, 0, smem, WG_SHIFT);
    else transpose_panel8(pin.in[I_WD] + lo + (size_t)m * EW, p.ws + OFF_ED + (size_t)m * EW, DE, D, rr >> 2, rr & 3, smem);
  }
}
DEVI void stage_prep_experts(const Params& p, const PrepIn& pin, unsigned char* smem, int layer) {
  int goff = 0; const size_t EW = (size_t)D * DE, lo = (size_t)layer * NE * EW;
  __syncthreads();
  transpose_tiles(pin.in[I_WG] + lo, p.ws + OFF_EGU, D, DE, 64, EW, (size_t)512 * D, smem, goff);
  transpose_tiles(pin.in[I_WU] + lo, p.ws + OFF_EGU + (size_t)256 * D * 2, D, DE, 64, EW, (size_t)512 * D, smem, goff);
  transpose_tiles(pin.in[I_WD] + lo, p.ws + OFF_ED, DE, D, 64, EW, EW, smem, goff);
  __syncthreads();
}

template <int LAYER> DEVI void stage_norm1(const Params& p) {
  const int wid = ltid() >> 6, lane = ltid() & 63;
  const float* g = sm(p, SM_N1G + LAYER * D);
  bf16_t* act = wsp<bf16_t>(p, OFF_ACT);
  for (int t = blockIdx.x * 8 + wid; t < T; t += gridDim.x * 8) {
    const float* row = LAYER == 0 ? in_row(p, t) : (const float*)hid_row(p, t);
    const float* sh = modv(p, LAYER, t, 0); const float* sc = modv(p, LAYER, t, 1);
    f32x4 v[4]; float ss = 0.f;
#pragma unroll
    for (int i = 0; i < 4; ++i) { v[i] = *(const f32x4*)(row + (i * 64 + lane) * 4); ss += v[i][0] * v[i][0] + v[i][1] * v[i][1] + v[i][2] * v[i][2] + v[i][3] * v[i][3]; }
    ss = wsum(ss); const float rstd = rsqrtf(ss * (1.0f / D) + EPS);
#pragma unroll
    for (int i = 0; i < 4; ++i) { const int c = (i * 64 + lane) * 4; const f32x4 gg = *(const f32x4*)(g + c), s1 = *(const f32x4*)(sc + c), s0 = *(const f32x4*)(sh + c);
      float y[4];
#pragma unroll
      for (int q = 0; q < 4; ++q) y[q] = v[i][q] * rstd * gg[q] * (1.0f + s1[q]) + s0[q];
      if ((LAYER == 0 && IN0_FP8) || (LAYER == 1 && IN1_FP8)) { const float xs = (float)(1 << X_SHIFT); int w8 = 0;
        w8 = __builtin_amdgcn_cvt_pk_fp8_f32(__builtin_amdgcn_fmed3f(y[0] * xs, -440.f, 440.f), __builtin_amdgcn_fmed3f(y[1] * xs, -440.f, 440.f), w8, false);
        w8 = __builtin_amdgcn_cvt_pk_fp8_f32(__builtin_amdgcn_fmed3f(y[2] * xs, -440.f, 440.f), __builtin_amdgcn_fmed3f(y[3] * xs, -440.f, 440.f), w8, true);
        *(int*)(p.ws + OFF_ACT8 + (size_t)t * D + c) = w8; }
      else { u32x2 w; w.x = pack2(y[0], y[1]); w.y = pack2(y[2], y[3]);
        *(u32x2*)(act + (size_t)t * D + c) = w; } }
  }
}

template <class GA, class GB, class ST>
DEVI void ngemm(int MT, int NT, int K, GA getA, GB getB, ST store) {
  const int wid = ltid() >> 6, lane = ltid() & 63, fr = lane & 15, fq = lane >> 4;
  const long nw = (long)gridDim.x * 8;
  for (long tile = (long)blockIdx.x * 8 + wid; tile < (long)MT * NT; tile += nw) {
    const int tm = (int)(tile / NT), tn = (int)(tile - (long)tm * NT);
    const bf16_t* a0 = getA(tm * 32 + fr); const bf16_t* a1 = getA(tm * 32 + 16 + fr);
    const bf16_t* b0 = getB(tn * 32 + fr); const bf16_t* b1 = getB(tn * 32 + 16 + fr);
    f32x4 c00 = {0.f, 0.f, 0.f, 0.f}, c01 = c00, c10 = c00, c11 = c00;
    const bf16x8 z = {0, 0, 0, 0, 0, 0, 0, 0};
    for (int k = 0; k < K; k += 32) {
      const bf16x8 A0 = a0 ? *(const bf16x8*)(a0 + k + fq * 8) : z, A1 = a1 ? *(const bf16x8*)(a1 + k + fq * 8) : z;
      const bf16x8 B0 = *(const bf16x8*)(b0 + k + fq * 8), B1 = *(const bf16x8*)(b1 + k + fq * 8);
      c00 = __builtin_amdgcn_mfma_f32_16x16x32_bf16(A0, B0, c00, 0, 0, 0);
      c01 = __builtin_amdgcn_mfma_f32_16x16x32_bf16(A0, B1, c01, 0, 0, 0);
      c10 = __builtin_amdgcn_mfma_f32_16x16x32_bf16(A1, B0, c10, 0, 0, 0);
      c11 = __builtin_amdgcn_mfma_f32_16x16x32_bf16(A1, B1, c11, 0, 0, 0);
    }
#pragma unroll
    for (int j = 0; j < 4; ++j) {
      store(tm * 32 + fq * 4 + j, tn * 32 + fr, tn * 32 + 16 + fr, c00[j], c01[j]);
      store(tm * 32 + 16 + fq * 4 + j, tn * 32 + fr, tn * 32 + 16 + fr, c10[j], c11[j]);
    }
  }
}

DEVI void n_inproj0(const Params& p) {
  const bf16_t* act = wsp<bf16_t>(p, OFF_ACT); const bf16_t* w = wsp<bf16_t>(p, OFF_WIN0T); bf16_t* proj = wsp<bf16_t>(p, OFF_PROJ);
  ngemm(T / 32, EVEN_IN / 32, D,
        [&](int r) { return act + (size_t)r * D; }, [&](int n) { return w + (size_t)n * D; },
        [&](int r, int n0, int n1, float v0, float v1) { proj[(size_t)r * EVEN_IN + n0] = f2bf(v0); proj[(size_t)r * EVEN_IN + n1] = f2bf(v1); });
}
DEVI void n_post0(const Params& p) {
  const int wid = ltid() >> 6, lane = ltid() & 63;
  bf16_t* proj = wsp<bf16_t>(p, OFF_PROJ); const float2* t64 = wsp<float2>(p, OFF_TAB64);
  for (int t = blockIdx.x * 8 + wid; t < T; t += gridDim.x * 8) {
    bf16_t* row = proj + (size_t)t * EVEN_IN; const int b = t / SB, j = t - b * SB;
    for (int i = 0; i < 16; ++i) { int c = i * 64 + lane; row[c] = f2bf(gelu_exact(bf2f(row[c]))); }
    for (int hh = 0; hh < 16; ++hh) {
      const int c = 1024 + hh * 64 + lane; float v = bf2f(row[c]);
      float ss = wsum(v * v); float g = sm(p, hh < 8 ? SM_BQN : SM_BKN)[lane];
      float y = v * rsqrtf(ss * (1.0f / 64) + EPS) * g;
      y = bf2f(f2bf(y));
      if (j >= NC) { const int pos = j - NC, pr = lane >> 1; const int ps = pr < 16 ? (pos >> 6) : (pos & 63); const float2 cs = t64[ps * 16 + (pr & 15)];
        const float other = shx<1>(y);
        y = (lane & 1) ? (other * cs.y + y * cs.x) : (y * cs.x - other * cs.y); }
      row[c] = f2bf(y);
    }
  }
}

DEVI void attn_row(const bf16_t* q, int dq, const bf16_t* kb, int ldk, const bf16_t* vb, int ldv, int nkeys, float scale,
                   volatile float* sc, volatile float* qs, float& o0, float& o1) {
  const int lane = ltid() & 63;
  for (int d = lane; d < dq; d += 64) qs[d] = bf2f(q[d]);
  float mx = -1e30f;
  for (int key = lane; key < nkeys; key += 64) { const bf16_t* kr = kb + (size_t)key * ldk; float dot = 0.f;
    for (int d = 0; d < dq; d += 8) { const bf16x8 kv = *(const bf16x8*)(kr + d);
#pragma unroll
      for (int e = 0; e < 8; ++e) dot += qs[d + e] * bf2f((bf16_t)kv[e]); }
    dot *= scale; sc[key] = dot; mx = fmaxf(mx, dot); }
  mx = wmax(mx); float sum = 0.f;
  for (int key = lane; key < nkeys; key += 64) { float pv = __expf(sc[key] - mx); sc[key] = pv; sum += pv; }
  sum = wsum(sum); float a0 = 0.f, a1 = 0.f;
  for (int key = 0; key < nkeys; ++key) { const float pv = sc[key]; const unsigned vv = *(const unsigned*)(vb + (size_t)key * ldv + 2 * lane);
    a0 += pv * bf2f((bf16_t)(vv & 0xffff)); a1 += pv * bf2f((bf16_t)(vv >> 16)); }
  const float inv = 1.0f / sum; o0 = a0 * inv; o1 = a1 * inv;
}
DEVI void n_attn0(const Params& p, unsigned char* smem) {
  const int wid = ltid() >> 6, lane = ltid() & 63;
  volatile float* sc = (volatile float*)(smem + wid * (2304 * 4 + 512)); volatile float* qs = sc + 2304;
  const bf16_t* proj = wsp<bf16_t>(p, OFF_PROJ); bf16_t* cat = wsp<bf16_t>(p, OFF_ACT);
  const float lam = wsp<float>(p, OFF_LAM)[0];
  for (int task = blockIdx.x * 8 + wid; task < T * 4; task += gridDim.x * 8) {
    const int t = task >> 2, h = task & 3, b = t / SB, j = t - b * SB; const int nkeys = j < NC ? NC : SB;
    const bf16_t* kbase = proj + (size_t)(b * SB) * EVEN_IN + 1536 + h * 128; const bf16_t* vbase = proj + (size_t)(b * SB) * EVEN_IN + 2048 + h * 128;
    const bf16_t* q = proj + (size_t)t * EVEN_IN + 1024 + h * 128;
    float a0, a1, b0, b1;
    attn_row(q, 64, kbase, EVEN_IN, vbase, EVEN_IN, nkeys, 0.125f, sc, qs, a0, a1);
    attn_row(q + 64, 64, kbase + 64, EVEN_IN, vbase, EVEN_IN, nkeys, 0.125f, sc, qs, b0, b1);
    float o0 = a0 - lam * b0, o1 = a1 - lam * b1;
    float ss = wsum(o0 * o0 + o1 * o1); const float r = rsqrtf(ss * (1.0f / 128) + EPS) * 0.8f;
    o0 = o0 * r * sm(p, SM_SUBLN)[2 * lane]; o1 = o1 * r * sm(p, SM_SUBLN)[2 * lane + 1];
    *(unsigned*)(cat + (size_t)t * D + 512 + h * 128 + 2 * lane) = pack2(o0, o1);
  }
}
DEVI void n_gmlp(const Params& p, unsigned char* smem) {
  const int tid = ltid(), wid = tid >> 6, lane = tid & 63;
  bf16_t* lv = (bf16_t*)smem;
  const bf16_t* proj = wsp<bf16_t>(p, OFF_PROJ); bf16_t* cat = wsp<bf16_t>(p, OFF_ACT);
  for (int ch = blockIdx.x; ch < T / 128; ch += gridDim.x) {
    __syncthreads();
    for (int r = wid; r < 128; r += 8) { const bf16_t* vr = proj + (size_t)(ch * 128 + r) * EVEN_IN + 512;
      float v[8]; float s = 0.f;
#pragma unroll
      for (int i = 0; i < 8; ++i) { v[i] = bf2f(vr[i * 64 + lane]); s += v[i]; }
      s = wsum(s); const float mu = s * (1.0f / 512); float q = 0.f;
#pragma unroll
      for (int i = 0; i < 8; ++i) { const float d = v[i] - mu; q += d * d; }
      q = wsum(q); const float rstd = rsqrtf(q * (1.0f / 512) + EPS);
#pragma unroll
      for (int i = 0; i < 8; ++i) { const int c = i * 64 + lane; lv[r * 512 + c] = f2bf((v[i] - mu) * rstd * sm(p, SM_ALNG)[c] + sm(p, SM_ALNB)[c]); } }
    __syncthreads();
    const int c = tid, g = c >> 7;
    const float* wsg = sm(p, SM_AWSF) + (size_t)g * 128 * 128;
    for (int pp = 0; pp < 128; ++pp) { float acc = 0.f; const float* wr = wsg + pp * 128;
      for (int q = 0; q < 128; ++q) acc += wr[q] * bf2f(lv[q * 512 + c]);
      acc += sm(p, SM_ABS)[g * 128 + pp];
      const size_t t = (size_t)ch * 128 + pp; const float u = bf2f(proj[t * EVEN_IN + c]);
      cat[t * D + c] = f2bf(u * acc); }
  }
}
template <int LAYER> DEVI void n_outproj(const Params& p) {
  const bf16_t* cat = wsp<bf16_t>(p, OFF_ACT); const bf16_t* w = wsp<bf16_t>(p, LAYER == 0 ? OFF_WOUT0T : OFF_WOUT1T);
  auto st1 = [&](int r, int n, float v) { const int b = r / SB, j = r - b * SB; if (LAYER == 1 && j < NC) return;
    const float* res = LAYER == 0 ? in_row(p, r) : (const float*)hid_row(p, r); float* dst = hid_row(p, r);
    dst[n] = res[n] + modv(p, LAYER, r, 2)[n] * v; };
  ngemm(T / 32, D / 32, D, [&](int r) { return cat + (size_t)r * D; }, [&](int n) { return w + (size_t)n * D; },
        [&](int r, int n0, int n1, float v0, float v1) { st1(r, n0, v0); st1(r, n1, v1); });
}

struct LCfg { int l, npb, j0, nph; };
DEVI int act_tok(const LCfg& c, int half, int tl) { const int bl = tl / c.npb, jj = tl - bl * c.npb; return (half * 8 + bl) * SB + c.j0 + jj; }
DEVI void stage_router(const Params& p, const LCfg c, unsigned char* smem) {
  const int wid = ltid() >> 6, lane = ltid() & 63, fr = lane & 15, fq = lane >> 4;
  float* lgs = (float*)smem + wid * 4096;
  int* ksl = (int*)lgs + 2048;
  const float* g = sm(p, SM_N2G + c.l * D); bf16_t* act = wsp<bf16_t>(p, OFF_ACT);
  const bf16_t* wrt = wsp<bf16_t>(p, OFF_WRT) + (size_t)c.l * NE * D; const float bias = sm(p, SM_MBIAS)[c.l * NE + lane];
  int* cnt = (int*)(p.ws + OFF_CNT) + c.l * 128; int* list = wsp<int>(p, OFF_LIST); float* topw = wsp<float>(p, OFF_TOPW);
  const int nact = c.nph, nwv = gridDim.x * 8, chunk0 = (nact + nwv - 1) / nwv, chunk = chunk0 < 32 ? chunk0 : 32;
  const bool agg = (nact == nwv * chunk);
  LAS int* blk = (LAS int*)((LAS unsigned char*)smem + 131072); LAS int* blkb = blk + 64;
  if (agg) {
    if (ltid() < 64) blk[ltid()] = 0;
    const u32x4* src = (const u32x4*)wrt;
    for (int i = ltid(); i < NE * 128; i += 512) { const int row = i >> 7, ch = i & 127; *(LAS u32x4*)((LAS unsigned char*)smem + row * 2048 + ((ch ^ (row & 7)) << 4)) = src[i]; }
    __syncthreads(); }
  for (int ga0 = (blockIdx.x * 8 + wid) * chunk; ga0 < nact; ga0 += nwv * chunk) {
    const int ntk = (nact - ga0) < chunk ? (nact - ga0) : chunk;
    f32x4 gg[4], s1v[4], s0v[4]; int curb = -1;
#pragma unroll
    for (int i = 0; i < 4; ++i) gg[i] = *(const f32x4*)(g + (i * 64 + lane) * 4);
    for (int j0 = 0; j0 < ntk; j0 += 3) {
      f32x4 v[3][4]; int tt[3];
#pragma unroll
      for (int u = 0; u < 3; ++u) { int j = j0 + u; j = j < ntk ? j : ntk - 1; const int ga = ga0 + j, half = ga / c.nph, tl = ga - half * c.nph; tt[u] = act_tok(c, half, tl);
        const bf16_t* row = wsp<bf16_t>(p, OFF_HB) + (size_t)tt[u] * D;
#pragma unroll
        for (int i = 0; i < 4; ++i) v[u][i] = bf4(*(const u32x2*)(row + (i * 64 + lane) * 4)); }
#pragma unroll
      for (int u = 0; u < 3; ++u) { float ss = 0.f;
#pragma unroll
        for (int i = 0; i < 4; ++i) ss += v[u][i][0] * v[u][i][0] + v[u][i][1] * v[u][i][1] + v[u][i][2] * v[u][i][2] + v[u][i][3] * v[u][i][3];
        const float rstd = rsqrtf(wsum_dpp(ss) * (1.0f / D) + EPS);
        const int bt = tt[u] / SB, jt = tt[u] - bt * SB, mrow = jt < NC ? 16 : bt;
        if (mrow != curb) { curb = mrow; const float* sh = modv(p, c.l, tt[u], 3); const float* sc = modv(p, c.l, tt[u], 4);
#pragma unroll
          for (int i = 0; i < 4; ++i) { s0v[i] = *(const f32x4*)(sh + (i * 64 + lane) * 4); s1v[i] = *(const f32x4*)(sc + (i * 64 + lane) * 4); } }
        if (j0 + u < ntk) {
#pragma unroll
          for (int i = 0; i < 4; ++i) { const int cc = (i * 64 + lane) * 4;
            float y[4];
#pragma unroll
            for (int q = 0; q < 4; ++q) y[q] = v[u][i][q] * rstd * gg[i][q] * (1.0f + s1v[i][q]) + s0v[i][q];
            u32x2 w; w.x = pack2(y[0], y[1]); w.y = pack2(y[2], y[3]);
            *(u32x2*)(act + (size_t)tt[u] * D + cc) = w;
            const float xs = (float)(1 << X_SHIFT); int w8 = 0;
            w8 = __builtin_amdgcn_cvt_pk_fp8_f32(__builtin_amdgcn_fmed3f(y[0] * xs, -440.f, 440.f), __builtin_amdgcn_fmed3f(y[1] * xs, -440.f, 440.f), w8, false);
            w8 = __builtin_amdgcn_cvt_pk_fp8_f32(__builtin_amdgcn_fmed3f(y[2] * xs, -440.f, 440.f), __builtin_amdgcn_fmed3f(y[3] * xs, -440.f, 440.f), w8, true);
            *(int*)(p.ws + OFF_ACT8 + (size_t)tt[u] * D + cc) = w8; } }
      }
    }
    asm volatile("s_waitcnt vmcnt(0)" ::: "memory");
    const bf16_t* ar[2];
#pragma unroll
    for (int m = 0; m < 2; ++m) { int jj = m * 16 + fr; jj = jj < ntk ? jj : 0; const int ga = ga0 + jj, half = ga / c.nph, tl = ga - half * c.nph; ar[m] = act + (size_t)act_tok(c, half, tl) * D + fq * 8; }
    const bf16_t* br = wrt + (size_t)fr * D + fq * 8;
    f32x4 acc[2][4];
#pragma unroll
    for (int m = 0; m < 2; ++m)
#pragma unroll
      for (int n = 0; n < 4; ++n) acc[m][n] = (f32x4){0.f, 0.f, 0.f, 0.f};
    if (agg) {
      const LAS unsigned char* bl = (const LAS unsigned char*)smem + fr * 2048; const int sw = fr & 7;
#pragma unroll 8
      for (int k0 = 0; k0 < D; k0 += 32) {
        bf16x8 af[2], bfr[4];
#pragma unroll
        for (int m = 0; m < 2; ++m) af[m] = *(const bf16x8*)(ar[m] + k0);
#pragma unroll
        for (int n = 0; n < 4; ++n) bfr[n] = *(const LAS bf16x8*)(bl + n * 32768 + ((((k0 >> 3) + fq) ^ sw) << 4));
#pragma unroll
        for (int m = 0; m < 2; ++m)
#pragma unroll
          for (int n = 0; n < 4; ++n) acc[m][n] = __builtin_amdgcn_mfma_f32_16x16x32_bf16(af[m], bfr[n], acc[m][n], 0, 0, 0);
      }
      __syncthreads();
    } else {
#pragma unroll 4
    for (int k0 = 0; k0 < D; k0 += 32) {
      bf16x8 af[2], bfr[4];
#pragma unroll
      for (int m = 0; m < 2; ++m) af[m] = *(const bf16x8*)(ar[m] + k0);
#pragma unroll
      for (int n = 0; n < 4; ++n) bfr[n] = *(const bf16x8*)(br + (size_t)(16 * n) * D + k0);
#pragma unroll
      for (int m = 0; m < 2; ++m)
#pragma unroll
        for (int n = 0; n < 4; ++n) acc[m][n] = __builtin_amdgcn_mfma_f32_16x16x32_bf16(af[m], bfr[n], acc[m][n], 0, 0, 0);
    }
    }
    __builtin_amdgcn_wave_barrier();
#pragma unroll
    for (int m = 0; m < 2; ++m)
#pragma unroll
      for (int n = 0; n < 4; ++n)
#pragma unroll
        for (int r = 0; r < 4; ++r) lgs[(m * 16 + 4 * fq + r) * 64 + 16 * n + fr] = acc[m][n][r];
    __builtin_amdgcn_fence(__ATOMIC_RELEASE, "wavefront"); __builtin_amdgcn_wave_barrier();
    const int half0 = ga0 / c.nph, half1 = (ga0 + ntk - 1) / c.nph;
    unsigned cm0 = 0u, cm1 = 0u;
    for (int j0 = 0; j0 < ntk; j0 += 3) {
      float wq[3]; int kq[3];
#pragma unroll
      for (int u = 0; u < 3; ++u) { const int j = (j0 + u) < ntk ? (j0 + u) : j0;
        const float lg = ((volatile float*)lgs)[j * 64 + lane];
        const float score = __builtin_amdgcn_rcpf(1.0f + __expf(-lg)); const float sel = score + bias;
        const float m1 = max8_dpp(sel);
        const unsigned long long isb = __ballot(sel == m1); const int gbase = lane & ~7; const unsigned gm = (unsigned)((isb >> gbase) & 0xffull);
        const int first = gbase + __builtin_ctz(gm);
        const float m2 = max8_dpp((lane == first) ? -INFINITY : sel);
        const float gs = m1 + m2; const int gi = lane >> 3; int grank = 0;
#pragma unroll
        for (int g2 = 0; g2 < 8; ++g2) { const float og = rlane(gs, g2 * 8); grank += (og > gs || (og == gs && g2 < gi)) ? 1 : 0; }
        float cur = grank < 4 ? sel : -INFINITY;
        int myk = -1; float wsumv = 0.f;
#pragma unroll
        for (int kk = 0; kk < TOPK; ++kk) { const float mxv = wmax_dpp(cur); const unsigned long long bm = __ballot(cur == mxv); const int win = __builtin_ctzll(bm);
          if (lane == win) { myk = kk; cur = -INFINITY; } wsumv += rlane(score, win); }
        wq[u] = score * __builtin_amdgcn_rcpf(wsumv) * 2.5f; kq[u] = myk; }
#pragma unroll
      for (int u = 0; u < 3; ++u) { const int j = j0 + u;
        if (j < ntk) { ((volatile float*)lgs)[j * 64 + lane] = wq[u]; ((volatile int*)ksl)[j * 64 + lane] = kq[u];
          const bool inh0 = (ga0 + j) / c.nph == half0;
          if (kq[u] >= 0) { if (inh0) cm0 |= 1u << j; else cm1 |= 1u << j; } } }
    }
    int base0 = 0, base1 = 0;
    if (agg) {
      const int n0 = __builtin_popcount(cm0); int wb = 0;
      if (n0) wb = __atomic_fetch_add(&blk[lane], n0, __ATOMIC_RELAXED);
      __syncthreads();
      if (wid == 0) { const int tot = blk[lane]; int gb = 0; if (tot) gb = atomicAdd(&cnt[half0 * 64 + lane], tot); blkb[lane] = gb; }
      __syncthreads();
      base0 = blkb[lane] + wb;
    } else {
      if (cm0) base0 = atomicAdd(&cnt[half0 * 64 + lane], __builtin_popcount(cm0));
      if (cm1) base1 = atomicAdd(&cnt[half1 * 64 + lane], __builtin_popcount(cm1));
    }
    for (int j = 0; j < ntk; ++j) {
      const int myk = ((volatile int*)ksl)[j * 64 + lane];
      if (myk >= 0) { const int ga = ga0 + j, half = ga / c.nph, tl = ga - half * c.nph; const unsigned below = (1u << j) - 1u;
        const int pos = half == half0 ? base0 + __builtin_popcount(cm0 & below) : base1 + __builtin_popcount(cm1 & below);
        list[((size_t)(half * 64 + lane)) * LCAP + pos] = tl * 6 + myk; topw[(size_t)ga * 6 + myk] = ((volatile float*)lgs)[j * 64 + lane]; wsp<int>(p, OFF_TOPP)[(size_t)ga * 6 + myk] = (lane << 24) | pos; }
    }
    __builtin_amdgcn_wave_barrier();
  }
}

DEVI void n_moe_gu(const Params& p, const LCfg c, int half) {
  const bf16_t* act = wsp<bf16_t>(p, OFF_ACT); bf16_t* hid = wsp<bf16_t>(p, OFF_HID);
  const int* cnt = (const int*)(p.ws + OFF_CNT) + c.l * 128 + half * 64; const int* list = wsp<int>(p, OFF_LIST) + (size_t)half * 64 * LCAP;
  int off = 0;
  for (int e = 0; e <= NE; ++e) {
    const int n = e < NE ? cnt[e] : c.nph;
    const bf16_t* w = e < NE ? wsp<bf16_t>(p, OFF_EGU) + (size_t)e * 512 * D : wsp<bf16_t>(p, OFF_SHGU) + (size_t)c.l * 512 * D;
    const int* le = list + (size_t)e * LCAP;
    ngemm((n + 31) / 32, DE / 16, D,
          [&](int r) -> const bf16_t* { if (r >= n) return nullptr; const int tl = e < NE ? le[r] / 6 : r; return act + (size_t)act_tok(c, half, tl) * D; },
          [&](int nn) { const int tn = nn >> 5, i = (nn >> 4) & 1, fr = nn & 15; return w + (size_t)(i * 256 + tn * 16 + fr) * D; },
          [&](int r, int n0, int n1, float v0, float v1) { if (r < n) hid[(size_t)(off + r) * DE + (n0 >> 5) * 16 + (n0 & 15)] = f2bf(silu(v0) * v1); });
    off += n;
  }
}
DEVI void n_moe_down(const Params& p, const LCfg c, int half) {
  const bf16_t* hid = wsp<bf16_t>(p, OFF_HID); bf16_t* slot = wsp<bf16_t>(p, OFF_SLOT);
  const int* cnt = (const int*)(p.ws + OFF_CNT) + c.l * 128 + half * 64; const int* list = wsp<int>(p, OFF_LIST) + (size_t)half * 64 * LCAP;
  int off = 0;
  for (int e = 0; e <= NE; ++e) {
    const int n = e < NE ? cnt[e] : c.nph;
    const bf16_t* w = e < NE ? wsp<bf16_t>(p, OFF_ED) + (size_t)e * D * DE : wsp<bf16_t>(p, OFF_SHD) + (size_t)c.l * D * DE;
    const int* le = list + (size_t)e * LCAP;
    auto st1 = [&](int r, int nn, float v) { if (r >= n) return;
      if (e < NE) slot[(size_t)le[r] * D + nn] = f2bf(v);
      else { const int t = act_tok(c, half, r); float* h = hid_row(p, t); h[nn] += modv(p, c.l, t, 5)[nn] * v; } };
    ngemm((n + 31) / 32, D / 32, DE,
          [&](int r) -> const bf16_t* { return r < n ? hid + (size_t)(off + r) * DE : nullptr; },
          [&](int nn) { return w + (size_t)nn * DE; },
          [&](int r, int n0, int n1, float v0, float v1) { st1(r, n0, v0); st1(r, n1, v1); });
    off += n;
  }
}
template <bool FUSE_NORM1> DEVI void stage_combine(const Params& p, const LCfg c, int half, unsigned char* smem, float dscale = 1.0f) {
  const int wid = ltid() >> 6, lane = ltid() & 63;
  int* off = (int*)smem;
  __syncthreads();
  if (ltid() == 0) { const int* cnt = (const int*)(p.ws + OFF_CNT) + c.l * 128 + half * 64; int o = 0; for (int e = 0; e < NE; ++e) { off[e] = o; o += cnt[e]; } off[NE] = o; }
  __syncthreads();
  const unsigned char* slot = p.ws + OFF_SLOT; const float* topw = wsp<float>(p, OFF_TOPW); const int* topp = wsp<int>(p, OFF_TOPP);
  for (int tl = blockIdx.x * 8 + wid; tl < c.nph; tl += gridDim.x * 8) {
    const int t = act_tok(c, half, tl); bf16_t* h = wsp<bf16_t>(p, OFF_HB) + (size_t)t * D; const float* g5 = modv(p, c.l, t, 5);
    float* orow = p.out + ((size_t)((t / SB) * S + (t % SB) - NC)) * D;
    const float* w = topw + ((size_t)(half * c.nph + tl)) * 6; const int* pp = topp + ((size_t)(half * c.nph + tl)) * 6;
    float wk[7]; size_t ro[7];
#pragma unroll
    for (int k = 0; k < 6; ++k) { wk[k] = w[k]; const int q = pp[k]; ro[k] = (size_t)(off[q >> 24] + (q & 0xffffff)) * D; }
    wk[6] = 1.0f; ro[6] = (size_t)(off[NE] + tl) * D;
    unsigned sv[4][7]; f32x4 hv[4];
#pragma unroll
    for (int i = 0; i < 4; ++i) { const int cc = (i * 64 + lane) * 4; hv[i] = bf4(*(const u32x2*)(h + cc));
#pragma unroll
      for (int k = 0; k < 7; ++k) sv[i][k] = *(const unsigned*)(slot + ro[k] + cc); }
#pragma unroll
    for (int i = 0; i < 4; ++i) { const int cc = (i * 64 + lane) * 4; f32x4 acc = {0.f, 0.f, 0.f, 0.f};
#pragma unroll
      for (int k = 0; k < 7; ++k) { const auto lo = __builtin_amdgcn_cvt_pk_f32_fp8((int)sv[i][k], false); const auto hi = __builtin_amdgcn_cvt_pk_f32_fp8((int)sv[i][k], true);
        acc[0] += wk[k] * lo[0]; acc[1] += wk[k] * lo[1]; acc[2] += wk[k] * hi[0]; acc[3] += wk[k] * hi[1]; }
      const f32x4 gg = *(const f32x4*)(g5 + cc);
#pragma unroll
      for (int q = 0; q < 4; ++q) hv[i][q] += gg[q] * acc[q] * dscale;
      if (FUSE_NORM1) { u32x2 w; w.x = pack2(hv[i][0], hv[i][1]); w.y = pack2(hv[i][2], hv[i][3]); *(u32x2*)(h + cc) = w; }
      else *(f32x4*)(orow + cc) = hv[i]; }
    if (FUSE_NORM1) {
      float ss = 0.f;
#pragma unroll
      for (int i = 0; i < 4; ++i) ss += hv[i][0] * hv[i][0] + hv[i][1] * hv[i][1] + hv[i][2] * hv[i][2] + hv[i][3] * hv[i][3];
      const float rstd = rsqrtf(wsum_dpp(ss) * (1.0f / D) + EPS);
      const float* g1 = sm(p, SM_N1G + (c.l + 1) * D); const float* sh = modv(p, c.l + 1, t, 0); const float* sc = modv(p, c.l + 1, t, 1);
      bf16_t* act = wsp<bf16_t>(p, OFF_ACT);
#pragma unroll
      for (int i = 0; i < 4; ++i) { const int cc = (i * 64 + lane) * 4; const f32x4 gg = *(const f32x4*)(g1 + cc), s1 = *(const f32x4*)(sc + cc), s0 = *(const f32x4*)(sh + cc);
        float y[4];
#pragma unroll
        for (int q = 0; q < 4; ++q) y[q] = hv[i][q] * rstd * gg[q] * (1.0f + s1[q]) + s0[q];
        if (IN1_FP8) { const float xs = (float)(1 << X_SHIFT); int w8 = 0;
          w8 = __builtin_amdgcn_cvt_pk_fp8_f32(__builtin_amdgcn_fmed3f(y[0] * xs, -440.f, 440.f), __builtin_amdgcn_fmed3f(y[1] * xs, -440.f, 440.f), w8, false);
          w8 = __builtin_amdgcn_cvt_pk_fp8_f32(__builtin_amdgcn_fmed3f(y[2] * xs, -440.f, 440.f), __builtin_amdgcn_fmed3f(y[3] * xs, -440.f, 440.f), w8, true);
          *(int*)(p.ws + OFF_ACT8 + (size_t)t * D + cc) = w8; }
        else { u32x2 w; w.x = pack2(y[0], y[1]); w.y = pack2(y[2], y[3]);
          *(u32x2*)(act + (size_t)t * D + cc) = w; } }
    }
  }
}

DEVI void n_inproj1(const Params& p) {
  const bf16_t* act = wsp<bf16_t>(p, OFF_ACT); const bf16_t* w = wsp<bf16_t>(p, OFF_WQKV1T); bf16_t* proj = wsp<bf16_t>(p, OFF_PROJ);
  ngemm(T / 32, ODD_IN / 32, D, [&](int r) { return act + (size_t)r * D; }, [&](int n) { return w + (size_t)n * D; },
        [&](int r, int n0, int n1, float v0, float v1) { proj[(size_t)r * ODD_IN + n0] = f2bf(v0); proj[(size_t)r * ODD_IN + n1] = f2bf(v1); });
}
DEVI void n_post1(const Params& p) {
  const int wid = ltid() >> 6, lane = ltid() & 63;
  bf16_t* proj = wsp<bf16_t>(p, OFF_PROJ); const float2* t128 = wsp<float2>(p, OFF_TAB128);
  for (int t = blockIdx.x * 8 + wid; t < T; t += gridDim.x * 8) {
    bf16_t* row = proj + (size_t)t * ODD_IN; const int b = t / SB, j = t - b * SB;
    for (int hh = 0; hh < 10; ++hh) {
      unsigned* pp = (unsigned*)(row + hh * 128 + 2 * lane); const unsigned u = *pp;
      float x1 = __uint_as_float(u << 16), x2 = __uint_as_float(u & 0xffff0000u);
      const float ss = wsum(x1 * x1 + x2 * x2); const float r = rsqrtf(ss * (1.0f / 128) + EPS);
      const float* g = sm(p, hh < 8 ? SM_CQN : SM_CKN);
      x1 = x1 * r * g[2 * lane]; x2 = x2 * r * g[2 * lane + 1];
      if (j >= NC) { const int pos = j - NC; const int ps = lane < 32 ? (pos >> 6) : (pos & 63); const float2 cs = t128[ps * 32 + (lane & 31)];
        const float y1 = x1 * cs.x - x2 * cs.y, y2 = x1 * cs.y + x2 * cs.x; x1 = y1; x2 = y2; }
      *pp = pack2(x1, x2);
    }
  }
}
DEVI void n_attn1(const Params& p, unsigned char* smem) {
  const int wid = ltid() >> 6, lane = ltid() & 63;
  volatile float* sc = (volatile float*)(smem + wid * (2304 * 4 + 512)); volatile float* qs = sc + 2304;
  const bf16_t* proj = wsp<bf16_t>(p, OFF_PROJ); bf16_t* att = wsp<bf16_t>(p, OFF_ACT);
  for (int task = blockIdx.x * 8 + wid; task < TX * 8; task += gridDim.x * 8) {
    const int tx = task >> 3, h = task & 7, b = tx / S, i = tx - b * S, t = b * SB + NC + i, kvh = h >> 2;
    const bf16_t* kbase = proj + (size_t)(b * SB) * ODD_IN + 1024 + kvh * 128; const bf16_t* vbase = kbase + 256;
    float o0, o1;
    attn_row(proj + (size_t)t * ODD_IN + h * 128, 128, kbase, ODD_IN, vbase, ODD_IN, SB, 0.08838834764831845f, sc, qs, o0, o1);
    *(unsigned*)(att + (size_t)t * D + h * 128 + 2 * lane) = pack2(o0, o1);
  }
}

namespace fg {
constexpr int BM = 256, BK = 64, HALF = 128, HTB = HALF * BK * 2, STAGE_BYTES = 8 * HTB;
constexpr int LDS_XCH = STAGE_BYTES, LDS_TAB = STAGE_BYTES + 4096, LDS_ROPE = STAGE_BYTES + 6144, LDS_GAIN = LDS_ROPE + 16384;
DEVI int lds_byte(int r, int c) { const int st = (r >> 4) * 2 + (c >> 5), rr = r & 15, cc = c & 31, ob = rr * 64 + cc * 2; return st * 1024 + (ob ^ (((ob >> 9) & 1) << 5)); }
DEVI void stage_rc(int b, int& R, int& C) { const int st = b / 1024, sb = b % 1024, swz = sb ^ (((sb >> 9) & 1) << 5); R = (st >> 1) * 16 + swz / 64; C = (st & 1) * 32 + (swz % 64) / 2; }
DEVI int perm32(int rho) { const int n = rho >> 4, i = rho & 15; return 8 * (i >> 2) + 4 * n + (i & 3); }
DEVI unsigned cvt_pk_bf16(float lo, float hi) { unsigned r; asm volatile("v_cvt_pk_bf16_f32 %0, %1, %2" : "=v"(r) : "v"(lo), "v"(hi)); return r; }
typedef float f32x2 __attribute__((ext_vector_type(2)));
DEVI f32x2 gelu_pk(f32x2 v) {
  const f32x2 av = __builtin_elementwise_abs(v), d = av * 0.2316418882f + 1.0f;
  f32x2 t; t.x = __builtin_amdgcn_rcpf(d.x); t.y = __builtin_amdgcn_rcpf(d.y);
  f32x2 q = t * 0.5307027145f + (-0.7265760135f); q = q * t + 0.7107068705f; q = q * t + (-0.142248368f); q = q * t + 0.127414796f; q = q * t;
  const f32x2 s = (v * v) * (-0.72134752044f);
  f32x2 e; e.x = __builtin_amdgcn_exp2f(s.x); e.y = __builtin_amdgcn_exp2f(s.y);
  const f32x2 m = v * (q * e), r = v - m;
  f32x2 o; o.x = v.x < 0.f ? m.x : r.x; o.y = v.y < 0.f ? m.y : r.y; return o;
}
struct Unit { const char* A; const char* B0; const char* B1; int pm, pn, e, cnt, off; };
typedef f32x4 Acc[2][2][4][2];
typedef int v8i_t __attribute__((ext_vector_type(8)));
template <int K> DEVI unsigned boff_m1(int R, int C) { return (unsigned)((64 * (R >> 5) + perm32(R & 31)) * K + C) * 2u; }
template <int K> DEVI unsigned boff_m2(int R, int C) { return (unsigned)(((R & ~31) + perm32(R & 31)) * K + C) * 2u; }

template <class Job>
DEVI void gemm_phase(LAS unsigned char* lds, Job& J) {
  constexpr int K = Job::K, nt = K / BK;
  const int tid = ltid(), wid = __builtin_amdgcn_readfirstlane(tid >> 6), lane = tid & 63, wr = wid >> 2, wc = wid & 3, fr = lane & 15, fq = lane >> 4;
  int Rr[2], Cc[2];
#pragma unroll
  for (int i = 0; i < 2; ++i) stage_rc(tid * 16 + i * 8192, Rr[i], Cc[i]);
  unsigned voffB[2];
#pragma unroll
  for (int i = 0; i < 2; ++i) voffB[i] = J.boff(Rr[i], Cc[i]);
  unsigned cv[2][2]; unsigned nv[2][2];
  constexpr size_t AH = Job::GATHER ? 0 : (size_t)HALF * K * 2;
#define CV1 cv[Job::GATHER ? 1 : 0]
  constexpr size_t kstep = (size_t)(BK * 2);
  const unsigned ldsw = (unsigned)wid * 1024u;
  const int aoff = lds_byte(wr * 64 + fr, fq * 8), boff = lds_byte(wc * 32 + fr, fq * 8);
  LAS unsigned char* abase = lds + aoff; LAS unsigned char* bbase = lds + 4 * HTB + boff;
  asm volatile("" : "+v"(abase), "+v"(bbase));
#define FG_SA(b, h) (((b) * 2 + (h)) * HTB)
#define FG_SB(b, h) ((4 + (b) * 2 + (h)) * HTB)
#define FG_STAGE(bufoff, gbase, voff) do { _Pragma("unroll") for (int _i = 0; _i < 2; ++_i) { \
    const unsigned _la = (unsigned)(uintptr_t)(lds + ldsw) + (unsigned)((bufoff) + _i * 8192); const char* _gb = (const char*)(gbase); \
    asm volatile("s_mov_b32 m0, %0\n\ts_nop 0\n\tglobal_load_lds_dwordx4 %1, %2" :: "s"(_la), "v"((voff)[_i]), "s"(_gb) : "memory", "m0"); } } while (0)
#define FG_LDA(dst, b, h) do { _Pragma("unroll") for (int m = 0; m < 4; ++m) _Pragma("unroll") for (int k = 0; k < 2; ++k) dst[m][k] = *(const LAS bf16x8*)(abase + (FG_SA(b, h) + m * 2048 + k * 1024)); } while (0)
#define FG_LDB(dst, b, h) do { _Pragma("unroll") for (int n = 0; n < 2; ++n) _Pragma("unroll") for (int k = 0; k < 2; ++k) dst[n][k] = *(const LAS bf16x8*)(bbase + (FG_SB(b, h) - 4 * HTB + n * 2048 + k * 1024)); } while (0)
#define FG_MMA(ai, bj, At, Bt) do { __builtin_amdgcn_s_setprio(1); _Pragma("unroll") for (int m = 0; m < 4; ++m) _Pragma("unroll") for (int n = 0; n < 2; ++n) _Pragma("unroll") for (int k = 0; k < 2; ++k) \
    acc[ai][bj][m][n] = __builtin_amdgcn_mfma_f32_16x16x32_bf16(Bt[n][k], At[m][k], acc[ai][bj][m][n], 0, 0, 0); __builtin_amdgcn_s_setprio(0); } while (0)
#define FG_MMA8(ai, bj, At, Bt) do { __builtin_amdgcn_s_setprio(1); _Pragma("unroll") for (int m = 0; m < 4; ++m) _Pragma("unroll") for (int n = 0; n < 2; ++n) { \
      v8i_t _b, _a; { const u32x4 b0 = *(const u32x4*)&Bt[n][0], b1 = *(const u32x4*)&Bt[n][1], a0 = *(const u32x4*)&At[m][0], a1 = *(const u32x4*)&At[m][1]; \
        _b = (v8i_t){(int)b0[0], (int)b0[1], (int)b0[2], (int)b0[3], (int)b1[0], (int)b1[1], (int)b1[2], (int)b1[3]}; _a = (v8i_t){(int)a0[0], (int)a0[1], (int)a0[2], (int)a0[3], (int)a1[0], (int)a1[1], (int)a1[2], (int)a1[3]}; } \
      acc[ai][bj][m][n] = __builtin_amdgcn_mfma_scale_f32_16x16x128_f8f6f4(_b, _a, acc[ai][bj][m][n], 0, 0, 0, Job::SCALE, 0, Job::SCALE); } __builtin_amdgcn_s_setprio(0); } while (0)
#define FG_WAIT_V(n) asm volatile("s_waitcnt vmcnt(" #n ")" ::: "memory")
#define FG_WAIT_L(n) asm volatile("s_waitcnt lgkmcnt(" #n ")" ::: "memory")
#define FG_MM(ai, bj, At, Bt) do { if constexpr (Job::FP8) FG_MMA8(ai, bj, At, Bt); else FG_MMA(ai, bj, At, Bt); } while (0)
#define FG_BAR __builtin_amdgcn_s_barrier()
#define FG_SCHED __builtin_amdgcn_sched_barrier(0)
  Unit cur, nxt;
  if (!J.next(cur)) return;
  Acc acc;
#pragma unroll
  for (int a = 0; a < 2; ++a)
#pragma unroll
    for (int b = 0; b < 2; ++b)
#pragma unroll
      for (int m = 0; m < 4; ++m)
#pragma unroll
        for (int n = 0; n < 2; ++n) acc[a][b][m][n] = (f32x4){0.f, 0.f, 0.f, 0.f};
  bf16x8 At[4][2], B0[2][2], B1[2][2];
  J.aoffs(cur, Rr, Cc, cv);
  asm volatile("s_waitcnt vmcnt(0)" ::: "memory");
  FG_STAGE(FG_SB(0, 0), cur.B0, voffB); FG_STAGE(FG_SA(0, 0), cur.A, cv[0]); FG_STAGE(FG_SB(0, 1), cur.B1, voffB); FG_STAGE(FG_SA(0, 1), cur.A + AH, CV1);
  if (wr == 1) FG_BAR;
  FG_WAIT_V(4); FG_BAR;
  FG_STAGE(FG_SB(1, 0), cur.B0 + kstep, voffB); FG_STAGE(FG_SA(1, 0), cur.A + kstep, cv[0]); FG_STAGE(FG_SB(1, 1), cur.B1 + kstep, voffB);
  FG_WAIT_V(6); FG_BAR;
  for (;;) {
    const bool has_next = J.next(nxt);
    const char* nA = has_next ? nxt.A : cur.A; const char* nB0 = has_next ? nxt.B0 : cur.B0; const char* nB1 = has_next ? nxt.B1 : cur.B1;
    for (int t = 0; t < nt; t += 2) {
      const bool last = (t == nt - 2);
      const char* a1 = cur.A + (size_t)(t + 1) * kstep;
      const char* a2 = last ? nA : cur.A + (size_t)(t + 2) * kstep;
      const char* b20 = last ? nB0 : cur.B0 + (size_t)(t + 2) * kstep; const char* b21 = last ? nB1 : cur.B1 + (size_t)(t + 2) * kstep;
      const char* a3 = a2 + kstep; const char* b30 = b20 + kstep; const char* b31 = b21 + kstep;
      asm volatile("" : "+s"(a1), "+s"(a2), "+s"(a3), "+s"(b20), "+s"(b21), "+s"(b30), "+s"(b31));
      if constexpr (Job::GATHER) { if (last && has_next) { J.aoffs(nxt, Rr, Cc, nv); asm volatile("s_waitcnt vmcnt(0)" ::: "memory"); } }
      FG_LDB(B0, 0, 0); FG_SCHED; FG_LDA(At, 0, 0); FG_STAGE(FG_SA(1, 1), a1 + AH, CV1);
      if constexpr (Job::GATHER) { if (last && has_next) { cv[0][0] = nv[0][0]; cv[0][1] = nv[0][1]; cv[1][0] = nv[1][0]; cv[1][1] = nv[1][1]; } }
      FG_WAIT_L(8); FG_BAR; FG_WAIT_L(0); FG_MM(0, 0, At, B0); FG_BAR; FG_SCHED;
      FG_LDB(B1, 0, 1); FG_STAGE(FG_SB(0, 0), b20, voffB);
      FG_BAR; FG_WAIT_L(0); FG_MM(0, 1, At, B1); FG_BAR;
      FG_LDA(At, 0, 1); FG_STAGE(FG_SA(0, 0), a2, cv[0]);
      FG_BAR; FG_WAIT_L(0); FG_MM(1, 0, At, B0); FG_BAR; FG_SCHED;
      FG_STAGE(FG_SB(0, 1), b21, voffB);
      FG_WAIT_V(6); FG_BAR; FG_MM(1, 1, At, B1); FG_BAR;
      FG_LDB(B0, 1, 0); FG_SCHED; FG_LDA(At, 1, 0); FG_STAGE(FG_SA(0, 1), a2 + AH, CV1);
      FG_WAIT_L(8); FG_BAR; FG_WAIT_L(0); FG_MM(0, 0, At, B0); FG_BAR; FG_SCHED;
      FG_LDB(B1, 1, 1); FG_STAGE(FG_SB(1, 0), b30, voffB);
      FG_BAR; FG_WAIT_L(0); FG_MM(0, 1, At, B1); FG_BAR;
      FG_LDA(At, 1, 1); FG_STAGE(FG_SA(1, 0), a3, cv[0]);
      FG_BAR; FG_WAIT_L(0); FG_MM(1, 0, At, B0); FG_BAR; FG_SCHED;
      FG_STAGE(FG_SB(1, 1), b31, voffB);
      FG_WAIT_V(6); FG_BAR; FG_MM(1, 1, At, B1); FG_BAR;
    }
    if (wr == 0) FG_BAR;
    { int l2; asm volatile("v_mbcnt_lo_u32_b32 %0, -1, 0\n\tv_mbcnt_hi_u32_b32 %0, -1, %0" : "=v"(l2));
      J.epilogue(acc, cur, wr, wc, l2 & 15, l2 >> 4, lds); }
    if (!has_next) break;
#pragma unroll
    for (int a = 0; a < 2; ++a)
#pragma unroll
      for (int b = 0; b < 2; ++b)
#pragma unroll
        for (int m = 0; m < 4; ++m)
#pragma unroll
          for (int n = 0; n < 2; ++n) acc[a][b][m][n] = (f32x4){0.f, 0.f, 0.f, 0.f};
    cur = nxt;
    if (wr == 1) FG_BAR;
  }
  FG_WAIT_V(0);
  FG_BAR;
#undef CV1
#undef FG_SA
#undef FG_SB
#undef FG_STAGE
#undef FG_LDA
#undef FG_LDB
#undef FG_MMA
#undef FG_MMA8
#undef FG_MM
#undef FG_WAIT_V
#undef FG_WAIT_L
#undef FG_BAR
#undef FG_SCHED
}

DEVI bool dense_decode(long L, int nM, int nN, int& pm, int& pn) {
  const int nwg = nM * nN; if (L >= nwg) return false;
  int wgid = (int)L; { const int q = nwg / 8, r = nwg % 8, xcd = wgid % 8, off = wgid / 8; wgid = (xcd < r ? xcd * (q + 1) : r * (q + 1) + (xcd - r) * q) + off; }
  const int nig = 8 * nN, gid = wgid / nig, fm = gid * 8, gsz = (nM - fm) < 8 ? (nM - fm) : 8;
  pm = fm + ((wgid % nig) % gsz); pn = (wgid % nig) / gsz; return true;
}
template <int K> DEVI void dense_aoffs(const int (&Rr)[2], const int (&Cc)[2], unsigned (&v)[2][2]) {
#pragma unroll
  for (int i = 0; i < 2; ++i) { v[0][i] = (unsigned)(Rr[i] * K + Cc[i]) * 2u; v[1][i] = 0u; }
}


struct Slab { LAS unsigned char* w0; LAS unsigned char* wf; LAS unsigned char* r0; };
DEVI Slab slab_init(LAS unsigned char* lds, int wid, int fr, int fq) {
  Slab s; LAS unsigned char* b = lds + 3 * HTB + wid * 1024;
  s.w0 = b + fr * 64 + fq * 16; s.wf = b + (fq >> 1) * 8192 + fr * 64 + (fq & 1) * 32; s.r0 = b + (fq * 16 + fr) * 16; return s; }
DEVI void slab_x16(const Slab& s, u32x4 a, u32x4 b, u32x4& ra, u32x4& rb) { *(LAS u32x4*)s.w0 = a; *(LAS u32x4*)(s.w0 + 8192) = b; ra = *(LAS u32x4*)s.r0; rb = *(LAS u32x4*)(s.r0 + 8192); }
DEVI void slab_x16(const Slab& s, u32x4 a, u32x4& ra) { *(LAS u32x4*)s.w0 = a; ra = *(LAS u32x4*)s.r0; }
DEVI void slab_x32(const Slab& s, f32x4 a, f32x4 b, f32x4& ra, f32x4& rb) { *(LAS f32x4*)s.wf = a; *(LAS f32x4*)(s.wf + 16) = b; ra = *(LAS f32x4*)s.r0; rb = *(LAS f32x4*)(s.r0 + 8192); }

template <int LAYER> struct JobOut {
  static constexpr bool FP8 = LAYER == 0 ? OUT0_FP8 : OUT1_FP8;
  static constexpr int K = FP8 ? D / 2 : D; static constexpr bool GATHER = false;
  static constexpr int SCALE = 0x01010101 * (127 - (WQ_SHIFT + A_SHIFT) / 2); static_assert((WQ_SHIFT + A_SHIFT) % 2 == 0, "");
  const Params& p; int i, c, G;
  DEVI JobOut(const Params& p_) : p(p_), i(0), c(vbid()), G(gridDim.x) {}
  DEVI unsigned boff(int R, int C) const { return boff_m2<K>(R, C); }
  DEVI bool next(Unit& u) {
    for (;;) { int pm, pn; if (!dense_decode((long)i * G + c, T / 256, D / 256, pm, pn)) return false; ++i;
      if (LAYER == 1 && pm % 9 == 0) continue;
      u.pm = pm; u.pn = pn; u.A = (const char*)(p.ws + (FP8 ? OFF_ACT8 : OFF_ACT)) + (size_t)pm * 256 * K * 2;
      u.B0 = (const char*)wsp<bf16_t>(p, LAYER == 0 ? OFF_WOUT0T : OFF_WOUT1T) + (size_t)(256 * pn) * K * 2; u.B1 = u.B0 + (size_t)128 * K * 2; return true; }
  }
  DEVI void aoffs(const Unit&, const int (&Rr)[2], const int (&Cc)[2], unsigned (&v)[2][2]) const { dense_aoffs<K>(Rr, Cc, v); }
  DEVI void epilogue(const Acc& acc, const Unit& u, int wr, int wc, int fr, int fq, LAS unsigned char* lds) const {
    asm volatile("" : "+v"(fr), "+v"(fq));
    const int t0 = u.pm * 256;
    const float* res = in_row(p, t0); bf16_t* dst = wsp<bf16_t>(p, OFF_HB) + (size_t)t0 * D;
    const float* gate = modv(p, LAYER, t0, 2);
    const int col0 = u.pn * 256 + wc * 32 + 8 * fq, lane = fq * 16 + fr;
    const Slab sl = slab_init(lds, wr * 4 + wc, fr, fq);
    const size_t rb = (size_t)(wr * 64 + (lane >> 2)) * D + u.pn * 256 + wc * 32 + 4 * (lane & 3);
    res += rb; dst += rb;
    asm volatile("" : "+v"(res), "+v"(dst));
    f32x4 gv[2][2];
#pragma unroll
    for (int bj = 0; bj < 2; ++bj)
#pragma unroll
      for (int n = 0; n < 2; ++n) gv[bj][n] = *(const f32x4*)(gate + col0 + bj * 128 + 4 * n);
#pragma unroll
    for (int ai = 0; ai < 2; ++ai) {
      f32x4 r4[4][2][2];
#pragma unroll
      for (int m = 0; m < 4; ++m) { const size_t ro = (size_t)(ai * 128 + m * 16) * D;
#pragma unroll
        for (int bj = 0; bj < 2; ++bj) {
          if (LAYER == 0) { r4[m][bj][0] = *(const f32x4*)(res + ro + bj * 128); r4[m][bj][1] = *(const f32x4*)(res + ro + bj * 128 + 16); }
          else { r4[m][bj][0] = bf4(*(const u32x2*)(dst + ro + bj * 128)); r4[m][bj][1] = bf4(*(const u32x2*)(dst + ro + bj * 128 + 16)); } } }
#pragma unroll
      for (int m = 0; m < 4; ++m) { const size_t ro = (size_t)(ai * 128 + m * 16) * D;
#pragma unroll
        for (int bj = 0; bj < 2; ++bj) { f32x4 x0, x1; slab_x32(sl, gv[bj][0] * acc[ai][bj][m][0], gv[bj][1] * acc[ai][bj][m][1], x0, x1);
          x0 += r4[m][bj][0]; x1 += r4[m][bj][1];
          u32x2 w0, w1; w0.x = pack2(x0[0], x0[1]); w0.y = pack2(x0[2], x0[3]); w1.x = pack2(x1[0], x1[1]); w1.y = pack2(x1[2], x1[3]);
          *(u32x2*)(dst + ro + bj * 128) = w0; *(u32x2*)(dst + ro + bj * 128 + 16) = w1; } }
      asm volatile("" ::: "memory"); }
  }
};

DEVI void load_rope_lds(const Params& p, size_t tab_off, int nrope, int gq, int gk, int ng, LAS unsigned char* lds) {
  const int tid = ltid(); __syncthreads();
  const f32x4* src = (const f32x4*)(p.ws + tab_off); LAS f32x4* dst = (LAS f32x4*)(lds + LDS_ROPE);
  for (int i = tid; i < nrope; i += 512) dst[i] = src[i];
  LAS float* g = (LAS float*)(lds + LDS_GAIN);
  if (tid < 2 * ng) g[tid] = tid < ng ? sm(p, gq)[tid] : sm(p, gk)[tid - ng];
  __syncthreads();
}
struct JobIn0 {
  static constexpr int K = IN0_FP8 ? D / 2 : D; static constexpr bool GATHER = false, FP8 = IN0_FP8;
  static constexpr int SCALE = 0x01010101 * (127 - (WQ_SHIFT + X_SHIFT) / 2);
  const Params& p; int i, c, G; int dry;
  DEVI JobIn0(const Params& p_, int dry_ = 0) : p(p_), i(0), c(vbid()), G(gridDim.x), dry(dry_) {}
  DEVI unsigned boff(int R, int C) const { return boff_m1<K>(R, C); }
  DEVI bool next(Unit& u) {
    int pm, pn; if (!dense_decode((long)i * G + c, T / 256, EVEN_IN / 256, pm, pn)) return false; ++i;
    u.pm = pm; u.pn = pn; u.A = (const char*)(p.ws + (IN0_FP8 ? OFF_ACT8 : OFF_ACT)) + (size_t)pm * 256 * K * 2;
    u.B0 = (const char*)wsp<bf16_t>(p, OFF_WIN0T) + (size_t)(256 * pn) * K * 2; u.B1 = u.B0 + (size_t)32 * K * 2; return true;
  }
  DEVI void aoffs(const Unit&, const int (&Rr)[2], const int (&Cc)[2], unsigned (&v)[2][2]) const { dense_aoffs<K>(Rr, Cc, v); }
  DEVI void epilogue(const Acc& acc, const Unit& u, int wr, int wc, int fr, int fq, LAS unsigned char* lds) const {
    asm volatile("" : "+v"(fr), "+v"(fq));
    if (dry == 1) {
#pragma unroll
      for (int ai = 0; ai < 2; ++ai)
#pragma unroll
        for (int bj = 0; bj < 2; ++bj)
#pragma unroll
          for (int m = 0; m < 4; ++m)
#pragma unroll
            for (int n = 0; n < 2; ++n) asm volatile("" :: "v"(acc[ai][bj][m][n]));
      return; }
    const int lane = fq * 16 + fr; const Slab sl = slab_init(lds, wr * 4 + wc, fr, fq);
    bf16_t* outp = wsp<bf16_t>(p, OFF_PROJ) + (size_t)(u.pm * 256 + wr * 64 + (lane >> 2)) * EVEN_IN + u.pn * 256 + wc * 64 + 8 * (lane & 3);
    asm volatile("" : "+v"(outp));
    const int pn = u.pn;
    if (pn < 4) {
#pragma unroll
      for (int ai = 0; ai < 2; ++ai)
#pragma unroll
        for (int m = 0; m < 4; ++m) {
          u32x4 wq[2];
#pragma unroll
          for (int bj = 0; bj < 2; ++bj) { const f32x4 v0 = acc[ai][bj][m][0], v1 = acc[ai][bj][m][1];
            const f32x2 a = gelu_pk((f32x2){v0[0], v0[1]}), b = gelu_pk((f32x2){v0[2], v0[3]}), c2 = gelu_pk((f32x2){v1[0], v1[1]}), d = gelu_pk((f32x2){v1[2], v1[3]});
            u32x4 w; w.x = cvt_pk_bf16(a.x, a.y); w.y = cvt_pk_bf16(b.x, b.y); w.z = cvt_pk_bf16(c2.x, c2.y); w.w = cvt_pk_bf16(d.x, d.y);
            wq[bj] = w; }
          { u32x4 ra, rb; slab_x16(sl, wq[0], wq[1], ra, rb); *(u32x4*)(outp + (size_t)(ai * 128 + m * 16) * EVEN_IN) = ra; *(u32x4*)(outp + (size_t)(ai * 128 + m * 16) * EVEN_IN + 32) = rb; } }
    } else if (pn >= 8 && ATT0_F8) {
      LAS unsigned char* sb = lds + 3 * HTB + (wr * 4 + wc) * 1024;
      const int bb = u.pm / 9, hh = (pn - 8) * 2 + (wc >> 1); const float vs = (float)(1 << VS_SHIFT);
      unsigned char* vt = p.ws + OFF_VT8_0 + ((size_t)((bb * 4 + hh) * 128 + (wc & 1) * 64 + lane)) * SB + (size_t)((u.pm % 9) * 4 + wr) * 64;
      asm volatile("" : "+v"(vt));
#pragma unroll
      for (int ai = 0; ai < 2; ++ai)
#pragma unroll
        for (int m = 0; m < 4; ++m) {
#pragma unroll
          for (int bj = 0; bj < 2; ++bj)
#pragma unroll
            for (int n = 0; n < 2; ++n) { const f32x4 x = acc[ai][bj][m][n];
              const int w01 = __builtin_amdgcn_cvt_pk_fp8_f32(__builtin_amdgcn_fmed3f(x[0] * vs, -440.f, 440.f), __builtin_amdgcn_fmed3f(x[1] * vs, -440.f, 440.f), 0, false);
              const int w23 = __builtin_amdgcn_cvt_pk_fp8_f32(__builtin_amdgcn_fmed3f(x[2] * vs, -440.f, 440.f), __builtin_amdgcn_fmed3f(x[3] * vs, -440.f, 440.f), 0, false);
              LAS unsigned char* d = sb + (32 * bj + 8 * fq + 4 * n) * 16 + fr;
              d[0] = (unsigned char)(w01 & 0xff); d[16] = (unsigned char)((w01 >> 8) & 0xff); d[32] = (unsigned char)(w23 & 0xff); d[48] = (unsigned char)((w23 >> 8) & 0xff); }
          const u32x4 rw = *(LAS u32x4*)(sb + lane * 16);
          unsigned char* dst = vt + ai * 128 + 16 * (m >> 1) + 8 * (m & 1);
          *(u32x2*)dst = (u32x2){rw.x, rw.z}; *(u32x2*)(dst + 32) = (u32x2){rw.y, rw.w};
          asm volatile("" ::: "memory"); }
    } else if (pn >= 8) {
#pragma unroll
      for (int ai = 0; ai < 2; ++ai)
#pragma unroll
        for (int m = 0; m < 4; ++m) {
          u32x4 wq[2];
#pragma unroll
          for (int bj = 0; bj < 2; ++bj) { const f32x4 v0 = acc[ai][bj][m][0], v1 = acc[ai][bj][m][1];
            u32x4 w; w.x = cvt_pk_bf16(v0[0], v0[1]); w.y = cvt_pk_bf16(v0[2], v0[3]); w.z = cvt_pk_bf16(v1[0], v1[1]); w.w = cvt_pk_bf16(v1[2], v1[3]);
            wq[bj] = w; }
          { u32x4 ra, rb; slab_x16(sl, wq[0], wq[1], ra, rb); *(u32x4*)(outp + (size_t)(ai * 128 + m * 16) * EVEN_IN) = ra; *(u32x4*)(outp + (size_t)(ai * 128 + m * 16) * EVEN_IN + 32) = rb; } }
    } else {
      LAS const float* gn = (LAS const float*)(lds + LDS_GAIN) + (pn < 6 ? 0 : 64) + 8 * fq;
      f32x4 g4[2][2];
#pragma unroll
      for (int bj = 0; bj < 2; ++bj)
#pragma unroll
        for (int n = 0; n < 2; ++n) g4[bj][n] = *(LAS const f32x4*)(gn + bj * 32 + 4 * n);
      const int jt = u.pm % 9; const bool lat = jt != 0;
      LAS const f32x4* t64 = (LAS const f32x4*)(lds + LDS_ROPE);
#pragma unroll
      for (int ai = 0; ai < 2; ++ai)
#pragma unroll
        for (int m = 0; m < 4; ++m) {
          f32x4 cs[2][2];
          if (lat) { const int il = (jt - 1) * 256 + ai * 128 + wr * 64 + m * 16 + fr; const int prow = il >> 6, pcol = il & 63;
#pragma unroll
            for (int bj = 0; bj < 2; ++bj)
#pragma unroll
              for (int n = 0; n < 2; ++n) cs[bj][n] = t64[(bj ? pcol : prow) * 8 + 2 * fq + n]; }
          float ss = 0.f;
#pragma unroll
          for (int bj = 0; bj < 2; ++bj)
#pragma unroll
            for (int n = 0; n < 2; ++n) { const f32x4 x = acc[ai][bj][m][n]; ss += (x[0] * x[0] + x[1] * x[1]) + (x[2] * x[2] + x[3] * x[3]); }
          ss += shx<16>(ss); ss = sum32x(ss);
          const float rstd = rsqrtf(ss * (1.0f / 64) + EPS);
          u32x4 wq[2];
#pragma unroll
          for (int bj = 0; bj < 2; ++bj) { f32x4 y[2];
#pragma unroll
            for (int n = 0; n < 2; ++n) { f32x4 x = acc[ai][bj][m][n] * rstd * g4[bj][n];
              if (lat) { const f32x4 c4 = cs[bj][n]; x = (f32x4){x[0] * c4[0] - x[1] * c4[1], x[0] * c4[1] + x[1] * c4[0], x[2] * c4[2] - x[3] * c4[3], x[2] * c4[3] + x[3] * c4[2]}; }
              y[n] = x; }
            if (ATT0_F8) { const float qs = (float)(1 << QS_SHIFT); int lo = 0, hi8 = 0;
#pragma unroll
              for (int n = 0; n < 2; ++n)
#pragma unroll
                for (int j = 0; j < 4; ++j) y[n][j] = __builtin_amdgcn_fmed3f(y[n][j] * qs, -440.f, 440.f);
              lo = __builtin_amdgcn_cvt_pk_fp8_f32(y[0][0], y[0][1], lo, false); lo = __builtin_amdgcn_cvt_pk_fp8_f32(y[0][2], y[0][3], lo, true);
              hi8 = __builtin_amdgcn_cvt_pk_fp8_f32(y[1][0], y[1][1], hi8, false); hi8 = __builtin_amdgcn_cvt_pk_fp8_f32(y[1][2], y[1][3], hi8, true);
              *(LAS u32x2*)(lds + 3 * HTB + (wr * 4 + wc) * 1024 + fr * 64 + bj * 32 + fq * 8) = (u32x2){(unsigned)lo, (unsigned)hi8}; }
            else {
            u32x4 w; w.x = cvt_pk_bf16(y[0][0], y[0][1]); w.y = cvt_pk_bf16(y[0][2], y[0][3]); w.z = cvt_pk_bf16(y[1][0], y[1][1]); w.w = cvt_pk_bf16(y[1][2], y[1][3]);
            wq[bj] = w; } }
          if (ATT0_F8) { const u32x4 rw = *(LAS u32x4*)(lds + 3 * HTB + (wr * 4 + wc) * 1024 + lane * 16);
            *(u32x4*)(p.ws + OFF_QK8_0 + (size_t)(u.pm * 256 + wr * 64 + (lane >> 2) + ai * 128 + m * 16) * 1024 + (pn - 4) * 256 + wc * 64 + 16 * (lane & 3)) = rw; }
          else { u32x4 ra, rb; slab_x16(sl, wq[0], wq[1], ra, rb); *(u32x4*)(outp + (size_t)(ai * 128 + m * 16) * EVEN_IN) = ra; *(u32x4*)(outp + (size_t)(ai * 128 + m * 16) * EVEN_IN + 32) = rb; }
          asm volatile("" ::: "memory");
        }
    }
  }
};

struct JobIn1 {
  static constexpr int K = IN1_FP8 ? D / 2 : D; static constexpr bool GATHER = false, FP8 = IN1_FP8;
  static constexpr int SCALE = 0x01010101 * (127 - (WQ_SHIFT + X_SHIFT) / 2); static_assert((WQ_SHIFT + X_SHIFT) % 2 == 0, "");
  const Params& p; int i, c, G;
  DEVI JobIn1(const Params& p_) : p(p_), i(0), c(vbid()), G(gridDim.x) {}
  DEVI unsigned boff(int R, int C) const { return boff_m1<K>(R, C); }
  DEVI bool next(Unit& u) {
    for (;;) { int pm, pn; if (!dense_decode((long)i * G + c, T / 256, ODD_IN / 256, pm, pn)) return false; ++i;
      if (pm % 9 == 0 && pn < 4) continue;
      u.pm = pm; u.pn = pn; u.A = (const char*)(p.ws + (IN1_FP8 ? OFF_ACT8 : OFF_ACT)) + (size_t)pm * 256 * K * 2;
      u.B0 = (const char*)wsp<bf16_t>(p, OFF_WQKV1T) + (size_t)(256 * pn) * K * 2; u.B1 = u.B0 + (size_t)32 * K * 2; return true; }
  }
  DEVI void aoffs(const Unit&, const int (&Rr)[2], const int (&Cc)[2], unsigned (&v)[2][2]) const { dense_aoffs<K>(Rr, Cc, v); }
  DEVI void epilogue(const Acc& acc, const Unit& u, int wr, int wc, int fr, int fq, LAS unsigned char* lds) const {
    asm volatile("" : "+v"(fr), "+v"(fq));
    const int lane = fq * 16 + fr; const Slab sl = slab_init(lds, wr * 4 + wc, fr, fq);
    int ooff = (u.pm * 256 + wr * 64 + (lane >> 2)) * ODD_IN + u.pn * 256 + wc * 64 + 8 * (lane & 3);
    asm volatile("" : "+v"(ooff));
    bf16_t* outp = wsp<bf16_t>(p, OFF_PROJ) + ooff;
    asm volatile("" : "+v"(outp));
    const int pn = u.pn;
    if (pn == 5 && ATT1_PV8) {
      LAS unsigned char* sb = lds + 3 * HTB + (wr * 4 + wc) * 1024;
      const int bb = u.pm / 9, kvh = wc >> 1; const float vs = (float)(1 << VS_SHIFT);
      unsigned char* vt = p.ws + OFF_VT8 + ((size_t)((bb * 2 + kvh) * 128 + (wc & 1) * 64 + lane)) * SB + (size_t)((u.pm % 9) * 4 + wr) * 64;
      asm volatile("" : "+v"(vt));
#pragma unroll
      for (int ai = 0; ai < 2; ++ai)
#pragma unroll
        for (int m = 0; m < 4; ++m) {
#pragma unroll
          for (int bj = 0; bj < 2; ++bj)
#pragma unroll
            for (int n = 0; n < 2; ++n) { const f32x4 x = acc[ai][bj][m][n];
              const int w01 = __builtin_amdgcn_cvt_pk_fp8_f32(__builtin_amdgcn_fmed3f(x[0] * vs, -440.f, 440.f), __builtin_amdgcn_fmed3f(x[1] * vs, -440.f, 440.f), 0, false);
              const int w23 = __builtin_amdgcn_cvt_pk_fp8_f32(__builtin_amdgcn_fmed3f(x[2] * vs, -440.f, 440.f), __builtin_amdgcn_fmed3f(x[3] * vs, -440.f, 440.f), 0, false);
              LAS unsigned char* d = sb + (32 * bj + 8 * fq + 4 * n) * 16 + fr;
              d[0] = (unsigned char)(w01 & 0xff); d[16] = (unsigned char)((w01 >> 8) & 0xff); d[32] = (unsigned char)(w23 & 0xff); d[48] = (unsigned char)((w23 >> 8) & 0xff); }
          const u32x4 rw = *(LAS u32x4*)(sb + lane * 16);
          unsigned char* dst = vt + ai * 128 + 16 * (m >> 1) + 8 * (m & 1);
          *(u32x2*)dst = (u32x2){rw.x, rw.z}; *(u32x2*)(dst + 32) = (u32x2){rw.y, rw.w};
          asm volatile("" ::: "memory"); }
    } else if (pn == 5) {
#pragma unroll
      for (int ai = 0; ai < 2; ++ai)
#pragma unroll
        for (int m = 0; m < 4; ++m) {
          u32x4 wq[2];
#pragma unroll
          for (int bj = 0; bj < 2; ++bj) { const f32x4 v0 = acc[ai][bj][m][0], v1 = acc[ai][bj][m][1];
            u32x4 w; w.x = cvt_pk_bf16(v0[0], v0[1]); w.y = cvt_pk_bf16(v0[2], v0[3]); w.z = cvt_pk_bf16(v1[0], v1[1]); w.w = cvt_pk_bf16(v1[2], v1[3]);
            wq[bj] = w; }
          { u32x4 ra, rb; slab_x16(sl, wq[0], wq[1], ra, rb); *(u32x4*)(outp + (size_t)(ai * 128 + m * 16) * ODD_IN) = ra; *(u32x4*)(outp + (size_t)(ai * 128 + m * 16) * ODD_IN + 32) = rb; } }
    } else {
      const int wid = wr * 4 + wc;
      LAS float* xw = (LAS float*)(lds + LDS_XCH) + wid * 128 + fr; LAS float* xr = (LAS float*)(lds + LDS_XCH) + (wid ^ 1) * 128 + fr;
      asm volatile("" : "+v"(xw), "+v"(xr));
      float ssr[2][4];
#pragma unroll
      for (int ai = 0; ai < 2; ++ai)
#pragma unroll
        for (int m = 0; m < 4; ++m) { float ss = 0.f;
#pragma unroll
          for (int bj = 0; bj < 2; ++bj)
#pragma unroll
            for (int n = 0; n < 2; ++n) { const f32x4 x = acc[ai][bj][m][n]; ss += (x[0] * x[0] + x[1] * x[1]) + (x[2] * x[2] + x[3] * x[3]); }
          ss += shx<16>(ss); ss = sum32x(ss); ssr[ai][m] = ss;
          if (fq == 0) xw[ai * 64 + m * 16] = ss; }
      asm volatile("s_waitcnt lgkmcnt(0)" ::: "memory"); __builtin_amdgcn_s_barrier(); asm volatile("" ::: "memory");
#pragma unroll
      for (int ai = 0; ai < 2; ++ai)
#pragma unroll
        for (int m = 0; m < 4; ++m) ssr[ai][m] += xr[ai * 64 + m * 16];
      const int hh = wc & 1;
      LAS const float* gn = (LAS const float*)(lds + LDS_GAIN) + (pn < 4 ? 0 : 128) + 64 * hh + 8 * fq;
      asm volatile("" : "+v"(gn));
      const int jt = u.pm % 9; const bool lat = jt != 0;
      LAS const f32x4* t128 = (LAS const f32x4*)(lds + LDS_ROPE);
#pragma unroll
      for (int ai = 0; ai < 2; ++ai)
#pragma unroll
        for (int m = 0; m < 4; ++m) {
          f32x4 g4[2][2];
#pragma unroll
          for (int bj = 0; bj < 2; ++bj)
#pragma unroll
            for (int n = 0; n < 2; ++n) g4[bj][n] = *(LAS const f32x4*)(gn + bj * 32 + 4 * n);
          f32x4 cs[2][2];
          if (lat) { const int il = (jt - 1) * 256 + ai * 128 + wr * 64 + m * 16 + fr; const int pos = hh ? (il & 63) : (il >> 6);
#pragma unroll
            for (int bj = 0; bj < 2; ++bj)
#pragma unroll
              for (int n = 0; n < 2; ++n) cs[bj][n] = t128[pos * 16 + 8 * bj + 2 * fq + n]; }
          const float rstd = rsqrtf(ssr[ai][m] * (1.0f / 128) + EPS);
          u32x4 wq[2];
#pragma unroll
          for (int bj = 0; bj < 2; ++bj) { f32x4 y[2];
#pragma unroll
            for (int n = 0; n < 2; ++n) { f32x4 x = acc[ai][bj][m][n] * rstd * g4[bj][n];
              if (lat) { const f32x4 c4 = cs[bj][n]; x = (f32x4){x[0] * c4[0] - x[1] * c4[1], x[0] * c4[1] + x[1] * c4[0], x[2] * c4[2] - x[3] * c4[3], x[2] * c4[3] + x[3] * c4[2]}; }
              y[n] = x; }
            if (ATT1_QK8) { const float qs = (float)(1 << QS_SHIFT); int lo = 0, hi8 = 0;
#pragma unroll
              for (int n = 0; n < 2; ++n)
#pragma unroll
                for (int j = 0; j < 4; ++j) y[n][j] = __builtin_amdgcn_fmed3f(y[n][j] * qs, -440.f, 440.f);
              lo = __builtin_amdgcn_cvt_pk_fp8_f32(y[0][0], y[0][1], lo, false); lo = __builtin_amdgcn_cvt_pk_fp8_f32(y[0][2], y[0][3], lo, true);
              hi8 = __builtin_amdgcn_cvt_pk_fp8_f32(y[1][0], y[1][1], hi8, false); hi8 = __builtin_amdgcn_cvt_pk_fp8_f32(y[1][2], y[1][3], hi8, true);
              *(LAS u32x2*)(lds + 3 * HTB + (wr * 4 + wc) * 1024 + fr * 64 + bj * 32 + fq * 8) = (u32x2){(unsigned)lo, (unsigned)hi8}; }
            else {
            u32x4 w; w.x = cvt_pk_bf16(y[0][0], y[0][1]); w.y = cvt_pk_bf16(y[0][2], y[0][3]); w.z = cvt_pk_bf16(y[1][0], y[1][1]); w.w = cvt_pk_bf16(y[1][2], y[1][3]);
            wq[bj] = w; } }
          if (ATT1_QK8) { const u32x4 rw = *(LAS u32x4*)(lds + 3 * HTB + (wr * 4 + wc) * 1024 + lane * 16);
            *(u32x4*)(p.ws + OFF_QK8 + (size_t)(u.pm * 256 + wr * 64 + (lane >> 2) + ai * 128 + m * 16) * 1280 + pn * 256 + wc * 64 + 16 * (lane & 3)) = rw; }
          else { u32x4 ra, rb; slab_x16(sl, wq[0], wq[1], ra, rb); *(u32x4*)(outp + (size_t)(ai * 128 + m * 16) * ODD_IN) = ra; *(u32x4*)(outp + (size_t)(ai * 128 + m * 16) * ODD_IN + 32) = rb; }
          asm volatile("" ::: "memory");
        }
    }
  }
};

DEVI void moe_tables(const Params& p, const LCfg c, int half, int nN, LAS unsigned char* lds) {
  LAS int* tb = (LAS int*)(lds + LDS_TAB);
  const int tid = ltid();
  __syncthreads();
  if (tid <= NE) tb[tid] = tid < NE ? ((const int*)(p.ws + OFF_CNT))[c.l * 128 + half * 64 + tid] : c.nph;
  __syncthreads();
  if (tid == 0) { int up = 0, off = 0; for (int e = 0; e <= NE; ++e) { const int n = tb[e]; tb[72 + e] = up; tb[144 + e] = off; up += ((n + 255) >> 8) * nN; off += n; } tb[72 + 65] = up; tb[144 + 65] = off; }
  __syncthreads();
}
struct MoeIter {
  int g, gend, step, e;
  DEVI void init(LAS const int* tb) { const int vb = vbid(); const int U = __builtin_amdgcn_readfirstlane(tb[72 + 65]), chunk = (U + 7) >> 3, x = vb & 7; g = x * chunk + (vb >> 3); gend = (x + 1) * chunk < U ? (x + 1) * chunk : U; step = gridDim.x >> 3; e = 0; }
  DEVI bool next(LAS const int* tb, int nN, int& ee, int& mt, int& pn) { if (g >= gend) return false; while (__builtin_amdgcn_readfirstlane(tb[72 + e + 1]) <= g) ++e; const int r = g - __builtin_amdgcn_readfirstlane(tb[72 + e]); mt = r / nN; pn = r - mt * nN; ee = e; g += step; return true; }
};
struct JobGU {
  static constexpr int K = D / 2; static constexpr bool GATHER = true, FP8 = true;
  static constexpr int SCALE = 0x01010101 * (127 - (WG_SHIFT + X_SHIFT) / 2); static_assert((WG_SHIFT + X_SHIFT) % 2 == 0, "");
  const Params& p; const LCfg c; int half; LAS const int* tb; MoeIter it; int dry;
  DEVI JobGU(const Params& p_, const LCfg c_, int half_, LAS unsigned char* lds, int dry_ = 0) : p(p_), c(c_), half(half_), tb((LAS const int*)(lds + LDS_TAB)), dry(dry_) { it.init(tb); }
  DEVI unsigned boff(int R, int C) const { return boff_m2<K>(R, C); }
  DEVI bool next(Unit& u) {
    int e, mt, pn; if (!it.next(tb, 2, e, mt, pn)) return false;
    u.e = e; u.pm = mt; u.pn = pn; u.cnt = __builtin_amdgcn_readfirstlane(tb[e]); u.off = __builtin_amdgcn_readfirstlane(tb[144 + e]); u.A = (const char*)(p.ws + OFF_ACT8);
    const char* w = e < NE ? (const char*)wsp<bf16_t>(p, OFF_EGU) + (size_t)e * 512 * K * 2 : (const char*)wsp<bf16_t>(p, OFF_SHGU) + (size_t)c.l * 512 * K * 2;
    u.B0 = w + (size_t)(128 * pn) * K * 2; u.B1 = w + (size_t)(256 + 128 * pn) * K * 2; return true;
  }
  DEVI void aoffs(const Unit& u, const int (&Rr)[2], const int (&Cc)[2], unsigned (&v)[2][2]) const {
    const int* le = wsp<int>(p, OFF_LIST) + ((size_t)(half * 64 + (u.e < NE ? u.e : 0))) * LCAP;
#pragma unroll
    for (int h = 0; h < 2; ++h)
#pragma unroll
      for (int i = 0; i < 2; ++i) { int r = u.pm * 256 + h * 128 + Rr[i]; r = r < u.cnt ? r : 0;
        int tl = r; if (u.e < NE) tl = le[r] / 6;
        v[h][i] = (unsigned)(act_tok(c, half, tl) * K + Cc[i]) * 2u; }
  }
  DEVI void epilogue(const Acc& acc, const Unit& u, int wr, int wc, int fr, int fq, LAS unsigned char* lds) const {
    asm volatile("" : "+v"(fr), "+v"(fq));
    if (dry == 1) {
#pragma unroll
      for (int ai = 0; ai < 2; ++ai)
#pragma unroll
        for (int bj = 0; bj < 2; ++bj)
#pragma unroll
          for (int m = 0; m < 4; ++m)
#pragma unroll
            for (int n = 0; n < 2; ++n) asm volatile("" :: "v"(acc[ai][bj][m][n]));
      return; }
    const int lane = fq * 16 + fr;
    LAS unsigned char* sb = lds + 3 * HTB + (wr * 4 + wc) * 1024;
    const int r0 = u.pm * 256 + wr * 64 + (lane >> 2);
    unsigned char* hid = p.ws + OFF_HID + ((size_t)u.off + r0) * DE + u.pn * 128 + wc * 32 + 8 * (lane & 3);
    asm volatile("" : "+v"(hid));
    const float hs = (float)(1 << H_SHIFT);
#pragma unroll
    for (int ai = 0; ai < 2; ++ai)
#pragma unroll
      for (int m = 0; m < 4; ++m) { const int r = r0 + ai * 128 + m * 16;
        float h[8];
#pragma unroll
        for (int n = 0; n < 2; ++n)
#pragma unroll
          for (int j = 0; j < 4; ++j) { const float gg = acc[ai][0][m][n][j]; h[n * 4 + j] = __builtin_amdgcn_fmed3f(gg * __builtin_amdgcn_rcpf(1.0f + __expf(-gg)) * acc[ai][1][m][n][j] * hs, -440.f, 440.f); }
        int lo = 0, hi = 0;
        lo = __builtin_amdgcn_cvt_pk_fp8_f32(h[0], h[1], lo, false); lo = __builtin_amdgcn_cvt_pk_fp8_f32(h[2], h[3], lo, true);
        hi = __builtin_amdgcn_cvt_pk_fp8_f32(h[4], h[5], hi, false); hi = __builtin_amdgcn_cvt_pk_fp8_f32(h[6], h[7], hi, true);
        *(LAS u32x2*)(sb + fr * 32 + fq * 8) = (u32x2){(unsigned)lo, (unsigned)hi};
        const u32x2 rw = *(LAS u32x2*)(sb + lane * 8);
        if (r < u.cnt) *(u32x2*)(hid + (size_t)(ai * 128 + m * 16) * DE) = rw; }
  }
};
struct JobDown {
  static constexpr int K = DE / 2; static constexpr bool GATHER = false, FP8 = true;
  static constexpr int SCALE = 0x01010101 * (127 - (WD_SHIFT + H_SHIFT) / 2); static_assert((WD_SHIFT + H_SHIFT) % 2 == 0, "");
  const Params& p; const LCfg c; int half; LAS const int* tb; MoeIter it; float dscale;
  DEVI JobDown(const Params& p_, const LCfg c_, int half_, LAS unsigned char* lds, float ds = 1.0f) : p(p_), c(c_), half(half_), tb((LAS const int*)(lds + LDS_TAB)), dscale(ds) { it.init(tb); }
  DEVI unsigned boff(int R, int C) const { return boff_m1<K>(R, C); }
  DEVI bool next(Unit& u) {
    int e, mt, pn; if (!it.next(tb, 4, e, mt, pn)) return false;
    u.e = e; u.pm = mt; u.pn = pn; u.cnt = __builtin_amdgcn_readfirstlane(tb[e]); u.off = __builtin_amdgcn_readfirstlane(tb[144 + e]);
    u.A = (const char*)wsp<bf16_t>(p, OFF_HID) + ((size_t)(u.off + mt * 256)) * K * 2;
    const char* w = e < NE ? (const char*)wsp<bf16_t>(p, OFF_ED) + (size_t)e * D * K * 2 : (const char*)wsp<bf16_t>(p, OFF_SHD) + (size_t)c.l * D * K * 2;
    u.B0 = w + (size_t)(256 * pn) * K * 2; u.B1 = u.B0 + (size_t)32 * K * 2; return true;
  }
  DEVI void aoffs(const Unit&, const int (&Rr)[2], const int (&Cc)[2], unsigned (&v)[2][2]) const { dense_aoffs<K>(Rr, Cc, v); }
  DEVI void epilogue(const Acc& acc, const Unit& u, int wr, int wc, int fr, int fq, LAS unsigned char* lds) const {
    asm volatile("" : "+v"(fr), "+v"(fq));
    const int lane = fq * 16 + fr;
    if (dscale < 0.f) {
#pragma unroll
      for (int ai = 0; ai < 2; ++ai)
#pragma unroll
        for (int bj = 0; bj < 2; ++bj)
#pragma unroll
          for (int m = 0; m < 4; ++m)
#pragma unroll
            for (int n = 0; n < 2; ++n) asm volatile("" :: "v"(acc[ai][bj][m][n]));
      return; }
    LAS unsigned char* sb = lds + 3 * HTB + (wr * 4 + wc) * 1024;
    const int r0 = u.pm * 256 + wr * 64 + (lane >> 2);
    unsigned char* slot = p.ws + OFF_SLOT + ((size_t)u.off + r0) * D + u.pn * 256 + wc * 64 + 16 * (lane & 3);
    asm volatile("" : "+v"(slot));
#pragma unroll
    for (int ai = 0; ai < 2; ++ai)
#pragma unroll
      for (int m = 0; m < 4; ++m) {
#pragma unroll
        for (int bj = 0; bj < 2; ++bj) { f32x4 v0 = acc[ai][bj][m][0], v1 = acc[ai][bj][m][1]; int lo = 0, hi = 0;
#pragma unroll
          for (int j = 0; j < 4; ++j) { v0[j] = __builtin_amdgcn_fmed3f(v0[j], -440.f, 440.f); v1[j] = __builtin_amdgcn_fmed3f(v1[j], -440.f, 440.f); }
          lo = __builtin_amdgcn_cvt_pk_fp8_f32(v0[0], v0[1], lo, false); lo = __builtin_amdgcn_cvt_pk_fp8_f32(v0[2], v0[3], lo, true);
          hi = __builtin_amdgcn_cvt_pk_fp8_f32(v1[0], v1[1], hi, false); hi = __builtin_amdgcn_cvt_pk_fp8_f32(v1[2], v1[3], hi, true);
          *(LAS u32x2*)(sb + fr * 64 + bj * 32 + fq * 8) = (u32x2){(unsigned)lo, (unsigned)hi}; }
        const u32x4 rw = *(LAS u32x4*)(sb + lane * 16);
        if (r0 + ai * 128 + m * 16 < u.cnt) *(u32x4*)(slot + (size_t)(ai * 128 + m * 16) * D) = rw; }
  }
};
}
namespace fa {
constexpr int NW = 8, QBLK = 32, KVBLK = 64;
constexpr float THR = 8.f;
constexpr size_t SHM_V = KVBLK * 128 * 2, SHM_K = KVBLK * 128 * 2, SHM_ATTN = 2 * SHM_V + 2 * SHM_K + NW * 64 * 4;
using s16x4 = __attribute__((ext_vector_type(4))) short;
using f32x16 = __attribute__((ext_vector_type(16))) float;
#define KSWZ(row, colB) ((row) * 256 + ((colB) ^ (((row) & 7) << 4)))
#define SBAR() __builtin_amdgcn_sched_barrier(0)
DEVI int crow(int r, int hi) { return (r & 3) + 8 * (r >> 2) + 4 * hi; }
DEVI unsigned cvtpk(float lo, float hi) { unsigned r; asm volatile("v_cvt_pk_bf16_f32 %0, %1, %2" : "=v"(r) : "v"(lo), "v"(hi)); return r; }

template <int SCALE_NUM> struct ScaleC;
DEVI void partialSM(f32x16& p0, f32x16& p1, float& m_reg, float& mn, float& alpha, const float SCALE, const float THRv = THR) {
  const float C = SCALE * 1.4426950408889634f;
  float pmax = p0[0];
#pragma unroll
  for (int r = 1; r < 16; ++r) pmax = fmaxf(pmax, p0[r]);
#pragma unroll
  for (int r = 0; r < 16; ++r) pmax = fmaxf(pmax, p1[r]);
  { auto rr = __builtin_amdgcn_permlane32_swap(__float_as_uint(pmax), __float_as_uint(pmax), false, false);
    pmax = fmaxf(__uint_as_float(rr[0]), __uint_as_float(rr[1])); }
  if (__builtin_expect(__all(pmax - m_reg <= THRv / SCALE), 1)) { mn = m_reg; alpha = 1.f; }
  else { mn = fmaxf(m_reg, pmax); alpha = __builtin_amdgcn_exp2f((m_reg - mn) * C); m_reg = mn; }
  float mnC = -mn * C;
#pragma unroll
  for (int r = 0; r < 16; ++r) p0[r] = fmaf(p0[r], C, mnC);
#pragma unroll
  for (int r = 0; r < 16; ++r) p1[r] = fmaf(p1[r], C, mnC);
#pragma unroll
  for (int r = 0; r < 16; ++r) p0[r] = __builtin_amdgcn_exp2f(p0[r]);
}
DEVI void finishSM(f32x16& p0, f32x16& p1, float alpha, float& l_reg, bf16x8& pa0, bf16x8& pa1, bf16x8& pa2, bf16x8& pa3) {
#pragma unroll
  for (int r = 0; r < 16; ++r) p1[r] = __builtin_amdgcn_exp2f(p1[r]);
  float ps = 0;
#pragma unroll
  for (int r = 0; r < 16; ++r) ps += p0[r];
#pragma unroll
  for (int r = 0; r < 16; ++r) ps += p1[r];
  { auto rr = __builtin_amdgcn_permlane32_swap(__float_as_uint(ps), __float_as_uint(ps), false, false);
    ps = __uint_as_float(rr[0]) + __uint_as_float(rr[1]); }
  l_reg = l_reg * alpha + ps;
#define PK4(P, BASE, OUT) do { unsigned a0 = cvtpk(P[BASE + 0], P[BASE + 1]), a1 = cvtpk(P[BASE + 2], P[BASE + 3]);   \
    unsigned b0 = cvtpk(P[BASE + 4], P[BASE + 5]), b1 = cvtpk(P[BASE + 6], P[BASE + 7]);                              \
    auto r0 = __builtin_amdgcn_permlane32_swap(a0, b0, false, false); auto r1 = __builtin_amdgcn_permlane32_swap(a1, b1, false, false); \
    u32x4 w = {r0[0], r1[0], r0[1], r1[1]}; OUT = *reinterpret_cast<bf16x8*>(&w); } while (0)
  PK4(p0, 0, pa0); PK4(p0, 8, pa1); PK4(p1, 0, pa2); PK4(p1, 8, pa3);
#undef PK4
}
template <int ND0> DEVI void qkt(f32x16& p0, f32x16& p1, const char* Ks, const bf16x8* qr, int r32, int hi, int cbase) {
  p0 = f32x16{}; p1 = f32x16{};
#pragma unroll
  for (int d0 = 0; d0 < ND0; ++d0) { int cb = cbase + (d0 * 16 + hi * 8) * 2;
    bf16x8 b0 = *reinterpret_cast<const bf16x8*>(Ks + KSWZ(r32, cb));
    bf16x8 b1 = *reinterpret_cast<const bf16x8*>(Ks + KSWZ(32 + r32, cb));
    p0 = __builtin_amdgcn_mfma_f32_32x32x16_bf16(b0, qr[d0], p0, 0, 0, 0);
    p1 = __builtin_amdgcn_mfma_f32_32x32x16_bf16(b1, qr[d0], p1, 0, 0, 0); }
}
using fg::v8i_t;
#define K8SWZ(row, chunk) ((row) * 128 + ((((chunk)) ^ ((row) & 7)) << 4))
template <int NKS> DEVI void qkt8(f32x16& p0, f32x16& p1, const char* Ks, const v8i_t* q8, int r32, int hi, int cb8) {
  p0 = f32x16{}; p1 = f32x16{};
  constexpr int SC = 0x01010101 * (127 - QS_SHIFT);
#pragma unroll
  for (int ks = 0; ks < NKS; ++ks) { const int c0 = cb8 + ks * 4 + hi * 2;
    const u32x4 a0 = *reinterpret_cast<const u32x4*>(Ks + K8SWZ(r32, c0)), a1 = *reinterpret_cast<const u32x4*>(Ks + K8SWZ(r32, c0 + 1));
    const u32x4 b0 = *reinterpret_cast<const u32x4*>(Ks + K8SWZ(32 + r32, c0)), b1 = *reinterpret_cast<const u32x4*>(Ks + K8SWZ(32 + r32, c0 + 1));
    const v8i_t ka = {(int)a0[0], (int)a0[1], (int)a0[2], (int)a0[3], (int)a1[0], (int)a1[1], (int)a1[2], (int)a1[3]};
    const v8i_t kb = {(int)b0[0], (int)b0[1], (int)b0[2], (int)b0[3], (int)b1[0], (int)b1[1], (int)b1[2], (int)b1[3]};
    p0 = __builtin_amdgcn_mfma_scale_f32_32x32x64_f8f6f4(ka, q8[ks], p0, 0, 0, 0, SC, 0, SC);
    p1 = __builtin_amdgcn_mfma_scale_f32_32x32x64_f8f6f4(kb, q8[ks], p1, 0, 0, 0, SC, 0, SC); }
}
constexpr float THR8 = 3.f;
#define VT8SWZ(d, c) ((d) * 64 + ((((c)) ^ (((d) >> 2) & 3)) << 4))
DEVI void finishSM8(f32x16& p0, f32x16& p1, float alpha, float& l_reg, v8i_t& pa) {
#pragma unroll
  for (int r = 0; r < 16; ++r) p1[r] = __builtin_amdgcn_exp2f(p1[r]);
  float ps = 0;
#pragma unroll
  for (int r = 0; r < 16; ++r) ps += p0[r];
#pragma unroll
  for (int r = 0; r < 16; ++r) ps += p1[r];
  { auto rr = __builtin_amdgcn_permlane32_swap(__float_as_uint(ps), __float_as_uint(ps), false, false);
    ps = __uint_as_float(rr[0]) + __uint_as_float(rr[1]); }
  l_reg = l_reg * alpha + ps;
  const float sc = (float)(1 << PS_SHIFT);
#pragma unroll
  for (int w = 0; w < 4; ++w) { int a = 0, b = 0;
    a = __builtin_amdgcn_cvt_pk_fp8_f32(p0[4 * w] * sc, p0[4 * w + 1] * sc, a, false); a = __builtin_amdgcn_cvt_pk_fp8_f32(p0[4 * w + 2] * sc, p0[4 * w + 3] * sc, a, true);
    b = __builtin_amdgcn_cvt_pk_fp8_f32(p1[4 * w] * sc, p1[4 * w + 1] * sc, b, false); b = __builtin_amdgcn_cvt_pk_fp8_f32(p1[4 * w + 2] * sc, p1[4 * w + 3] * sc, b, true);
    pa[w] = a; pa[4 + w] = b; }
}
DEVI void pv8(f32x16* o, const char* Vs, const v8i_t pa, int r32, int hi) {
  constexpr int SC = 0x01010101 * (127 - (PS_SHIFT + VS_SHIFT) / 2); static_assert((PS_SHIFT + VS_SHIFT) % 2 == 0, "");
  u32x4 lo[4], hh[4];
#pragma unroll
  for (int d0 = 0; d0 < 4; ++d0) { const int d = d0 * 32 + r32; lo[d0] = *reinterpret_cast<const u32x4*>(Vs + VT8SWZ(d, 2 * hi)); hh[d0] = *reinterpret_cast<const u32x4*>(Vs + VT8SWZ(d, 2 * hi + 1)); }
  asm volatile("s_waitcnt lgkmcnt(0)" ::: "memory"); SBAR();
#pragma unroll
  for (int d0 = 0; d0 < 4; ++d0) { const v8i_t vb = {(int)lo[d0][0], (int)lo[d0][1], (int)lo[d0][2], (int)lo[d0][3], (int)hh[d0][0], (int)hh[d0][1], (int)hh[d0][2], (int)hh[d0][3]};
    o[d0] = __builtin_amdgcn_mfma_scale_f32_32x32x64_f8f6f4(pa, vb, o[d0], 0, 0, 0, SC, 0, SC); }
}
DEVI int v_st(int k, int c) { const int kk = (k & ~0xC) | ((k & 4) << 1) | ((k & 8) >> 1); return ((kk >> 3) * 4 + (c >> 5)) * 512 + ((kk & 7) * 32 + (c & 31)) * 2; }
DEVI int v_rd_base(int lane) { return ((lane & 3) << 3) | (((lane >> 2) & 3) << 6) | (((lane >> 4) & 1) << 5) | (((lane >> 5) & 1) << 8); }
constexpr int v_rd_off(int d0, int ks, int half) { return d0 * 512 + ks * 4096 + half * 2048; }
template <int OFF> DEVI s16x4 tr_read(int vb) { s16x4 r; asm volatile("ds_read_b64_tr_b16 %0, %1 offset:%2" : "=&v"(r) : "v"(vb), "i"(OFF) : "memory"); return r; }
template <int D0> DEVI void pv_one(f32x16& od, int vb, bf16x8 pa0, bf16x8 pa1, bf16x8 pa2, bf16x8 pa3) {
  const s16x4 l0 = tr_read<v_rd_off(D0, 0, 0)>(vb), h0 = tr_read<v_rd_off(D0, 0, 1)>(vb), l1 = tr_read<v_rd_off(D0, 1, 0)>(vb), h1 = tr_read<v_rd_off(D0, 1, 1)>(vb);
  const s16x4 l2 = tr_read<v_rd_off(D0, 2, 0)>(vb), h2 = tr_read<v_rd_off(D0, 2, 1)>(vb), l3 = tr_read<v_rd_off(D0, 3, 0)>(vb), h3 = tr_read<v_rd_off(D0, 3, 1)>(vb);
  asm volatile("s_waitcnt lgkmcnt(0)" ::: "memory"); SBAR();
#define PK(L, H) (bf16x8){L[0], L[1], L[2], L[3], H[0], H[1], H[2], H[3]}
  od = __builtin_amdgcn_mfma_f32_32x32x16_bf16(pa0, PK(l0, h0), od, 0, 0, 0);
  od = __builtin_amdgcn_mfma_f32_32x32x16_bf16(pa1, PK(l1, h1), od, 0, 0, 0);
  od = __builtin_amdgcn_mfma_f32_32x32x16_bf16(pa2, PK(l2, h2), od, 0, 0, 0);
  od = __builtin_amdgcn_mfma_f32_32x32x16_bf16(pa3, PK(l3, h3), od, 0, 0, 0);
#undef PK
}
DEVI void pv_d0(f32x16* o, int vb, bf16x8 pa0, bf16x8 pa1, bf16x8 pa2, bf16x8 pa3) {
  pv_one<0>(o[0], vb, pa0, pa1, pa2, pa3); pv_one<1>(o[1], vb, pa0, pa1, pa2, pa3); pv_one<2>(o[2], vb, pa0, pa1, pa2, pa3); pv_one<3>(o[3], vb, pa0, pa1, pa2, pa3);
}

template <int ND0, int LD, bool KF8 = false, bool PV8 = false>
DEVI void attn_loop(const bf16_t* __restrict__ Qw, const bf16_t* __restrict__ Kh, const bf16_t* __restrict__ Vh, int seq, char* lds, int kcol_bytes, const float SCALE,
                    f32x16 (&o)[4], float& l_out) {
  const int tid = ltid(), wid = tid >> 6, lane = tid & 63, r32 = lane & 31, hi = lane >> 5;
  char* V_lds = lds; char* K_lds = lds + 2 * SHM_V;
  float* ws = (float*)(lds + 2 * SHM_V + 2 * SHM_K) + wid * 64; float* al_l = ws + 32;
  float m_reg = -1e30f, l_reg = 0; bf16x8 qr[ND0]; v8i_t q8[2];
#pragma unroll
  for (int d = 0; d < 4; ++d) o[d] = f32x16{};
  if constexpr (KF8) {
#pragma unroll
    for (int ks = 0; ks < ND0 / 4; ++ks) q8[ks] = *reinterpret_cast<const v8i_t*>((const unsigned char*)Qw + ks * 64);
  } else {
#pragma unroll
  for (int d0 = 0; d0 < ND0; ++d0) qr[d0] = *reinterpret_cast<const bf16x8*>(Qw + d0 * 16);
  }
  const int sr = tid >> 4, sc = (tid & 15) * 8, vst0 = v_st(sr, sc), vst1 = v_st(32 + sr, sc);
  const int vb0 = (int)(uintptr_t)V_lds + v_rd_base(lane);
  struct { bf16x8 vs0, vs1, ks0, ks1; } sr_[2];
#define SLOAD(i, k0) do { if constexpr (PV8) { sr_[i].vs0 = *reinterpret_cast<const bf16x8*>((const unsigned char*)Vh + (long)(tid >> 2) * SB + (k0) + (tid & 3) * 16); } else { \
    sr_[i].vs0 = *reinterpret_cast<const bf16x8*>(&Vh[(long)((k0) + sr) * LD + sc]); sr_[i].vs1 = *reinterpret_cast<const bf16x8*>(&Vh[(long)((k0) + 32 + sr) * LD + sc]); } \
    if constexpr (KF8) { sr_[i].ks0 = *reinterpret_cast<const bf16x8*>((const unsigned char*)Kh + (long)((k0) + (tid >> 3)) * (ND0 == 8 ? 1280 : 1024) + (tid & 7) * 16); } else { \
    sr_[i].ks0 = *reinterpret_cast<const bf16x8*>(&Kh[(long)((k0) + sr) * LD + sc]); sr_[i].ks1 = *reinterpret_cast<const bf16x8*>(&Kh[(long)((k0) + 32 + sr) * LD + sc]); } } while (0)
#define SWRITE(b, i) do { if constexpr (PV8) { *(bf16x8*)(V_lds + (b) * SHM_V + VT8SWZ(tid >> 2, tid & 3)) = sr_[i].vs0; } else { *(bf16x8*)(V_lds + (b) * SHM_V + vst0) = sr_[i].vs0;          \
    *(bf16x8*)(V_lds + (b) * SHM_V + vst1) = sr_[i].vs1; } int kc = sc * 2;               \
    if constexpr (KF8) { *(bf16x8*)(K_lds + (b) * SHM_K + K8SWZ(tid >> 3, tid & 7)) = sr_[i].ks0; } else { \
    *(bf16x8*)(K_lds + (b) * SHM_K + KSWZ(sr, kc)) = sr_[i].ks0;                       \
    *(bf16x8*)(K_lds + (b) * SHM_K + KSWZ(32 + sr, kc)) = sr_[i].ks1; } } while (0)
#define SWAIT() do { if constexpr (KF8 && PV8) asm volatile("s_waitcnt vmcnt(2)" ::: "memory"); else if constexpr (KF8) asm volatile("s_waitcnt vmcnt(3)" ::: "memory"); else asm volatile("s_waitcnt vmcnt(4)" ::: "memory"); } while (0)
#define FINSM(P0, P1, al) do { if constexpr (PV8) finishSM8(P0, P1, al, l_reg, pa8); else finishSM(P0, P1, al, l_reg, pa0, pa1, pa2, pa3); } while (0)
#define PVD(vboff) do { if constexpr (PV8) pv8(o, V_lds + (vboff), pa8, r32, hi); else pv_d0(o, vb0 + (int)(vboff), pa0, pa1, pa2, pa3); } while (0)
#define PSM(P0, P1, mn, al) do { if constexpr (PV8) partialSM(P0, P1, m_reg, mn, al, SCALE, THR8); else partialSM(P0, P1, m_reg, mn, al, SCALE); } while (0)
#define QKT(P0, P1, KS) do { if constexpr (KF8) qkt8<ND0 / 4>(P0, P1, KS, q8, r32, hi, kcol_bytes >> 5); else qkt<ND0>(P0, P1, KS, qr, r32, hi, kcol_bytes); } while (0)
#define RESC(a) do { if (__any((a) < 1.f)) { if (hi == 0) al_l[r32] = (a); asm volatile("s_waitcnt lgkmcnt(0)" ::: "memory"); \
    _Pragma("unroll") for (int d = 0; d < 4; ++d) _Pragma("unroll") for (int r = 0; r < 16; ++r) o[d][r] *= al_l[crow(r, hi)]; } } while (0)
  f32x16 pA0, pA1, pB0, pB1; float mnA, mnB, alA, alB; bf16x8 pa0, pa1, pa2, pa3; v8i_t pa8; const int NT = seq / KVBLK;
  constexpr int SE = 0, SO = 1;
  SLOAD(SE, 0); asm volatile("s_waitcnt vmcnt(0)" ::: "memory"); SWRITE(0, SE); __syncthreads();
  QKT(pA0, pA1, K_lds); PSM(pA0, pA1, mnA, alA);
  SLOAD(SO, KVBLK); if (2 < NT) SLOAD(SE, 2 * KVBLK);
  SWAIT(); SWRITE(1, SO); __syncthreads();
  for (int j = 1; j + 1 < NT; j += 2) {
    SBAR(); QKT(pB0, pB1, K_lds + SHM_K);
    FINSM(pA0, pA1, alA); SBAR();
    SLOAD(SO, (j + 2) * KVBLK); SBAR();
    PVD(0); PSM(pB0, pB1, mnB, alB);
    __syncthreads(); SWAIT(); SWRITE(0, SE);
    RESC(alB); __syncthreads();
    SBAR(); QKT(pA0, pA1, K_lds);
    FINSM(pB0, pB1, alB); SBAR();
    if (j + 3 < NT) SLOAD(SE, (j + 3) * KVBLK); SBAR();
    PVD(SHM_V); PSM(pA0, pA1, mnA, alA);
    __syncthreads(); SWAIT(); SWRITE(1, SO);
    RESC(alA); __syncthreads();
  }
  SBAR(); QKT(pB0, pB1, K_lds + SHM_K);
  FINSM(pA0, pA1, alA); SBAR();
  PVD(0); PSM(pB0, pB1, mnB, alB);
  __syncthreads(); RESC(alB);
  FINSM(pB0, pB1, alB); SBAR();
  PVD(SHM_V);
  asm volatile("s_waitcnt vmcnt(0)" ::: "memory");
  l_out = l_reg;
#undef QKT
#undef FINSM
#undef PVD
#undef PSM
#undef SLOAD
#undef SWRITE
#undef SWAIT
#undef RESC
}

DEVI void store_tile_bf16(const f32x16 (&o)[4], const float (&scl)[16], bf16_t* Ow, int ldo, int r32, int hi) {
#pragma unroll
  for (int d0 = 0; d0 < 4; ++d0)
#pragma unroll
    for (int r = 0; r < 16; r += 2) {
      const float va = o[d0][r] * scl[r], vb = o[d0][r + 1] * scl[r + 1];
      const float snd = (r32 & 1) ? va : vb; const float got = shx<1>(snd);
      const int row = (r32 & 1) ? crow(r + 1, hi) : crow(r, hi); const int col = d0 * 32 + (r32 & ~1);
      const unsigned w = (r32 & 1) ? cvtpk(got, vb) : cvtpk(va, got);
      *(unsigned*)(Ow + (long)row * ldo + col) = w; }
}

DEVI void store_tile_fp8(const f32x16 (&o)[4], const float (&scl)[16], unsigned char* Ow, int ldo, int r32, int hi, const float xs) {
  const int q = r32 & 3; const bool b0 = q & 1, b1 = q & 2;
#pragma unroll
  for (int d0 = 0; d0 < 4; ++d0)
#pragma unroll
    for (int r4 = 0; r4 < 16; r4 += 4) {
      float v[4];
#pragma unroll
      for (int kk = 0; kk < 4; ++kk) v[kk] = __builtin_amdgcn_fmed3f(o[d0][r4 + kk] * scl[r4 + kk] * xs, -440.f, 440.f);
      const float gA = shx<1>(b0 ? v[0] : v[1]), gB = shx<1>(b0 ? v[2] : v[3]);
      const float aLo = b0 ? gA : v[0], aHi = b0 ? v[1] : gA;
      const float bLo = b0 ? gB : v[2], bHi = b0 ? v[3] : gB;
      const int pA = __builtin_amdgcn_cvt_pk_fp8_f32(aLo, aHi, 0, false) & 0xffff, pB = __builtin_amdgcn_cvt_pk_fp8_f32(bLo, bHi, 0, false) & 0xffff;
      const int got = __float_as_int(shx<2>(__int_as_float(b1 ? pA : pB))) & 0xffff;
      const unsigned w = b1 ? ((unsigned)got | ((unsigned)pB << 16)) : ((unsigned)pA | ((unsigned)got << 16));
      *(unsigned*)(Ow + (long)crow(r4 + q, hi) * ldo + d0 * 32 + (r32 & ~3)) = w; }
}

DEVI void phase_attn1(const Params& p, const PrepIn& pin, unsigned char* smem) {
  const bf16_t* qkv = wsp<bf16_t>(p, OFF_PROJ); bf16_t* att = wsp<bf16_t>(p, OFF_ACT);
  const int tid = ltid(), wid = tid >> 6, lane = tid & 63, r32 = lane & 31, hi = lane >> 5;
  const int vb_ = vbid(); const int xcd = vb_ & 7, slot = vb_ >> 3, nslot = gridDim.x >> 3;
  float* li_l = (float*)((char*)smem + 2 * SHM_V + 2 * SHM_K) + wid * 64;
  for (int it = slot; it < 4 * 32; it += nslot) {
    const int g = xcd + 8 * (it >> 5), item = it & 31, b = g >> 1, kvh = g & 1, h = kvh * 4 + (item >> 3), qb = item & 7;
    const bf16_t* Qb = qkv + (size_t)(b * SB + NC + qb * 256) * ODD_IN + h * 128;
    const bf16_t* Kh = qkv + (size_t)(b * SB) * ODD_IN + 1024 + kvh * 128; const bf16_t* Vh = Kh + 256;
    const unsigned char* Q8 = p.ws + OFF_QK8 + (size_t)(b * SB + NC + qb * 256) * 1280 + h * 128; const unsigned char* K8 = p.ws + OFF_QK8 + (size_t)(b * SB) * 1280 + 1024 + kvh * 128;
    f32x16 o[4]; float l;
    __syncthreads();
    if constexpr (ATT1_QK8 && ATT1_PV8) attn_loop<8, ODD_IN, true, true>((const bf16_t*)(Q8 + (long)(wid * QBLK + r32) * 1280 + hi * 32), (const bf16_t*)K8, (const bf16_t*)(p.ws + OFF_VT8 + (size_t)((b * 2 + kvh) * 128) * SB), SB, (char*)smem, 0, 0.08838834764831845f, o, l);
    else if constexpr (ATT1_QK8) attn_loop<8, ODD_IN, true>((const bf16_t*)(Q8 + (long)(wid * QBLK + r32) * 1280 + hi * 32), (const bf16_t*)K8, Vh, SB, (char*)smem, 0, 0.08838834764831845f, o, l);
    else attn_loop<8, ODD_IN>(Qb + (long)(wid * QBLK + r32) * ODD_IN + hi * 8, Kh, Vh, SB, (char*)smem, 0, 0.08838834764831845f, o, l);
    if (hi == 0) li_l[r32] = l; asm volatile("s_waitcnt lgkmcnt(0)" ::: "memory");
    float rli[16];
#pragma unroll
    for (int r = 0; r < 16; ++r) rli[r] = __builtin_amdgcn_rcpf(li_l[crow(r, hi)]);
    if (OUT1_FP8) store_tile_fp8(o, rli, p.ws + OFF_ACT8 + (size_t)(b * SB + NC + qb * 256 + wid * QBLK) * D + h * 128, D, r32, hi, (float)(1 << A_SHIFT));
    else store_tile_bf16(o, rli, att + (size_t)(b * SB + NC + qb * 256 + wid * QBLK) * D + h * 128, D, r32, hi);
  }
}

DEVI void phase_attn0(const Params& p, const PrepIn& pin, unsigned char* smem) {
  const bf16_t* proj = wsp<bf16_t>(p, OFF_PROJ); bf16_t* cat = wsp<bf16_t>(p, OFF_ACT);
  const int tid = ltid(), wid = tid >> 6, lane = tid & 63, r32 = lane & 31, hi = lane >> 5, mp = wid >> 2, w4 = wid & 3;
  const int vb_ = vbid(); const int xcd = vb_ & 7, slot = vb_ >> 3, nslot = gridDim.x >> 3;
  float* li_l = (float*)((char*)smem + 2 * SHM_V + 2 * SHM_K) + wid * 64;
  float* ex = (float*)smem + (size_t)w4 * 4096 + lane;
  const float lam = wsp<float>(p, OFF_LAM)[0];
  const float* subln = sm(p, SM_SUBLN);
  for (int it = slot; it < 8 * 18; it += nslot) {
    int g, qrow0, seq;
    if (it < 128) { g = xcd + 8 * (it >> 4); qrow0 = NC + (it & 15) * 128; seq = SB; }
    else { const int j = it - 128; g = xcd + 8 * (j >> 1); qrow0 = (j & 1) * 128; seq = NC; }
    const int b = g >> 2, h = g & 3;
    const bf16_t* Qw = proj + (size_t)(b * SB + qrow0 + w4 * QBLK + r32) * EVEN_IN + 1024 + h * 128 + mp * 64 + hi * 8;
    const bf16_t* Kh = proj + (size_t)(b * SB) * EVEN_IN + 1536 + h * 128; const bf16_t* Vh = Kh + 512;
    f32x16 o[4]; float l;
    __syncthreads();
    if constexpr (ATT0_F8) attn_loop<4, EVEN_IN, true, true>((const bf16_t*)(p.ws + OFF_QK8_0 + (size_t)(b * SB + qrow0 + w4 * QBLK + r32) * 1024 + h * 128 + mp * 64 + hi * 32),
                                                           (const bf16_t*)(p.ws + OFF_QK8_0 + (size_t)(b * SB) * 1024 + 512 + h * 128), (const bf16_t*)(p.ws + OFF_VT8_0 + (size_t)((b * 4 + h) * 128) * SB),
                                                           seq, (char*)smem, mp * 128, 0.125f, o, l);
    else attn_loop<4, EVEN_IN>(Qw, Kh, Vh, seq, (char*)smem, mp * 128, 0.125f, o, l);
    if (hi == 0) li_l[r32] = l; asm volatile("s_waitcnt lgkmcnt(0)" ::: "memory");
    float rli[16];
#pragma unroll
    for (int r = 0; r < 16; ++r) rli[r] = __builtin_amdgcn_rcpf(li_l[crow(r, hi)]);
    __syncthreads();
    if (mp == 1) {
#pragma unroll
      for (int d0 = 0; d0 < 4; ++d0)
#pragma unroll
        for (int r = 0; r < 16; ++r) ex[(d0 * 16 + r) * 64] = o[d0][r] * rli[r];
    }
    __syncthreads();
    if (mp == 0) {
      float ss[16];
#pragma unroll
      for (int r = 0; r < 16; ++r) ss[r] = 0.f;
#pragma unroll
      for (int d0 = 0; d0 < 4; ++d0) { const float gcol = subln[d0 * 32 + r32];
#pragma unroll
        for (int r = 0; r < 16; ++r) { const float dv = o[d0][r] * rli[r] - lam * ex[(d0 * 16 + r) * 64]; ss[r] += dv * dv; o[d0][r] = dv * gcol; } }
#pragma unroll
      for (int r = 0; r < 16; ++r) { float v = ss[r];
        v += shx<1>(v); v += shx<2>(v); v += shx<4>(v); v += shx<8>(v); v += shx<16>(v);
        ss[r] = rsqrtf(v * (1.0f / 128) + EPS) * 0.8f; }
      if (OUT0_FP8) store_tile_fp8(o, ss, p.ws + OFF_ACT8 + (size_t)(b * SB + qrow0 + w4 * QBLK) * D + 512 + h * 128, D, r32, hi, (float)(1 << A_SHIFT));
      else store_tile_bf16(o, ss, cat + (size_t)(b * SB + qrow0 + w4 * QBLK) * D + 512 + h * 128, D, r32, hi);
    }
  }
}

DEVI void phase_gmlp(const Params& p, unsigned char* smem) {
  const bf16_t* proj = wsp<bf16_t>(p, OFF_PROJ); bf16_t* cat = wsp<bf16_t>(p, OFF_ACT); const bf16_t* wsa = wsp<bf16_t>(p, OFF_WSA);
  const float* lng = sm(p, SM_ALNG); const float* lnb = sm(p, SM_ALNB); const float* abs_ = sm(p, SM_ABS);
  for (int it = blockIdx.x; it < (T / 128 + 1) / 2; it += gridDim.x) {
    const int tid = ltid(), hf = tid >> 8, ht = tid & 255, wl = ht >> 6, lane = tid & 63, fr = lane & 15, fq = lane >> 4;
    bf16_t* Tl = (bf16_t*)(smem + hf * 36864);
    const int ch = it * 2 + hf; const bool live = ch < T / 128; const int t0 = (live ? ch : 0) * 128;
    const int q = ht >> 1, part = ht & 1;
    float mu, rstd;
    { const bf16_t* vr = proj + (size_t)(t0 + q) * EVEN_IN + 512 + part * 256;
      float s = 0.f, s2 = 0.f;
#pragma unroll
      for (int i = 0; i < 32; ++i) { const u32x4 x = *(const u32x4*)(vr + i * 8);
#pragma unroll
        for (int e = 0; e < 4; ++e) { const float f0 = __uint_as_float(x[e] << 16), f1 = __uint_as_float(x[e] & 0xffff0000u); s += f0 + f1; s2 += f0 * f0 + f1 * f1; } }
      s += shx<1>(s); s2 += shx<1>(s2);
      mu = s * (1.0f / 512); rstd = rsqrtf(fmaxf(s2 * (1.0f / 512) - mu * mu, 0.f) + EPS); }
    for (int g = 0; g < 4; ++g) {
      __syncthreads();
      { const bf16_t* vg = proj + (size_t)(t0 + q) * EVEN_IN + 512 + g * 128 + part * 64;
#pragma unroll
        for (int i = 0; i < 8; ++i) { const u32x4 x = *(const u32x4*)(vg + i * 8); const int d0 = part * 64 + i * 8;
          const f32x4 ga = *(const f32x4*)(lng + g * 128 + d0), gb = *(const f32x4*)(lng + g * 128 + d0 + 4), ba = *(const f32x4*)(lnb + g * 128 + d0), bb = *(const f32x4*)(lnb + g * 128 + d0 + 4);
#pragma unroll
          for (int e = 0; e < 4; ++e) { const float f0 = __uint_as_float(x[e] << 16), f1 = __uint_as_float(x[e] & 0xffff0000u);
            const float gg0 = e < 2 ? ga[2 * e] : gb[2 * e - 4], gg1 = e < 2 ? ga[2 * e + 1] : gb[2 * e - 3], bb0 = e < 2 ? ba[2 * e] : bb[2 * e - 4], bb1 = e < 2 ? ba[2 * e + 1] : bb[2 * e - 3];
            const unsigned w = cvtpk((f0 - mu) * rstd * gg0 + bb0, (f1 - mu) * rstd * gg1 + bb1);
            Tl[(d0 + 2 * e) * 136 + q] = (bf16_t)(w & 0xffff); Tl[(d0 + 2 * e + 1) * 136 + q] = (bf16_t)(w >> 16); } }
      }
      __syncthreads();
      bf16x8 af[2][4];
#pragma unroll
      for (int m = 0; m < 2; ++m)
#pragma unroll
        for (int k = 0; k < 4; ++k) af[m][k] = *(const bf16x8*)(wsa + (size_t)(g * 128 + wl * 32 + m * 16 + fr) * 128 + k * 32 + fq * 8);
      f32x4 acc[2][8];
#pragma unroll
      for (int m = 0; m < 2; ++m)
#pragma unroll
        for (int n = 0; n < 8; ++n) acc[m][n] = (f32x4){0.f, 0.f, 0.f, 0.f};
#pragma unroll
      for (int k = 0; k < 4; ++k)
#pragma unroll
        for (int n = 0; n < 8; ++n) { const bf16x8 bfr = *(const bf16x8*)(Tl + (16 * n + fr) * 136 + k * 32 + fq * 8);
          acc[0][n] = __builtin_amdgcn_mfma_f32_16x16x32_bf16(bfr, af[0][k], acc[0][n], 0, 0, 0);
          acc[1][n] = __builtin_amdgcn_mfma_f32_16x16x32_bf16(bfr, af[1][k], acc[1][n], 0, 0, 0); }
      if (live) {
#pragma unroll
        for (int m = 0; m < 2; ++m) { const int pp = wl * 32 + m * 16 + fr; const size_t t = (size_t)t0 + pp; const float bias = abs_[g * 128 + pp];
#pragma unroll
          for (int n = 0; n < 8; ++n) { const int c = g * 128 + 16 * n + 4 * fq;
            const u32x2 uu = *(const u32x2*)(proj + t * EVEN_IN + c);
            const float o0 = __uint_as_float(uu.x << 16) * (acc[m][n][0] + bias), o1 = __uint_as_float(uu.x & 0xffff0000u) * (acc[m][n][1] + bias);
            const float o2 = __uint_as_float(uu.y << 16) * (acc[m][n][2] + bias), o3 = __uint_as_float(uu.y & 0xffff0000u) * (acc[m][n][3] + bias);
            if (OUT0_FP8) { const float xs = (float)(1 << A_SHIFT); int w8 = 0;
              w8 = __builtin_amdgcn_cvt_pk_fp8_f32(__builtin_amdgcn_fmed3f(o0 * xs, -440.f, 440.f), __builtin_amdgcn_fmed3f(o1 * xs, -440.f, 440.f), w8, false);
              w8 = __builtin_amdgcn_cvt_pk_fp8_f32(__builtin_amdgcn_fmed3f(o2 * xs, -440.f, 440.f), __builtin_amdgcn_fmed3f(o3 * xs, -440.f, 440.f), w8, true);
              *(int*)(p.ws + OFF_ACT8 + t * D + c) = w8; }
            else { u32x2 w; w.x = cvtpk(o0, o1); w.y = cvtpk(o2, o3);
              *(u32x2*)(cat + t * D + c) = w; } } }
      }
    }
  }
}
#undef KSWZ
#undef SBAR
}
#define REP_PREP 1
#define REP_NORM1 1
#define REP_IN0 1
#define REP_ATT0 1
#define REP_GMLP 1
#define REP_OUT0 1
#define REP_GU 1
#define REP_IN1 1
#define REP_ATT1 1
#define REP_SYNC 0
#define DRY_IN0 0
#define DRY_DOWN 0
#define DRY_GU 0
#define REP_ROUTER 1
#define REP_DOWN 1
#define REP_COMB 1
#define REPEAT(n, stmt) { int _n = (n); if ((n) > 1) asm volatile("" : "+s"(_n)); for (int _r = 0; _r < _n; ++_r) { stmt; if (_r + 1 < _n) GSYNC(); } }
__global__ __launch_bounds__(512) void mega(Params p0, PrepIn pin) {
  cg::grid_group grid = cg::this_grid();
  LAS unsigned char* lds = (LAS unsigned char*)smem;
  volatile LAS unsigned* xst = (volatile LAS unsigned*)(lds + SMEM_BYTES - 16);
  if (threadIdx.x == 0) { xst[0] = 0u; xst[1] = 0u; }
  ltid_init();
  XcdBarrier xb = xcd_barrier_post((unsigned*)(p0.ws + OFF_ZERO), xst);
  if (threadIdx.x == 0) { volatile LAS int* vbp = (volatile LAS int*)(lds + LDS_VBID); vbp[0] = (int)blockIdx.x;
    vbp[1] = (int)xb_add((unsigned*)(p0.ws + OFF_XRANK) + xb.x, 1u); }
#define GSYNC() xcd_barrier(xb)
#define ROUTER(c) { int _n = REP_ROUTER; if (REP_ROUTER > 1) asm volatile("" : "+s"(_n)); for (int _r = 0; _r < _n; ++_r) { \
      if (_r > 0) { if (blockIdx.x == 0 && threadIdx.x < 128) ((int*)(p0.ws + OFF_CNT))[c.l * 128 + threadIdx.x] = 0; GSYNC(); } \
      stage_router(launder(p0), c, smem); if (_r + 1 < _n) GSYNC(); } }
#define MOE_HALF(c, half, FUSE) do { \
    REPEAT(REP_GU, { const Params pl = launder(p0); fg::moe_tables(pl, c, half, 2, lds); int dry = (DRY_GU && _r > 0) ? DRY_GU : 0; if (DRY_GU) { asm volatile("" : "+v"(dry)); dry = __builtin_amdgcn_readfirstlane(dry); } fg::JobGU J(pl, c, half, lds, dry); fg::gemm_phase(lds, J); }) \
    GSYNC(); \
    { int _n = REP_DOWN; if (REP_DOWN > 1) asm volatile("" : "+s"(_n)); for (int _r = 0; _r < _n; ++_r) { float ds = _r == 0 ? 1.0f : (DRY_DOWN ? -1.0f : 0.0f); if (REP_DOWN > 1) { asm volatile("" : "+v"(ds)); ds = __int_as_float(__builtin_amdgcn_readfirstlane(__float_as_int(ds))); } \
        const Params pl = launder(p0); fg::moe_tables(pl, c, half, 4, lds); fg::JobDown J(pl, c, half, lds, ds); fg::gemm_phase(lds, J); if (_r + 1 < _n) GSYNC(); } } \
    GSYNC(); \
    { int _n = REP_COMB; if (REP_COMB > 1) asm volatile("" : "+s"(_n)); for (int _r = 0; _r < _n; ++_r) { float ds = _r == 0 ? 1.0f : 0.0f; if (REP_COMB > 1) asm volatile("" : "+v"(ds)); \
        stage_combine<FUSE>(launder(p0), c, half, smem, ds); if (_r + 1 < _n) GSYNC(); } } \
    } while (0)
  for (int _r = 0; _r < REP_PREP; ++_r) { stage_prep(p0, pin, smem); if (_r + 1 < REP_PREP) __syncthreads(); }
  grid.sync();
  if (threadIdx.x == 0) {
    bool ok = true; const unsigned per = gridDim.x >> 3;
    for (int j = 0; j < 16; ++j) { const unsigned c = xb_ld((unsigned*)(p0.ws + OFF_XRANK) + j); ok = ok && (c == (j < 8 ? per : 0u)); }
    volatile LAS int* vbp = (volatile LAS int*)(lds + LDS_VBID);
    if (ok && (gridDim.x & 7) == 0) vbp[0] = (int)xb.x + 8 * vbp[1]; }
  __syncthreads();
  REPEAT(REP_NORM1, stage_norm1<0>(launder(p0))) GSYNC();
  REPEAT(REP_IN0, { const Params pl = launder(p0); fg::load_rope_lds(pl, OFF_TAB64, 512, SM_BQN, SM_BKN, 64, lds); int dry = (DRY_IN0 && _r > 0) ? DRY_IN0 : 0; if (DRY_IN0) { asm volatile("" : "+v"(dry)); dry = __builtin_amdgcn_readfirstlane(dry); } fg::JobIn0 J(pl, dry); fg::gemm_phase(lds, J); })
  GSYNC();
  REPEAT(REP_ATT0, fa::phase_attn0(launder(p0), pin, smem))
  REPEAT(REP_GMLP, fa::phase_gmlp(launder(p0), smem))
  GSYNC();
  REPEAT(REP_OUT0, { const Params pl = launder(p0); fg::JobOut<0> J(pl); fg::gemm_phase(lds, J); })
  expert_prep_steal(launder(p0), pin, smem, 0);
  GSYNC();
  { const LCfg c{0, SB, 0, 16 * SB};
    ROUTER(c); GSYNC();
    MOE_HALF(c, 0, true); GSYNC(); }
  { int _n = REP_SYNC; if (REP_SYNC > 0) asm volatile("" : "+s"(_n)); for (int _r = 0; _r < _n; ++_r) GSYNC(); }
  REPEAT(REP_IN1, { const Params pl = launder(p0); fg::load_rope_lds(pl, OFF_TAB128, 1024, SM_CQN, SM_CKN, 128, lds); fg::JobIn1 J(pl); fg::gemm_phase(lds, J); })
  expert_prep_steal(launder(p0), pin, smem, 1);
  GSYNC();
  REPEAT(REP_ATT1, fa::phase_attn1(launder(p0), pin, smem))
  GSYNC();
  { const Params pl = launder(p0); fg::JobOut<1> J(pl); fg::gemm_phase(lds, J); }
  GSYNC();
  { const LCfg c{1, S, NC, 16 * S};
    ROUTER(c); GSYNC();
    MOE_HALF(c, 0, false); }
}

extern "C" void kernel_launch(void* const* d_in, const int* in_sizes, int n_in, void* d_out, int out_size, void* d_ws, size_t ws_size, hipStream_t stream) {
  static int grid_blocks = 0;
  if (!grid_blocks) {
    if (n_in != 33 || ws_size < WS_TOTAL) { fprintf(stderr, "kernel_launch: bad n_in %d or ws %zu < %zu\n", n_in, ws_size, (size_t)WS_TOTAL); return; }
    if (hipFuncSetAttribute((const void*)mega, hipFuncAttributeMaxDynamicSharedMemorySize, SMEM_BYTES) != hipSuccess) { fprintf(stderr, "set attr failed\n"); return; }
    int dev = 0, cus = 0, per_cu = 0;
    hipGetDevice(&dev); hipDeviceGetAttribute(&cus, hipDeviceAttributeMultiprocessorCount, dev);
    hipOccupancyMaxActiveBlocksPerMultiprocessor(&per_cu, mega, 512, SMEM_BYTES);
    if (per_cu < 1) { fprintf(stderr, "occupancy 0\n"); return; }
    grid_blocks = cus;
  }
  Params p; memset(&p, 0, sizeof(p)); PrepIn pin; memset(&pin, 0, sizeof(pin));
  for (int i = 0; i < 33; ++i) pin.in[i] = (const float*)d_in[i];
  p.out = (float*)d_out; p.ws = (unsigned char*)d_ws;
  p.x = pin.in[I_X]; p.ctx = pin.in[I_CTX];
  hipMemsetAsync(d_ws, 0, ZERO_BYTES, stream);
  void* args[] = {&p, &pin};
  hipError_t e = hipLaunchCooperativeKernel((void*)mega, dim3(grid_blocks), dim3(512), args, SMEM_BYTES, stream);
  if (e != hipSuccess) fprintf(stderr, "cooperative launch failed: %s (grid %d)\n", hipGetErrorString(e), grid_blocks);
}
```

```cpp
#include <hip/hip_runtime.h>
#include <hip/hip_cooperative_groups.h>
#include <cstdio>
#include <cstdint>
#include <cstring>
namespace cg = cooperative_groups;

#define DEVI __device__ __forceinline__
#define LAS __attribute__((address_space(3)))
typedef unsigned short bf16_t;
typedef short bf16x8 __attribute__((ext_vector_type(8)));
typedef float f32x4 __attribute__((ext_vector_type(4)));
typedef unsigned u32x4 __attribute__((ext_vector_type(4)));
typedef unsigned u32x2 __attribute__((ext_vector_type(2)));

constexpr int D = 1024, NB = 16, S = 2048, NC = 256, SB = 2304, T = NB * SB, TX = NB * S;
constexpr int NE = 64, TOPK = 6, DE = 256;
constexpr int EVEN_IN = 2560, ODD_IN = 1536;
constexpr float EPS = 1e-6f;

constexpr size_t al256(size_t x) { return (x + 255) & ~(size_t)255; }
constexpr size_t OFF_ZERO = 0, ZERO_BYTES = 65536;
constexpr size_t OFF_CNT = 16384;
constexpr size_t OFF_XRANK = 20608;
constexpr size_t OFF_STEAL = 20480;
constexpr size_t OFF_TAB64 = OFF_ZERO + ZERO_BYTES;
constexpr size_t OFF_TAB128 = OFF_TAB64 + 64 * 16 * 8;
constexpr size_t OFF_LAM = OFF_TAB128 + 64 * 32 * 8;
constexpr size_t OFF_MODV = al256(OFF_LAM + 256);
constexpr size_t OFF_SMALL = al256(OFF_MODV + (size_t)2 * 17 * 6144 * 4);
enum { SM_N1G = 0, SM_N2G = 2048, SM_ALNG = 4096, SM_ALNB = 4608, SM_ABS = 5120, SM_BQN = 5632, SM_BKN = 5696, SM_SUBLN = 5760, SM_CQN = 5888, SM_CKN = 6016, SM_MBIAS = 6144,
       SM_AWSF = 8192, SM_ROUTER = 73728, SM_END = 204800 };
constexpr size_t OFF_WIN0T = al256(OFF_SMALL + (size_t)SM_END * 4);
constexpr size_t OFF_WOUT0T = OFF_WIN0T + (size_t)EVEN_IN * D * 2;
constexpr size_t OFF_WQKV1T = OFF_WOUT0T + (size_t)D * D * 2;
constexpr size_t OFF_WOUT1T = OFF_WQKV1T + (size_t)ODD_IN * D * 2;
constexpr size_t OFF_WSA = OFF_WOUT1T + (size_t)D * D * 2;
constexpr size_t OFF_WRT = OFF_WSA + (size_t)4 * 128 * 128 * 2;
constexpr size_t OFF_SHGU = OFF_WRT + (size_t)2 * NE * D * 2;
constexpr size_t OFF_SHD = OFF_SHGU + (size_t)2 * 512 * D * 2;
constexpr size_t OFF_EGU = OFF_SHD + (size_t)2 * D * DE * 2;
constexpr size_t OFF_ED = OFF_EGU + (size_t)NE * 512 * D;
constexpr size_t OFF_HB = OFF_ED + (size_t)NE * D * DE;
constexpr size_t OFF_HC = OFF_HB;
constexpr size_t OFF_ACT = OFF_HB + (size_t)T * D * 2;
constexpr size_t OFF_TOPW = OFF_ACT + (size_t)T * D * 2;
constexpr size_t OFF_TOPP = al256(OFF_TOPW + (size_t)T * 6 * 4);
constexpr size_t OFF_LIST = al256(OFF_TOPP + (size_t)T * 6 * 4);
constexpr int LCAP = 36864;
constexpr size_t OFF_R = al256(OFF_LIST + (size_t)NE * LCAP * 4);
constexpr size_t OFF_PROJ = OFF_R;
constexpr size_t OFF_SLOT = OFF_R;
constexpr size_t OFF_QK8 = al256(OFF_R + (size_t)120000000);
constexpr size_t OFF_VT8 = al256(OFF_QK8 + (size_t)T * 1280);
constexpr size_t OFF_QK8_0 = al256(OFF_R + (size_t)192000000);
constexpr size_t OFF_VT8_0 = al256(OFF_QK8_0 + (size_t)T * 1024);
constexpr size_t OFF_HID = al256(OFF_SLOT + (size_t)258048 * D);
constexpr size_t OFF_ACT8 = al256(OFF_HID + (size_t)(258048 + 256) * DE);
constexpr size_t WS_TOTAL = OFF_ACT8 + (size_t)T * D;
static_assert(OFF_HID >= OFF_R + (size_t)0, "layout");
static_assert(OFF_R + (size_t)T * EVEN_IN * 2 <= WS_TOTAL, "proj fits");
static_assert(WS_TOTAL <= 636368384ull, "workspace budget");
static_assert((size_t)T * ODD_IN * 2 <= 120000000ull && OFF_VT8 + (size_t)NB * 2 * 128 * SB <= OFF_SLOT + (size_t)258048 * D, "QK8 / VT8 placement");
static_assert((size_t)T * EVEN_IN * 2 <= 192000000ull && OFF_VT8_0 + (size_t)NB * 4 * 128 * SB <= OFF_SLOT + (size_t)258048 * D, "layer-0 QK8 / VT8 placement");

struct Params {
  float* out;
  unsigned char* ws;
  const float* x; const float* ctx;
};
struct PrepIn { const float* in[33]; };
typedef __attribute__((address_space(1))) unsigned char* gptr_t;
__device__ __forceinline__ Params launder(const Params& p) {
  unsigned long long a = (unsigned long long)p.out, b = (unsigned long long)p.ws, c = (unsigned long long)p.x, d = (unsigned long long)p.ctx;
  asm volatile("" : "+s"(a), "+s"(b), "+s"(c), "+s"(d));
  Params q; q.out = (float*)(gptr_t)a; q.ws = (unsigned char*)(gptr_t)b; q.x = (const float*)(gptr_t)c; q.ctx = (const float*)(gptr_t)d; return q; }
enum { I_X = 0, I_C, I_CTX, I_CCTX, I_MODW, I_MODB, I_N1G, I_N2G, I_EVWIN, I_EVWOUT, I_ALNG, I_ALNB, I_AWS, I_ABS, I_BQN, I_BKN,
       I_LQ1, I_LK1, I_LQ2, I_LK2, I_SUBLN, I_ODQKV, I_ODOUT, I_CQN, I_CKN, I_ROUTER, I_MBIAS, I_WG, I_WU, I_WD, I_SG, I_SU, I_SD };

extern __shared__ __attribute__((aligned(16))) unsigned char smem[];
constexpr int SMEM_BYTES = 152 * 1024;
constexpr int LDS_WTAB = SMEM_BYTES - 512;
DEVI int ltid() {
  const unsigned slot = (unsigned)__builtin_amdgcn_s_getreg(63492) & 0x3fu;
  const int wv = __builtin_amdgcn_readfirstlane(*(volatile LAS int*)((LAS unsigned char*)smem + LDS_WTAB + slot * 4));
  int l; asm volatile("v_mbcnt_lo_u32_b32 %0, -1, 0\n\tv_mbcnt_hi_u32_b32 %0, -1, %0" : "=v"(l));
  return wv * 64 + l;
}
constexpr int LDS_VBID = LDS_WTAB + 256;
DEVI int vbid() { return __builtin_amdgcn_readfirstlane(*(volatile LAS int*)((LAS unsigned char*)smem + LDS_VBID)); }
DEVI void ltid_init() {
  const unsigned slot = (unsigned)__builtin_amdgcn_s_getreg(63492) & 0x3fu;
  if ((threadIdx.x & 63) == 0) *(volatile LAS int*)((LAS unsigned char*)smem + LDS_WTAB + slot * 4) = (int)(threadIdx.x >> 6);
  __syncthreads();
}
template <int M> DEVI float shx(float v) { static_assert(M == 1 || M == 2 || M == 4 || M == 8 || M == 16, "xor mask");
  return __int_as_float(__builtin_amdgcn_ds_swizzle(__float_as_int(v), (M << 10) | 0x1f)); }
template <int CTRL> DEVI float dppf(float v) { return __int_as_float(__builtin_amdgcn_update_dpp(0, __float_as_int(v), CTRL, 0xf, 0xf, true)); }
DEVI float rlane(float v, int l) { return __int_as_float(__builtin_amdgcn_readlane(__float_as_int(v), l)); }
DEVI float wsum_dpp(float v) { v += dppf<0xB1>(v); v += dppf<0x4E>(v); v += dppf<0x141>(v); v += dppf<0x140>(v); return (rlane(v, 0) + rlane(v, 16)) + (rlane(v, 32) + rlane(v, 48)); }
DEVI float wmax_dpp(float v) { v = fmaxf(v, dppf<0xB1>(v)); v = fmaxf(v, dppf<0x4E>(v)); v = fmaxf(v, dppf<0x141>(v)); v = fmaxf(v, dppf<0x140>(v)); return fmaxf(fmaxf(rlane(v, 0), rlane(v, 16)), fmaxf(rlane(v, 32), rlane(v, 48))); }
DEVI float max8_dpp(float v) { v = fmaxf(v, dppf<0xB1>(v)); v = fmaxf(v, dppf<0x4E>(v)); return fmaxf(v, dppf<0x141>(v)); }
DEVI float sum32x(float v) { auto r = __builtin_amdgcn_permlane32_swap(__float_as_uint(v), __float_as_uint(v), false, false); return __uint_as_float(r[0]) + __uint_as_float(r[1]); }
DEVI float max32x(float v) { auto r = __builtin_amdgcn_permlane32_swap(__float_as_uint(v), __float_as_uint(v), false, false); return fmaxf(__uint_as_float(r[0]), __uint_as_float(r[1])); }
DEVI bf16_t f2bf(float f) { unsigned u = __float_as_uint(f); u += 0x7FFFu + ((u >> 16) & 1u); return (bf16_t)(u >> 16); }
DEVI float bf2f(bf16_t b) { return __uint_as_float(((unsigned)b) << 16); }
DEVI unsigned pack2(float lo, float hi) { return (unsigned)f2bf(lo) | ((unsigned)f2bf(hi) << 16); }
DEVI float wsum(float v) { v += shx<1>(v); v += shx<2>(v); v += shx<4>(v); v += shx<8>(v); v += shx<16>(v); return sum32x(v); }
DEVI float wmax(float v) { v = fmaxf(v, shx<1>(v)); v = fmaxf(v, shx<2>(v)); v = fmaxf(v, shx<4>(v)); v = fmaxf(v, shx<8>(v)); v = fmaxf(v, shx<16>(v)); return max32x(v); }
DEVI float gelu_exact(float v) { return 0.5f * v * (1.0f + erff(v * 0.70710678118654752f)); }
DEVI float silu(float v) { return v / (1.0f + __expf(-v)); }

template <class Tp> DEVI Tp* wsp(const Params& p, size_t off) { return (Tp*)(p.ws + off); }
DEVI const float* sm(const Params& p, int off) { return (const float*)(p.ws + OFF_SMALL) + off; }
DEVI const float* in_row(const Params& p, int t) { int b = t / SB, j = t - b * SB;
  unsigned long long xa = (unsigned long long)p.x, ca = (unsigned long long)p.ctx; asm volatile("" : "+s"(xa), "+s"(ca));
  const float* xp = (const float*)(gptr_t)xa; const float* cp = (const float*)(gptr_t)ca;
  return j < NC ? cp + ((size_t)(b * NC + j)) * D : xp + ((size_t)(b * S + j - NC)) * D; }
DEVI f32x4 bf4(u32x2 r) { return (f32x4){__uint_as_float(r.x << 16), __uint_as_float(r.x & 0xffff0000u), __uint_as_float(r.y << 16), __uint_as_float(r.y & 0xffff0000u)}; }
DEVI float* hid_row(const Params& p, int t) { int b = t / SB, j = t - b * SB;
  return j < NC ? wsp<float>(p, OFF_HC) + ((size_t)(b * NC + j)) * D : p.out + ((size_t)(b * S + j - NC)) * D; }
DEVI const float* modv(const Params& p, int l, int t, int which) { int b = t / SB, j = t - b * SB; int r = j < NC ? 16 : b;
  return wsp<float>(p, OFF_MODV) + ((size_t)(l * 17 + r)) * 6144 + which * D; }

#define XB_TMO      128
#define XB_XCNT(j)  (256  + 64 * (j))
#define XB_XSUB(j)  (1280 + 64 * (j))
#define XB_XGEN(j)  (2304 + 64 * (j))
#define XB_TOP      3328
#define XB_TOPGEN   3392
#define XCD_BAR_WORDS 3456
#define XB_SPIN_CAP (1u << 22)
DEVI unsigned xb_ld(unsigned* p) { return __hip_atomic_load(p, __ATOMIC_RELAXED, __HIP_MEMORY_SCOPE_AGENT); }
DEVI unsigned xb_add(unsigned* p, unsigned v) { return __hip_atomic_fetch_add(p, v, __ATOMIC_RELAXED, __HIP_MEMORY_SCOPE_AGENT); }
DEVI unsigned xb_xcc_id() { return (unsigned)__builtin_amdgcn_s_getreg((3 << 11) | 20) & 0xFu; }
#define XB_SPIN(cond, bar) do { unsigned _sp = 0; while (cond) { __builtin_amdgcn_s_sleep(1); \
    if ((++_sp & 255u) == 0u) { if (xb_ld(&(bar)[XB_TMO])) break; if (_sp > XB_SPIN_CAP) { atomicAdd(&(bar)[XB_TMO], 1u); break; } } } } while (0)
struct XcdBarrier { unsigned* bar; unsigned x; volatile LAS unsigned* st; };
DEVI XcdBarrier xcd_barrier_post(unsigned* bar, volatile LAS unsigned* st) {
  XcdBarrier b; b.bar = bar; b.x = xb_xcc_id(); b.st = st;
  if (ltid() == 0) (void)xb_add(&bar[XB_XCNT(b.x)], 1u);
  return b;
}
DEVI void xcd_barrier_complete(unsigned* bar, unsigned x, unsigned& nloc, unsigned& nx) {
  const unsigned G = gridDim.x * gridDim.y * gridDim.z;
  unsigned sum, cnt, mine, sp = 0u;
  for (;;) {
    sum = 0u; cnt = 0u; mine = 0u;
#pragma unroll
    for (unsigned j = 0; j < 16; ++j) { const unsigned c = xb_ld(&bar[XB_XCNT(j)]); sum += c; cnt += (c > 0u) ? 1u : 0u; mine = (j == x) ? c : mine; }
    if (sum == G) break;
    __builtin_amdgcn_s_sleep(1);
    if ((++sp & 255u) == 0u) { if (xb_ld(&bar[XB_TMO])) break; if (sp > XB_SPIN_CAP) { atomicAdd(&bar[XB_TMO], 1u); break; } }
  }
  nloc = mine > 0u ? mine : 1u; nx = cnt > 0u ? cnt : 1u;
}
DEVI void xcd_barrier(const XcdBarrier& b) {
  asm volatile("s_waitcnt vmcnt(0)" ::: "memory");
  __syncthreads();
  if (ltid() == 0) {
    unsigned* bar = b.bar;
    __builtin_amdgcn_s_waitcnt(0);
    unsigned nloc = b.st[0], nx = b.st[1];
    if (nloc == 0u) { xcd_barrier_complete(bar, b.x, nloc, nx); b.st[0] = nloc; b.st[1] = nx; }
    const unsigned old = xb_add(&bar[XB_XSUB(b.x)], 1u);
    const unsigned gen = old / nloc;
    if (old + 1u == (gen + 1u) * nloc) {
      __builtin_amdgcn_fence(__ATOMIC_RELEASE, "agent");
      asm volatile("s_waitcnt vmcnt(0)" ::: "memory");
      const unsigned og = xb_add(&bar[XB_TOP], 1u);
      const unsigned tg = og / nx;
      if (og + 1u == (tg + 1u) * nx) xb_add(&bar[XB_TOPGEN], 1u);
      else XB_SPIN(xb_ld(&bar[XB_TOPGEN]) == tg, bar);
      __builtin_amdgcn_fence(__ATOMIC_ACQUIRE, "agent");
      xb_add(&bar[XB_XGEN(b.x)], 1u);
      asm volatile("s_waitcnt vmcnt(0)" ::: "memory");
    } else {
      XB_SPIN(xb_ld(&bar[XB_XGEN(b.x)]) == gen, bar);
      __builtin_amdgcn_fence(__ATOMIC_ACQUIRE, "agent");
      asm volatile("s_waitcnt vmcnt(0)" ::: "memory");
    }
  }
  __syncthreads();
}

DEVI void transpose_tiles(const float* srcb, unsigned char* dstb, int K, int N, int nb, size_t sstride, size_t dstride, unsigned char* smem, int& goff) {
  const int G = gridDim.x, tk = K / 128, tn = N / 256, per = tk * tn, total = per * nb, tid = ltid();
  const int first = (((int)blockIdx.x - goff) % G + G) % G;
  const int n4 = tid & 63, kp0 = tid >> 6;
  f32x4 va[8], vb[8];
  auto issue = [&](int ti) { const int m = ti / per, r = ti - m * per, kb = r / tn, nb_ = r - kb * tn;
    const float* src = srcb + (size_t)m * sstride + (size_t)(kb * 128) * N + nb_ * 256 + n4 * 4;
#pragma unroll
    for (int i = 0; i < 8; ++i) { const int kp = kp0 + 8 * i; va[i] = __builtin_nontemporal_load((const f32x4*)(src + (size_t)(2 * kp) * N)); vb[i] = __builtin_nontemporal_load((const f32x4*)(src + (size_t)(2 * kp + 1) * N)); } };
  if (first < total) issue(first);
  int par = 0;
  for (int ti = first; ti < total; ti += G, par ^= 1) {
    unsigned* Tb = (unsigned*)smem + par * 16384;
#pragma unroll
    for (int i = 0; i < 8; ++i) { const int kp = kp0 + 8 * i;
#pragma unroll
      for (int j = 0; j < 4; ++j) { const int n = n4 * 4 + j; Tb[n * 64 + (kp ^ (((n >> 2) & 7) << 2))] = pack2(va[i][j], vb[i][j]); } }
    if (ti + G < total) issue(ti + G);
    __syncthreads();
    const int m = ti / per, r = ti - m * per, kb = r / tn, nb_ = r - kb * tn;
    bf16_t* dst = (bf16_t*)dstb + (size_t)m * dstride + (size_t)(nb_ * 256) * K + kb * 128;
#pragma unroll
    for (int i = 0; i < 8; ++i) { const int pc = tid + 512 * i, n = pc >> 4, q = pc & 15;
      const u32x4 w = *(const u32x4*)(Tb + n * 64 + ((4 * q) ^ (((n >> 2) & 7) << 2)));
      *(u32x4*)(dst + (size_t)n * K + 8 * q) = w; }
  }
  __syncthreads();
  goff = (goff + total) % G;
}

constexpr int WD_SHIFT = 4, H_SHIFT = 2, WG_SHIFT = 5, X_SHIFT = 3, WQ_SHIFT = 5;
constexpr bool IN1_FP8 = true, IN0_FP8 = true, OUT0_FP8 = true, OUT1_FP8 = true;
constexpr bool ATT1_QK8 = true;
constexpr bool ATT0_F8 = true;
constexpr bool ATT1_PV8 = true;
constexpr int VS_SHIFT = 2, PS_SHIFT = 4;
constexpr int QS_SHIFT = 2;
constexpr int A_SHIFT = 3;
DEVI void transpose_panel8(const float* src0, unsigned char* dst0, int K, int N, int kb, int nb_, unsigned char* smem, int shift = WD_SHIFT) {
  const int tid = ltid(), n4 = tid & 63, kq0 = tid >> 6; unsigned* Tb = (unsigned*)smem;
  const float* src = src0 + (size_t)(kb * 128) * N + nb_ * 256 + n4 * 4; unsigned char* dst = dst0 + (size_t)(nb_ * 256) * K + kb * 128;
  f32x4 v[4][4];
#pragma unroll
  for (int i = 0; i < 4; ++i)
#pragma unroll
    for (int r = 0; r < 4; ++r) v[i][r] = __builtin_nontemporal_load((const f32x4*)(src + (size_t)(4 * (kq0 + 8 * i) + r) * N));
  const float sc = (float)(1 << shift);
#pragma unroll
  for (int i = 0; i < 4; ++i) { const int kq = kq0 + 8 * i;
#pragma unroll
    for (int j = 0; j < 4; ++j) { const int n = n4 * 4 + j; int w = 0;
      w = __builtin_amdgcn_cvt_pk_fp8_f32(v[i][0][j] * sc, v[i][1][j] * sc, w, false); w = __builtin_amdgcn_cvt_pk_fp8_f32(v[i][2][j] * sc, v[i][3][j] * sc, w, true);
      Tb[n * 32 + (kq ^ (((n >> 2) & 7) << 2))] = (unsigned)w; } }
  __syncthreads();
#pragma unroll
  for (int i = 0; i < 4; ++i) { const int pc = tid + 512 * i, n = pc >> 3, q = pc & 7;
    const u32x4 w = *(const u32x4*)(Tb + n * 32 + ((4 * q) ^ (((n >> 2) & 7) << 2)));
    *(u32x4*)(dst + (size_t)n * K + 16 * q) = w; }
}
DEVI void transpose_all8(const float* src, unsigned char* dst, int K, int N, int shift, unsigned char* smem, int& goff) {
  const int G = gridDim.x, tk = K / 128, tn = N / 256, total = tk * tn;
  const int first = (((int)blockIdx.x - goff) % G + G) % G;
  for (int ti = first; ti < total; ti += G) { __syncthreads(); const int kb = ti / tn, nb_ = ti - kb * tn; transpose_panel8(src, dst, K, N, kb, nb_, smem, shift); }
  __syncthreads();
  goff = (goff + total) % G;
}
DEVI void stage_prep(const Params& p, const PrepIn& pin, unsigned char* smem) {
  const int tid = ltid(), bid = blockIdx.x, G = gridDim.x;
  {
    float* sl = (float*)smem;
    for (int i = tid; i < 17 * 1024; i += 512) { int r = i >> 10, k = i & 1023; float v; if (r < 16) v = pin.in[I_C][r * 1024 + k]; else v = pin.in[I_CCTX][k]; sl[i] = silu(v); }
    __syncthreads();
    float* part = (float*)(smem + 17 * 1024 * 4);
    for (int cb = bid; cb < 256; cb += G) {
      const int col0 = cb * 48;
      if (tid < 384) {
        const int kc = tid / 48, c = tid - kc * 48, gc = col0 + c, l = gc / 6144, n = gc - l * 6144;
        const float* w = pin.in[I_MODW] + (size_t)l * 1024 * 6144 + n;
        float acc[17];
#pragma unroll
        for (int r = 0; r < 17; ++r) acc[r] = 0.f;
        for (int k = kc * 128; k < kc * 128 + 128; ++k) { float wv = w[(size_t)k * 6144];
#pragma unroll
          for (int r = 0; r < 17; ++r) acc[r] += sl[r * 1024 + k] * wv; }
#pragma unroll
        for (int r = 0; r < 17; ++r) part[(kc * 17 + r) * 48 + c] = acc[r];
      }
      __syncthreads();
      for (int i = tid; i < 17 * 48; i += 512) { int r = i / 48, c = i - r * 48, gc = col0 + c, l = gc / 6144, n = gc - l * 6144;
        float s = pin.in[I_MODB][l * 6144 + n];
        for (int kc = 0; kc < 8; ++kc) s += part[(kc * 17 + r) * 48 + c];
        wsp<float>(p, OFF_MODV)[((size_t)(l * 17 + r)) * 6144 + n] = s; }
      __syncthreads();
    }
  }
  if (bid == 0) {
    float2* t64 = wsp<float2>(p, OFF_TAB64); float2* t128 = wsp<float2>(p, OFF_TAB128);
    for (int i = tid; i < 64 * 16; i += 512) { int pos = i >> 4, f = i & 15; float inv = exp2f(-(float)f * (13.287712379549449f / 16.0f)); float a = (float)pos * inv; t64[i] = make_float2(__cosf(a), __sinf(a)); }
    for (int i = tid; i < 64 * 32; i += 512) { int pos = i >> 5, f = i & 31; float inv = exp2f(-(float)f * (13.287712379549449f / 32.0f)); float a = (float)pos * inv; t128[i] = make_float2(__cosf(a), __sinf(a)); }
    if (tid < 64) { float a = pin.in[I_LQ1][tid] * pin.in[I_LK1][tid], b = pin.in[I_LQ2][tid] * pin.in[I_LK2][tid]; a = wsum(a); b = wsum(b);
      if (tid == 0) wsp<float>(p, OFF_LAM)[0] = expf(a) - expf(b) + 0.2f; }
  }
  { float* smw = wsp<float>(p, OFF_SMALL); const int gt = bid * 512 + tid, gs = G * 512;
#define CPY(idx, off, n) for (int i = gt; i < (n); i += gs) smw[(off) + i] = pin.in[idx][i];
    CPY(I_N1G, SM_N1G, 2048) CPY(I_N2G, SM_N2G, 2048) CPY(I_ALNG, SM_ALNG, 512) CPY(I_ALNB, SM_ALNB, 512) CPY(I_ABS, SM_ABS, 512) CPY(I_BQN, SM_BQN, 64) CPY(I_BKN, SM_BKN, 64)
    CPY(I_SUBLN, SM_SUBLN, 128) CPY(I_CQN, SM_CQN, 128) CPY(I_CKN, SM_CKN, 128) CPY(I_MBIAS, SM_MBIAS, 128) CPY(I_AWS, SM_AWSF, 65536) CPY(I_ROUTER, SM_ROUTER, 131072)
#undef CPY
  }
  for (int i = bid * 512 + tid; i < 2 * NE * D; i += G * 512) { const int l = i >> 16, e = (i >> 10) & 63, kk = i & 1023; wsp<bf16_t>(p, OFF_WRT)[i] = f2bf(pin.in[I_ROUTER][((size_t)l * D + kk) * NE + e]); }
  for (int i = bid * 512 + tid; i < 4 * 128 * 128; i += G * 512) wsp<bf16_t>(p, OFF_WSA)[i] = f2bf(pin.in[I_AWS][i]);
  int goff = 0;
  const size_t EW = (size_t)D * DE;
  __syncthreads();
  if (IN0_FP8) transpose_all8(pin.in[I_EVWIN], p.ws + OFF_WIN0T, D, EVEN_IN, WQ_SHIFT, smem, goff);
  else transpose_tiles(pin.in[I_EVWIN], p.ws + OFF_WIN0T, D, EVEN_IN, 1, 0, 0, smem, goff);
  if (OUT0_FP8) transpose_all8(pin.in[I_EVWOUT], p.ws + OFF_WOUT0T, D, D, WQ_SHIFT, smem, goff);
  else transpose_tiles(pin.in[I_EVWOUT], p.ws + OFF_WOUT0T, D, D, 1, 0, 0, smem, goff);
  if (IN1_FP8) transpose_all8(pin.in[I_ODQKV], p.ws + OFF_WQKV1T, D, ODD_IN, WQ_SHIFT, smem, goff);
  else transpose_tiles(pin.in[I_ODQKV], p.ws + OFF_WQKV1T, D, ODD_IN, 1, 0, 0, smem, goff);
  if (OUT1_FP8) transpose_all8(pin.in[I_ODOUT], p.ws + OFF_WOUT1T, D, D, WQ_SHIFT, smem, goff);
  else transpose_tiles(pin.in[I_ODOUT], p.ws + OFF_WOUT1T, D, D, 1, 0, 0, smem, goff);
  for (int pi = bid; pi < 32; pi += G) { __syncthreads(); const int l = pi >> 4, up = (pi >> 3) & 1, kb = pi & 7;
    const float* sgu; if (up) sgu = pin.in[I_SU]; else sgu = pin.in[I_SG]; asm volatile("" : "+s"(sgu));
    transpose_panel8(sgu + (size_t)l * EW, p.ws + OFF_SHGU + (size_t)l * 512 * D + (size_t)up * 256 * D, D, DE, kb, 0, smem, WG_SHIFT); }
  __syncthreads();
  for (int pi = bid; pi < 16; pi += G) { __syncthreads(); const int l = pi >> 3, rr = pi & 7; transpose_panel8(pin.in[I_SD] + (size_t)l * EW, p.ws + OFF_SHD + (size_t)l * EW, DE, D, rr >> 2, rr & 3, smem); }
  __syncthreads();
}
DEVI void transpose_panel(const float* src0, bf16_t* dst0, int K, int N, int kb, int nb_, unsigned char* smem) {
  const int tid = ltid(), n4 = tid & 63, kp0 = tid >> 6; unsigned* Tb = (unsigned*)smem;
  const float* src = src0 + (size_t)(kb * 128) * N + nb_ * 256 + n4 * 4; bf16_t* dst = dst0 + (size_t)(nb_ * 256) * K + kb * 128;
  f32x4 va[8], vb[8];
#pragma unroll
  for (int i = 0; i < 8; ++i) { const int kp = kp0 + 8 * i; va[i] = __builtin_nontemporal_load((const f32x4*)(src + (size_t)(2 * kp) * N)); vb[i] = __builtin_nontemporal_load((const f32x4*)(src + (size_t)(2 * kp + 1) * N)); }
#pragma unroll
  for (int i = 0; i < 8; ++i) { const int kp = kp0 + 8 * i;
#pragma unroll
    for (int j = 0; j < 4; ++j) { const int n = n4 * 4 + j; Tb[n * 64 + (kp ^ (((n >> 2) & 7) << 2))] = pack2(va[i][j], vb[i][j]); } }
  __syncthreads();
#pragma unroll
  for (int i = 0; i < 8; ++i) { const int pc = tid + 512 * i, n = pc >> 4, q = pc & 15;
    const u32x4 w = *(const u32x4*)(Tb + n * 64 + ((4 * q) ^ (((n >> 2) & 7) << 2)));
    *(u32x4*)(dst + (size_t)n * K + 8 * q) = w; }
}
DEVI void expert_prep_steal(const Params& p, const PrepIn& pin, unsigned char* smem, int layer) {
  const size_t EW = (size_t)D * DE, lo = (size_t)layer * NE * EW; int* ctr = (int*)(p.ws + OFF_STEAL) + layer; int* bc = (int*)(smem + 65536);
  for (;;) {
    __syncthreads();
    if (ltid() == 0) bc[0] = atomicAdd(ctr, 1);
    __syncthreads();
    const int idx = bc[0]; if (idx >= 3 * 512) break;
    const int j = idx >> 9, r = idx & 511, m = r >> 3, rr = r & 7;
    if (j == 0) transpose_panel8(pin.in[I_WG] + lo + (size_t)m * EW, p.ws + OFF_EGU + (size_t)m * 512 * D, D, DE, rr, 0, smem, WG_SHIFT);
    else if (j == 1) transpose_panel8(pin.in[I_WU] + lo + (size_t)m * EW, p.ws + OFF_EGU + (size_t)m * 512 * D + (size_t)256 * D, D, DE, rr, 0, smem, WG_SHIFT);
    else transpose_panel8(pin.in[I_WD] + lo + (size_t)m * EW, p.ws + OFF_ED + (size_t)m * EW, DE, D, rr >> 2, rr & 3, smem);
  }
}
DEVI void stage_prep_experts(const Params& p, const PrepIn& pin, unsigned char* smem, int layer) {
  int goff = 0; const size_t EW = (size_t)D * DE, lo = (size_t)layer * NE * EW;
  __syncthreads();
  transpose_tiles(pin.in[I_WG] + lo, p.ws + OFF_EGU, D, DE, 64, EW, (size_t)512 * D, smem, goff);
  transpose_tiles(pin.in[I_WU] + lo, p.ws + OFF_EGU + (size_t)256 * D * 2, D, DE, 64, EW, (size_t)512 * D, smem, goff);
  transpose_tiles(pin.in[I_WD] + lo, p.ws + OFF_ED, DE, D, 64, EW, EW, smem, goff);
  __syncthreads();
}

template <int LAYER> DEVI void stage_norm1(const Params& p) {
  const int wid = ltid() >> 6, lane = ltid() & 63;
  const float* g = sm(p, SM_N1G + LAYER * D);
  bf16_t* act = wsp<bf16_t>(p, OFF_ACT);
  for (int t = blockIdx.x * 8 + wid; t < T; t += gridDim.x * 8) {
    const float* row = LAYER == 0 ? in_row(p, t) : (const float*)hid_row(p, t);
    const float* sh = modv(p, LAYER, t, 0); const float* sc = modv(p, LAYER, t, 1);
    f32x4 v[4]; float ss = 0.f;
#pragma unroll
    for (int i = 0; i < 4; ++i) { v[i] = *(const f32x4*)(row + (i * 64 + lane) * 4); ss += v[i][0] * v[i][0] + v[i][1] * v[i][1] + v[i][2] * v[i][2] + v[i][3] * v[i][3]; }
    ss = wsum(ss); const float rstd = rsqrtf(ss * (1.0f / D) + EPS);
#pragma unroll
    for (int i = 0; i < 4; ++i) { const int c = (i * 64 + lane) * 4; const f32x4 gg = *(const f32x4*)(g + c), s1 = *(const f32x4*)(sc + c), s0 = *(const f32x4*)(sh + c);
      float y[4];
#pragma unroll
      for (int q = 0; q < 4; ++q) y[q] = v[i][q] * rstd * gg[q] * (1.0f + s1[q]) + s0[q];
      if ((LAYER == 0 && IN0_FP8) || (LAYER == 1 && IN1_FP8)) { const float xs = (float)(1 << X_SHIFT); int w8 = 0;
        w8 = __builtin_amdgcn_cvt_pk_fp8_f32(__builtin_amdgcn_fmed3f(y[0] * xs, -440.f, 440.f), __builtin_amdgcn_fmed3f(y[1] * xs, -440.f, 440.f), w8, false);
        w8 = __builtin_amdgcn_cvt_pk_fp8_f32(__builtin_amdgcn_fmed3f(y[2] * xs, -440.f, 440.f), __builtin_amdgcn_fmed3f(y[3] * xs, -440.f, 440.f), w8, true);
        *(int*)(p.ws + OFF_ACT8 + (size_t)t * D + c) = w8; }
      else { u32x2 w; w.x = pack2(y[0], y[1]); w.y = pack2(y[2], y[3]);
        *(u32x2*)(act + (size_t)t * D + c) = w; } }
  }
}

template <class GA, class GB, class ST>
DEVI void ngemm(int MT, int NT, int K, GA getA, GB getB, ST store) {
  const int wid = ltid() >> 6, lane = ltid() & 63, fr = lane & 15, fq = lane >> 4;
  const long nw = (long)gridDim.x * 8;
  for (long tile = (long)blockIdx.x * 8 + wid; tile < (long)MT * NT; tile += nw) {
    const int tm = (int)(tile / NT), tn = (int)(tile - (long)tm * NT);
    const bf16_t* a0 = getA(tm * 32 + fr); const bf16_t* a1 = getA(tm * 32 + 16 + fr);
    const bf16_t* b0 = getB(tn * 32 + fr); const bf16_t* b1 = getB(tn * 32 + 16 + fr);
    f32x4 c00 = {0.f, 0.f, 0.f, 0.f}, c01 = c00, c10 = c00, c11 = c00;
    const bf16x8 z = {0, 0, 0, 0, 0, 0, 0, 0};
    for (int k = 0; k < K; k += 32) {
      const bf16x8 A0 = a0 ? *(const bf16x8*)(a0 + k + fq * 8) : z, A1 = a1 ? *(const bf16x8*)(a1 + k + fq * 8) : z;
      const bf16x8 B0 = *(const bf16x8*)(b0 + k + fq * 8), B1 = *(const bf16x8*)(b1 + k + fq * 8);
      c00 = __builtin_amdgcn_mfma_f32_16x16x32_bf16(A0, B0, c00, 0, 0, 0);
      c01 = __builtin_amdgcn_mfma_f32_16x16x32_bf16(A0, B1, c01, 0, 0, 0);
      c10 = __builtin_amdgcn_mfma_f32_16x16x32_bf16(A1, B0, c10, 0, 0, 0);
      c11 = __builtin_amdgcn_mfma_f32_16x16x32_bf16(A1, B1, c11, 0, 0, 0);
    }
#pragma unroll
    for (int j = 0; j < 4; ++j) {
      store(tm * 32 + fq * 4 + j, tn * 32 + fr, tn * 32 + 16 + fr, c00[j], c01[j]);
      store(tm * 32 + 16 + fq * 4 + j, tn * 32 + fr, tn * 32 + 16 + fr, c10[j], c11[j]);
    }
  }
}

DEVI void n_inproj0(const Params& p) {
  const bf16_t* act = wsp<bf16_t>(p, OFF_ACT); const bf16_t* w = wsp<bf16_t>(p, OFF_WIN0T); bf16_t* proj = wsp<bf16_t>(p, OFF_PROJ);
  ngemm(T / 32, EVEN_IN / 32, D,
        [&](int r) { return act + (size_t)r * D; }, [&](int n) { return w + (size_t)n * D; },
        [&](int r, int n0, int n1, float v0, float v1) { proj[(size_t)r * EVEN_IN + n0] = f2bf(v0); proj[(size_t)r * EVEN_IN + n1] = f2bf(v1); });
}
DEVI void n_post0(const Params& p) {
  const int wid = ltid() >> 6, lane = ltid() & 63;
  bf16_t* proj = wsp<bf16_t>(p, OFF_PROJ); const float2* t64 = wsp<float2>(p, OFF_TAB64);
  for (int t = blockIdx.x * 8 + wid; t < T; t += gridDim.x * 8) {
    bf16_t* row = proj + (size_t)t * EVEN_IN; const int b = t / SB, j = t - b * SB;
    for (int i = 0; i < 16; ++i) { int c = i * 64 + lane; row[c] = f2bf(gelu_exact(bf2f(row[c]))); }
    for (int hh = 0; hh < 16; ++hh) {
      const int c = 1024 + hh * 64 + lane; float v = bf2f(row[c]);
      float ss = wsum(v * v); float g = sm(p, hh < 8 ? SM_BQN : SM_BKN)[lane];
      float y = v * rsqrtf(ss * (1.0f / 64) + EPS) * g;
      y = bf2f(f2bf(y));
      if (j >= NC) { const int pos = j - NC, pr = lane >> 1; const int ps = pr < 16 ? (pos >> 6) : (pos & 63); const float2 cs = t64[ps * 16 + (pr & 15)];
        const float other = shx<1>(y);
        y = (lane & 1) ? (other * cs.y + y * cs.x) : (y * cs.x - other * cs.y); }
      row[c] = f2bf(y);
    }
  }
}

DEVI void attn_row(const bf16_t* q, int dq, const bf16_t* kb, int ldk, const bf16_t* vb, int ldv, int nkeys, float scale,
                   volatile float* sc, volatile float* qs, float& o0, float& o1) {
  const int lane = ltid() & 63;
  for (int d = lane; d < dq; d += 64) qs[d] = bf2f(q[d]);
  float mx = -1e30f;
  for (int key = lane; key < nkeys; key += 64) { const bf16_t* kr = kb + (size_t)key * ldk; float dot = 0.f;
    for (int d = 0; d < dq; d += 8) { const bf16x8 kv = *(const bf16x8*)(kr + d);
#pragma unroll
      for (int e = 0; e < 8; ++e) dot += qs[d + e] * bf2f((bf16_t)kv[e]); }
    dot *= scale; sc[key] = dot; mx = fmaxf(mx, dot); }
  mx = wmax(mx); float sum = 0.f;
  for (int key = lane; key < nkeys; key += 64) { float pv = __expf(sc[key] - mx); sc[key] = pv; sum += pv; }
  sum = wsum(sum); float a0 = 0.f, a1 = 0.f;
  for (int key = 0; key < nkeys; ++key) { const float pv = sc[key]; const unsigned vv = *(const unsigned*)(vb + (size_t)key * ldv + 2 * lane);
    a0 += pv * bf2f((bf16_t)(vv & 0xffff)); a1 += pv * bf2f((bf16_t)(vv >> 16)); }
  const float inv = 1.0f / sum; o0 = a0 * inv; o1 = a1 * inv;
}
DEVI void n_attn0(const Params& p, unsigned char* smem) {
  const int wid = ltid() >> 6, lane = ltid() & 63;
  volatile float* sc = (volatile float*)(smem + wid * (2304 * 4 + 512)); volatile float* qs = sc + 2304;
  const bf16_t* proj = wsp<bf16_t>(p, OFF_PROJ); bf16_t* cat = wsp<bf16_t>(p, OFF_ACT);
  const float lam = wsp<float>(p, OFF_LAM)[0];
  for (int task = blockIdx.x * 8 + wid; task < T * 4; task += gridDim.x * 8) {
    const int t = task >> 2, h = task & 3, b = t / SB, j = t - b * SB; const int nkeys = j < NC ? NC : SB;
    const bf16_t* kbase = proj + (size_t)(b * SB) * EVEN_IN + 1536 + h * 128; const bf16_t* vbase = proj + (size_t)(b * SB) * EVEN_IN + 2048 + h * 128;
    const bf16_t* q = proj + (size_t)t * EVEN_IN + 1024 + h * 128;
    float a0, a1, b0, b1;
    attn_row(q, 64, kbase, EVEN_IN, vbase, EVEN_IN, nkeys, 0.125f, sc, qs, a0, a1);
    attn_row(q + 64, 64, kbase + 64, EVEN_IN, vbase, EVEN_IN, nkeys, 0.125f, sc, qs, b0, b1);
    float o0 = a0 - lam * b0, o1 = a1 - lam * b1;
    float ss = wsum(o0 * o0 + o1 * o1); const float r = rsqrtf(ss * (1.0f / 128) + EPS) * 0.8f;
    o0 = o0 * r * sm(p, SM_SUBLN)[2 * lane]; o1 = o1 * r * sm(p, SM_SUBLN)[2 * lane + 1];
    *(unsigned*)(cat + (size_t)t * D + 512 + h * 128 + 2 * lane) = pack2(o0, o1);
  }
}
DEVI void n_gmlp(const Params& p, unsigned char* smem) {
  const int tid = ltid(), wid = tid >> 6, lane = tid & 63;
  bf16_t* lv = (bf16_t*)smem;
  const bf16_t* proj = wsp<bf16_t>(p, OFF_PROJ); bf16_t* cat = wsp<bf16_t>(p, OFF_ACT);
  for (int ch = blockIdx.x; ch < T / 128; ch += gridDim.x) {
    __syncthreads();
    for (int r = wid; r < 128; r += 8) { const bf16_t* vr = proj + (size_t)(ch * 128 + r) * EVEN_IN + 512;
      float v[8]; float s = 0.f;
#pragma unroll
      for (int i = 0; i < 8; ++i) { v[i] = bf2f(vr[i * 64 + lane]); s += v[i]; }
      s = wsum(s); const float mu = s * (1.0f / 512); float q = 0.f;
#pragma unroll
      for (int i = 0; i < 8; ++i) { const float d = v[i] - mu; q += d * d; }
      q = wsum(q); const float rstd = rsqrtf(q * (1.0f / 512) + EPS);
#pragma unroll
      for (int i = 0; i < 8; ++i) { const int c = i * 64 + lane; lv[r * 512 + c] = f2bf((v[i] - mu) * rstd * sm(p, SM_ALNG)[c] + sm(p, SM_ALNB)[c]); } }
    __syncthreads();
    const int c = tid, g = c >> 7;
    const float* wsg = sm(p, SM_AWSF) + (size_t)g * 128 * 128;
    for (int pp = 0; pp < 128; ++pp) { float acc = 0.f; const float* wr = wsg + pp * 128;
      for (int q = 0; q < 128; ++q) acc += wr[q] * bf2f(lv[q * 512 + c]);
      acc += sm(p, SM_ABS)[g * 128 + pp];
      const size_t t = (size_t)ch * 128 + pp; const float u = bf2f(proj[t * EVEN_IN + c]);
      cat[t * D + c] = f2bf(u * acc); }
  }
}
template <int LAYER> DEVI void n_outproj(const Params& p) {
  const bf16_t* cat = wsp<bf16_t>(p, OFF_ACT); const bf16_t* w = wsp<bf16_t>(p, LAYER == 0 ? OFF_WOUT0T : OFF_WOUT1T);
  auto st1 = [&](int r, int n, float v) { const int b = r / SB, j = r - b * SB; if (LAYER == 1 && j < NC) return;
    const float* res = LAYER == 0 ? in_row(p, r) : (const float*)hid_row(p, r); float* dst = hid_row(p, r);
    dst[n] = res[n] + modv(p, LAYER, r, 2)[n] * v; };
  ngemm(T / 32, D / 32, D, [&](int r) { return cat + (size_t)r * D; }, [&](int n) { return w + (size_t)n * D; },
        [&](int r, int n0, int n1, float v0, float v1) { st1(r, n0, v0); st1(r, n1, v1); });
}

struct LCfg { int l, npb, j0, nph; };
DEVI int act_tok(const LCfg& c, int half, int tl) { const int bl = tl / c.npb, jj = tl - bl * c.npb; return (half * 8 + bl) * SB + c.j0 + jj; }
DEVI void stage_router(const Params& p, const LCfg c, unsigned char* smem) {
  const int wid = ltid() >> 6, lane = ltid() & 63, fr = lane & 15, fq = lane >> 4;
  float* lgs = (float*)smem + wid * 4096;
  int* ksl = (int*)lgs + 2048;
  const float* g = sm(p, SM_N2G + c.l * D); bf16_t* act = wsp<bf16_t>(p, OFF_ACT);
  const bf16_t* wrt = wsp<bf16_t>(p, OFF_WRT) + (size_t)c.l * NE * D; const float bias = sm(p, SM_MBIAS)[c.l * NE + lane];
  int* cnt = (int*)(p.ws + OFF_CNT) + c.l * 128; int* list = wsp<int>(p, OFF_LIST); float* topw = wsp<float>(p, OFF_TOPW);
  const int nact = c.nph, nwv = gridDim.x * 8, chunk0 = (nact + nwv - 1) / nwv, chunk = chunk0 < 32 ? chunk0 : 32;
  const bool agg = (nact == nwv * chunk);
  LAS int* blk = (LAS int*)((LAS unsigned char*)smem + 131072); LAS int* blkb = blk + 64;
  if (agg) {
    if (ltid() < 64) blk[ltid()] = 0;
    const u32x4* src = (const u32x4*)wrt;
    for (int i = ltid(); i < NE * 128; i += 512) { const int row = i >> 7, ch = i & 127; *(LAS u32x4*)((LAS unsigned char*)smem + row * 2048 + ((ch ^ (row & 7)) << 4)) = src[i]; }
    __syncthreads(); }
  for (int ga0 = (blockIdx.x * 8 + wid) * chunk; ga0 < nact; ga0 += nwv * chunk) {
    const int ntk = (nact - ga0) < chunk ? (nact - ga0) : chunk;
    f32x4 gg[4], s1v[4], s0v[4]; int curb = -1;
#pragma unroll
    for (int i = 0; i < 4; ++i) gg[i] = *(const f32x4*)(g + (i * 64 + lane) * 4);
    for (int j0 = 0; j0 < ntk; j0 += 3) {
      f32x4 v[3][4]; int tt[3];
#pragma unroll
      for (int u = 0; u < 3; ++u) { int j = j0 + u; j = j < ntk ? j : ntk - 1; const int ga = ga0 + j, half = ga / c.nph, tl = ga - half * c.nph; tt[u] = act_tok(c, half, tl);
        const bf16_t* row = wsp<bf16_t>(p, OFF_HB) + (size_t)tt[u] * D;
#pragma unroll
        for (int i = 0; i < 4; ++i) v[u][i] = bf4(*(const u32x2*)(row + (i * 64 + lane) * 4)); }
#pragma unroll
      for (int u = 0; u < 3; ++u) { float ss = 0.f;
#pragma unroll
        for (int i = 0; i < 4; ++i) ss += v[u][i][0] * v[u][i][0] + v[u][i][1] * v[u][i][1] + v[u][i][2] * v[u][i][2] + v[u][i][3] * v[u][i][3];
        const float rstd = rsqrtf(wsum_dpp(ss) * (1.0f / D) + EPS);
        const int bt = tt[u] / SB, jt = tt[u] - bt * SB, mrow = jt < NC ? 16 : bt;
        if (mrow != curb) { curb = mrow; const float* sh = modv(p, c.l, tt[u], 3); const float* sc = modv(p, c.l, tt[u], 4);
#pragma unroll
          for (int i = 0; i < 4; ++i) { s0v[i] = *(const f32x4*)(sh + (i * 64 + lane) * 4); s1v[i] = *(const f32x4*)(sc + (i * 64 + lane) * 4); } }
        if (j0 + u < ntk) {
#pragma unroll
          for (int i = 0; i < 4; ++i) { const int cc = (i * 64 + lane) * 4;
            float y[4];
#pragma unroll
            for (int q = 0; q < 4; ++q) y[q] = v[u][i][q] * rstd * gg[i][q] * (1.0f + s1v[i][q]) + s0v[i][q];
            u32x2 w; w.x = pack2(y[0], y[1]); w.y = pack2(y[2], y[3]);
            *(u32x2*)(act + (size_t)tt[u] * D + cc) = w;
            const float xs = (float)(1 << X_SHIFT); int w8 = 0;
            w8 = __builtin_amdgcn_cvt_pk_fp8_f32(__builtin_amdgcn_fmed3f(y[0] * xs, -440.f, 440.f), __builtin_amdgcn_fmed3f(y[1] * xs, -440.f, 440.f), w8, false);
            w8 = __builtin_amdgcn_cvt_pk_fp8_f32(__builtin_amdgcn_fmed3f(y[2] * xs, -440.f, 440.f), __builtin_amdgcn_fmed3f(y[3] * xs, -440.f, 440.f), w8, true);
            *(int*)(p.ws + OFF_ACT8 + (size_t)tt[u] * D + cc) = w8; } }
      }
    }
    asm volatile("s_waitcnt vmcnt(0)" ::: "memory");
    const bf16_t* ar[2];
#pragma unroll
    for (int m = 0; m < 2; ++m) { int jj = m * 16 + fr; jj = jj < ntk ? jj : 0; const int ga = ga0 + jj, half = ga / c.nph, tl = ga - half * c.nph; ar[m] = act + (size_t)act_tok(c, half, tl) * D + fq * 8; }
    const bf16_t* br = wrt + (size_t)fr * D + fq * 8;
    f32x4 acc[2][4];
#pragma unroll
    for (int m = 0; m < 2; ++m)
#pragma unroll
      for (int n = 0; n < 4; ++n) acc[m][n] = (f32x4){0.f, 0.f, 0.f, 0.f};
    if (agg) {
      const LAS unsigned char* bl = (const LAS unsigned char*)smem + fr * 2048; const int sw = fr & 7;
#pragma unroll 8
      for (int k0 = 0; k0 < D; k0 += 32) {
        bf16x8 af[2], bfr[4];
#pragma unroll
        for (int m = 0; m < 2; ++m) af[m] = *(const bf16x8*)(ar[m] + k0);
#pragma unroll
        for (int n = 0; n < 4; ++n) bfr[n] = *(const LAS bf16x8*)(bl + n * 32768 + ((((k0 >> 3) + fq) ^ sw) << 4));
#pragma unroll
        for (int m = 0; m < 2; ++m)
#pragma unroll
          for (int n = 0; n < 4; ++n) acc[m][n] = __builtin_amdgcn_mfma_f32_16x16x32_bf16(af[m], bfr[n], acc[m][n], 0, 0, 0);
      }
      __syncthreads();
    } else {
#pragma unroll 4
    for (int k0 = 0; k0 < D; k0 += 32) {
      bf16x8 af[2], bfr[4];
#pragma unroll
      for (int m = 0; m < 2; ++m) af[m] = *(const bf16x8*)(ar[m] + k0);
#pragma unroll
      for (int n = 0; n < 4; ++n) bfr[n] = *(const bf16x8*)(br + (size_t)(16 * n) * D + k0);
#pragma unroll
      for (int m = 0; m < 2; ++m)
#pragma unroll
        for (int n = 0; n < 4; ++n) acc[m][n] = __builtin_amdgcn_mfma_f32_16x16x32_bf16(af[m], bfr[n], acc[m][n], 0, 0, 0);
    }
    }
    __builtin_amdgcn_wave_barrier();
#pragma unroll
    for (int m = 0; m < 2; ++m)
#pragma unroll
      for (int n = 0; n < 4; ++n)
#pragma unroll
        for (int r = 0; r < 4; ++r) lgs[(m * 16 + 4 * fq + r) * 64 + 16 * n + fr] = acc[m][n][r];
    __builtin_amdgcn_fence(__ATOMIC_RELEASE, "wavefront"); __builtin_amdgcn_wave_barrier();
    const int half0 = ga0 / c.nph, half1 = (ga0 + ntk - 1) / c.nph;
    unsigned cm0 = 0u, cm1 = 0u;
    for (int j0 = 0; j0 < ntk; j0 += 3) {
      float wq[3]; int kq[3];
#pragma unroll
      for (int u = 0; u < 3; ++u) { const int j = (j0 + u) < ntk ? (j0 + u) : j0;
        const float lg = ((volatile float*)lgs)[j * 64 + lane];
        const float score = __builtin_amdgcn_rcpf(1.0f + __expf(-lg)); const float sel = score + bias;
        const float m1 = max8_dpp(sel);
        const unsigned long long isb = __ballot(sel == m1); const int gbase = lane & ~7; const unsigned gm = (unsigned)((isb >> gbase) & 0xffull);
        const int first = gbase + __builtin_ctz(gm);
        const float m2 = max8_dpp((lane == first) ? -INFINITY : sel);
        const float gs = m1 + m2; const int gi = lane >> 3; int grank = 0;
#pragma unroll
        for (int g2 = 0; g2 < 8; ++g2) { const float og = rlane(gs, g2 * 8); grank += (og > gs || (og == gs && g2 < gi)) ? 1 : 0; }
        float cur = grank < 4 ? sel : -INFINITY;
        int myk = -1; float wsumv = 0.f;
#pragma unroll
        for (int kk = 0; kk < TOPK; ++kk) { const float mxv = wmax_dpp(cur); const unsigned long long bm = __ballot(cur == mxv); const int win = __builtin_ctzll(bm);
          if (lane == win) { myk = kk; cur = -INFINITY; } wsumv += rlane(score, win); }
        wq[u] = score * __builtin_amdgcn_rcpf(wsumv) * 2.5f; kq[u] = myk; }
#pragma unroll
      for (int u = 0; u < 3; ++u) { const int j = j0 + u;
        if (j < ntk) { ((volatile float*)lgs)[j * 64 + lane] = wq[u]; ((volatile int*)ksl)[j * 64 + lane] = kq[u];
          const bool inh0 = (ga0 + j) / c.nph == half0;
          if (kq[u] >= 0) { if (inh0) cm0 |= 1u << j; else cm1 |= 1u << j; } } }
    }
    int base0 = 0, base1 = 0;
    if (agg) {
      const int n0 = __builtin_popcount(cm0); int wb = 0;
      if (n0) wb = __atomic_fetch_add(&blk[lane], n0, __ATOMIC_RELAXED);
      __syncthreads();
      if (wid == 0) { const int tot = blk[lane]; int gb = 0; if (tot) gb = atomicAdd(&cnt[half0 * 64 + lane], tot); blkb[lane] = gb; }
      __syncthreads();
      base0 = blkb[lane] + wb;
    } else {
      if (cm0) base0 = atomicAdd(&cnt[half0 * 64 + lane], __builtin_popcount(cm0));
      if (cm1) base1 = atomicAdd(&cnt[half1 * 64 + lane], __builtin_popcount(cm1));
    }
    for (int j = 0; j < ntk; ++j) {
      const int myk = ((volatile int*)ksl)[j * 64 + lane];
      if (myk >= 0) { const int ga = ga0 + j, half = ga / c.nph, tl = ga - half * c.nph; const unsigned below = (1u << j) - 1u;
        const int pos = half == half0 ? base0 + __builtin_popcount(cm0 & below) : base1 + __builtin_popcount(cm1 & below);
        list[((size_t)(half * 64 + lane)) * LCAP + pos] = tl * 6 + myk; topw[(size_t)ga * 6 + myk] = ((volatile float*)lgs)[j * 64 + lane]; wsp<int>(p, OFF_TOPP)[(size_t)ga * 6 + myk] = (lane << 24) | pos; }
    }
    __builtin_amdgcn_wave_barrier();
  }
}

DEVI void n_moe_gu(const Params& p, const LCfg c, int half) {
  const bf16_t* act = wsp<bf16_t>(p, OFF_ACT); bf16_t* hid = wsp<bf16_t>(p, OFF_HID);
  const int* cnt = (const int*)(p.ws + OFF_CNT) + c.l * 128 + half * 64; const int* list = wsp<int>(p, OFF_LIST) + (size_t)half * 64 * LCAP;
  int off = 0;
  for (int e = 0; e <= NE; ++e) {
    const int n = e < NE ? cnt[e] : c.nph;
    const bf16_t* w = e < NE ? wsp<bf16_t>(p, OFF_EGU) + (size_t)e * 512 * D : wsp<bf16_t>(p, OFF_SHGU) + (size_t)c.l * 512 * D;
    const int* le = list + (size_t)e * LCAP;
    ngemm((n + 31) / 32, DE / 16, D,
          [&](int r) -> const bf16_t* { if (r >= n) return nullptr; const int tl = e < NE ? le[r] / 6 : r; return act + (size_t)act_tok(c, half, tl) * D; },
          [&](int nn) { const int tn = nn >> 5, i = (nn >> 4) & 1, fr = nn & 15; return w + (size_t)(i * 256 + tn * 16 + fr) * D; },
          [&](int r, int n0, int n1, float v0, float v1) { if (r < n) hid[(size_t)(off + r) * DE + (n0 >> 5) * 16 + (n0 & 15)] = f2bf(silu(v0) * v1); });
    off += n;
  }
}
DEVI void n_moe_down(const Params& p, const LCfg c, int half) {
  const bf16_t* hid = wsp<bf16_t>(p, OFF_HID); bf16_t* slot = wsp<bf16_t>(p, OFF_SLOT);
  const int* cnt = (const int*)(p.ws + OFF_CNT) + c.l * 128 + half * 64; const int* list = wsp<int>(p, OFF_LIST) + (size_t)half * 64 * LCAP;
  int off = 0;
  for (int e = 0; e <= NE; ++e) {
    const int n = e < NE ? cnt[e] : c.nph;
    const bf16_t* w = e < NE ? wsp<bf16_t>(p, OFF_ED) + (size_t)e * D * DE : wsp<bf16_t>(p, OFF_SHD) + (size_t)c.l * D * DE;
    const int* le = list + (size_t)e * LCAP;
    auto st1 = [&](int r, int nn, float v) { if (r >= n) return;
      if (e < NE) slot[(size_t)le[r] * D + nn] = f2bf(v);
      else { const int t = act_tok(c, half, r); float* h = hid_row(p, t); h[nn] += modv(p, c.l, t, 5)[nn] * v; } };
    ngemm((n + 31) / 32, D / 32, DE,
          [&](int r) -> const bf16_t* { return r < n ? hid + (size_t)(off + r) * DE : nullptr; },
          [&](int nn) { return w + (size_t)nn * DE; },
          [&](int r, int n0, int n1, float v0, float v1) { st1(r, n0, v0); st1(r, n1, v1); });
    off += n;
  }
}
template <bool FUSE_NORM1> DEVI void stage_combine(const Params& p, const LCfg c, int half, unsigned char* smem, float dscale = 1.0f) {
  const int wid = ltid() >> 6, lane = ltid() & 63;
  int* off = (int*)smem;
  __syncthreads();
  if (ltid() == 0) { const int* cnt = (const int*)(p.ws + OFF_CNT) + c.l * 128 + half * 64; int o = 0; for (int e = 0; e < NE; ++e) { off[e] = o; o += cnt[e]; } off[NE] = o; }
  __syncthreads();
  const unsigned char* slot = p.ws + OFF_SLOT; const float* topw = wsp<float>(p, OFF_TOPW); const int* topp = wsp<int>(p, OFF_TOPP);
  for (int tl = blockIdx.x * 8 + wid; tl < c.nph; tl += gridDim.x * 8) {
    const int t = act_tok(c, half, tl); bf16_t* h = wsp<bf16_t>(p, OFF_HB) + (size_t)t * D; const float* g5 = modv(p, c.l, t, 5);
    float* orow = p.out + ((size_t)((t / SB) * S + (t % SB) - NC)) * D;
    const float* w = topw + ((size_t)(half * c.nph + tl)) * 6; const int* pp = topp + ((size_t)(half * c.nph + tl)) * 6;
    float wk[7]; size_t ro[7];
#pragma unroll
    for (int k = 0; k < 6; ++k) { wk[k] = w[k]; const int q = pp[k]; ro[k] = (size_t)(off[q >> 24] + (q & 0xffffff)) * D; }
    wk[6] = 1.0f; ro[6] = (size_t)(off[NE] + tl) * D;
    unsigned sv[4][7]; f32x4 hv[4];
#pragma unroll
    for (int i = 0; i < 4; ++i) { const int cc = (i * 64 + lane) * 4; hv[i] = bf4(*(const u32x2*)(h + cc));
#pragma unroll
      for (int k = 0; k < 7; ++k) sv[i][k] = *(const unsigned*)(slot + ro[k] + cc); }
#pragma unroll
    for (int i = 0; i < 4; ++i) { const int cc = (i * 64 + lane) * 4; f32x4 acc = {0.f, 0.f, 0.f, 0.f};
#pragma unroll
      for (int k = 0; k < 7; ++k) { const auto lo = __builtin_amdgcn_cvt_pk_f32_fp8((int)sv[i][k], false); const auto hi = __builtin_amdgcn_cvt_pk_f32_fp8((int)sv[i][k], true);
        acc[0] += wk[k] * lo[0]; acc[1] += wk[k] * lo[1]; acc[2] += wk[k] * hi[0]; acc[3] += wk[k] * hi[1]; }
      const f32x4 gg = *(const f32x4*)(g5 + cc);
#pragma unroll
      for (int q = 0; q < 4; ++q) hv[i][q] += gg[q] * acc[q] * dscale;
      if (FUSE_NORM1) { u32x2 w; w.x = pack2(hv[i][0], hv[i][1]); w.y = pack2(hv[i][2], hv[i][3]); *(u32x2*)(h + cc) = w; }
      else *(f32x4*)(orow + cc) = hv[i]; }
    if (FUSE_NORM1) {
      float ss = 0.f;
#pragma unroll
      for (int i = 0; i < 4; ++i) ss += hv[i][0] * hv[i][0] + hv[i][1] * hv[i][1] + hv[i][2] * hv[i][2] + hv[i][3] * hv[i][3];
      const float rstd = rsqrtf(wsum_dpp(ss) * (1.0f / D) + EPS);
      const float* g1 = sm(p, SM_N1G + (c.l + 1) * D); const float* sh = modv(p, c.l + 1, t, 0); const float* sc = modv(p, c.l + 1, t, 1);
      bf16_t* act = wsp<bf16_t>(p, OFF_ACT);
#pragma unroll
      for (int i = 0; i < 4; ++i) { const int cc = (i * 64 + lane) * 4; const f32x4 gg = *(const f32x4*)(g1 + cc), s1 = *(const f32x4*)(sc + cc), s0 = *(const f32x4*)(sh + cc);
        float y[4];
#pragma unroll
        for (int q = 0; q < 4; ++q) y[q] = hv[i][q] * rstd * gg[q] * (1.0f + s1[q]) + s0[q];
        if (IN1_FP8) { const float xs = (float)(1 << X_SHIFT); int w8 = 0;
          w8 = __builtin_amdgcn_cvt_pk_fp8_f32(__builtin_amdgcn_fmed3f(y[0] * xs, -440.f, 440.f), __builtin_amdgcn_fmed3f(y[1] * xs, -440.f, 440.f), w8, false);
          w8 = __builtin_amdgcn_cvt_pk_fp8_f32(__builtin_amdgcn_fmed3f(y[2] * xs, -440.f, 440.f), __builtin_amdgcn_fmed3f(y[3] * xs, -440.f, 440.f), w8, true);
          *(int*)(p.ws + OFF_ACT8 + (size_t)t * D + cc) = w8; }
        else { u32x2 w; w.x = pack2(y[0], y[1]); w.y = pack2(y[2], y[3]);
          *(u32x2*)(act + (size_t)t * D + cc) = w; } }
    }
  }
}

DEVI void n_inproj1(const Params& p) {
  const bf16_t* act = wsp<bf16_t>(p, OFF_ACT); const bf16_t* w = wsp<bf16_t>(p, OFF_WQKV1T); bf16_t* proj = wsp<bf16_t>(p, OFF_PROJ);
  ngemm(T / 32, ODD_IN / 32, D, [&](int r) { return act + (size_t)r * D; }, [&](int n) { return w + (size_t)n * D; },
        [&](int r, int n0, int n1, float v0, float v1) { proj[(size_t)r * ODD_IN + n0] = f2bf(v0); proj[(size_t)r * ODD_IN + n1] = f2bf(v1); });
}
DEVI void n_post1(const Params& p) {
  const int wid = ltid() >> 6, lane = ltid() & 63;
  bf16_t* proj = wsp<bf16_t>(p, OFF_PROJ); const float2* t128 = wsp<float2>(p, OFF_TAB128);
  for (int t = blockIdx.x * 8 + wid; t < T; t += gridDim.x * 8) {
    bf16_t* row = proj + (size_t)t * ODD_IN; const int b = t / SB, j = t - b * SB;
    for (int hh = 0; hh < 10; ++hh) {
      unsigned* pp = (unsigned*)(row + hh * 128 + 2 * lane); const unsigned u = *pp;
      float x1 = __uint_as_float(u << 16), x2 = __uint_as_float(u & 0xffff0000u);
      const float ss = wsum(x1 * x1 + x2 * x2); const float r = rsqrtf(ss * (1.0f / 128) + EPS);
      const float* g = sm(p, hh < 8 ? SM_CQN : SM_CKN);
      x1 = x1 * r * g[2 * lane]; x2 = x2 * r * g[2 * lane + 1];
      if (j >= NC) { const int pos = j - NC; const int ps = lane < 32 ? (pos >> 6) : (pos & 63); const float2 cs = t128[ps * 32 + (lane & 31)];
        const float y1 = x1 * cs.x - x2 * cs.y, y2 = x1 * cs.y + x2 * cs.x; x1 = y1; x2 = y2; }
      *pp = pack2(x1, x2);
    }
  }
}
DEVI void n_attn1(const Params& p, unsigned char* smem) {
  const int wid = ltid() >> 6, lane = ltid() & 63;
  volatile float* sc = (volatile float*)(smem + wid * (2304 * 4 + 512)); volatile float* qs = sc + 2304;
  const bf16_t* proj = wsp<bf16_t>(p, OFF_PROJ); bf16_t* att = wsp<bf16_t>(p, OFF_ACT);
  for (int task = blockIdx.x * 8 + wid; task < TX * 8; task += gridDim.x * 8) {
    const int tx = task >> 3, h = task & 7, b = tx / S, i = tx - b * S, t = b * SB + NC + i, kvh = h >> 2;
    const bf16_t* kbase = proj + (size_t)(b * SB) * ODD_IN + 1024 + kvh * 128; const bf16_t* vbase = kbase + 256;
    float o0, o1;
    attn_row(proj + (size_t)t * ODD_IN + h * 128, 128, kbase, ODD_IN, vbase, ODD_IN, SB, 0.08838834764831845f, sc, qs, o0, o1);
    *(unsigned*)(att + (size_t)t * D + h * 128 + 2 * lane) = pack2(o0, o1);
  }
}

namespace fg {
constexpr int BM = 256, BK = 64, HALF = 128, HTB = HALF * BK * 2, STAGE_BYTES = 8 * HTB;
constexpr int LDS_XCH = STAGE_BYTES, LDS_TAB = STAGE_BYTES + 4096, LDS_ROPE = STAGE_BYTES + 6144, LDS_GAIN = LDS_ROPE + 16384;
DEVI int lds_byte(int r, int c) { const int st = (r >> 4) * 2 + (c >> 5), rr = r & 15, cc = c & 31, ob = rr * 64 + cc * 2; return st * 1024 + (ob ^ (((ob >> 9) & 1) << 5)); }
DEVI void stage_rc(int b, int& R, int& C) { const int st = b / 1024, sb = b % 1024, swz = sb ^ (((sb >> 9) & 1) << 5); R = (st >> 1) * 16 + swz / 64; C = (st & 1) * 32 + (swz % 64) / 2; }
DEVI int perm32(int rho) { const int n = rho >> 4, i = rho & 15; return 8 * (i >> 2) + 4 * n + (i & 3); }
DEVI unsigned cvt_pk_bf16(float lo, float hi) { unsigned r; asm volatile("v_cvt_pk_bf16_f32 %0, %1, %2" : "=v"(r) : "v"(lo), "v"(hi)); return r; }
typedef float f32x2 __attribute__((ext_vector_type(2)));
DEVI f32x2 gelu_pk(f32x2 v) {
  const f32x2 av = __builtin_elementwise_abs(v), d = av * 0.2316418882f + 1.0f;
  f32x2 t; t.x = __builtin_amdgcn_rcpf(d.x); t.y = __builtin_amdgcn_rcpf(d.y);
  f32x2 q = t * 0.5307027145f + (-0.7265760135f); q = q * t + 0.7107068705f; q = q * t + (-0.142248368f); q = q * t + 0.127414796f; q = q * t;
  const f32x2 s = (v * v) * (-0.72134752044f);
  f32x2 e; e.x = __builtin_amdgcn_exp2f(s.x); e.y = __builtin_amdgcn_exp2f(s.y);
  const f32x2 m = v * (q * e), r = v - m;
  f32x2 o; o.x = v.x < 0.f ? m.x : r.x; o.y = v.y < 0.f ? m.y : r.y; return o;
}
struct Unit { const char* A; const char* B0; const char* B1; int pm, pn, e, cnt, off; };
typedef f32x4 Acc[2][2][4][2];
typedef int v8i_t __attribute__((ext_vector_type(8)));
template <int K> DEVI unsigned boff_m1(int R, int C) { return (unsigned)((64 * (R >> 5) + perm32(R & 31)) * K + C) * 2u; }
template <int K> DEVI unsigned boff_m2(int R, int C) { return (unsigned)(((R & ~31) + perm32(R & 31)) * K + C) * 2u; }

template <class Job>
DEVI void gemm_phase(LAS unsigned char* lds, Job& J) {
  constexpr int K = Job::K, nt = K / BK;
  const int tid = ltid(), wid = __builtin_amdgcn_readfirstlane(tid >> 6), lane = tid & 63, wr = wid >> 2, wc = wid & 3, fr = lane & 15, fq = lane >> 4;
  int Rr[2], Cc[2];
#pragma unroll
  for (int i = 0; i < 2; ++i) stage_rc(tid * 16 + i * 8192, Rr[i], Cc[i]);
  unsigned voffB[2];
#pragma unroll
  for (int i = 0; i < 2; ++i) voffB[i] = J.boff(Rr[i], Cc[i]);
  unsigned cv[2][2]; unsigned nv[2][2];
  constexpr size_t AH = Job::GATHER ? 0 : (size_t)HALF * K * 2;
#define CV1 cv[Job::GATHER ? 1 : 0]
  constexpr size_t kstep = (size_t)(BK * 2);
  const unsigned ldsw = (unsigned)wid * 1024u;
  const int aoff = lds_byte(wr * 64 + fr, fq * 8), boff = lds_byte(wc * 32 + fr, fq * 8);
  LAS unsigned char* abase = lds + aoff; LAS unsigned char* bbase = lds + 4 * HTB + boff;
  asm volatile("" : "+v"(abase), "+v"(bbase));
#define FG_SA(b, h) (((b) * 2 + (h)) * HTB)
#define FG_SB(b, h) ((4 + (b) * 2 + (h)) * HTB)
#define FG_STAGE(bufoff, gbase, voff) do { _Pragma("unroll") for (int _i = 0; _i < 2; ++_i) { \
    const unsigned _la = (unsigned)(uintptr_t)(lds + ldsw) + (unsigned)((bufoff) + _i * 8192); const char* _gb = (const char*)(gbase); \
    asm volatile("s_mov_b32 m0, %0\n\ts_nop 0\n\tglobal_load_lds_dwordx4 %1, %2" :: "s"(_la), "v"((voff)[_i]), "s"(_gb) : "memory", "m0"); } } while (0)
#define FG_LDA(dst, b, h) do { _Pragma("unroll") for (int m = 0; m < 4; ++m) _Pragma("unroll") for (int k = 0; k < 2; ++k) dst[m][k] = *(const LAS bf16x8*)(abase + (FG_SA(b, h) + m * 2048 + k * 1024)); } while (0)
#define FG_LDB(dst, b, h) do { _Pragma("unroll") for (int n = 0; n < 2; ++n) _Pragma("unroll") for (int k = 0; k < 2; ++k) dst[n][k] = *(const LAS bf16x8*)(bbase + (FG_SB(b, h) - 4 * HTB + n * 2048 + k * 1024)); } while (0)
#define FG_MMA(ai, bj, At, Bt) do { __builtin_amdgcn_s_setprio(1); _Pragma("unroll") for (int m = 0; m < 4; ++m) _Pragma("unroll") for (int n = 0; n < 2; ++n) _Pragma("unroll") for (int k = 0; k < 2; ++k) \
    acc[ai][bj][m][n] = __builtin_amdgcn_mfma_f32_16x16x32_bf16(Bt[n][k], At[m][k], acc[ai][bj][m][n], 0, 0, 0); __builtin_amdgcn_s_setprio(0); } while (0)
#define FG_MMA8(ai, bj, At, Bt) do { __builtin_amdgcn_s_setprio(1); _Pragma("unroll") for (int m = 0; m < 4; ++m) _Pragma("unroll") for (int n = 0; n < 2; ++n) { \
      v8i_t _b, _a; { const u32x4 b0 = *(const u32x4*)&Bt[n][0], b1 = *(const u32x4*)&Bt[n][1], a0 = *(const u32x4*)&At[m][0], a1 = *(const u32x4*)&At[m][1]; \
        _b = (v8i_t){(int)b0[0], (int)b0[1], (int)b0[2], (int)b0[3], (int)b1[0], (int)b1[1], (int)b1[2], (int)b1[3]}; _a = (v8i_t){(int)a0[0], (int)a0[1], (int)a0[2], (int)a0[3], (int)a1[0], (int)a1[1], (int)a1[2], (int)a1[3]}; } \
      acc[ai][bj][m][n] = __builtin_amdgcn_mfma_scale_f32_16x16x128_f8f6f4(_b, _a, acc[ai][bj][m][n], 0, 0, 0, Job::SCALE, 0, Job::SCALE); } __builtin_amdgcn_s_setprio(0); } while (0)
#define FG_WAIT_V(n) asm volatile("s_waitcnt vmcnt(" #n ")" ::: "memory")
#define FG_WAIT_L(n) asm volatile("s_waitcnt lgkmcnt(" #n ")" ::: "memory")
#define FG_MM(ai, bj, At, Bt) do { if constexpr (Job::FP8) FG_MMA8(ai, bj, At, Bt); else FG_MMA(ai, bj, At, Bt); } while (0)
#define FG_BAR __builtin_amdgcn_s_barrier()
#define FG_SCHED __builtin_amdgcn_sched_barrier(0)
  Unit cur, nxt;
  if (!J.next(cur)) return;
  Acc acc;
#pragma unroll
  for (int a = 0; a < 2; ++a)
#pragma unroll
    for (int b = 0; b < 2; ++b)
#pragma unroll
      for (int m = 0; m < 4; ++m)
#pragma unroll
        for (int n = 0; n < 2; ++n) acc[a][b][m][n] = (f32x4){0.f, 0.f, 0.f, 0.f};
  bf16x8 At[4][2], B0[2][2], B1[2][2];
  J.aoffs(cur, Rr, Cc, cv);
  asm volatile("s_waitcnt vmcnt(0)" ::: "memory");
  FG_STAGE(FG_SB(0, 0), cur.B0, voffB); FG_STAGE(FG_SA(0, 0), cur.A, cv[0]); FG_STAGE(FG_SB(0, 1), cur.B1, voffB); FG_STAGE(FG_SA(0, 1), cur.A + AH, CV1);
  if (wr == 1) FG_BAR;
  FG_WAIT_V(4); FG_BAR;
  FG_STAGE(FG_SB(1, 0), cur.B0 + kstep, voffB); FG_STAGE(FG_SA(1, 0), cur.A + kstep, cv[0]); FG_STAGE(FG_SB(1, 1), cur.B1 + kstep, voffB);
  FG_WAIT_V(6); FG_BAR;
  for (;;) {
    const bool has_next = J.next(nxt);
    const char* nA = has_next ? nxt.A : cur.A; const char* nB0 = has_next ? nxt.B0 : cur.B0; const char* nB1 = has_next ? nxt.B1 : cur.B1;
    for (int t = 0; t < nt; t += 2) {
      const bool last = (t == nt - 2);
      const char* a1 = cur.A + (size_t)(t + 1) * kstep;
      const char* a2 = last ? nA : cur.A + (size_t)(t + 2) * kstep;
      const char* b20 = last ? nB0 : cur.B0 + (size_t)(t + 2) * kstep; const char* b21 = last ? nB1 : cur.B1 + (size_t)(t + 2) * kstep;
      const char* a3 = a2 + kstep; const char* b30 = b20 + kstep; const char* b31 = b21 + kstep;
      asm volatile("" : "+s"(a1), "+s"(a2), "+s"(a3), "+s"(b20), "+s"(b21), "+s"(b30), "+s"(b31));
      if constexpr (Job::GATHER) { if (last && has_next) { J.aoffs(nxt, Rr, Cc, nv); asm volatile("s_waitcnt vmcnt(0)" ::: "memory"); } }
      FG_LDB(B0, 0, 0); FG_SCHED; FG_LDA(At, 0, 0); FG_STAGE(FG_SA(1, 1), a1 + AH, CV1);
      if constexpr (Job::GATHER) { if (last && has_next) { cv[0][0] = nv[0][0]; cv[0][1] = nv[0][1]; cv[1][0] = nv[1][0]; cv[1][1] = nv[1][1]; } }
      FG_WAIT_L(8); FG_BAR; FG_WAIT_L(0); FG_MM(0, 0, At, B0); FG_BAR; FG_SCHED;
      FG_LDB(B1, 0, 1); FG_STAGE(FG_SB(0, 0), b20, voffB);
      FG_BAR; FG_WAIT_L(0); FG_MM(0, 1, At, B1); FG_BAR;
      FG_LDA(At, 0, 1); FG_STAGE(FG_SA(0, 0), a2, cv[0]);
      FG_BAR; FG_WAIT_L(0); FG_MM(1, 0, At, B0); FG_BAR; FG_SCHED;
      FG_STAGE(FG_SB(0, 1), b21, voffB);
      FG_WAIT_V(6); FG_BAR; FG_MM(1, 1, At, B1); FG_BAR;
      FG_LDB(B0, 1, 0); FG_SCHED; FG_LDA(At, 1, 0); FG_STAGE(FG_SA(0, 1), a2 + AH, CV1);
      FG_WAIT_L(8); FG_BAR; FG_WAIT_L(0); FG_MM(0, 0, At, B0); FG_BAR; FG_SCHED;
      FG_LDB(B1, 1, 1); FG_STAGE(FG_SB(1, 0), b30, voffB);
      FG_BAR; FG_WAIT_L(0); FG_MM(0, 1, At, B1); FG_BAR;
      FG_LDA(At, 1, 1); FG_STAGE(FG_SA(1, 0), a3, cv[0]);
      FG_BAR; FG_WAIT_L(0); FG_MM(1, 0, At, B0); FG_BAR; FG_SCHED;
      FG_STAGE(FG_SB(1, 1), b31, voffB);
      FG_WAIT_V(6); FG_BAR; FG_MM(1, 1, At, B1); FG_BAR;
    }
    if (wr == 0) FG_BAR;
    { int l2; asm volatile("v_mbcnt_lo_u32_b32 %0, -1, 0\n\tv_mbcnt_hi_u32_b32 %0, -1, %0" : "=v"(l2));
      J.epilogue(acc, cur, wr, wc, l2 & 15, l2 >> 4, lds); }
    if (!has_next) break;
#pragma unroll
    for (int a = 0; a < 2; ++a)
#pragma unroll
      for (int b = 0; b < 2; ++b)
#pragma unroll
        for (int m = 0; m < 4; ++m)
#pragma unroll
          for (int n = 0; n < 2; ++n) acc[a][b][m][n] = (f32x4){0.f, 0.f, 0.f, 0.f};
    cur = nxt;
    if (wr == 1) FG_BAR;
  }
  FG_WAIT_V(0);
  FG_BAR;
#undef CV1
#undef FG_SA
#undef FG_SB
#undef FG_STAGE
#undef FG_LDA
#undef FG_LDB
#undef FG_MMA
#undef FG_MMA8
#undef FG_MM
#undef FG_WAIT_V
#undef FG_WAIT_L
#undef FG_BAR
#undef FG_SCHED
}

DEVI bool dense_decode(long L, int nM, int nN, int& pm, int& pn) {
  const int nwg = nM * nN; if (L >= nwg) return false;
  int wgid = (int)L; { const int q = nwg / 8, r = nwg % 8, xcd = wgid % 8, off = wgid / 8; wgid = (xcd < r ? xcd * (q + 1) : r * (q + 1) + (xcd - r) * q) + off; }
  const int nig = 8 * nN, gid = wgid / nig, fm = gid * 8, gsz = (nM - fm) < 8 ? (nM - fm) : 8;
  pm = fm + ((wgid % nig) % gsz); pn = (wgid % nig) / gsz; return true;
}
template <int K> DEVI void dense_aoffs(const int (&Rr)[2], const int (&Cc)[2], unsigned (&v)[2][2]) {
#pragma unroll
  for (int i = 0; i < 2; ++i) { v[0][i] = (unsigned)(Rr[i] * K + Cc[i]) * 2u; v[1][i] = 0u; }
}


struct Slab { LAS unsigned char* w0; LAS unsigned char* wf; LAS unsigned char* r0; };
DEVI Slab slab_init(LAS unsigned char* lds, int wid, int fr, int fq) {
  Slab s; LAS unsigned char* b = lds + 3 * HTB + wid * 1024;
  s.w0 = b + fr * 64 + fq * 16; s.wf = b + (fq >> 1) * 8192 + fr * 64 + (fq & 1) * 32; s.r0 = b + (fq * 16 + fr) * 16; return s; }
DEVI void slab_x16(const Slab& s, u32x4 a, u32x4 b, u32x4& ra, u32x4& rb) { *(LAS u32x4*)s.w0 = a; *(LAS u32x4*)(s.w0 + 8192) = b; ra = *(LAS u32x4*)s.r0; rb = *(LAS u32x4*)(s.r0 + 8192); }
DEVI void slab_x16(const Slab& s, u32x4 a, u32x4& ra) { *(LAS u32x4*)s.w0 = a; ra = *(LAS u32x4*)s.r0; }
DEVI void slab_x32(const Slab& s, f32x4 a, f32x4 b, f32x4& ra, f32x4& rb) { *(LAS f32x4*)s.wf = a; *(LAS f32x4*)(s.wf + 16) = b; ra = *(LAS f32x4*)s.r0; rb = *(LAS f32x4*)(s.r0 + 8192); }

template <int LAYER> struct JobOut {
  static constexpr bool FP8 = LAYER == 0 ? OUT0_FP8 : OUT1_FP8;
  static constexpr int K = FP8 ? D / 2 : D; static constexpr bool GATHER = false;
  static constexpr int SCALE = 0x01010101 * (127 - (WQ_SHIFT + A_SHIFT) / 2); static_assert((WQ_SHIFT + A_SHIFT) % 2 == 0, "");
  const Params& p; int i, c, G;
  DEVI JobOut(const Params& p_) : p(p_), i(0), c(vbid()), G(gridDim.x) {}
  DEVI unsigned boff(int R, int C) const { return boff_m2<K>(R, C); }
  DEVI bool next(Unit& u) {
    for (;;) { int pm, pn; if (!dense_decode((long)i * G + c, T / 256, D / 256, pm, pn)) return false; ++i;
      if (LAYER == 1 && pm % 9 == 0) continue;
      u.pm = pm; u.pn = pn; u.A = (const char*)(p.ws + (FP8 ? OFF_ACT8 : OFF_ACT)) + (size_t)pm * 256 * K * 2;
      u.B0 = (const char*)wsp<bf16_t>(p, LAYER == 0 ? OFF_WOUT0T : OFF_WOUT1T) + (size_t)(256 * pn) * K * 2; u.B1 = u.B0 + (size_t)128 * K * 2; return true; }
  }
  DEVI void aoffs(const Unit&, const int (&Rr)[2], const int (&Cc)[2], unsigned (&v)[2][2]) const { dense_aoffs<K>(Rr, Cc, v); }
  DEVI void epilogue(const Acc& acc, const Unit& u, int wr, int wc, int fr, int fq, LAS unsigned char* lds) const {
    asm volatile("" : "+v"(fr), "+v"(fq));
    const int t0 = u.pm * 256;
    const float* res = in_row(p, t0); bf16_t* dst = wsp<bf16_t>(p, OFF_HB) + (size_t)t0 * D;
    const float* gate = modv(p, LAYER, t0, 2);
    const int col0 = u.pn * 256 + wc * 32 + 8 * fq, lane = fq * 16 + fr;
    const Slab sl = slab_init(lds, wr * 4 + wc, fr, fq);
    const size_t rb = (size_t)(wr * 64 + (lane >> 2)) * D + u.pn * 256 + wc * 32 + 4 * (lane & 3);
    res += rb; dst += rb;
    asm volatile("" : "+v"(res), "+v"(dst));
    f32x4 gv[2][2];
#pragma unroll
    for (int bj = 0; bj < 2; ++bj)
#pragma unroll
      for (int n = 0; n < 2; ++n) gv[bj][n] = *(const f32x4*)(gate + col0 + bj * 128 + 4 * n);
#pragma unroll
    for (int ai = 0; ai < 2; ++ai) {
      f32x4 r4[4][2][2];
#pragma unroll
      for (int m = 0; m < 4; ++m) { const size_t ro = (size_t)(ai * 128 + m * 16) * D;
#pragma unroll
        for (int bj = 0; bj < 2; ++bj) {
          if (LAYER == 0) { r4[m][bj][0] = *(const f32x4*)(res + ro + bj * 128); r4[m][bj][1] = *(const f32x4*)(res + ro + bj * 128 + 16); }
          else { r4[m][bj][0] = bf4(*(const u32x2*)(dst + ro + bj * 128)); r4[m][bj][1] = bf4(*(const u32x2*)(dst + ro + bj * 128 + 16)); } } }
#pragma unroll
      for (int m = 0; m < 4; ++m) { const size_t ro = (size_t)(ai * 128 + m * 16) * D;
#pragma unroll
        for (int bj = 0; bj < 2; ++bj) { f32x4 x0, x1; slab_x32(sl, gv[bj][0] * acc[ai][bj][m][0], gv[bj][1] * acc[ai][bj][m][1], x0, x1);
          x0 += r4[m][bj][0]; x1 += r4[m][bj][1];
          u32x2 w0, w1; w0.x = pack2(x0[0], x0[1]); w0.y = pack2(x0[2], x0[3]); w1.x = pack2(x1[0], x1[1]); w1.y = pack2(x1[2], x1[3]);
          *(u32x2*)(dst + ro + bj * 128) = w0; *(u32x2*)(dst + ro + bj * 128 + 16) = w1; } }
      asm volatile("" ::: "memory"); }
  }
};

DEVI void load_rope_lds(const Params& p, size_t tab_off, int nrope, int gq, int gk, int ng, LAS unsigned char* lds) {
  const int tid = ltid(); __syncthreads();
  const f32x4* src = (const f32x4*)(p.ws + tab_off); LAS f32x4* dst = (LAS f32x4*)(lds + LDS_ROPE);
  for (int i = tid; i < nrope; i += 512) dst[i] = src[i];
  LAS float* g = (LAS float*)(lds + LDS_GAIN);
  if (tid < 2 * ng) g[tid] = tid < ng ? sm(p, gq)[tid] : sm(p, gk)[tid - ng];
  __syncthreads();
}
struct JobIn0 {
  static constexpr int K = IN0_FP8 ? D / 2 : D; static constexpr bool GATHER = false, FP8 = IN0_FP8;
  static constexpr int SCALE = 0x01010101 * (127 - (WQ_SHIFT + X_SHIFT) / 2);
  const Params& p; int i, c, G; int dry;
  DEVI JobIn0(const Params& p_, int dry_ = 0) : p(p_), i(0), c(vbid()), G(gridDim.x), dry(dry_) {}
  DEVI unsigned boff(int R, int C) const { return boff_m1<K>(R, C); }
  DEVI bool next(Unit& u) {
    int pm, pn; if (!dense_decode((long)i * G + c, T / 256, EVEN_IN / 256, pm, pn)) return false; ++i;
    u.pm = pm; u.pn = pn; u.A = (const char*)(p.ws + (IN0_FP8 ? OFF_ACT8 : OFF_ACT)) + (size_t)pm * 256 * K * 2;
    u.B0 = (const char*)wsp<bf16_t>(p, OFF_WIN0T) + (size_t)(256 * pn) * K * 2; u.B1 = u.B0 + (size_t)32 * K * 2; return true;
  }
  DEVI void aoffs(const Unit&, const int (&Rr)[2], const int (&Cc)[2], unsigned (&v)[2][2]) const { dense_aoffs<K>(Rr, Cc, v); }
  DEVI void epilogue(const Acc& acc, const Unit& u, int wr, int wc, int fr, int fq, LAS unsigned char* lds) const {
    asm volatile("" : "+v"(fr), "+v"(fq));
    if (dry == 1) {
#pragma unroll
      for (int ai = 0; ai < 2; ++ai)
#pragma unroll
        for (int bj = 0; bj < 2; ++bj)
#pragma unroll
          for (int m = 0; m < 4; ++m)
#pragma unroll
            for (int n = 0; n < 2; ++n) asm volatile("" :: "v"(acc[ai][bj][m][n]));
      return; }
    const int lane = fq * 16 + fr; const Slab sl = slab_init(lds, wr * 4 + wc, fr, fq);
    bf16_t* outp = wsp<bf16_t>(p, OFF_PROJ) + (size_t)(u.pm * 256 + wr * 64 + (lane >> 2)) * EVEN_IN + u.pn * 256 + wc * 64 + 8 * (lane & 3);
    asm volatile("" : "+v"(outp));
    const int pn = u.pn;
    if (pn < 4) {
#pragma unroll
      for (int ai = 0; ai < 2; ++ai)
#pragma unroll
        for (int m = 0; m < 4; ++m) {
          u32x4 wq[2];
#pragma unroll
          for (int bj = 0; bj < 2; ++bj) { const f32x4 v0 = acc[ai][bj][m][0], v1 = acc[ai][bj][m][1];
            const f32x2 a = gelu_pk((f32x2){v0[0], v0[1]}), b = gelu_pk((f32x2){v0[2], v0[3]}), c2 = gelu_pk((f32x2){v1[0], v1[1]}), d = gelu_pk((f32x2){v1[2], v1[3]});
            u32x4 w; w.x = cvt_pk_bf16(a.x, a.y); w.y = cvt_pk_bf16(b.x, b.y); w.z = cvt_pk_bf16(c2.x, c2.y); w.w = cvt_pk_bf16(d.x, d.y);
            wq[bj] = w; }
          { u32x4 ra, rb; slab_x16(sl, wq[0], wq[1], ra, rb); *(u32x4*)(outp + (size_t)(ai * 128 + m * 16) * EVEN_IN) = ra; *(u32x4*)(outp + (size_t)(ai * 128 + m * 16) * EVEN_IN + 32) = rb; } }
    } else if (pn >= 8 && ATT0_F8) {
      LAS unsigned char* sb = lds + 3 * HTB + (wr * 4 + wc) * 1024;
      const int bb = u.pm / 9, hh = (pn - 8) * 2 + (wc >> 1); const float vs = (float)(1 << VS_SHIFT);
      unsigned char* vt = p.ws + OFF_VT8_0 + ((size_t)((bb * 4 + hh) * 128 + (wc & 1) * 64 + lane)) * SB + (size_t)((u.pm % 9) * 4 + wr) * 64;
      asm volatile("" : "+v"(vt));
#pragma unroll
      for (int ai = 0; ai < 2; ++ai)
#pragma unroll
        for (int m = 0; m < 4; ++m) {
#pragma unroll
          for (int bj = 0; bj < 2; ++bj)
#pragma unroll
            for (int n = 0; n < 2; ++n) { const f32x4 x = acc[ai][bj][m][n];
              const int w01 = __builtin_amdgcn_cvt_pk_fp8_f32(__builtin_amdgcn_fmed3f(x[0] * vs, -440.f, 440.f), __builtin_amdgcn_fmed3f(x[1] * vs, -440.f, 440.f), 0, false);
              const int w23 = __builtin_amdgcn_cvt_pk_fp8_f32(__builtin_amdgcn_fmed3f(x[2] * vs, -440.f, 440.f), __builtin_amdgcn_fmed3f(x[3] * vs, -440.f, 440.f), 0, false);
              LAS unsigned char* d = sb + (32 * bj + 8 * fq + 4 * n) * 16 + fr;
              d[0] = (unsigned char)(w01 & 0xff); d[16] = (unsigned char)((w01 >> 8) & 0xff); d[32] = (unsigned char)(w23 & 0xff); d[48] = (unsigned char)((w23 >> 8) & 0xff); }
          const u32x4 rw = *(LAS u32x4*)(sb + lane * 16);
          unsigned char* dst = vt + ai * 128 + 16 * (m >> 1) + 8 * (m & 1);
          *(u32x2*)dst = (u32x2){rw.x, rw.z}; *(u32x2*)(dst + 32) = (u32x2){rw.y, rw.w};
          asm volatile("" ::: "memory"); }
    } else if (pn >= 8) {
#pragma unroll
      for (int ai = 0; ai < 2; ++ai)
#pragma unroll
        for (int m = 0; m < 4; ++m) {
          u32x4 wq[2];
#pragma unroll
          for (int bj = 0; bj < 2; ++bj) { const f32x4 v0 = acc[ai][bj][m][0], v1 = acc[ai][bj][m][1];
            u32x4 w; w.x = cvt_pk_bf16(v0[0], v0[1]); w.y = cvt_pk_bf16(v0[2], v0[3]); w.z = cvt_pk_bf16(v1[0], v1[1]); w.w = cvt_pk_bf16(v1[2], v1[3]);
            wq[bj] = w; }
          { u32x4 ra, rb; slab_x16(sl, wq[0], wq[1], ra, rb); *(u32x4*)(outp + (size_t)(ai * 128 + m * 16) * EVEN_IN) = ra; *(u32x4*)(outp + (size_t)(ai * 128 + m * 16) * EVEN_IN + 32) = rb; } }
    } else {
      LAS const float* gn = (LAS const float*)(lds + LDS_GAIN) + (pn < 6 ? 0 : 64) + 8 * fq;
      f32x4 g4[2][2];
#pragma unroll
      for (int bj = 0; bj < 2; ++bj)
#pragma unroll
        for (int n = 0; n < 2; ++n) g4[bj][n] = *(LAS const f32x4*)(gn + bj * 32 + 4 * n);
      const int jt = u.pm % 9; const bool lat = jt != 0;
      LAS const f32x4* t64 = (LAS const f32x4*)(lds + LDS_ROPE);
#pragma unroll
      for (int ai = 0; ai < 2; ++ai)
#pragma unroll
        for (int m = 0; m < 4; ++m) {
          f32x4 cs[2][2];
          if (lat) { const int il = (jt - 1) * 256 + ai * 128 + wr * 64 + m * 16 + fr; const int prow = il >> 6, pcol = il & 63;
#pragma unroll
            for (int bj = 0; bj < 2; ++bj)
#pragma unroll
              for (int n = 0; n < 2; ++n) cs[bj][n] = t64[(bj ? pcol : prow) * 8 + 2 * fq + n]; }
          float ss = 0.f;
#pragma unroll
          for (int bj = 0; bj < 2; ++bj)
#pragma unroll
            for (int n = 0; n < 2; ++n) { const f32x4 x = acc[ai][bj][m][n]; ss += (x[0] * x[0] + x[1] * x[1]) + (x[2] * x[2] + x[3] * x[3]); }
          ss += shx<16>(ss); ss = sum32x(ss);
          const float rstd = rsqrtf(ss * (1.0f / 64) + EPS);
          u32x4 wq[2];
#pragma unroll
          for (int bj = 0; bj < 2; ++bj) { f32x4 y[2];
#pragma unroll
            for (int n = 0; n < 2; ++n) { f32x4 x = acc[ai][bj][m][n] * rstd * g4[bj][n];
              if (lat) { const f32x4 c4 = cs[bj][n]; x = (f32x4){x[0] * c4[0] - x[1] * c4[1], x[0] * c4[1] + x[1] * c4[0], x[2] * c4[2] - x[3] * c4[3], x[2] * c4[3] + x[3] * c4[2]}; }
              y[n] = x; }
            if (ATT0_F8) { const float qs = (float)(1 << QS_SHIFT); int lo = 0, hi8 = 0;
#pragma unroll
              for (int n = 0; n < 2; ++n)
#pragma unroll
                for (int j = 0; j < 4; ++j) y[n][j] = __builtin_amdgcn_fmed3f(y[n][j] * qs, -440.f, 440.f);
              lo = __builtin_amdgcn_cvt_pk_fp8_f32(y[0][0], y[0][1], lo, false); lo = __builtin_amdgcn_cvt_pk_fp8_f32(y[0][2], y[0][3], lo, true);
              hi8 = __builtin_amdgcn_cvt_pk_fp8_f32(y[1][0], y[1][1], hi8, false); hi8 = __builtin_amdgcn_cvt_pk_fp8_f32(y[1][2], y[1][3], hi8, true);
              *(LAS u32x2*)(lds + 3 * HTB + (wr * 4 + wc) * 1024 + fr * 64 + bj * 32 + fq * 8) = (u32x2){(unsigned)lo, (unsigned)hi8}; }
            else {
            u32x4 w; w.x = cvt_pk_bf16(y[0][0], y[0][1]); w.y = cvt_pk_bf16(y[0][2], y[0][3]); w.z = cvt_pk_bf16(y[1][0], y[1][1]); w.w = cvt_pk_bf16(y[1][2], y[1][3]);
            wq[bj] = w; } }
          if (ATT0_F8) { const u32x4 rw = *(LAS u32x4*)(lds + 3 * HTB + (wr * 4 + wc) * 1024 + lane * 16);
            *(u32x4*)(p.ws + OFF_QK8_0 + (size_t)(u.pm * 256 + wr * 64 + (lane >> 2) + ai * 128 + m * 16) * 1024 + (pn - 4) * 256 + wc * 64 + 16 * (lane & 3)) = rw; }
          else { u32x4 ra, rb; slab_x16(sl, wq[0], wq[1], ra, rb); *(u32x4*)(outp + (size_t)(ai * 128 + m * 16) * EVEN_IN) = ra; *(u32x4*)(outp + (size_t)(ai * 128 + m * 16) * EVEN_IN + 32) = rb; }
          asm volatile("" ::: "memory");
        }
    }
  }
};

struct JobIn1 {
  static constexpr int K = IN1_FP8 ? D / 2 : D; static constexpr bool GATHER = false, FP8 = IN1_FP8;
  static constexpr int SCALE = 0x01010101 * (127 - (WQ_SHIFT + X_SHIFT) / 2); static_assert((WQ_SHIFT + X_SHIFT) % 2 == 0, "");
  const Params& p; int i, c, G;
  DEVI JobIn1(const Params& p_) : p(p_), i(0), c(vbid()), G(gridDim.x) {}
  DEVI unsigned boff(int R, int C) const { return boff_m1<K>(R, C); }
  DEVI bool next(Unit& u) {
    for (;;) { int pm, pn; if (!dense_decode((long)i * G + c, T / 256, ODD_IN / 256, pm, pn)) return false; ++i;
      if (pm % 9 == 0 && pn < 4) continue;
      u.pm = pm; u.pn = pn; u.A = (const char*)(p.ws + (IN1_FP8 ? OFF_ACT8 : OFF_ACT)) + (size_t)pm * 256 * K * 2;
      u.B0 = (const char*)wsp<bf16_t>(p, OFF_WQKV1T) + (size_t)(256 * pn) * K * 2; u.B1 = u.B0 + (size_t)32 * K * 2; return true; }
  }
  DEVI void aoffs(const Unit&, const int (&Rr)[2], const int (&Cc)[2], unsigned (&v)[2][2]) const { dense_aoffs<K>(Rr, Cc, v); }
  DEVI void epilogue(const Acc& acc, const Unit& u, int wr, int wc, int fr, int fq, LAS unsigned char* lds) const {
    asm volatile("" : "+v"(fr), "+v"(fq));
    const int lane = fq * 16 + fr; const Slab sl = slab_init(lds, wr * 4 + wc, fr, fq);
    int ooff = (u.pm * 256 + wr * 64 + (lane >> 2)) * ODD_IN + u.pn * 256 + wc * 64 + 8 * (lane & 3);
    asm volatile("" : "+v"(ooff));
    bf16_t* outp = wsp<bf16_t>(p, OFF_PROJ) + ooff;
    asm volatile("" : "+v"(outp));
    const int pn = u.pn;
    if (pn == 5 && ATT1_PV8) {
      LAS unsigned char* sb = lds + 3 * HTB + (wr * 4 + wc) * 1024;
      const int bb = u.pm / 9, kvh = wc >> 1; const float vs = (float)(1 << VS_SHIFT);
      unsigned char* vt = p.ws + OFF_VT8 + ((size_t)((bb * 2 + kvh) * 128 + (wc & 1) * 64 + lane)) * SB + (size_t)((u.pm % 9) * 4 + wr) * 64;
      asm volatile("" : "+v"(vt));
#pragma unroll
      for (int ai = 0; ai < 2; ++ai)
#pragma unroll
        for (int m = 0; m < 4; ++m) {
#pragma unroll
          for (int bj = 0; bj < 2; ++bj)
#pragma unroll
            for (int n = 0; n < 2; ++n) { const f32x4 x = acc[ai][bj][m][n];
              const int w01 = __builtin_amdgcn_cvt_pk_fp8_f32(__builtin_amdgcn_fmed3f(x[0] * vs, -440.f, 440.f), __builtin_amdgcn_fmed3f(x[1] * vs, -440.f, 440.f), 0, false);
              const int w23 = __builtin_amdgcn_cvt_pk_fp8_f32(__builtin_amdgcn_fmed3f(x[2] * vs, -440.f, 440.f), __builtin_amdgcn_fmed3f(x[3] * vs, -440.f, 440.f), 0, false);
              LAS unsigned char* d = sb + (32 * bj + 8 * fq + 4 * n) * 16 + fr;
              d[0] = (unsigned char)(w01 & 0xff); d[16] = (unsigned char)((w01 >> 8) & 0xff); d[32] = (unsigned char)(w23 & 0xff); d[48] = (unsigned char)((w23 >> 8) & 0xff); }
          const u32x4 rw = *(LAS u32x4*)(sb + lane * 16);
          unsigned char* dst = vt + ai * 128 + 16 * (m >> 1) + 8 * (m & 1);
          *(u32x2*)dst = (u32x2){rw.x, rw.z}; *(u32x2*)(dst + 32) = (u32x2){rw.y, rw.w};
          asm volatile("" ::: "memory"); }
    } else if (pn == 5) {
#pragma unroll
      for (int ai = 0; ai < 2; ++ai)
#pragma unroll
        for (int m = 0; m < 4; ++m) {
          u32x4 wq[2];
#pragma unroll
          for (int bj = 0; bj < 2; ++bj) { const f32x4 v0 = acc[ai][bj][m][0], v1 = acc[ai][bj][m][1];
            u32x4 w; w.x = cvt_pk_bf16(v0[0], v0[1]); w.y = cvt_pk_bf16(v0[2], v0[3]); w.z = cvt_pk_bf16(v1[0], v1[1]); w.w = cvt_pk_bf16(v1[2], v1[3]);
            wq[bj] = w; }
          { u32x4 ra, rb; slab_x16(sl, wq[0], wq[1], ra, rb); *(u32x4*)(outp + (size_t)(ai * 128 + m * 16) * ODD_IN) = ra; *(u32x4*)(outp + (size_t)(ai * 128 + m * 16) * ODD_IN + 32) = rb; } }
    } else {
      const int wid = wr * 4 + wc;
      LAS float* xw = (LAS float*)(lds + LDS_XCH) + wid * 128 + fr; LAS float* xr = (LAS float*)(lds + LDS_XCH) + (wid ^ 1) * 128 + fr;
      asm volatile("" : "+v"(xw), "+v"(xr));
      float ssr[2][4];
#pragma unroll
      for (int ai = 0; ai < 2; ++ai)
#pragma unroll
        for (int m = 0; m < 4; ++m) { float ss = 0.f;
#pragma unroll
          for (int bj = 0; bj < 2; ++bj)
#pragma unroll
            for (int n = 0; n < 2; ++n) { const f32x4 x = acc[ai][bj][m][n]; ss += (x[0] * x[0] + x[1] * x[1]) + (x[2] * x[2] + x[3] * x[3]); }
          ss += shx<16>(ss); ss = sum32x(ss); ssr[ai][m] = ss;
          if (fq == 0) xw[ai * 64 + m * 16] = ss; }
      asm volatile("s_waitcnt lgkmcnt(0)" ::: "memory"); __builtin_amdgcn_s_barrier(); asm volatile("" ::: "memory");
#pragma unroll
      for (int ai = 0; ai < 2; ++ai)
#pragma unroll
        for (int m = 0; m < 4; ++m) ssr[ai][m] += xr[ai * 64 + m * 16];
      const int hh = wc & 1;
      LAS const float* gn = (LAS const float*)(lds + LDS_GAIN) + (pn < 4 ? 0 : 128) + 64 * hh + 8 * fq;
      asm volatile("" : "+v"(gn));
      const int jt = u.pm % 9; const bool lat = jt != 0;
      LAS const f32x4* t128 = (LAS const f32x4*)(lds + LDS_ROPE);
#pragma unroll
      for (int ai = 0; ai < 2; ++ai)
#pragma unroll
        for (int m = 0; m < 4; ++m) {
          f32x4 g4[2][2];
#pragma unroll
          for (int bj = 0; bj < 2; ++bj)
#pragma unroll
            for (int n = 0; n < 2; ++n) g4[bj][n] = *(LAS const f32x4*)(gn + bj * 32 + 4 * n);
          f32x4 cs[2][2];
          if (lat) { const int il = (jt - 1) * 256 + ai * 128 + wr * 64 + m * 16 + fr; const int pos = hh ? (il & 63) : (il >> 6);
#pragma unroll
            for (int bj = 0; bj < 2; ++bj)
#pragma unroll
              for (int n = 0; n < 2; ++n) cs[bj][n] = t128[pos * 16 + 8 * bj + 2 * fq + n]; }
          const float rstd = rsqrtf(ssr[ai][m] * (1.0f / 128) + EPS);
          u32x4 wq[2];
#pragma unroll
          for (int bj = 0; bj < 2; ++bj) { f32x4 y[2];
#pragma unroll
            for (int n = 0; n < 2; ++n) { f32x4 x = acc[ai][bj][m][n] * rstd * g4[bj][n];
              if (lat) { const f32x4 c4 = cs[bj][n]; x = (f32x4){x[0] * c4[0] - x[1] * c4[1], x[0] * c4[1] + x[1] * c4[0], x[2] * c4[2] - x[3] * c4[3], x[2] * c4[3] + x[3] * c4[2]}; }
              y[n] = x; }
            if (ATT1_QK8) { const float qs = (float)(1 << QS_SHIFT); int lo = 0, hi8 = 0;
#pragma unroll
              for (int n = 0; n < 2; ++n)
#pragma unroll
                for (int j = 0; j < 4; ++j) y[n][j] = __builtin_amdgcn_fmed3f(y[n][j] * qs, -440.f, 440.f);
              lo = __builtin_amdgcn_cvt_pk_fp8_f32(y[0][0], y[0][1], lo, false); lo = __builtin_amdgcn_cvt_pk_fp8_f32(y[0][2], y[0][3], lo, true);
              hi8 = __builtin_amdgcn_cvt_pk_fp8_f32(y[1][0], y[1][1], hi8, false); hi8 = __builtin_amdgcn_cvt_pk_fp8_f32(y[1][2], y[1][3], hi8, true);
              *(LAS u32x2*)(lds + 3 * HTB + (wr * 4 + wc) * 1024 + fr * 64 + bj * 32 + fq * 8) = (u32x2){(unsigned)lo, (unsigned)hi8}; }
            else {
            u32x4 w; w.x = cvt_pk_bf16(y[0][0], y[0][1]); w.y = cvt_pk_bf16(y[0][2], y[0][3]); w.z = cvt_pk_bf16(y[1][0], y[1][1]); w.w = cvt_pk_bf16(y[1][2], y[1][3]);
            wq[bj] = w; } }
          if (ATT1_QK8) { const u32x4 rw = *(LAS u32x4*)(lds + 3 * HTB + (wr * 4 + wc) * 1024 + lane * 16);
            *(u32x4*)(p.ws + OFF_QK8 + (size_t)(u.pm * 256 + wr * 64 + (lane >> 2) + ai * 128 + m * 16) * 1280 + pn * 256 + wc * 64 + 16 * (lane & 3)) = rw; }
          else { u32x4 ra, rb; slab_x16(sl, wq[0], wq[1], ra, rb); *(u32x4*)(outp + (size_t)(ai * 128 + m * 16) * ODD_IN) = ra; *(u32x4*)(outp + (size_t)(ai * 128 + m * 16) * ODD_IN + 32) = rb; }
          asm volatile("" ::: "memory");
        }
    }
  }
};

DEVI void moe_tables(const Params& p, const LCfg c, int half, int nN, LAS unsigned char* lds) {
  LAS int* tb = (LAS int*)(lds + LDS_TAB);
  const int tid = ltid();
  __syncthreads();
  if (tid <= NE) tb[tid] = tid < NE ? ((const int*)(p.ws + OFF_CNT))[c.l * 128 + half * 64 + tid] : c.nph;
  __syncthreads();
  if (tid == 0) { int up = 0, off = 0; for (int e = 0; e <= NE; ++e) { const int n = tb[e]; tb[72 + e] = up; tb[144 + e] = off; up += ((n + 255) >> 8) * nN; off += n; } tb[72 + 65] = up; tb[144 + 65] = off; }
  __syncthreads();
}
struct MoeIter {
  int g, gend, step, e;
  DEVI void init(LAS const int* tb) { const int vb = vbid(); const int U = __builtin_amdgcn_readfirstlane(tb[72 + 65]), chunk = (U + 7) >> 3, x = vb & 7; g = x * chunk + (vb >> 3); gend = (x + 1) * chunk < U ? (x + 1) * chunk : U; step = gridDim.x >> 3; e = 0; }
  DEVI bool next(LAS const int* tb, int nN, int& ee, int& mt, int& pn) { if (g >= gend) return false; while (__builtin_amdgcn_readfirstlane(tb[72 + e + 1]) <= g) ++e; const int r = g - __builtin_amdgcn_readfirstlane(tb[72 + e]); mt = r / nN; pn = r - mt * nN; ee = e; g += step; return true; }
};
struct JobGU {
  static constexpr int K = D / 2; static constexpr bool GATHER = true, FP8 = true;
  static constexpr int SCALE = 0x01010101 * (127 - (WG_SHIFT + X_SHIFT) / 2); static_assert((WG_SHIFT + X_SHIFT) % 2 == 0, "");
  const Params& p; const LCfg c; int half; LAS const int* tb; MoeIter it; int dry;
  DEVI JobGU(const Params& p_, const LCfg c_, int half_, LAS unsigned char* lds, int dry_ = 0) : p(p_), c(c_), half(half_), tb((LAS const int*)(lds + LDS_TAB)), dry(dry_) { it.init(tb); }
  DEVI unsigned boff(int R, int C) const { return boff_m2<K>(R, C); }
  DEVI bool next(Unit& u) {
    int e, mt, pn; if (!it.next(tb, 2, e, mt, pn)) return false;
    u.e = e; u.pm = mt; u.pn = pn; u.cnt = __builtin_amdgcn_readfirstlane(tb[e]); u.off = __builtin_amdgcn_readfirstlane(tb[144 + e]); u.A = (const char*)(p.ws + OFF_ACT8);
    const char* w = e < NE ? (const char*)wsp<bf16_t>(p, OFF_EGU) + (size_t)e * 512 * K * 2 : (const char*)wsp<bf16_t>(p, OFF_SHGU) + (size_t)c.l * 512 * K * 2;
    u.B0 = w + (size_t)(128 * pn) * K * 2; u.B1 = w + (size_t)(256 + 128 * pn) * K * 2; return true;
  }
  DEVI void aoffs(const Unit& u, const int (&Rr)[2], const int (&Cc)[2], unsigned (&v)[2][2]) const {
    const int* le = wsp<int>(p, OFF_LIST) + ((size_t)(half * 64 + (u.e < NE ? u.e : 0))) * LCAP;
#pragma unroll
    for (int h = 0; h < 2; ++h)
#pragma unroll
      for (int i = 0; i < 2; ++i) { int r = u.pm * 256 + h * 128 + Rr[i]; r = r < u.cnt ? r : 0;
        int tl = r; if (u.e < NE) tl = le[r] / 6;
        v[h][i] = (unsigned)(act_tok(c, half, tl) * K + Cc[i]) * 2u; }
  }
  DEVI void epilogue(const Acc& acc, const Unit& u, int wr, int wc, int fr, int fq, LAS unsigned char* lds) const {
    asm volatile("" : "+v"(fr), "+v"(fq));
    if (dry == 1) {
#pragma unroll
      for (int ai = 0; ai < 2; ++ai)
#pragma unroll
        for (int bj = 0; bj < 2; ++bj)
#pragma unroll
          for (int m = 0; m < 4; ++m)
#pragma unroll
            for (int n = 0; n < 2; ++n) asm volatile("" :: "v"(acc[ai][bj][m][n]));
      return; }
    const int lane = fq * 16 + fr;
    LAS unsigned char* sb = lds + 3 * HTB + (wr * 4 + wc) * 1024;
    const int r0 = u.pm * 256 + wr * 64 + (lane >> 2);
    unsigned char* hid = p.ws + OFF_HID + ((size_t)u.off + r0) * DE + u.pn * 128 + wc * 32 + 8 * (lane & 3);
    asm volatile("" : "+v"(hid));
    const float hs = (float)(1 << H_SHIFT);
#pragma unroll
    for (int ai = 0; ai < 2; ++ai)
#pragma unroll
      for (int m = 0; m < 4; ++m) { const int r = r0 + ai * 128 + m * 16;
        float h[8];
#pragma unroll
        for (int n = 0; n < 2; ++n)
#pragma unroll
          for (int j = 0; j < 4; ++j) { const float gg = acc[ai][0][m][n][j]; h[n * 4 + j] = __builtin_amdgcn_fmed3f(gg * __builtin_amdgcn_rcpf(1.0f + __expf(-gg)) * acc[ai][1][m][n][j] * hs, -440.f, 440.f); }
        int lo = 0, hi = 0;
        lo = __builtin_amdgcn_cvt_pk_fp8_f32(h[0], h[1], lo, false); lo = __builtin_amdgcn_cvt_pk_fp8_f32(h[2], h[3], lo, true);
        hi = __builtin_amdgcn_cvt_pk_fp8_f32(h[4], h[5], hi, false); hi = __builtin_amdgcn_cvt_pk_fp8_f32(h[6], h[7], hi, true);
        *(LAS u32x2*)(sb + fr * 32 + fq * 8) = (u32x2){(unsigned)lo, (unsigned)hi};
        const u32x2 rw = *(LAS u32x2*)(sb + lane * 8);
        if (r < u.cnt) *(u32x2*)(hid + (size_t)(ai * 128 + m * 16) * DE) = rw; }
  }
};
struct JobDown {
  static constexpr int K = DE / 2; static constexpr bool GATHER = false, FP8 = true;
  static constexpr int SCALE = 0x01010101 * (127 - (WD_SHIFT + H_SHIFT) / 2); static_assert((WD_SHIFT + H_SHIFT) % 2 == 0, "");
  const Params& p; const LCfg c; int half; LAS const int* tb; MoeIter it; float dscale;
  DEVI JobDown(const Params& p_, const LCfg c_, int half_, LAS unsigned char* lds, float ds = 1.0f) : p(p_), c(c_), half(half_), tb((LAS const int*)(lds + LDS_TAB)), dscale(ds) { it.init(tb); }
  DEVI unsigned boff(int R, int C) const { return boff_m1<K>(R, C); }
  DEVI bool next(Unit& u) {
    int e, mt, pn; if (!it.next(tb, 4, e, mt, pn)) return false;
    u.e = e; u.pm = mt; u.pn = pn; u.cnt = __builtin_amdgcn_readfirstlane(tb[e]); u.off = __builtin_amdgcn_readfirstlane(tb[144 + e]);
    u.A = (const char*)wsp<bf16_t>(p, OFF_HID) + ((size_t)(u.off + mt * 256)) * K * 2;
    const char* w = e < NE ? (const char*)wsp<bf16_t>(p, OFF_ED) + (size_t)e * D * K * 2 : (const char*)wsp<bf16_t>(p, OFF_SHD) + (size_t)c.l * D * K * 2;
    u.B0 = w + (size_t)(256 * pn) * K * 2; u.B1 = u.B0 + (size_t)32 * K * 2; return true;
  }
  DEVI void aoffs(const Unit&, const int (&Rr)[2], const int (&Cc)[2], unsigned (&v)[2][2]) const { dense_aoffs<K>(Rr, Cc, v); }
  DEVI void epilogue(const Acc& acc, const Unit& u, int wr, int wc, int fr, int fq, LAS unsigned char* lds) const {
    asm volatile("" : "+v"(fr), "+v"(fq));
    const int lane = fq * 16 + fr;
    if (dscale < 0.f) {
#pragma unroll
      for (int ai = 0; ai < 2; ++ai)
#pragma unroll
        for (int bj = 0; bj < 2; ++bj)
#pragma unroll
          for (int m = 0; m < 4; ++m)
#pragma unroll
            for (int n = 0; n < 2; ++n) asm volatile("" :: "v"(acc[ai][bj][m][n]));
      return; }
    LAS unsigned char* sb = lds + 3 * HTB + (wr * 4 + wc) * 1024;
    const int r0 = u.pm * 256 + wr * 64 + (lane >> 2);
    unsigned char* slot = p.ws + OFF_SLOT + ((size_t)u.off + r0) * D + u.pn * 256 + wc * 64 + 16 * (lane & 3);
    asm volatile("" : "+v"(slot));
#pragma unroll
    for (int ai = 0; ai < 2; ++ai)
#pragma unroll
      for (int m = 0; m < 4; ++m) {
#pragma unroll
        for (int bj = 0; bj < 2; ++bj) { f32x4 v0 = acc[ai][bj][m][0], v1 = acc[ai][bj][m][1]; int lo = 0, hi = 0;
#pragma unroll
          for (int j = 0; j < 4; ++j) { v0[j] = __builtin_amdgcn_fmed3f(v0[j], -440.f, 440.f); v1[j] = __builtin_amdgcn_fmed3f(v1[j], -440.f, 440.f); }
          lo = __builtin_amdgcn_cvt_pk_fp8_f32(v0[0], v0[1], lo, false); lo = __builtin_amdgcn_cvt_pk_fp8_f32(v0[2], v0[3], lo, true);
          hi = __builtin_amdgcn_cvt_pk_fp8_f32(v1[0], v1[1], hi, false); hi = __builtin_amdgcn_cvt_pk_fp8_f32(v1[2], v1[3], hi, true);
          *(LAS u32x2*)(sb + fr * 64 + bj * 32 + fq * 8) = (u32x2){(unsigned)lo, (unsigned)hi}; }
        const u32x4 rw = *(LAS u32x4*)(sb + lane * 16);
        if (r0 + ai * 128 + m * 16 < u.cnt) *(u32x4*)(slot + (size_t)(ai * 128 + m * 16) * D) = rw; }
  }
};
}
namespace fa {
constexpr int NW = 8, QBLK = 32, KVBLK = 64;
constexpr float THR = 8.f;
constexpr size_t SHM_V = KVBLK * 128 * 2, SHM_K = KVBLK * 128 * 2, SHM_ATTN = 2 * SHM_V + 2 * SHM_K + NW * 64 * 4;
using s16x4 = __attribute__((ext_vector_type(4))) short;
using f32x16 = __attribute__((ext_vector_type(16))) float;
#define KSWZ(row, colB) ((row) * 256 + ((colB) ^ (((row) & 7) << 4)))
#define SBAR() __builtin_amdgcn_sched_barrier(0)
DEVI int crow(int r, int hi) { return (r & 3) + 8 * (r >> 2) + 4 * hi; }
DEVI unsigned cvtpk(float lo, float hi) { unsigned r; asm volatile("v_cvt_pk_bf16_f32 %0, %1, %2" : "=v"(r) : "v"(lo), "v"(hi)); return r; }

template <int SCALE_NUM> struct ScaleC;
DEVI void partialSM(f32x16& p0, f32x16& p1, float& m_reg, float& mn, float& alpha, const float SCALE, const float THRv = THR, const float ebias = 0.f) {
  const float C = SCALE * 1.4426950408889634f;
  float pmax = p0[0];
#pragma unroll
  for (int r = 1; r < 16; ++r) pmax = fmaxf(pmax, p0[r]);
#pragma unroll
  for (int r = 0; r < 16; ++r) pmax = fmaxf(pmax, p1[r]);
  { auto rr = __builtin_amdgcn_permlane32_swap(__float_as_uint(pmax), __float_as_uint(pmax), false, false);
    pmax = fmaxf(__uint_as_float(rr[0]), __uint_as_float(rr[1])); }
  if (__builtin_expect(__all(pmax - m_reg <= THRv / SCALE), 1)) { mn = m_reg; alpha = 1.f; }
  else { mn = fmaxf(m_reg, pmax); alpha = __builtin_amdgcn_exp2f((m_reg - mn) * C); m_reg = mn; }
  float mnC = -mn * C + ebias;
#pragma unroll
  for (int r = 0; r < 16; ++r) p0[r] = fmaf(p0[r], C, mnC);
#pragma unroll
  for (int r = 0; r < 16; ++r) p1[r] = fmaf(p1[r], C, mnC);
#pragma unroll
  for (int r = 0; r < 16; ++r) p0[r] = __builtin_amdgcn_exp2f(p0[r]);
}
DEVI void finishSM(f32x16& p0, f32x16& p1, float alpha, float& l_reg, bf16x8& pa0, bf16x8& pa1, bf16x8& pa2, bf16x8& pa3) {
#pragma unroll
  for (int r = 0; r < 16; ++r) p1[r] = __builtin_amdgcn_exp2f(p1[r]);
  float ps = 0;
#pragma unroll
  for (int r = 0; r < 16; ++r) ps += p0[r];
#pragma unroll
  for (int r = 0; r < 16; ++r) ps += p1[r];
  { auto rr = __builtin_amdgcn_permlane32_swap(__float_as_uint(ps), __float_as_uint(ps), false, false);
    ps = __uint_as_float(rr[0]) + __uint_as_float(rr[1]); }
  l_reg = l_reg * alpha + ps;
#define PK4(P, BASE, OUT) do { unsigned a0 = cvtpk(P[BASE + 0], P[BASE + 1]), a1 = cvtpk(P[BASE + 2], P[BASE + 3]);   \
    unsigned b0 = cvtpk(P[BASE + 4], P[BASE + 5]), b1 = cvtpk(P[BASE + 6], P[BASE + 7]);                              \
    auto r0 = __builtin_amdgcn_permlane32_swap(a0, b0, false, false); auto r1 = __builtin_amdgcn_permlane32_swap(a1, b1, false, false); \
    u32x4 w = {r0[0], r1[0], r0[1], r1[1]}; OUT = *reinterpret_cast<bf16x8*>(&w); } while (0)
  PK4(p0, 0, pa0); PK4(p0, 8, pa1); PK4(p1, 0, pa2); PK4(p1, 8, pa3);
#undef PK4
}
template <int ND0> DEVI void qkt(f32x16& p0, f32x16& p1, const char* Ks, const bf16x8* qr, int r32, int hi, int cbase) {
  p0 = f32x16{}; p1 = f32x16{};
#pragma unroll
  for (int d0 = 0; d0 < ND0; ++d0) { int cb = cbase + (d0 * 16 + hi * 8) * 2;
    bf16x8 b0 = *reinterpret_cast<const bf16x8*>(Ks + KSWZ(r32, cb));
    bf16x8 b1 = *reinterpret_cast<const bf16x8*>(Ks + KSWZ(32 + r32, cb));
    p0 = __builtin_amdgcn_mfma_f32_32x32x16_bf16(b0, qr[d0], p0, 0, 0, 0);
    p1 = __builtin_amdgcn_mfma_f32_32x32x16_bf16(b1, qr[d0], p1, 0, 0, 0); }
}
using fg::v8i_t;
#define K8SWZ(row, chunk) ((row) * 128 + ((((chunk)) ^ ((row) & 7)) << 4))
template <int NKS> DEVI void qkt8(f32x16& p0, f32x16& p1, const char* Ks, const v8i_t* q8, int r32, int hi, int cb8) {
  p0 = f32x16{}; p1 = f32x16{};
  constexpr int SC = 0x01010101 * (127 - QS_SHIFT);
#pragma unroll
  for (int ks = 0; ks < NKS; ++ks) { const int c0 = cb8 + ks * 4 + hi * 2;
    const u32x4 a0 = *reinterpret_cast<const u32x4*>(Ks + K8SWZ(r32, c0)), a1 = *reinterpret_cast<const u32x4*>(Ks + K8SWZ(r32, c0 + 1));
    const u32x4 b0 = *reinterpret_cast<const u32x4*>(Ks + K8SWZ(32 + r32, c0)), b1 = *reinterpret_cast<const u32x4*>(Ks + K8SWZ(32 + r32, c0 + 1));
    const v8i_t ka = {(int)a0[0], (int)a0[1], (int)a0[2], (int)a0[3], (int)a1[0], (int)a1[1], (int)a1[2], (int)a1[3]};
    const v8i_t kb = {(int)b0[0], (int)b0[1], (int)b0[2], (int)b0[3], (int)b1[0], (int)b1[1], (int)b1[2], (int)b1[3]};
    p0 = __builtin_amdgcn_mfma_scale_f32_32x32x64_f8f6f4(ka, q8[ks], p0, 0, 0, 0, SC, 0, SC);
    p1 = __builtin_amdgcn_mfma_scale_f32_32x32x64_f8f6f4(kb, q8[ks], p1, 0, 0, 0, SC, 0, SC); }
}
constexpr float THR8 = 3.f;
#define VT8SWZ(d, c) ((d) * 64 + ((((c)) ^ (((d) >> 2) & 3)) << 4))
DEVI void finishSM8(f32x16& p0, f32x16& p1, float alpha, float& l_reg, v8i_t& pa) {
#pragma unroll
  for (int r = 0; r < 16; ++r) p1[r] = __builtin_amdgcn_exp2f(p1[r]);
  float ps = 0;
#pragma unroll
  for (int r = 0; r < 16; ++r) ps += p0[r];
#pragma unroll
  for (int r = 0; r < 16; ++r) ps += p1[r];
  { auto rr = __builtin_amdgcn_permlane32_swap(__float_as_uint(ps), __float_as_uint(ps), false, false);
    ps = __uint_as_float(rr[0]) + __uint_as_float(rr[1]); }
  l_reg = l_reg * alpha + ps;
#pragma unroll
  for (int w = 0; w < 4; ++w) { int a = 0, b = 0;
    a = __builtin_amdgcn_cvt_pk_fp8_f32(p0[4 * w], p0[4 * w + 1], a, false); a = __builtin_amdgcn_cvt_pk_fp8_f32(p0[4 * w + 2], p0[4 * w + 3], a, true);
    b = __builtin_amdgcn_cvt_pk_fp8_f32(p1[4 * w], p1[4 * w + 1], b, false); b = __builtin_amdgcn_cvt_pk_fp8_f32(p1[4 * w + 2], p1[4 * w + 3], b, true);
    pa[w] = a; pa[4 + w] = b; }
}
DEVI void pv8(f32x16* o, const char* Vs, const v8i_t pa, int r32, int hi) {
  constexpr int SC = 0x01010101 * (127 - (PS_SHIFT + VS_SHIFT) / 2); static_assert((PS_SHIFT + VS_SHIFT) % 2 == 0, "");
  u32x4 lo[4], hh[4];
#pragma unroll
  for (int d0 = 0; d0 < 4; ++d0) { const int d = d0 * 32 + r32; lo[d0] = *reinterpret_cast<const u32x4*>(Vs + VT8SWZ(d, 2 * hi)); hh[d0] = *reinterpret_cast<const u32x4*>(Vs + VT8SWZ(d, 2 * hi + 1)); }
  asm volatile("s_waitcnt lgkmcnt(0)" ::: "memory"); SBAR();
#pragma unroll
  for (int d0 = 0; d0 < 4; ++d0) { const v8i_t vb = {(int)lo[d0][0], (int)lo[d0][1], (int)lo[d0][2], (int)lo[d0][3], (int)hh[d0][0], (int)hh[d0][1], (int)hh[d0][2], (int)hh[d0][3]};
    o[d0] = __builtin_amdgcn_mfma_scale_f32_32x32x64_f8f6f4(pa, vb, o[d0], 0, 0, 0, SC, 0, SC); }
}
DEVI int v_st(int k, int c) { const int kk = (k & ~0xC) | ((k & 4) << 1) | ((k & 8) >> 1); return ((kk >> 3) * 4 + (c >> 5)) * 512 + ((kk & 7) * 32 + (c & 31)) * 2; }
DEVI int v_rd_base(int lane) { return ((lane & 3) << 3) | (((lane >> 2) & 3) << 6) | (((lane >> 4) & 1) << 5) | (((lane >> 5) & 1) << 8); }
constexpr int v_rd_off(int d0, int ks, int half) { return d0 * 512 + ks * 4096 + half * 2048; }
template <int OFF> DEVI s16x4 tr_read(int vb) { s16x4 r; asm volatile("ds_read_b64_tr_b16 %0, %1 offset:%2" : "=&v"(r) : "v"(vb), "i"(OFF) : "memory"); return r; }
template <int D0> DEVI void pv_one(f32x16& od, int vb, bf16x8 pa0, bf16x8 pa1, bf16x8 pa2, bf16x8 pa3) {
  const s16x4 l0 = tr_read<v_rd_off(D0, 0, 0)>(vb), h0 = tr_read<v_rd_off(D0, 0, 1)>(vb), l1 = tr_read<v_rd_off(D0, 1, 0)>(vb), h1 = tr_read<v_rd_off(D0, 1, 1)>(vb);
  const s16x4 l2 = tr_read<v_rd_off(D0, 2, 0)>(vb), h2 = tr_read<v_rd_off(D0, 2, 1)>(vb), l3 = tr_read<v_rd_off(D0, 3, 0)>(vb), h3 = tr_read<v_rd_off(D0, 3, 1)>(vb);
  asm volatile("s_waitcnt lgkmcnt(0)" ::: "memory"); SBAR();
#define PK(L, H) (bf16x8){L[0], L[1], L[2], L[3], H[0], H[1], H[2], H[3]}
  od = __builtin_amdgcn_mfma_f32_32x32x16_bf16(pa0, PK(l0, h0), od, 0, 0, 0);
  od = __builtin_amdgcn_mfma_f32_32x32x16_bf16(pa1, PK(l1, h1), od, 0, 0, 0);
  od = __builtin_amdgcn_mfma_f32_32x32x16_bf16(pa2, PK(l2, h2), od, 0, 0, 0);
  od = __builtin_amdgcn_mfma_f32_32x32x16_bf16(pa3, PK(l3, h3), od, 0, 0, 0);
#undef PK
}
DEVI void pv_d0(f32x16* o, int vb, bf16x8 pa0, bf16x8 pa1, bf16x8 pa2, bf16x8 pa3) {
  pv_one<0>(o[0], vb, pa0, pa1, pa2, pa3); pv_one<1>(o[1], vb, pa0, pa1, pa2, pa3); pv_one<2>(o[2], vb, pa0, pa1, pa2, pa3); pv_one<3>(o[3], vb, pa0, pa1, pa2, pa3);
}

template <int ND0, int LD, bool KF8 = false, bool PV8 = false>
DEVI void attn_loop(const bf16_t* __restrict__ Qw, const bf16_t* __restrict__ Kh, const bf16_t* __restrict__ Vh, int seq, char* lds, int kcol_bytes, const float SCALE,
                    f32x16 (&o)[4], float& l_out) {
  const int tid = ltid(), wid = tid >> 6, lane = tid & 63, r32 = lane & 31, hi = lane >> 5;
  char* V_lds = lds; char* K_lds = lds + 2 * SHM_V;
  float* ws = (float*)(lds + 2 * SHM_V + 2 * SHM_K) + wid * 64; float* al_l = ws + 32;
  float m_reg = -1e30f, l_reg = 0; bf16x8 qr[ND0]; v8i_t q8[2];
#pragma unroll
  for (int d = 0; d < 4; ++d) o[d] = f32x16{};
  if constexpr (KF8) {
#pragma unroll
    for (int ks = 0; ks < ND0 / 4; ++ks) q8[ks] = *reinterpret_cast<const v8i_t*>((const unsigned char*)Qw + ks * 64);
  } else {
#pragma unroll
  for (int d0 = 0; d0 < ND0; ++d0) qr[d0] = *reinterpret_cast<const bf16x8*>(Qw + d0 * 16);
  }
  const int sr = tid >> 4, sc = (tid & 15) * 8, vst0 = v_st(sr, sc), vst1 = v_st(32 + sr, sc);
  const int vb0 = (int)(uintptr_t)V_lds + v_rd_base(lane);
  struct { bf16x8 vs0, vs1, ks0, ks1; } sr_[2];
#define SLOAD(i, k0) do { if constexpr (PV8) { sr_[i].vs0 = *reinterpret_cast<const bf16x8*>((const unsigned char*)Vh + (long)(tid >> 2) * SB + (k0) + (tid & 3) * 16); } else { \
    sr_[i].vs0 = *reinterpret_cast<const bf16x8*>(&Vh[(long)((k0) + sr) * LD + sc]); sr_[i].vs1 = *reinterpret_cast<const bf16x8*>(&Vh[(long)((k0) + 32 + sr) * LD + sc]); } \
    if constexpr (KF8) { sr_[i].ks0 = *reinterpret_cast<const bf16x8*>((const unsigned char*)Kh + (long)((k0) + (tid >> 3)) * (ND0 == 8 ? 1280 : 1024) + (tid & 7) * 16); } else { \
    sr_[i].ks0 = *reinterpret_cast<const bf16x8*>(&Kh[(long)((k0) + sr) * LD + sc]); sr_[i].ks1 = *reinterpret_cast<const bf16x8*>(&Kh[(long)((k0) + 32 + sr) * LD + sc]); } } while (0)
#define SWRITE(b, i) do { if constexpr (PV8) { *(bf16x8*)(V_lds + (b) * SHM_V + VT8SWZ(tid >> 2, tid & 3)) = sr_[i].vs0; } else { *(bf16x8*)(V_lds + (b) * SHM_V + vst0) = sr_[i].vs0;          \
    *(bf16x8*)(V_lds + (b) * SHM_V + vst1) = sr_[i].vs1; } int kc = sc * 2;               \
    if constexpr (KF8) { *(bf16x8*)(K_lds + (b) * SHM_K + K8SWZ(tid >> 3, tid & 7)) = sr_[i].ks0; } else { \
    *(bf16x8*)(K_lds + (b) * SHM_K + KSWZ(sr, kc)) = sr_[i].ks0;                       \
    *(bf16x8*)(K_lds + (b) * SHM_K + KSWZ(32 + sr, kc)) = sr_[i].ks1; } } while (0)
#define SWAIT() do { if constexpr (KF8 && PV8) asm volatile("s_waitcnt vmcnt(2)" ::: "memory"); else if constexpr (KF8) asm volatile("s_waitcnt vmcnt(3)" ::: "memory"); else asm volatile("s_waitcnt vmcnt(4)" ::: "memory"); } while (0)
#define FINSM(P0, P1, al) do { if constexpr (PV8) finishSM8(P0, P1, al, l_reg, pa8); else finishSM(P0, P1, al, l_reg, pa0, pa1, pa2, pa3); } while (0)
#define PVD(vboff) do { if constexpr (PV8) pv8(o, V_lds + (vboff), pa8, r32, hi); else pv_d0(o, vb0 + (int)(vboff), pa0, pa1, pa2, pa3); } while (0)
#define PSM(P0, P1, mn, al) do { if constexpr (PV8) partialSM(P0, P1, m_reg, mn, al, SCALE, THR8, (float)PS_SHIFT); else partialSM(P0, P1, m_reg, mn, al, SCALE); } while (0)
#define QKT(P0, P1, KS) do { if constexpr (KF8) qkt8<ND0 / 4>(P0, P1, KS, q8, r32, hi, kcol_bytes >> 5); else qkt<ND0>(P0, P1, KS, qr, r32, hi, kcol_bytes); } while (0)
#define RESC(a) do { if (__any((a) < 1.f)) { if (hi == 0) al_l[r32] = (a); asm volatile("s_waitcnt lgkmcnt(0)" ::: "memory"); \
    _Pragma("unroll") for (int d = 0; d < 4; ++d) _Pragma("unroll") for (int r = 0; r < 16; ++r) o[d][r] *= al_l[crow(r, hi)]; } } while (0)
  f32x16 pA0, pA1, pB0, pB1; float mnA, mnB, alA, alB; bf16x8 pa0, pa1, pa2, pa3; v8i_t pa8; const int NT = seq / KVBLK;
  constexpr int SE = 0, SO = 1;
  SLOAD(SE, 0); asm volatile("s_waitcnt vmcnt(0)" ::: "memory"); SWRITE(0, SE); __syncthreads();
  QKT(pA0, pA1, K_lds); PSM(pA0, pA1, mnA, alA);
  SLOAD(SO, KVBLK); if (2 < NT) SLOAD(SE, 2 * KVBLK);
  SWAIT(); SWRITE(1, SO); __syncthreads();
  for (int j = 1; j + 1 < NT; j += 2) {
    SBAR(); QKT(pB0, pB1, K_lds + SHM_K);
    FINSM(pA0, pA1, alA); SBAR();
    SLOAD(SO, (j + 2) * KVBLK); SBAR();
    PVD(0); PSM(pB0, pB1, mnB, alB);
    __syncthreads(); SWAIT(); SWRITE(0, SE);
    RESC(alB); __syncthreads();
    SBAR(); QKT(pA0, pA1, K_lds);
    FINSM(pB0, pB1, alB); SBAR();
    if (j + 3 < NT) SLOAD(SE, (j + 3) * KVBLK); SBAR();
    PVD(SHM_V); PSM(pA0, pA1, mnA, alA);
    __syncthreads(); SWAIT(); SWRITE(1, SO);
    RESC(alA); __syncthreads();
  }
  SBAR(); QKT(pB0, pB1, K_lds + SHM_K);
  FINSM(pA0, pA1, alA); SBAR();
  PVD(0); PSM(pB0, pB1, mnB, alB);
  __syncthreads(); RESC(alB);
  FINSM(pB0, pB1, alB); SBAR();
  PVD(SHM_V);
  asm volatile("s_waitcnt vmcnt(0)" ::: "memory");
  l_out = PV8 ? l_reg * (1.0f / (float)(1 << PS_SHIFT)) : l_reg;
#undef QKT
#undef FINSM
#undef PVD
#undef PSM
#undef SLOAD
#undef SWRITE
#undef SWAIT
#undef RESC
}

DEVI void store_tile_bf16(const f32x16 (&o)[4], const float (&scl)[16], bf16_t* Ow, int ldo, int r32, int hi) {
#pragma unroll
  for (int d0 = 0; d0 < 4; ++d0)
#pragma unroll
    for (int r = 0; r < 16; r += 2) {
      const float va = o[d0][r] * scl[r], vb = o[d0][r + 1] * scl[r + 1];
      const float snd = (r32 & 1) ? va : vb; const float got = shx<1>(snd);
      const int row = (r32 & 1) ? crow(r + 1, hi) : crow(r, hi); const int col = d0 * 32 + (r32 & ~1);
      const unsigned w = (r32 & 1) ? cvtpk(got, vb) : cvtpk(va, got);
      *(unsigned*)(Ow + (long)row * ldo + col) = w; }
}

DEVI void store_tile_fp8(const f32x16 (&o)[4], const float (&scl)[16], unsigned char* Ow, int ldo, int r32, int hi, const float xs) {
  const int q = r32 & 3; const bool b0 = q & 1, b1 = q & 2;
#pragma unroll
  for (int d0 = 0; d0 < 4; ++d0)
#pragma unroll
    for (int r4 = 0; r4 < 16; r4 += 4) {
      float v[4];
#pragma unroll
      for (int kk = 0; kk < 4; ++kk) v[kk] = __builtin_amdgcn_fmed3f(o[d0][r4 + kk] * scl[r4 + kk] * xs, -440.f, 440.f);
      const float gA = shx<1>(b0 ? v[0] : v[1]), gB = shx<1>(b0 ? v[2] : v[3]);
      const float aLo = b0 ? gA : v[0], aHi = b0 ? v[1] : gA;
      const float bLo = b0 ? gB : v[2], bHi = b0 ? v[3] : gB;
      const int pA = __builtin_amdgcn_cvt_pk_fp8_f32(aLo, aHi, 0, false) & 0xffff, pB = __builtin_amdgcn_cvt_pk_fp8_f32(bLo, bHi, 0, false) & 0xffff;
      const int got = __float_as_int(shx<2>(__int_as_float(b1 ? pA : pB))) & 0xffff;
      const unsigned w = b1 ? ((unsigned)got | ((unsigned)pB << 16)) : ((unsigned)pA | ((unsigned)got << 16));
      *(unsigned*)(Ow + (long)crow(r4 + q, hi) * ldo + d0 * 32 + (r32 & ~3)) = w; }
}

DEVI void phase_attn1(const Params& p, const PrepIn& pin, unsigned char* smem) {
  const bf16_t* qkv = wsp<bf16_t>(p, OFF_PROJ); bf16_t* att = wsp<bf16_t>(p, OFF_ACT);
  const int tid = ltid(), wid = tid >> 6, lane = tid & 63, r32 = lane & 31, hi = lane >> 5;
  const int vb_ = vbid(); const int xcd = vb_ & 7, slot = vb_ >> 3, nslot = gridDim.x >> 3;
  float* li_l = (float*)((char*)smem + 2 * SHM_V + 2 * SHM_K) + wid * 64;
  for (int it = slot; it < 4 * 32; it += nslot) {
    const int g = xcd + 8 * (it >> 5), item = it & 31, b = g >> 1, kvh = g & 1, h = kvh * 4 + (item >> 3), qb = item & 7;
    const bf16_t* Qb = qkv + (size_t)(b * SB + NC + qb * 256) * ODD_IN + h * 128;
    const bf16_t* Kh = qkv + (size_t)(b * SB) * ODD_IN + 1024 + kvh * 128; const bf16_t* Vh = Kh + 256;
    const unsigned char* Q8 = p.ws + OFF_QK8 + (size_t)(b * SB + NC + qb * 256) * 1280 + h * 128; const unsigned char* K8 = p.ws + OFF_QK8 + (size_t)(b * SB) * 1280 + 1024 + kvh * 128;
    f32x16 o[4]; float l;
    __syncthreads();
    if constexpr (ATT1_QK8 && ATT1_PV8) attn_loop<8, ODD_IN, true, true>((const bf16_t*)(Q8 + (long)(wid * QBLK + r32) * 1280 + hi * 32), (const bf16_t*)K8, (const bf16_t*)(p.ws + OFF_VT8 + (size_t)((b * 2 + kvh) * 128) * SB), SB, (char*)smem, 0, 0.08838834764831845f, o, l);
    else if constexpr (ATT1_QK8) attn_loop<8, ODD_IN, true>((const bf16_t*)(Q8 + (long)(wid * QBLK + r32) * 1280 + hi * 32), (const bf16_t*)K8, Vh, SB, (char*)smem, 0, 0.08838834764831845f, o, l);
    else attn_loop<8, ODD_IN>(Qb + (long)(wid * QBLK + r32) * ODD_IN + hi * 8, Kh, Vh, SB, (char*)smem, 0, 0.08838834764831845f, o, l);
    if (hi == 0) li_l[r32] = l; asm volatile("s_waitcnt lgkmcnt(0)" ::: "memory");
    float rli[16];
#pragma unroll
    for (int r = 0; r < 16; ++r) rli[r] = __builtin_amdgcn_rcpf(li_l[crow(r, hi)]);
    if (OUT1_FP8) store_tile_fp8(o, rli, p.ws + OFF_ACT8 + (size_t)(b * SB + NC + qb * 256 + wid * QBLK) * D + h * 128, D, r32, hi, (float)(1 << A_SHIFT));
    else store_tile_bf16(o, rli, att + (size_t)(b * SB + NC + qb * 256 + wid * QBLK) * D + h * 128, D, r32, hi);
  }
}

DEVI void phase_attn0(const Params& p, const PrepIn& pin, unsigned char* smem) {
  const bf16_t* proj = wsp<bf16_t>(p, OFF_PROJ); bf16_t* cat = wsp<bf16_t>(p, OFF_ACT);
  const int tid = ltid(), wid = tid >> 6, lane = tid & 63, r32 = lane & 31, hi = lane >> 5, mp = wid >> 2, w4 = wid & 3;
  const int vb_ = vbid(); const int xcd = vb_ & 7, slot = vb_ >> 3, nslot = gridDim.x >> 3;
  float* li_l = (float*)((char*)smem + 2 * SHM_V + 2 * SHM_K) + wid * 64;
  float* ex = (float*)smem + (size_t)w4 * 4096 + lane;
  const float lam = wsp<float>(p, OFF_LAM)[0];
  const float* subln = sm(p, SM_SUBLN);
  for (int it = slot; it < 8 * 18; it += nslot) {
    int g, qrow0, seq;
    if (it < 128) { g = xcd + 8 * (it >> 4); qrow0 = NC + (it & 15) * 128; seq = SB; }
    else { const int j = it - 128; g = xcd + 8 * (j >> 1); qrow0 = (j & 1) * 128; seq = NC; }
    const int b = g >> 2, h = g & 3;
    const bf16_t* Qw = proj + (size_t)(b * SB + qrow0 + w4 * QBLK + r32) * EVEN_IN + 1024 + h * 128 + mp * 64 + hi * 8;
    const bf16_t* Kh = proj + (size_t)(b * SB) * EVEN_IN + 1536 + h * 128; const bf16_t* Vh = Kh + 512;
    f32x16 o[4]; float l;
    __syncthreads();
    if constexpr (ATT0_F8) attn_loop<4, EVEN_IN, true, true>((const bf16_t*)(p.ws + OFF_QK8_0 + (size_t)(b * SB + qrow0 + w4 * QBLK + r32) * 1024 + h * 128 + mp * 64 + hi * 32),
                                                           (const bf16_t*)(p.ws + OFF_QK8_0 + (size_t)(b * SB) * 1024 + 512 + h * 128), (const bf16_t*)(p.ws + OFF_VT8_0 + (size_t)((b * 4 + h) * 128) * SB),
                                                           seq, (char*)smem, mp * 128, 0.125f, o, l);
    else attn_loop<4, EVEN_IN>(Qw, Kh, Vh, seq, (char*)smem, mp * 128, 0.125f, o, l);
    if (hi == 0) li_l[r32] = l; asm volatile("s_waitcnt lgkmcnt(0)" ::: "memory");
    float rli[16];
#pragma unroll
    for (int r = 0; r < 16; ++r) rli[r] = __builtin_amdgcn_rcpf(li_l[crow(r, hi)]);
    __syncthreads();
    if (mp == 1) {
#pragma unroll
      for (int d0 = 0; d0 < 4; ++d0)
#pragma unroll
        for (int r = 0; r < 16; ++r) ex[(d0 * 16 + r) * 64] = o[d0][r] * rli[r];
    }
    __syncthreads();
    if (mp == 0) {
      float ss[16];
#pragma unroll
      for (int r = 0; r < 16; ++r) ss[r] = 0.f;
#pragma unroll
      for (int d0 = 0; d0 < 4; ++d0) { const float gcol = subln[d0 * 32 + r32];
#pragma unroll
        for (int r = 0; r < 16; ++r) { const float dv = o[d0][r] * rli[r] - lam * ex[(d0 * 16 + r) * 64]; ss[r] += dv * dv; o[d0][r] = dv * gcol; } }
#pragma unroll
      for (int r = 0; r < 16; ++r) { float v = ss[r];
        v += shx<1>(v); v += shx<2>(v); v += shx<4>(v); v += shx<8>(v); v += shx<16>(v);
        ss[r] = rsqrtf(v * (1.0f / 128) + EPS) * 0.8f; }
      if (OUT0_FP8) store_tile_fp8(o, ss, p.ws + OFF_ACT8 + (size_t)(b * SB + qrow0 + w4 * QBLK) * D + 512 + h * 128, D, r32, hi, (float)(1 << A_SHIFT));
      else store_tile_bf16(o, ss, cat + (size_t)(b * SB + qrow0 + w4 * QBLK) * D + 512 + h * 128, D, r32, hi);
    }
  }
}

DEVI void phase_gmlp(const Params& p, unsigned char* smem) {
  const bf16_t* proj = wsp<bf16_t>(p, OFF_PROJ); bf16_t* cat = wsp<bf16_t>(p, OFF_ACT); const bf16_t* wsa = wsp<bf16_t>(p, OFF_WSA);
  const float* lng = sm(p, SM_ALNG); const float* lnb = sm(p, SM_ALNB); const float* abs_ = sm(p, SM_ABS);
  for (int it = blockIdx.x; it < (T / 128 + 1) / 2; it += gridDim.x) {
    const int tid = ltid(), hf = tid >> 8, ht = tid & 255, wl = ht >> 6, lane = tid & 63, fr = lane & 15, fq = lane >> 4;
    bf16_t* Tl = (bf16_t*)(smem + hf * 36864);
    const int ch = it * 2 + hf; const bool live = ch < T / 128; const int t0 = (live ? ch : 0) * 128;
    const int q = ht >> 1, part = ht & 1;
    float mu, rstd;
    { const bf16_t* vr = proj + (size_t)(t0 + q) * EVEN_IN + 512 + part * 256;
      float s = 0.f, s2 = 0.f;
#pragma unroll
      for (int i = 0; i < 32; ++i) { const u32x4 x = *(const u32x4*)(vr + i * 8);
#pragma unroll
        for (int e = 0; e < 4; ++e) { const float f0 = __uint_as_float(x[e] << 16), f1 = __uint_as_float(x[e] & 0xffff0000u); s += f0 + f1; s2 += f0 * f0 + f1 * f1; } }
      s += shx<1>(s); s2 += shx<1>(s2);
      mu = s * (1.0f / 512); rstd = rsqrtf(fmaxf(s2 * (1.0f / 512) - mu * mu, 0.f) + EPS); }
    for (int g = 0; g < 4; ++g) {
      __syncthreads();
      { const bf16_t* vg = proj + (size_t)(t0 + q) * EVEN_IN + 512 + g * 128 + part * 64;
#pragma unroll
        for (int i = 0; i < 8; ++i) { const u32x4 x = *(const u32x4*)(vg + i * 8); const int d0 = part * 64 + i * 8;
          const f32x4 ga = *(const f32x4*)(lng + g * 128 + d0), gb = *(const f32x4*)(lng + g * 128 + d0 + 4), ba = *(const f32x4*)(lnb + g * 128 + d0), bb = *(const f32x4*)(lnb + g * 128 + d0 + 4);
#pragma unroll
          for (int e = 0; e < 4; ++e) { const float f0 = __uint_as_float(x[e] << 16), f1 = __uint_as_float(x[e] & 0xffff0000u);
            const float gg0 = e < 2 ? ga[2 * e] : gb[2 * e - 4], gg1 = e < 2 ? ga[2 * e + 1] : gb[2 * e - 3], bb0 = e < 2 ? ba[2 * e] : bb[2 * e - 4], bb1 = e < 2 ? ba[2 * e + 1] : bb[2 * e - 3];
            const unsigned w = cvtpk((f0 - mu) * rstd * gg0 + bb0, (f1 - mu) * rstd * gg1 + bb1);
            Tl[(d0 + 2 * e) * 136 + q] = (bf16_t)(w & 0xffff); Tl[(d0 + 2 * e + 1) * 136 + q] = (bf16_t)(w >> 16); } }
      }
      __syncthreads();
      bf16x8 af[2][4];
#pragma unroll
      for (int m = 0; m < 2; ++m)
#pragma unroll
        for (int k = 0; k < 4; ++k) af[m][k] = *(const bf16x8*)(wsa + (size_t)(g * 128 + wl * 32 + m * 16 + fr) * 128 + k * 32 + fq * 8);
      f32x4 acc[2][8];
#pragma unroll
      for (int m = 0; m < 2; ++m)
#pragma unroll
        for (int n = 0; n < 8; ++n) acc[m][n] = (f32x4){0.f, 0.f, 0.f, 0.f};
#pragma unroll
      for (int k = 0; k < 4; ++k)
#pragma unroll
        for (int n = 0; n < 8; ++n) { const bf16x8 bfr = *(const bf16x8*)(Tl + (16 * n + fr) * 136 + k * 32 + fq * 8);
          acc[0][n] = __builtin_amdgcn_mfma_f32_16x16x32_bf16(bfr, af[0][k], acc[0][n], 0, 0, 0);
          acc[1][n] = __builtin_amdgcn_mfma_f32_16x16x32_bf16(bfr, af[1][k], acc[1][n], 0, 0, 0); }
      if (live) {
#pragma unroll
        for (int m = 0; m < 2; ++m) { const int pp = wl * 32 + m * 16 + fr; const size_t t = (size_t)t0 + pp; const float bias = abs_[g * 128 + pp];
#pragma unroll
          for (int n = 0; n < 8; ++n) { const int c = g * 128 + 16 * n + 4 * fq;
            const u32x2 uu = *(const u32x2*)(proj + t * EVEN_IN + c);
            const float o0 = __uint_as_float(uu.x << 16) * (acc[m][n][0] + bias), o1 = __uint_as_float(uu.x & 0xffff0000u) * (acc[m][n][1] + bias);
            const float o2 = __uint_as_float(uu.y << 16) * (acc[m][n][2] + bias), o3 = __uint_as_float(uu.y & 0xffff0000u) * (acc[m][n][3] + bias);
            if (OUT0_FP8) { const float xs = (float)(1 << A_SHIFT); int w8 = 0;
              w8 = __builtin_amdgcn_cvt_pk_fp8_f32(__builtin_amdgcn_fmed3f(o0 * xs, -440.f, 440.f), __builtin_amdgcn_fmed3f(o1 * xs, -440.f, 440.f), w8, false);
              w8 = __builtin_amdgcn_cvt_pk_fp8_f32(__builtin_amdgcn_fmed3f(o2 * xs, -440.f, 440.f), __builtin_amdgcn_fmed3f(o3 * xs, -440.f, 440.f), w8, true);
              *(int*)(p.ws + OFF_ACT8 + t * D + c) = w8; }
            else { u32x2 w; w.x = cvtpk(o0, o1); w.y = cvtpk(o2, o3);
              *(u32x2*)(cat + t * D + c) = w; } } }
      }
    }
  }
}
#undef KSWZ
#undef SBAR
}
#define REP_PREP 1
#define REP_NORM1 1
#define REP_IN0 1
#define REP_ATT0 1
#define REP_GMLP 1
#define REP_OUT0 1
#define REP_GU 1
#define REP_IN1 1
#define REP_ATT1 1
#define REP_SYNC 0
#define DRY_IN0 0
#define DRY_DOWN 0
#define DRY_GU 0
#define REP_ROUTER 1
#define REP_DOWN 1
#define REP_COMB 1
#define REPEAT(n, stmt) { int _n = (n); if ((n) > 1) asm volatile("" : "+s"(_n)); for (int _r = 0; _r < _n; ++_r) { stmt; if (_r + 1 < _n) GSYNC(); } }
__global__ __launch_bounds__(512) void mega(Params p0, PrepIn pin) {
  cg::grid_group grid = cg::this_grid();
  LAS unsigned char* lds = (LAS unsigned char*)smem;
  volatile LAS unsigned* xst = (volatile LAS unsigned*)(lds + SMEM_BYTES - 16);
  if (threadIdx.x == 0) { xst[0] = 0u; xst[1] = 0u; }
  ltid_init();
  XcdBarrier xb = xcd_barrier_post((unsigned*)(p0.ws + OFF_ZERO), xst);
  if (threadIdx.x == 0) { volatile LAS int* vbp = (volatile LAS int*)(lds + LDS_VBID); vbp[0] = (int)blockIdx.x;
    vbp[1] = (int)xb_add((unsigned*)(p0.ws + OFF_XRANK) + xb.x, 1u); }
#define GSYNC() xcd_barrier(xb)
#define ROUTER(c) { int _n = REP_ROUTER; if (REP_ROUTER > 1) asm volatile("" : "+s"(_n)); for (int _r = 0; _r < _n; ++_r) { \
      if (_r > 0) { if (blockIdx.x == 0 && threadIdx.x < 128) ((int*)(p0.ws + OFF_CNT))[c.l * 128 + threadIdx.x] = 0; GSYNC(); } \
      stage_router(launder(p0), c, smem); if (_r + 1 < _n) GSYNC(); } }
#define MOE_HALF(c, half, FUSE) do { \
    REPEAT(REP_GU, { const Params pl = launder(p0); fg::moe_tables(pl, c, half, 2, lds); int dry = (DRY_GU && _r > 0) ? DRY_GU : 0; if (DRY_GU) { asm volatile("" : "+v"(dry)); dry = __builtin_amdgcn_readfirstlane(dry); } fg::JobGU J(pl, c, half, lds, dry); fg::gemm_phase(lds, J); }) \
    GSYNC(); \
    { int _n = REP_DOWN; if (REP_DOWN > 1) asm volatile("" : "+s"(_n)); for (int _r = 0; _r < _n; ++_r) { float ds = _r == 0 ? 1.0f : (DRY_DOWN ? -1.0f : 0.0f); if (REP_DOWN > 1) { asm volatile("" : "+v"(ds)); ds = __int_as_float(__builtin_amdgcn_readfirstlane(__float_as_int(ds))); } \
        const Params pl = launder(p0); fg::moe_tables(pl, c, half, 4, lds); fg::JobDown J(pl, c, half, lds, ds); fg::gemm_phase(lds, J); if (_r + 1 < _n) GSYNC(); } } \
    GSYNC(); \
    { int _n = REP_COMB; if (REP_COMB > 1) asm volatile("" : "+s"(_n)); for (int _r = 0; _r < _n; ++_r) { float ds = _r == 0 ? 1.0f : 0.0f; if (REP_COMB > 1) asm volatile("" : "+v"(ds)); \
        stage_combine<FUSE>(launder(p0), c, half, smem, ds); if (_r + 1 < _n) GSYNC(); } } \
    } while (0)
  for (int _r = 0; _r < REP_PREP; ++_r) { stage_prep(p0, pin, smem); if (_r + 1 < REP_PREP) __syncthreads(); }
  grid.sync();
  if (threadIdx.x == 0) {
    bool ok = true; const unsigned per = gridDim.x >> 3;
    for (int j = 0; j < 16; ++j) { const unsigned c = xb_ld((unsigned*)(p0.ws + OFF_XRANK) + j); ok = ok && (c == (j < 8 ? per : 0u)); }
    volatile LAS int* vbp = (volatile LAS int*)(lds + LDS_VBID);
    if (ok && (gridDim.x & 7) == 0) vbp[0] = (int)xb.x + 8 * vbp[1]; }
  __syncthreads();
  REPEAT(REP_NORM1, stage_norm1<0>(launder(p0))) GSYNC();
  REPEAT(REP_IN0, { const Params pl = launder(p0); fg::load_rope_lds(pl, OFF_TAB64, 512, SM_BQN, SM_BKN, 64, lds); int dry = (DRY_IN0 && _r > 0) ? DRY_IN0 : 0; if (DRY_IN0) { asm volatile("" : "+v"(dry)); dry = __builtin_amdgcn_readfirstlane(dry); } fg::JobIn0 J(pl, dry); fg::gemm_phase(lds, J); })
  GSYNC();
  REPEAT(REP_ATT0, fa::phase_attn0(launder(p0), pin, smem))
  REPEAT(REP_GMLP, fa::phase_gmlp(launder(p0), smem))
  GSYNC();
  REPEAT(REP_OUT0, { const Params pl = launder(p0); fg::JobOut<0> J(pl); fg::gemm_phase(lds, J); })
  expert_prep_steal(launder(p0), pin, smem, 0);
  GSYNC();
  { const LCfg c{0, SB, 0, 16 * SB};
    ROUTER(c); GSYNC();
    MOE_HALF(c, 0, true); GSYNC(); }
  { int _n = REP_SYNC; if (REP_SYNC > 0) asm volatile("" : "+s"(_n)); for (int _r = 0; _r < _n; ++_r) GSYNC(); }
  REPEAT(REP_IN1, { const Params pl = launder(p0); fg::load_rope_lds(pl, OFF_TAB128, 1024, SM_CQN, SM_CKN, 128, lds); fg::JobIn1 J(pl); fg::gemm_phase(lds, J); })
  expert_prep_steal(launder(p0), pin, smem, 1);
  GSYNC();
  REPEAT(REP_ATT1, fa::phase_attn1(launder(p0), pin, smem))
  GSYNC();
  { const Params pl = launder(p0); fg::JobOut<1> J(pl); fg::gemm_phase(lds, J); }
  GSYNC();
  { const LCfg c{1, S, NC, 16 * S};
    ROUTER(c); GSYNC();
    MOE_HALF(c, 0, false); }
}

extern "C" void kernel_launch(void* const* d_in, const int* in_sizes, int n_in, void* d_out, int out_size, void* d_ws, size_t ws_size, hipStream_t stream) {
  static int grid_blocks = 0;
  if (!grid_blocks) {
    if (n_in != 33 || ws_size < WS_TOTAL) { fprintf(stderr, "kernel_launch: bad n_in %d or ws %zu < %zu\n", n_in, ws_size, (size_t)WS_TOTAL); return; }
    if (hipFuncSetAttribute((const void*)mega, hipFuncAttributeMaxDynamicSharedMemorySize, SMEM_BYTES) != hipSuccess) { fprintf(stderr, "set attr failed\n"); return; }
    int dev = 0, cus = 0, per_cu = 0;
    hipGetDevice(&dev); hipDeviceGetAttribute(&cus, hipDeviceAttributeMultiprocessorCount, dev);
    hipOccupancyMaxActiveBlocksPerMultiprocessor(&per_cu, mega, 512, SMEM_BYTES);
    if (per_cu < 1) { fprintf(stderr, "occupancy 0\n"); return; }
    grid_blocks = cus;
  }
  Params p; memset(&p, 0, sizeof(p)); PrepIn pin; memset(&pin, 0, sizeof(pin));
  for (int i = 0; i < 33; ++i) pin.in[i] = (const float*)d_in[i];
  p.out = (float*)d_out; p.ws = (unsigned char*)d_ws;
  p.x = pin.in[I_X]; p.ctx = pin.in[I_CTX];
  hipMemsetAsync(d_ws, 0, ZERO_BYTES, stream);
  void* args[] = {&p, &pin};
  hipError_t e = hipLaunchCooperativeKernel((void*)mega, dim3(grid_blocks), dim3(512), args, SMEM_BYTES, stream);
  if (e != hipSuccess) fprintf(stderr, "cooperative launch failed: %s (grid %d)\n", hipGetErrorString(e), grid_blocks);
}
```

```cpp
#include <hip/hip_runtime.h>
#include <hip/hip_cooperative_groups.h>
#include <cstdio>
#include <cstdint>
#include <cstring>
namespace cg = cooperative_groups;

#define DEVI __device__ __forceinline__
#define LAS __attribute__((address_space(3)))
typedef unsigned short bf16_t;
typedef short bf16x8 __attribute__((ext_vector_type(8)));
typedef float f32x4 __attribute__((ext_vector_type(4)));
typedef unsigned u32x4 __attribute__((ext_vector_type(4)));
typedef unsigned u32x2 __attribute__((ext_vector_type(2)));

constexpr int D = 1024, NB = 16, S = 2048, NC = 256, SB = 2304, T = NB * SB, TX = NB * S;
constexpr int NE = 64, TOPK = 6, DE = 256;
constexpr int EVEN_IN = 2560, ODD_IN = 1536;
constexpr float EPS = 1e-6f;

constexpr size_t al256(size_t x) { return (x + 255) & ~(size_t)255; }
constexpr size_t OFF_ZERO = 0, ZERO_BYTES = 65536;
constexpr size_t OFF_CNT = 16384;
constexpr size_t OFF_XRANK = 20608;
constexpr size_t OFF_STEAL = 20480;
constexpr size_t OFF_TAB64 = OFF_ZERO + ZERO_BYTES;
constexpr size_t OFF_TAB128 = OFF_TAB64 + 64 * 16 * 8;
constexpr size_t OFF_LAM = OFF_TAB128 + 64 * 32 * 8;
constexpr size_t OFF_MODV = al256(OFF_LAM + 256);
constexpr size_t OFF_SMALL = al256(OFF_MODV + (size_t)2 * 17 * 6144 * 4);
enum { SM_N1G = 0, SM_N2G = 2048, SM_ALNG = 4096, SM_ALNB = 4608, SM_ABS = 5120, SM_BQN = 5632, SM_BKN = 5696, SM_SUBLN = 5760, SM_CQN = 5888, SM_CKN = 6016, SM_MBIAS = 6144,
       SM_AWSF = 8192, SM_ROUTER = 73728, SM_END = 204800 };
constexpr size_t OFF_WIN0T = al256(OFF_SMALL + (size_t)SM_END * 4);
constexpr size_t OFF_WOUT0T = OFF_WIN0T + (size_t)EVEN_IN * D * 2;
constexpr size_t OFF_WQKV1T = OFF_WOUT0T + (size_t)D * D * 2;
constexpr size_t OFF_WOUT1T = OFF_WQKV1T + (size_t)ODD_IN * D * 2;
constexpr size_t OFF_WSA = OFF_WOUT1T + (size_t)D * D * 2;
constexpr size_t OFF_WRT = OFF_WSA + (size_t)4 * 128 * 128 * 2;
constexpr size_t OFF_SHGU = OFF_WRT + (size_t)2 * NE * D * 2;
constexpr size_t OFF_SHD = OFF_SHGU + (size_t)2 * 512 * D * 2;
constexpr size_t OFF_EGU = OFF_SHD + (size_t)2 * D * DE * 2;
constexpr size_t OFF_ED = OFF_EGU + (size_t)NE * 512 * D;
constexpr size_t OFF_HB = OFF_ED + (size_t)NE * D * DE;
constexpr size_t OFF_HC = OFF_HB;
constexpr size_t OFF_ACT = OFF_HB + (size_t)T * D * 2;
constexpr size_t OFF_TOPW = OFF_ACT + (size_t)T * D * 2;
constexpr size_t OFF_TOPP = al256(OFF_TOPW + (size_t)T * 6 * 4);
constexpr size_t OFF_LIST = al256(OFF_TOPP + (size_t)T * 6 * 4);
constexpr int LCAP = 36864;
constexpr size_t OFF_R = al256(OFF_LIST + (size_t)NE * LCAP * 4);
constexpr size_t OFF_PROJ = OFF_R;
constexpr size_t OFF_SLOT = OFF_R;
constexpr size_t OFF_QK8 = al256(OFF_R + (size_t)120000000);
constexpr size_t OFF_VT8 = al256(OFF_QK8 + (size_t)T * 1280);
constexpr size_t OFF_QK8_0 = al256(OFF_R + (size_t)192000000);
constexpr size_t OFF_VT8_0 = al256(OFF_QK8_0 + (size_t)T * 1024);
constexpr size_t OFF_HID = al256(OFF_SLOT + (size_t)258048 * D);
constexpr size_t OFF_ACT8 = al256(OFF_HID + (size_t)(258048 + 256) * DE);
constexpr size_t WS_TOTAL = OFF_ACT8 + (size_t)T * D;
static_assert(OFF_HID >= OFF_R + (size_t)0, "layout");
static_assert(OFF_R + (size_t)T * EVEN_IN * 2 <= WS_TOTAL, "proj fits");
static_assert(WS_TOTAL <= 636368384ull, "workspace budget");
static_assert((size_t)T * ODD_IN * 2 <= 120000000ull && OFF_VT8 + (size_t)NB * 2 * 128 * SB <= OFF_SLOT + (size_t)258048 * D, "QK8 / VT8 placement");
static_assert((size_t)T * EVEN_IN * 2 <= 192000000ull && OFF_VT8_0 + (size_t)NB * 4 * 128 * SB <= OFF_SLOT + (size_t)258048 * D, "layer-0 QK8 / VT8 placement");

struct Params {
  float* out;
  unsigned char* ws;
  const float* x; const float* ctx;
};
struct PrepIn { const float* in[33]; };
typedef __attribute__((address_space(1))) unsigned char* gptr_t;
__device__ __forceinline__ Params launder(const Params& p) {
  unsigned long long a = (unsigned long long)p.out, b = (unsigned long long)p.ws, c = (unsigned long long)p.x, d = (unsigned long long)p.ctx;
  asm volatile("" : "+s"(a), "+s"(b), "+s"(c), "+s"(d));
  Params q; q.out = (float*)(gptr_t)a; q.ws = (unsigned char*)(gptr_t)b; q.x = (const float*)(gptr_t)c; q.ctx = (const float*)(gptr_t)d; return q; }
enum { I_X = 0, I_C, I_CTX, I_CCTX, I_MODW, I_MODB, I_N1G, I_N2G, I_EVWIN, I_EVWOUT, I_ALNG, I_ALNB, I_AWS, I_ABS, I_BQN, I_BKN,
       I_LQ1, I_LK1, I_LQ2, I_LK2, I_SUBLN, I_ODQKV, I_ODOUT, I_CQN, I_CKN, I_ROUTER, I_MBIAS, I_WG, I_WU, I_WD, I_SG, I_SU, I_SD };

extern __shared__ __attribute__((aligned(16))) unsigned char smem[];
constexpr int SMEM_BYTES = 152 * 1024;
constexpr int LDS_WTAB = SMEM_BYTES - 512;
DEVI int ltid() {
  const unsigned slot = (unsigned)__builtin_amdgcn_s_getreg(63492) & 0x3fu;
  const int wv = __builtin_amdgcn_readfirstlane(*(volatile LAS int*)((LAS unsigned char*)smem + LDS_WTAB + slot * 4));
  int l; asm volatile("v_mbcnt_lo_u32_b32 %0, -1, 0\n\tv_mbcnt_hi_u32_b32 %0, -1, %0" : "=v"(l));
  return wv * 64 + l;
}
constexpr int LDS_VBID = LDS_WTAB + 256;
DEVI int vbid() { return __builtin_amdgcn_readfirstlane(*(volatile LAS int*)((LAS unsigned char*)smem + LDS_VBID)); }
DEVI void ltid_init() {
  const unsigned slot = (unsigned)__builtin_amdgcn_s_getreg(63492) & 0x3fu;
  if ((threadIdx.x & 63) == 0) *(volatile LAS int*)((LAS unsigned char*)smem + LDS_WTAB + slot * 4) = (int)(threadIdx.x >> 6);
  __syncthreads();
}
template <int M> DEVI float shx(float v) { static_assert(M == 1 || M == 2 || M == 4 || M == 8 || M == 16, "xor mask");
  return __int_as_float(__builtin_amdgcn_ds_swizzle(__float_as_int(v), (M << 10) | 0x1f)); }
template <int CTRL> DEVI float dppf(float v) { return __int_as_float(__builtin_amdgcn_update_dpp(0, __float_as_int(v), CTRL, 0xf, 0xf, true)); }
DEVI float rlane(float v, int l) { return __int_as_float(__builtin_amdgcn_readlane(__float_as_int(v), l)); }
DEVI float wsum_dpp(float v) { v += dppf<0xB1>(v); v += dppf<0x4E>(v); v += dppf<0x141>(v); v += dppf<0x140>(v); return (rlane(v, 0) + rlane(v, 16)) + (rlane(v, 32) + rlane(v, 48)); }
DEVI float wmax_dpp(float v) { v = fmaxf(v, dppf<0xB1>(v)); v = fmaxf(v, dppf<0x4E>(v)); v = fmaxf(v, dppf<0x141>(v)); v = fmaxf(v, dppf<0x140>(v)); return fmaxf(fmaxf(rlane(v, 0), rlane(v, 16)), fmaxf(rlane(v, 32), rlane(v, 48))); }
DEVI float max8_dpp(float v) { v = fmaxf(v, dppf<0xB1>(v)); v = fmaxf(v, dppf<0x4E>(v)); return fmaxf(v, dppf<0x141>(v)); }
DEVI float sum32x(float v) { auto r = __builtin_amdgcn_permlane32_swap(__float_as_uint(v), __float_as_uint(v), false, false); return __uint_as_float(r[0]) + __uint_as_float(r[1]); }
DEVI float max32x(float v) { auto r = __builtin_amdgcn_permlane32_swap(__float_as_uint(v), __float_as_uint(v), false, false); return fmaxf(__uint_as_float(r[0]), __uint_as_float(r[1])); }
DEVI bf16_t f2bf(float f) { unsigned u = __float_as_uint(f); u += 0x7FFFu + ((u >> 16) & 1u); return (bf16_t)(u >> 16); }
DEVI float bf2f(bf16_t b) { return __uint_as_float(((unsigned)b) << 16); }
DEVI unsigned pack2(float lo, float hi) { return (unsigned)f2bf(lo) | ((unsigned)f2bf(hi) << 16); }
DEVI float wsum(float v) { v += shx<1>(v); v += shx<2>(v); v += shx<4>(v); v += shx<8>(v); v += shx<16>(v); return sum32x(v); }
DEVI float wmax(float v) { v = fmaxf(v, shx<1>(v)); v = fmaxf(v, shx<2>(v)); v = fmaxf(v, shx<4>(v)); v = fmaxf(v, shx<8>(v)); v = fmaxf(v, shx<16>(v)); return max32x(v); }
DEVI float gelu_exact(float v) { return 0.5f * v * (1.0f + erff(v * 0.70710678118654752f)); }
DEVI float silu(float v) { return v / (1.0f + __expf(-v)); }

template <class Tp> DEVI Tp* wsp(const Params& p, size_t off) { return (Tp*)(p.ws + off); }
DEVI const float* sm(const Params& p, int off) { return (const float*)(p.ws + OFF_SMALL) + off; }
DEVI const float* in_row(const Params& p, int t) { int b = t / SB, j = t - b * SB;
  unsigned long long xa = (unsigned long long)p.x, ca = (unsigned long long)p.ctx; asm volatile("" : "+s"(xa), "+s"(ca));
  const float* xp = (const float*)(gptr_t)xa; const float* cp = (const float*)(gptr_t)ca;
  return j < NC ? cp + ((size_t)(b * NC + j)) * D : xp + ((size_t)(b * S + j - NC)) * D; }
DEVI f32x4 bf4(u32x2 r) { return (f32x4){__uint_as_float(r.x << 16), __uint_as_float(r.x & 0xffff0000u), __uint_as_float(r.y << 16), __uint_as_float(r.y & 0xffff0000u)}; }
DEVI float* hid_row(const Params& p, int t) { int b = t / SB, j = t - b * SB;
  return j < NC ? wsp<float>(p, OFF_HC) + ((size_t)(b * NC + j)) * D : p.out + ((size_t)(b * S + j - NC)) * D; }
DEVI const float* modv(const Params& p, int l, int t, int which) { int b = t / SB, j = t - b * SB; int r = j < NC ? 16 : b;
  return wsp<float>(p, OFF_MODV) + ((size_t)(l * 17 + r)) * 6144 + which * D; }

#define XB_TMO      128
#define XB_XCNT(j)  (256  + 64 * (j))
#define XB_XSUB(j)  (1280 + 64 * (j))
#define XB_XGEN(j)  (2304 + 64 * (j))
#define XB_TOP      3328
#define XB_TOPGEN   3392
#define XCD_BAR_WORDS 3456
#define XB_SPIN_CAP (1u << 22)
DEVI unsigned xb_ld(unsigned* p) { return __hip_atomic_load(p, __ATOMIC_RELAXED, __HIP_MEMORY_SCOPE_AGENT); }
DEVI unsigned xb_add(unsigned* p, unsigned v) { return __hip_atomic_fetch_add(p, v, __ATOMIC_RELAXED, __HIP_MEMORY_SCOPE_AGENT); }
DEVI unsigned xb_xcc_id() { return (unsigned)__builtin_amdgcn_s_getreg((3 << 11) | 20) & 0xFu; }
#define XB_SPIN(cond, bar) do { unsigned _sp = 0; while (cond) { __builtin_amdgcn_s_sleep(1); \
    if ((++_sp & 255u) == 0u) { if (xb_ld(&(bar)[XB_TMO])) break; if (_sp > XB_SPIN_CAP) { atomicAdd(&(bar)[XB_TMO], 1u); break; } } } } while (0)
struct XcdBarrier { unsigned* bar; unsigned x; volatile LAS unsigned* st; };
DEVI XcdBarrier xcd_barrier_post(unsigned* bar, volatile LAS unsigned* st) {
  XcdBarrier b; b.bar = bar; b.x = xb_xcc_id(); b.st = st;
  if (ltid() == 0) (void)xb_add(&bar[XB_XCNT(b.x)], 1u);
  return b;
}
DEVI void xcd_barrier_complete(unsigned* bar, unsigned x, unsigned& nloc, unsigned& nx) {
  const unsigned G = gridDim.x * gridDim.y * gridDim.z;
  unsigned sum, cnt, mine, sp = 0u;
  for (;;) {
    sum = 0u; cnt = 0u; mine = 0u;
#pragma unroll
    for (unsigned j = 0; j < 16; ++j) { const unsigned c = xb_ld(&bar[XB_XCNT(j)]); sum += c; cnt += (c > 0u) ? 1u : 0u; mine = (j == x) ? c : mine; }
    if (sum == G) break;
    __builtin_amdgcn_s_sleep(1);
    if ((++sp & 255u) == 0u) { if (xb_ld(&bar[XB_TMO])) break; if (sp > XB_SPIN_CAP) { atomicAdd(&bar[XB_TMO], 1u); break; } }
  }
  nloc = mine > 0u ? mine : 1u; nx = cnt > 0u ? cnt : 1u;
}
DEVI void xcd_barrier(const XcdBarrier& b) {
  asm volatile("s_waitcnt vmcnt(0)" ::: "memory");
  __syncthreads();
  if (ltid() == 0) {
    unsigned* bar = b.bar;
    __builtin_amdgcn_s_waitcnt(0);
    unsigned nloc = b.st[0], nx = b.st[1];
    if (nloc == 0u) { xcd_barrier_complete(bar, b.x, nloc, nx); b.st[0] = nloc; b.st[1] = nx; }
    const unsigned old = xb_add(&bar[XB_XSUB(b.x)], 1u);
    const unsigned gen = old / nloc;
    if (old + 1u == (gen + 1u) * nloc) {
      __builtin_amdgcn_fence(__ATOMIC_RELEASE, "agent");
      asm volatile("s_waitcnt vmcnt(0)" ::: "memory");
      const unsigned og = xb_add(&bar[XB_TOP], 1u);
      const unsigned tg = og / nx;
      if (og + 1u == (tg + 1u) * nx) xb_add(&bar[XB_TOPGEN], 1u);
      else XB_SPIN(xb_ld(&bar[XB_TOPGEN]) == tg, bar);
      __builtin_amdgcn_fence(__ATOMIC_ACQUIRE, "agent");
      xb_add(&bar[XB_XGEN(b.x)], 1u);
      asm volatile("s_waitcnt vmcnt(0)" ::: "memory");
    } else {
      XB_SPIN(xb_ld(&bar[XB_XGEN(b.x)]) == gen, bar);
      __builtin_amdgcn_fence(__ATOMIC_ACQUIRE, "agent");
      asm volatile("s_waitcnt vmcnt(0)" ::: "memory");
    }
  }
  __syncthreads();
}

DEVI void transpose_tiles(const float* srcb, unsigned char* dstb, int K, int N, int nb, size_t sstride, size_t dstride, unsigned char* smem, int& goff) {
  const int G = gridDim.x, tk = K / 128, tn = N / 256, per = tk * tn, total = per * nb, tid = ltid();
  const int first = (((int)blockIdx.x - goff) % G + G) % G;
  const int n4 = tid & 63, kp0 = tid >> 6;
  f32x4 va[8], vb[8];
  auto issue = [&](int ti) { const int m = ti / per, r = ti - m * per, kb = r / tn, nb_ = r - kb * tn;
    const float* src = srcb + (size_t)m * sstride + (size_t)(kb * 128) * N + nb_ * 256 + n4 * 4;
#pragma unroll
    for (int i = 0; i < 8; ++i) { const int kp = kp0 + 8 * i; va[i] = __builtin_nontemporal_load((const f32x4*)(src + (size_t)(2 * kp) * N)); vb[i] = __builtin_nontemporal_load((const f32x4*)(src + (size_t)(2 * kp + 1) * N)); } };
  if (first < total) issue(first);
  int par = 0;
  for (int ti = first; ti < total; ti += G, par ^= 1) {
    unsigned* Tb = (unsigned*)smem + par * 16384;
#pragma unroll
    for (int i = 0; i < 8; ++i) { const int kp = kp0 + 8 * i;
#pragma unroll
      for (int j = 0; j < 4; ++j) { const int n = n4 * 4 + j; Tb[n * 64 + (kp ^ (((n >> 2) & 7) << 2))] = pack2(va[i][j], vb[i][j]); } }
    if (ti + G < total) issue(ti + G);
    __syncthreads();
    const int m = ti / per, r = ti - m * per, kb = r / tn, nb_ = r - kb * tn;
    bf16_t* dst = (bf16_t*)dstb + (size_t)m * dstride + (size_t)(nb_ * 256) * K + kb * 128;
#pragma unroll
    for (int i = 0; i < 8; ++i) { const int pc = tid + 512 * i, n = pc >> 4, q = pc & 15;
      const u32x4 w = *(const u32x4*)(Tb + n * 64 + ((4 * q) ^ (((n >> 2) & 7) << 2)));
      *(u32x4*)(dst + (size_t)n * K + 8 * q) = w; }
  }
  __syncthreads();
  goff = (goff + total) % G;
}

constexpr int WD_SHIFT = 4, H_SHIFT = 2, WG_SHIFT = 5, X_SHIFT = 3, WQ_SHIFT = 5;
constexpr bool IN1_FP8 = true, IN0_FP8 = true, OUT0_FP8 = true, OUT1_FP8 = true;
constexpr bool ATT1_QK8 = true;
constexpr bool ATT0_F8 = true;
constexpr bool ATT1_PV8 = true;
constexpr int VS_SHIFT = 2, PS_SHIFT = 4;
constexpr int QS_SHIFT = 3;
constexpr int A_SHIFT = 3;
DEVI void transpose_panel8(const float* src0, unsigned char* dst0, int K, int N, int kb, int nb_, unsigned char* smem, int shift = WD_SHIFT) {
  const int tid = ltid(), n4 = tid & 63, kq0 = tid >> 6; unsigned* Tb = (unsigned*)smem;
  const float* src = src0 + (size_t)(kb * 128) * N + nb_ * 256 + n4 * 4; unsigned char* dst = dst0 + (size_t)(nb_ * 256) * K + kb * 128;
  f32x4 v[4][4];
#pragma unroll
  for (int i = 0; i < 4; ++i)
#pragma unroll
    for (int r = 0; r < 4; ++r) v[i][r] = __builtin_nontemporal_load((const f32x4*)(src + (size_t)(4 * (kq0 + 8 * i) + r) * N));
  const float sc = (float)(1 << shift);
#pragma unroll
  for (int i = 0; i < 4; ++i) { const int kq = kq0 + 8 * i;
#pragma unroll
    for (int j = 0; j < 4; ++j) { const int n = n4 * 4 + j; int w = 0;
      w = __builtin_amdgcn_cvt_pk_fp8_f32(v[i][0][j] * sc, v[i][1][j] * sc, w, false); w = __builtin_amdgcn_cvt_pk_fp8_f32(v[i][2][j] * sc, v[i][3][j] * sc, w, true);
      Tb[n * 32 + (kq ^ (((n >> 2) & 7) << 2))] = (unsigned)w; } }
  __syncthreads();
#pragma unroll
  for (int i = 0; i < 4; ++i) { const int pc = tid + 512 * i, n = pc >> 3, q = pc & 7;
    const u32x4 w = *(const u32x4*)(Tb + n * 32 + ((4 * q) ^ (((n >> 2) & 7) << 2)));
    *(u32x4*)(dst + (size_t)n * K + 16 * q) = w; }
}
DEVI void transpose_all8(const float* src, unsigned char* dst, int K, int N, int shift, unsigned char* smem, int& goff) {
  const int G = gridDim.x, tk = K / 128, tn = N / 256, total = tk * tn;
  const int first = (((int)blockIdx.x - goff) % G + G) % G;
  for (int ti = first; ti < total; ti += G) { __syncthreads(); const int kb = ti / tn, nb_ = ti - kb * tn; transpose_panel8(src, dst, K, N, kb, nb_, smem, shift); }
  __syncthreads();
  goff = (goff + total) % G;
}
typedef float fa_f32x16_t __attribute__((ext_vector_type(16)));
DEVI void stage_prep(const Params& p, const PrepIn& pin, unsigned char* smem) {
  const int tid = ltid(), bid = blockIdx.x, G = gridDim.x;
  {
    float* sl = (float*)smem;
    { float cv[34];
#pragma unroll
      for (int j = 0; j < 32; ++j) cv[j] = pin.in[I_C][tid + 512 * j];
#pragma unroll
      for (int j = 0; j < 2; ++j) cv[32 + j] = pin.in[I_CCTX][tid + 512 * j];
#pragma unroll
      for (int j = 0; j < 34; ++j) sl[tid + 512 * j] = silu(cv[j]); }
    __syncthreads();
    float* part = (float*)(smem + 17 * 1024 * 4);
    for (int cb = bid; cb < 256; cb += G) {
      const int col0 = cb * 48;
      if (tid < 192) {
        const int kc = tid / 12, c4 = tid - kc * 12, gc = col0 + c4 * 4, l = gc / 6144, n = gc - l * 6144;
        const float* w = pin.in[I_MODW] + (size_t)l * 1024 * 6144 + n;
        f32x4 acc[17];
#pragma unroll
        for (int r = 0; r < 17; ++r) acc[r] = (f32x4){0.f, 0.f, 0.f, 0.f};
#pragma clang loop unroll(disable)
        for (int k0 = kc * 64; k0 < kc * 64 + 64; k0 += 8) {
          f32x4 wr[8];
#pragma unroll
          for (int j = 0; j < 8; ++j) wr[j] = *(const f32x4*)(w + (size_t)(k0 + j) * 6144);
#pragma unroll
          for (int r = 0; r < 17; ++r) { const f32x4 s4 = *(const f32x4*)(sl + r * 1024 + k0), t4 = *(const f32x4*)(sl + r * 1024 + k0 + 4);
            acc[r] += ((wr[0] * s4[0] + wr[1] * s4[1]) + (wr[2] * s4[2] + wr[3] * s4[3])) + ((wr[4] * t4[0] + wr[5] * t4[1]) + (wr[6] * t4[2] + wr[7] * t4[3])); } }
#pragma unroll
        for (int r = 0; r < 17; ++r) *(f32x4*)(part + (kc * 17 + r) * 48 + c4 * 4) = acc[r];
      }
      __syncthreads();
      for (int i = tid; i < 17 * 48; i += 512) { int r = i / 48, c = i - r * 48, gc = col0 + c, l = gc / 6144, n = gc - l * 6144;
        float s = pin.in[I_MODB][l * 6144 + n];
        for (int kc = 0; kc < 16; ++kc) s += part[(kc * 17 + r) * 48 + c];
        wsp<float>(p, OFF_MODV)[((size_t)(l * 17 + r)) * 6144 + n] = s; }
      __syncthreads();
    }
  }
  if (bid == 0) {
    float2* t64 = wsp<float2>(p, OFF_TAB64); float2* t128 = wsp<float2>(p, OFF_TAB128);
    for (int i = tid; i < 64 * 16; i += 512) { int pos = i >> 4, f = i & 15; float inv = exp2f(-(float)f * (13.287712379549449f / 16.0f)); float a = (float)pos * inv; t64[i] = make_float2(__cosf(a), __sinf(a)); }
    for (int i = tid; i < 64 * 32; i += 512) { int pos = i >> 5, f = i & 31; float inv = exp2f(-(float)f * (13.287712379549449f / 32.0f)); float a = (float)pos * inv; t128[i] = make_float2(__cosf(a), __sinf(a)); }
    if (tid < 64) { float a = pin.in[I_LQ1][tid] * pin.in[I_LK1][tid], b = pin.in[I_LQ2][tid] * pin.in[I_LK2][tid]; a = wsum(a); b = wsum(b);
      if (tid == 0) wsp<float>(p, OFF_LAM)[0] = expf(a) - expf(b) + 0.2f; }
  }
  { float* smw = wsp<float>(p, OFF_SMALL); const int gt = bid * 512 + tid, gs = G * 512;
#define CPY(idx, off, n) for (int i = gt; i < (n); i += gs) smw[(off) + i] = pin.in[idx][i];
    CPY(I_N1G, SM_N1G, 2048) CPY(I_N2G, SM_N2G, 2048) CPY(I_ALNG, SM_ALNG, 512) CPY(I_ALNB, SM_ALNB, 512) CPY(I_ABS, SM_ABS, 512) CPY(I_BQN, SM_BQN, 64) CPY(I_BKN, SM_BKN, 64)
    CPY(I_SUBLN, SM_SUBLN, 128) CPY(I_CQN, SM_CQN, 128) CPY(I_CKN, SM_CKN, 128) CPY(I_MBIAS, SM_MBIAS, 128) CPY(I_AWS, SM_AWSF, 65536) CPY(I_ROUTER, SM_ROUTER, 131072)
#undef CPY
  }
  for (int i = bid * 512 + tid; i < 2 * NE * D; i += G * 512) { const int l = i >> 16, e = (i >> 10) & 63, kk = i & 1023; wsp<bf16_t>(p, OFF_WRT)[i] = f2bf(pin.in[I_ROUTER][((size_t)l * D + kk) * NE + e]); }
  for (int i = bid * 512 + tid; i < 4 * 128 * 128; i += G * 512) wsp<bf16_t>(p, OFF_WSA)[i] = f2bf(pin.in[I_AWS][i]);
  int goff = 0;
  const size_t EW = (size_t)D * DE;
  __syncthreads();
  if (IN0_FP8) transpose_all8(pin.in[I_EVWIN], p.ws + OFF_WIN0T, D, EVEN_IN, WQ_SHIFT, smem, goff);
  else transpose_tiles(pin.in[I_EVWIN], p.ws + OFF_WIN0T, D, EVEN_IN, 1, 0, 0, smem, goff);
  if (OUT0_FP8) transpose_all8(pin.in[I_EVWOUT], p.ws + OFF_WOUT0T, D, D, WQ_SHIFT, smem, goff);
  else transpose_tiles(pin.in[I_EVWOUT], p.ws + OFF_WOUT0T, D, D, 1, 0, 0, smem, goff);
  if (IN1_FP8) transpose_all8(pin.in[I_ODQKV], p.ws + OFF_WQKV1T, D, ODD_IN, WQ_SHIFT, smem, goff);
  else transpose_tiles(pin.in[I_ODQKV], p.ws + OFF_WQKV1T, D, ODD_IN, 1, 0, 0, smem, goff);
  if (OUT1_FP8) transpose_all8(pin.in[I_ODOUT], p.ws + OFF_WOUT1T, D, D, WQ_SHIFT, smem, goff);
  else transpose_tiles(pin.in[I_ODOUT], p.ws + OFF_WOUT1T, D, D, 1, 0, 0, smem, goff);
  for (int pi = bid; pi < 32; pi += G) { __syncthreads(); const int l = pi >> 4, up = (pi >> 3) & 1, kb = pi & 7;
    const float* sgu; if (up) sgu = pin.in[I_SU]; else sgu = pin.in[I_SG]; asm volatile("" : "+s"(sgu));
    transpose_panel8(sgu + (size_t)l * EW, p.ws + OFF_SHGU + (size_t)l * 512 * D + (size_t)up * 256 * D, D, DE, kb, 0, smem, WG_SHIFT); }
  __syncthreads();
  for (int pi = bid; pi < 16; pi += G) { __syncthreads(); const int l = pi >> 3, rr = pi & 7; transpose_panel8(pin.in[I_SD] + (size_t)l * EW, p.ws + OFF_SHD + (size_t)l * EW, DE, D, rr >> 2, rr & 3, smem); }
  __syncthreads();
}
DEVI void transpose_panel(const float* src0, bf16_t* dst0, int K, int N, int kb, int nb_, unsigned char* smem) {
  const int tid = ltid(), n4 = tid & 63, kp0 = tid >> 6; unsigned* Tb = (unsigned*)smem;
  const float* src = src0 + (size_t)(kb * 128) * N + nb_ * 256 + n4 * 4; bf16_t* dst = dst0 + (size_t)(nb_ * 256) * K + kb * 128;
  f32x4 va[8], vb[8];
#pragma unroll
  for (int i = 0; i < 8; ++i) { const int kp = kp0 + 8 * i; va[i] = __builtin_nontemporal_load((const f32x4*)(src + (size_t)(2 * kp) * N)); vb[i] = __builtin_nontemporal_load((const f32x4*)(src + (size_t)(2 * kp + 1) * N)); }
#pragma unroll
  for (int i = 0; i < 8; ++i) { const int kp = kp0 + 8 * i;
#pragma unroll
    for (int j = 0; j < 4; ++j) { const int n = n4 * 4 + j; Tb[n * 64 + (kp ^ (((n >> 2) & 7) << 2))] = pack2(va[i][j], vb[i][j]); } }
  __syncthreads();
#pragma unroll
  for (int i = 0; i < 8; ++i) { const int pc = tid + 512 * i, n = pc >> 4, q = pc & 15;
    const u32x4 w = *(const u32x4*)(Tb + n * 64 + ((4 * q) ^ (((n >> 2) & 7) << 2)));
    *(u32x4*)(dst + (size_t)n * K + 8 * q) = w; }
}
DEVI void expert_prep_steal(const Params& p, const PrepIn& pin, unsigned char* smem, int layer) {
  const size_t EW = (size_t)D * DE, lo = (size_t)layer * NE * EW; int* ctr = (int*)(p.ws + OFF_STEAL) + layer; int* bc = (int*)(smem + 65536);
  int nxt = 0; if (ltid() == 0) nxt = atomicAdd(ctr, 1);
  for (;;) {
    __syncthreads();
    if (ltid() == 0) bc[0] = nxt;
    __syncthreads();
    const int idx = bc[0]; if (idx >= 3 * 512) break;
    if (ltid() == 0) nxt = atomicAdd(ctr, 1);
    const int j = idx >> 9, r = idx & 511, m = r >> 3, rr = r & 7;
    if (j == 0) transpose_panel8(pin.in[I_WG] + lo + (size_t)m * EW, p.ws + OFF_EGU + (size_t)m * 512 * D, D, DE, rr, 0, smem, WG_SHIFT);
    else if (j == 1) transpose_panel8(pin.in[I_WU] + lo + (size_t)m * EW, p.ws + OFF_EGU + (size_t)m * 512 * D + (size_t)256 * D, D, DE, rr, 0, smem, WG_SHIFT);
    else transpose_panel8(pin.in[I_WD] + lo + (size_t)m * EW, p.ws + OFF_ED + (size_t)m * EW, DE, D, rr >> 2, rr & 3, smem);
  }
}
DEVI void stage_prep_experts(const Params& p, const PrepIn& pin, unsigned char* smem, int layer) {
  int goff = 0; const size_t EW = (size_t)D * DE, lo = (size_t)layer * NE * EW;
  __syncthreads();
  transpose_tiles(pin.in[I_WG] + lo, p.ws + OFF_EGU, D, DE, 64, EW, (size_t)512 * D, smem, goff);
  transpose_tiles(pin.in[I_WU] + lo, p.ws + OFF_EGU + (size_t)256 * D * 2, D, DE, 64, EW, (size_t)512 * D, smem, goff);
  transpose_tiles(pin.in[I_WD] + lo, p.ws + OFF_ED, DE, D, 64, EW, EW, smem, goff);
  __syncthreads();
}

template <int LAYER> DEVI void stage_norm1(const Params& p) {
  const int wid = ltid() >> 6, lane = ltid() & 63;
  const float* g = sm(p, SM_N1G + LAYER * D);
  bf16_t* act = wsp<bf16_t>(p, OFF_ACT);
  f32x4 gg[4];
#pragma unroll
  for (int i = 0; i < 4; ++i) gg[i] = *(const f32x4*)(g + (i * 64 + lane) * 4);
  const int nw = gridDim.x * 8;
  for (int tb = blockIdx.x * 8 + wid; tb < T; tb += 3 * nw) {
    f32x4 v[3][4], s0[3][4], s1[3][4]; int tt[3];
#pragma unroll
    for (int u = 0; u < 3; ++u) { tt[u] = tb + u * nw; const int tc = tt[u] < T ? tt[u] : tb;
      const float* row = LAYER == 0 ? in_row(p, tc) : (const float*)hid_row(p, tc);
      const float* sh = modv(p, LAYER, tc, 0); const float* sc = modv(p, LAYER, tc, 1);
#pragma unroll
      for (int i = 0; i < 4; ++i) { const int c = (i * 64 + lane) * 4; v[u][i] = *(const f32x4*)(row + c); s0[u][i] = *(const f32x4*)(sh + c); s1[u][i] = *(const f32x4*)(sc + c); } }
#pragma unroll
    for (int u = 0; u < 3; ++u) {
      if (tt[u] < T) { const int t = tt[u];
        float ss = 0.f;
#pragma unroll
        for (int i = 0; i < 4; ++i) ss += v[u][i][0] * v[u][i][0] + v[u][i][1] * v[u][i][1] + v[u][i][2] * v[u][i][2] + v[u][i][3] * v[u][i][3];
        ss = wsum(ss); const float rstd = rsqrtf(ss * (1.0f / D) + EPS);
#pragma unroll
        for (int i = 0; i < 4; ++i) { const int c = (i * 64 + lane) * 4;
          float y[4];
#pragma unroll
          for (int q = 0; q < 4; ++q) y[q] = v[u][i][q] * rstd * gg[i][q] * (1.0f + s1[u][i][q]) + s0[u][i][q];
          if ((LAYER == 0 && IN0_FP8) || (LAYER == 1 && IN1_FP8)) { const float xs = (float)(1 << X_SHIFT); int w8 = 0;
            w8 = __builtin_amdgcn_cvt_pk_fp8_f32(__builtin_amdgcn_fmed3f(y[0] * xs, -440.f, 440.f), __builtin_amdgcn_fmed3f(y[1] * xs, -440.f, 440.f), w8, false);
            w8 = __builtin_amdgcn_cvt_pk_fp8_f32(__builtin_amdgcn_fmed3f(y[2] * xs, -440.f, 440.f), __builtin_amdgcn_fmed3f(y[3] * xs, -440.f, 440.f), w8, true);
            *(int*)(p.ws + OFF_ACT8 + (size_t)t * D + c) = w8; }
          else { u32x2 w; w.x = pack2(y[0], y[1]); w.y = pack2(y[2], y[3]);
            *(u32x2*)(act + (size_t)t * D + c) = w; } }
      }
    }
  }
}

template <class GA, class GB, class ST>
DEVI void ngemm(int MT, int NT, int K, GA getA, GB getB, ST store) {
  const int wid = ltid() >> 6, lane = ltid() & 63, fr = lane & 15, fq = lane >> 4;
  const long nw = (long)gridDim.x * 8;
  for (long tile = (long)blockIdx.x * 8 + wid; tile < (long)MT * NT; tile += nw) {
    const int tm = (int)(tile / NT), tn = (int)(tile - (long)tm * NT);
    const bf16_t* a0 = getA(tm * 32 + fr); const bf16_t* a1 = getA(tm * 32 + 16 + fr);
    const bf16_t* b0 = getB(tn * 32 + fr); const bf16_t* b1 = getB(tn * 32 + 16 + fr);
    f32x4 c00 = {0.f, 0.f, 0.f, 0.f}, c01 = c00, c10 = c00, c11 = c00;
    const bf16x8 z = {0, 0, 0, 0, 0, 0, 0, 0};
    for (int k = 0; k < K; k += 32) {
      const bf16x8 A0 = a0 ? *(const bf16x8*)(a0 + k + fq * 8) : z, A1 = a1 ? *(const bf16x8*)(a1 + k + fq * 8) : z;
      const bf16x8 B0 = *(const bf16x8*)(b0 + k + fq * 8), B1 = *(const bf16x8*)(b1 + k + fq * 8);
      c00 = __builtin_amdgcn_mfma_f32_16x16x32_bf16(A0, B0, c00, 0, 0, 0);
      c01 = __builtin_amdgcn_mfma_f32_16x16x32_bf16(A0, B1, c01, 0, 0, 0);
      c10 = __builtin_amdgcn_mfma_f32_16x16x32_bf16(A1, B0, c10, 0, 0, 0);
      c11 = __builtin_amdgcn_mfma_f32_16x16x32_bf16(A1, B1, c11, 0, 0, 0);
    }
#pragma unroll
    for (int j = 0; j < 4; ++j) {
      store(tm * 32 + fq * 4 + j, tn * 32 + fr, tn * 32 + 16 + fr, c00[j], c01[j]);
      store(tm * 32 + 16 + fq * 4 + j, tn * 32 + fr, tn * 32 + 16 + fr, c10[j], c11[j]);
    }
  }
}

DEVI void n_inproj0(const Params& p) {
  const bf16_t* act = wsp<bf16_t>(p, OFF_ACT); const bf16_t* w = wsp<bf16_t>(p, OFF_WIN0T); bf16_t* proj = wsp<bf16_t>(p, OFF_PROJ);
  ngemm(T / 32, EVEN_IN / 32, D,
        [&](int r) { return act + (size_t)r * D; }, [&](int n) { return w + (size_t)n * D; },
        [&](int r, int n0, int n1, float v0, float v1) { proj[(size_t)r * EVEN_IN + n0] = f2bf(v0); proj[(size_t)r * EVEN_IN + n1] = f2bf(v1); });
}
DEVI void n_post0(const Params& p) {
  const int wid = ltid() >> 6, lane = ltid() & 63;
  bf16_t* proj = wsp<bf16_t>(p, OFF_PROJ); const float2* t64 = wsp<float2>(p, OFF_TAB64);
  for (int t = blockIdx.x * 8 + wid; t < T; t += gridDim.x * 8) {
    bf16_t* row = proj + (size_t)t * EVEN_IN; const int b = t / SB, j = t - b * SB;
    for (int i = 0; i < 16; ++i) { int c = i * 64 + lane; row[c] = f2bf(gelu_exact(bf2f(row[c]))); }
    for (int hh = 0; hh < 16; ++hh) {
      const int c = 1024 + hh * 64 + lane; float v = bf2f(row[c]);
      float ss = wsum(v * v); float g = sm(p, hh < 8 ? SM_BQN : SM_BKN)[lane];
      float y = v * rsqrtf(ss * (1.0f / 64) + EPS) * g;
      y = bf2f(f2bf(y));
      if (j >= NC) { const int pos = j - NC, pr = lane >> 1; const int ps = pr < 16 ? (pos >> 6) : (pos & 63); const float2 cs = t64[ps * 16 + (pr & 15)];
        const float other = shx<1>(y);
        y = (lane & 1) ? (other * cs.y + y * cs.x) : (y * cs.x - other * cs.y); }
      row[c] = f2bf(y);
    }
  }
}

DEVI void attn_row(const bf16_t* q, int dq, const bf16_t* kb, int ldk, const bf16_t* vb, int ldv, int nkeys, float scale,
                   volatile float* sc, volatile float* qs, float& o0, float& o1) {
  const int lane = ltid() & 63;
  for (int d = lane; d < dq; d += 64) qs[d] = bf2f(q[d]);
  float mx = -1e30f;
  for (int key = lane; key < nkeys; key += 64) { const bf16_t* kr = kb + (size_t)key * ldk; float dot = 0.f;
    for (int d = 0; d < dq; d += 8) { const bf16x8 kv = *(const bf16x8*)(kr + d);
#pragma unroll
      for (int e = 0; e < 8; ++e) dot += qs[d + e] * bf2f((bf16_t)kv[e]); }
    dot *= scale; sc[key] = dot; mx = fmaxf(mx, dot); }
  mx = wmax(mx); float sum = 0.f;
  for (int key = lane; key < nkeys; key += 64) { float pv = __expf(sc[key] - mx); sc[key] = pv; sum += pv; }
  sum = wsum(sum); float a0 = 0.f, a1 = 0.f;
  for (int key = 0; key < nkeys; ++key) { const float pv = sc[key]; const unsigned vv = *(const unsigned*)(vb + (size_t)key * ldv + 2 * lane);
    a0 += pv * bf2f((bf16_t)(vv & 0xffff)); a1 += pv * bf2f((bf16_t)(vv >> 16)); }
  const float inv = 1.0f / sum; o0 = a0 * inv; o1 = a1 * inv;
}
DEVI void n_attn0(const Params& p, unsigned char* smem) {
  const int wid = ltid() >> 6, lane = ltid() & 63;
  volatile float* sc = (volatile float*)(smem + wid * (2304 * 4 + 512)); volatile float* qs = sc + 2304;
  const bf16_t* proj = wsp<bf16_t>(p, OFF_PROJ); bf16_t* cat = wsp<bf16_t>(p, OFF_ACT);
  const float lam = wsp<float>(p, OFF_LAM)[0];
  for (int task = blockIdx.x * 8 + wid; task < T * 4; task += gridDim.x * 8) {
    const int t = task >> 2, h = task & 3, b = t / SB, j = t - b * SB; const int nkeys = j < NC ? NC : SB;
    const bf16_t* kbase = proj + (size_t)(b * SB) * EVEN_IN + 1536 + h * 128; const bf16_t* vbase = proj + (size_t)(b * SB) * EVEN_IN + 2048 + h * 128;
    const bf16_t* q = proj + (size_t)t * EVEN_IN + 1024 + h * 128;
    float a0, a1, b0, b1;
    attn_row(q, 64, kbase, EVEN_IN, vbase, EVEN_IN, nkeys, 0.125f, sc, qs, a0, a1);
    attn_row(q + 64, 64, kbase + 64, EVEN_IN, vbase, EVEN_IN, nkeys, 0.125f, sc, qs, b0, b1);
    float o0 = a0 - lam * b0, o1 = a1 - lam * b1;
    float ss = wsum(o0 * o0 + o1 * o1); const float r = rsqrtf(ss * (1.0f / 128) + EPS) * 0.8f;
    o0 = o0 * r * sm(p, SM_SUBLN)[2 * lane]; o1 = o1 * r * sm(p, SM_SUBLN)[2 * lane + 1];
    *(unsigned*)(cat + (size_t)t * D + 512 + h * 128 + 2 * lane) = pack2(o0, o1);
  }
}
DEVI void n_gmlp(const Params& p, unsigned char* smem) {
  const int tid = ltid(), wid = tid >> 6, lane = tid & 63;
  bf16_t* lv = (bf16_t*)smem;
  const bf16_t* proj = wsp<bf16_t>(p, OFF_PROJ); bf16_t* cat = wsp<bf16_t>(p, OFF_ACT);
  for (int ch = blockIdx.x; ch < T / 128; ch += gridDim.x) {
    __syncthreads();
    for (int r = wid; r < 128; r += 8) { const bf16_t* vr = proj + (size_t)(ch * 128 + r) * EVEN_IN + 512;
      float v[8]; float s = 0.f;
#pragma unroll
      for (int i = 0; i < 8; ++i) { v[i] = bf2f(vr[i * 64 + lane]); s += v[i]; }
      s = wsum(s); const float mu = s * (1.0f / 512); float q = 0.f;
#pragma unroll
      for (int i = 0; i < 8; ++i) { const float d = v[i] - mu; q += d * d; }
      q = wsum(q); const float rstd = rsqrtf(q * (1.0f / 512) + EPS);
#pragma unroll
      for (int i = 0; i < 8; ++i) { const int c = i * 64 + lane; lv[r * 512 + c] = f2bf((v[i] - mu) * rstd * sm(p, SM_ALNG)[c] + sm(p, SM_ALNB)[c]); } }
    __syncthreads();
    const int c = tid, g = c >> 7;
    const float* wsg = sm(p, SM_AWSF) + (size_t)g * 128 * 128;
    for (int pp = 0; pp < 128; ++pp) { float acc = 0.f; const float* wr = wsg + pp * 128;
      for (int q = 0; q < 128; ++q) acc += wr[q] * bf2f(lv[q * 512 + c]);
      acc += sm(p, SM_ABS)[g * 128 + pp];
      const size_t t = (size_t)ch * 128 + pp; const float u = bf2f(proj[t * EVEN_IN + c]);
      cat[t * D + c] = f2bf(u * acc); }
  }
}
template <int LAYER> DEVI void n_outproj(const Params& p) {
  const bf16_t* cat = wsp<bf16_t>(p, OFF_ACT); const bf16_t* w = wsp<bf16_t>(p, LAYER == 0 ? OFF_WOUT0T : OFF_WOUT1T);
  auto st1 = [&](int r, int n, float v) { const int b = r / SB, j = r - b * SB; if (LAYER == 1 && j < NC) return;
    const float* res = LAYER == 0 ? in_row(p, r) : (const float*)hid_row(p, r); float* dst = hid_row(p, r);
    dst[n] = res[n] + modv(p, LAYER, r, 2)[n] * v; };
  ngemm(T / 32, D / 32, D, [&](int r) { return cat + (size_t)r * D; }, [&](int n) { return w + (size_t)n * D; },
        [&](int r, int n0, int n1, float v0, float v1) { st1(r, n0, v0); st1(r, n1, v1); });
}

struct LCfg { int l, npb, j0, nph; };
DEVI int act_tok(const LCfg& c, int half, int tl) { const int bl = tl / c.npb, jj = tl - bl * c.npb; return (half * 8 + bl) * SB + c.j0 + jj; }
DEVI void stage_router(const Params& p, const LCfg c, unsigned char* smem) {
  const int wid = ltid() >> 6, lane = ltid() & 63, fr = lane & 15, fq = lane >> 4;
  float* lgs = (float*)smem + wid * 4096;
  int* ksl = (int*)lgs + 2048;
  const float* g = sm(p, SM_N2G + c.l * D); bf16_t* act = wsp<bf16_t>(p, OFF_ACT);
  const bf16_t* wrt = wsp<bf16_t>(p, OFF_WRT) + (size_t)c.l * NE * D; const float bias = sm(p, SM_MBIAS)[c.l * NE + lane];
  int* cnt = (int*)(p.ws + OFF_CNT) + c.l * 128; int* list = wsp<int>(p, OFF_LIST); float* topw = wsp<float>(p, OFF_TOPW);
  const int nact = c.nph, nwv = gridDim.x * 8, chunk0 = (nact + nwv - 1) / nwv, chunk = chunk0 < 32 ? chunk0 : 32;
  const bool agg = (nact == nwv * chunk);
  LAS int* blk = (LAS int*)((LAS unsigned char*)smem + 131072); LAS int* blkb = blk + 64;
  if (agg) {
    if (ltid() < 64) blk[ltid()] = 0;
    const u32x4* src = (const u32x4*)wrt;
    { u32x4 rv[16];
#pragma unroll
      for (int j = 0; j < 16; ++j) rv[j] = src[ltid() + 512 * j];
#pragma unroll
      for (int j = 0; j < 16; ++j) { const int i = ltid() + 512 * j, row = i >> 7, ch = i & 127; *(LAS u32x4*)((LAS unsigned char*)smem + row * 2048 + ((ch ^ (row & 7)) << 4)) = rv[j]; } }
    __syncthreads(); }
  for (int ga0 = (blockIdx.x * 8 + wid) * chunk; ga0 < nact; ga0 += nwv * chunk) {
    const int ntk = (nact - ga0) < chunk ? (nact - ga0) : chunk;
    f32x4 gg[4], s1v[4], s0v[4]; int curb = -1;
#pragma unroll
    for (int i = 0; i < 4; ++i) gg[i] = *(const f32x4*)(g + (i * 64 + lane) * 4);
    u32x2 nx[3][4]; int tn[3];
#define RLOAD(jb) do { _Pragma("unroll") for (int u = 0; u < 3; ++u) { int j = (jb) + u; j = j < ntk ? j : ntk - 1; const int ga = ga0 + j, half = ga / c.nph, tl = ga - half * c.nph; tn[u] = act_tok(c, half, tl); \
      const bf16_t* row = wsp<bf16_t>(p, OFF_HB) + (size_t)tn[u] * D; _Pragma("unroll") for (int i = 0; i < 4; ++i) nx[u][i] = *(const u32x2*)(row + (i * 64 + lane) * 4); } } while (0)
    RLOAD(0);
    { const int bt0 = tn[0] / SB, jt0 = tn[0] - bt0 * SB; curb = jt0 < NC ? 16 : bt0;
      const float* sh = modv(p, c.l, tn[0], 3); const float* sc = modv(p, c.l, tn[0], 4);
#pragma unroll
      for (int i = 0; i < 4; ++i) { s0v[i] = *(const f32x4*)(sh + (i * 64 + lane) * 4); s1v[i] = *(const f32x4*)(sc + (i * 64 + lane) * 4); } }
    for (int j0 = 0; j0 < ntk; j0 += 3) {
      f32x4 v[3][4]; int tt[3];
#pragma unroll
      for (int u = 0; u < 3; ++u) { tt[u] = tn[u];
#pragma unroll
        for (int i = 0; i < 4; ++i) v[u][i] = bf4(nx[u][i]); }
      if (j0 + 3 < ntk) RLOAD(j0 + 3);
#pragma unroll
      for (int u = 0; u < 3; ++u) { float ss = 0.f;
#pragma unroll
        for (int i = 0; i < 4; ++i) ss += v[u][i][0] * v[u][i][0] + v[u][i][1] * v[u][i][1] + v[u][i][2] * v[u][i][2] + v[u][i][3] * v[u][i][3];
        const float rstd = rsqrtf(wsum_dpp(ss) * (1.0f / D) + EPS);
        const int bt = tt[u] / SB, jt = tt[u] - bt * SB, mrow = jt < NC ? 16 : bt;
        if (mrow != curb) { curb = mrow; const float* sh = modv(p, c.l, tt[u], 3); const float* sc = modv(p, c.l, tt[u], 4);
#pragma unroll
          for (int i = 0; i < 4; ++i) { s0v[i] = *(const f32x4*)(sh + (i * 64 + lane) * 4); s1v[i] = *(const f32x4*)(sc + (i * 64 + lane) * 4); } }
        if (j0 + u < ntk) {
#pragma unroll
          for (int i = 0; i < 4; ++i) { const int cc = (i * 64 + lane) * 4;
            float y[4];
#pragma unroll
            for (int q = 0; q < 4; ++q) y[q] = v[u][i][q] * rstd * gg[i][q] * (1.0f + s1v[i][q]) + s0v[i][q];
            u32x2 w; w.x = pack2(y[0], y[1]); w.y = pack2(y[2], y[3]);
            *(u32x2*)(act + (size_t)tt[u] * D + cc) = w;
            const float xs = (float)(1 << X_SHIFT); int w8 = 0;
            w8 = __builtin_amdgcn_cvt_pk_fp8_f32(__builtin_amdgcn_fmed3f(y[0] * xs, -440.f, 440.f), __builtin_amdgcn_fmed3f(y[1] * xs, -440.f, 440.f), w8, false);
            w8 = __builtin_amdgcn_cvt_pk_fp8_f32(__builtin_amdgcn_fmed3f(y[2] * xs, -440.f, 440.f), __builtin_amdgcn_fmed3f(y[3] * xs, -440.f, 440.f), w8, true);
            *(int*)(p.ws + OFF_ACT8 + (size_t)tt[u] * D + cc) = w8; } }
      }
    }
#undef RLOAD
    asm volatile("s_waitcnt vmcnt(0)" ::: "memory");
    const bf16_t* ar[2];
#pragma unroll
    for (int m = 0; m < 2; ++m) { int jj = m * 16 + fr; jj = jj < ntk ? jj : 0; const int ga = ga0 + jj, half = ga / c.nph, tl = ga - half * c.nph; ar[m] = act + (size_t)act_tok(c, half, tl) * D + fq * 8; }
    const bf16_t* br = wrt + (size_t)fr * D + fq * 8;
    f32x4 acc[2][4];
#pragma unroll
    for (int m = 0; m < 2; ++m)
#pragma unroll
      for (int n = 0; n < 4; ++n) acc[m][n] = (f32x4){0.f, 0.f, 0.f, 0.f};
    if (agg) {
      const LAS unsigned char* bl = (const LAS unsigned char*)smem + fr * 2048; const int sw = fr & 7;
#pragma unroll 16
      for (int k0 = 0; k0 < D; k0 += 32) {
        bf16x8 af[2], bfr[4];
#pragma unroll
        for (int m = 0; m < 2; ++m) af[m] = *(const bf16x8*)(ar[m] + k0);
#pragma unroll
        for (int n = 0; n < 4; ++n) bfr[n] = *(const LAS bf16x8*)(bl + n * 32768 + ((((k0 >> 3) + fq) ^ sw) << 4));
#pragma unroll
        for (int m = 0; m < 2; ++m)
#pragma unroll
          for (int n = 0; n < 4; ++n) acc[m][n] = __builtin_amdgcn_mfma_f32_16x16x32_bf16(af[m], bfr[n], acc[m][n], 0, 0, 0);
      }
      __syncthreads();
    } else {
#pragma unroll 4
    for (int k0 = 0; k0 < D; k0 += 32) {
      bf16x8 af[2], bfr[4];
#pragma unroll
      for (int m = 0; m < 2; ++m) af[m] = *(const bf16x8*)(ar[m] + k0);
#pragma unroll
      for (int n = 0; n < 4; ++n) bfr[n] = *(const bf16x8*)(br + (size_t)(16 * n) * D + k0);
#pragma unroll
      for (int m = 0; m < 2; ++m)
#pragma unroll
        for (int n = 0; n < 4; ++n) acc[m][n] = __builtin_amdgcn_mfma_f32_16x16x32_bf16(af[m], bfr[n], acc[m][n], 0, 0, 0);
    }
    }
    __builtin_amdgcn_wave_barrier();
#pragma unroll
    for (int m = 0; m < 2; ++m)
#pragma unroll
      for (int n = 0; n < 4; ++n)
#pragma unroll
        for (int r = 0; r < 4; ++r) lgs[(m * 16 + 4 * fq + r) * 64 + 16 * n + fr] = acc[m][n][r];
    __builtin_amdgcn_fence(__ATOMIC_RELEASE, "wavefront"); __builtin_amdgcn_wave_barrier();
    const int half0 = ga0 / c.nph, half1 = (ga0 + ntk - 1) / c.nph;
    unsigned cm0 = 0u, cm1 = 0u;
    for (int j0 = 0; j0 < ntk; j0 += 3) {
      float wq[3]; int kq[3];
#pragma unroll
      for (int u = 0; u < 3; ++u) { const int j = (j0 + u) < ntk ? (j0 + u) : j0;
        const float lg = ((volatile float*)lgs)[j * 64 + lane];
        const float score = __builtin_amdgcn_rcpf(1.0f + __expf(-lg)); const float sel = score + bias;
        const float m1 = max8_dpp(sel);
        const unsigned long long isb = __ballot(sel == m1); const int gbase = lane & ~7; const unsigned gm = (unsigned)((isb >> gbase) & 0xffull);
        const int first = gbase + __builtin_ctz(gm);
        const float m2 = max8_dpp((lane == first) ? -INFINITY : sel);
        const float gs = m1 + m2; const int gi = lane >> 3; int grank = 0;
#pragma unroll
        for (int g2 = 0; g2 < 8; ++g2) { const float og = rlane(gs, g2 * 8); grank += (og > gs || (og == gs && g2 < gi)) ? 1 : 0; }
        float cur = grank < 4 ? sel : -INFINITY;
        int myk = -1; float wsumv = 0.f;
#pragma unroll
        for (int kk = 0; kk < TOPK; ++kk) { const float mxv = wmax_dpp(cur); const unsigned long long bm = __ballot(cur == mxv); const int win = __builtin_ctzll(bm);
          if (lane == win) { myk = kk; cur = -INFINITY; } wsumv += rlane(score, win); }
        wq[u] = score * __builtin_amdgcn_rcpf(wsumv) * 2.5f; kq[u] = myk; }
#pragma unroll
      for (int u = 0; u < 3; ++u) { const int j = j0 + u;
        if (j < ntk) { ((volatile float*)lgs)[j * 64 + lane] = wq[u]; ((volatile int*)ksl)[j * 64 + lane] = kq[u];
          const bool inh0 = (ga0 + j) / c.nph == half0;
          if (kq[u] >= 0) { if (inh0) cm0 |= 1u << j; else cm1 |= 1u << j; } } }
    }
    int base0 = 0, base1 = 0;
    if (agg) {
      const int n0 = __builtin_popcount(cm0); int wb = 0;
      if (n0) wb = __atomic_fetch_add(&blk[lane], n0, __ATOMIC_RELAXED);
      __syncthreads();
      if (wid == 0) { const int tot = blk[lane]; int gb = 0; if (tot) gb = atomicAdd(&cnt[half0 * 64 + lane], tot); blkb[lane] = gb; }
      __syncthreads();
      base0 = blkb[lane] + wb;
    } else {
      if (cm0) base0 = atomicAdd(&cnt[half0 * 64 + lane], __builtin_popcount(cm0));
      if (cm1) base1 = atomicAdd(&cnt[half1 * 64 + lane], __builtin_popcount(cm1));
    }
    for (int j = 0; j < ntk; ++j) {
      const int myk = ((volatile int*)ksl)[j * 64 + lane];
      if (myk >= 0) { const int ga = ga0 + j, half = ga / c.nph, tl = ga - half * c.nph; const unsigned below = (1u << j) - 1u;
        const int pos = half == half0 ? base0 + __builtin_popcount(cm0 & below) : base1 + __builtin_popcount(cm1 & below);
        list[((size_t)(half * 64 + lane)) * LCAP + pos] = tl * 6 + myk; topw[(size_t)ga * 6 + myk] = ((volatile float*)lgs)[j * 64 + lane]; wsp<int>(p, OFF_TOPP)[(size_t)ga * 6 + myk] = (lane << 24) | pos; }
    }
    __builtin_amdgcn_wave_barrier();
  }
}

DEVI void n_moe_gu(const Params& p, const LCfg c, int half) {
  const bf16_t* act = wsp<bf16_t>(p, OFF_ACT); bf16_t* hid = wsp<bf16_t>(p, OFF_HID);
  const int* cnt = (const int*)(p.ws + OFF_CNT) + c.l * 128 + half * 64; const int* list = wsp<int>(p, OFF_LIST) + (size_t)half * 64 * LCAP;
  int off = 0;
  for (int e = 0; e <= NE; ++e) {
    const int n = e < NE ? cnt[e] : c.nph;
    const bf16_t* w = e < NE ? wsp<bf16_t>(p, OFF_EGU) + (size_t)e * 512 * D : wsp<bf16_t>(p, OFF_SHGU) + (size_t)c.l * 512 * D;
    const int* le = list + (size_t)e * LCAP;
    ngemm((n + 31) / 32, DE / 16, D,
          [&](int r) -> const bf16_t* { if (r >= n) return nullptr; const int tl = e < NE ? le[r] / 6 : r; return act + (size_t)act_tok(c, half, tl) * D; },
          [&](int nn) { const int tn = nn >> 5, i = (nn >> 4) & 1, fr = nn & 15; return w + (size_t)(i * 256 + tn * 16 + fr) * D; },
          [&](int r, int n0, int n1, float v0, float v1) { if (r < n) hid[(size_t)(off + r) * DE + (n0 >> 5) * 16 + (n0 & 15)] = f2bf(silu(v0) * v1); });
    off += n;
  }
}
DEVI void n_moe_down(const Params& p, const LCfg c, int half) {
  const bf16_t* hid = wsp<bf16_t>(p, OFF_HID); bf16_t* slot = wsp<bf16_t>(p, OFF_SLOT);
  const int* cnt = (const int*)(p.ws + OFF_CNT) + c.l * 128 + half * 64; const int* list = wsp<int>(p, OFF_LIST) + (size_t)half * 64 * LCAP;
  int off = 0;
  for (int e = 0; e <= NE; ++e) {
    const int n = e < NE ? cnt[e] : c.nph;
    const bf16_t* w = e < NE ? wsp<bf16_t>(p, OFF_ED) + (size_t)e * D * DE : wsp<bf16_t>(p, OFF_SHD) + (size_t)c.l * D * DE;
    const int* le = list + (size_t)e * LCAP;
    auto st1 = [&](int r, int nn, float v) { if (r >= n) return;
      if (e < NE) slot[(size_t)le[r] * D + nn] = f2bf(v);
      else { const int t = act_tok(c, half, r); float* h = hid_row(p, t); h[nn] += modv(p, c.l, t, 5)[nn] * v; } };
    ngemm((n + 31) / 32, D / 32, DE,
          [&](int r) -> const bf16_t* { return r < n ? hid + (size_t)(off + r) * DE : nullptr; },
          [&](int nn) { return w + (size_t)nn * DE; },
          [&](int r, int n0, int n1, float v0, float v1) { st1(r, n0, v0); st1(r, n1, v1); });
    off += n;
  }
}
template <bool FUSE_NORM1> DEVI void stage_combine(const Params& p, const LCfg c, int half, unsigned char* smem, float dscale = 1.0f) {
  const int wid = ltid() >> 6, lane = ltid() & 63;
  int* off = (int*)smem;
  __syncthreads();
  if (ltid() < NE) off[128 + ltid()] = ((const int*)(p.ws + OFF_CNT))[c.l * 128 + half * 64 + ltid()];
  __syncthreads();
  if (ltid() == 0) { int o = 0; for (int e = 0; e < NE; ++e) { off[e] = o; o += off[128 + e]; } off[NE] = o; }
  __syncthreads();
  const unsigned char* slot = p.ws + OFF_SLOT; const float* topw = wsp<float>(p, OFF_TOPW); const int* topp = wsp<int>(p, OFF_TOPP);
  f32x4 g1v[4];
  if (FUSE_NORM1) { const float* g1 = sm(p, SM_N1G + (c.l + 1) * D);
#pragma unroll
    for (int i = 0; i < 4; ++i) g1v[i] = *(const f32x4*)(g1 + (i * 64 + lane) * 4); }
  float wn[6]; int qn[6];
  { const int tl0 = blockIdx.x * 8 + wid; const int tc = tl0 < c.nph ? tl0 : 0;
#pragma unroll
    for (int k = 0; k < 6; ++k) { wn[k] = topw[((size_t)(half * c.nph + tc)) * 6 + k]; qn[k] = topp[((size_t)(half * c.nph + tc)) * 6 + k]; } }
  for (int tl = blockIdx.x * 8 + wid; tl < c.nph; tl += gridDim.x * 8) {
    const int t = act_tok(c, half, tl); bf16_t* h = wsp<bf16_t>(p, OFF_HB) + (size_t)t * D; const float* g5 = modv(p, c.l, t, 5);
    float* orow = p.out + ((size_t)((t / SB) * S + (t % SB) - NC)) * D;
    float wk[7]; size_t ro[7];
#pragma unroll
    for (int k = 0; k < 6; ++k) { wk[k] = wn[k]; const int q = qn[k]; ro[k] = (size_t)(off[q >> 24] + (q & 0xffffff)) * D; }
    wk[6] = 1.0f; ro[6] = (size_t)(off[NE] + tl) * D;
    { const int tn = tl + gridDim.x * 8; const int tc = tn < c.nph ? tn : tl;
#pragma unroll
      for (int k = 0; k < 6; ++k) { wn[k] = topw[((size_t)(half * c.nph + tc)) * 6 + k]; qn[k] = topp[((size_t)(half * c.nph + tc)) * 6 + k]; } }
    unsigned sv[4][7]; f32x4 hv[4], g5v[4], n1s[4], n1h[4];
    const float* shn = FUSE_NORM1 ? modv(p, c.l + 1, t, 0) : g5; const float* scn = FUSE_NORM1 ? modv(p, c.l + 1, t, 1) : g5;
#pragma unroll
    for (int i = 0; i < 4; ++i) { const int cc = (i * 64 + lane) * 4; hv[i] = bf4(*(const u32x2*)(h + cc));
#pragma unroll
      for (int k = 0; k < 7; ++k) sv[i][k] = *(const unsigned*)(slot + ro[k] + cc);
      g5v[i] = *(const f32x4*)(g5 + cc);
      if (FUSE_NORM1) { n1s[i] = *(const f32x4*)(scn + cc); n1h[i] = *(const f32x4*)(shn + cc); } }
#pragma unroll
    for (int i = 0; i < 4; ++i) { const int cc = (i * 64 + lane) * 4; f32x4 acc = {0.f, 0.f, 0.f, 0.f};
#pragma unroll
      for (int k = 0; k < 7; ++k) { const auto lo = __builtin_amdgcn_cvt_pk_f32_fp8((int)sv[i][k], false); const auto hi = __builtin_amdgcn_cvt_pk_f32_fp8((int)sv[i][k], true);
        acc[0] += wk[k] * lo[0]; acc[1] += wk[k] * lo[1]; acc[2] += wk[k] * hi[0]; acc[3] += wk[k] * hi[1]; }
      const f32x4 gg = g5v[i];
#pragma unroll
      for (int q = 0; q < 4; ++q) hv[i][q] += gg[q] * acc[q] * dscale;
      if (FUSE_NORM1) { u32x2 w; w.x = pack2(hv[i][0], hv[i][1]); w.y = pack2(hv[i][2], hv[i][3]); *(u32x2*)(h + cc) = w; }
      else *(f32x4*)(orow + cc) = hv[i]; }
    if (FUSE_NORM1) {
      float ss = 0.f;
#pragma unroll
      for (int i = 0; i < 4; ++i) ss += hv[i][0] * hv[i][0] + hv[i][1] * hv[i][1] + hv[i][2] * hv[i][2] + hv[i][3] * hv[i][3];
      const float rstd = rsqrtf(wsum_dpp(ss) * (1.0f / D) + EPS);
      bf16_t* act = wsp<bf16_t>(p, OFF_ACT);
#pragma unroll
      for (int i = 0; i < 4; ++i) { const int cc = (i * 64 + lane) * 4; const f32x4 gg = g1v[i], s1 = n1s[i], s0 = n1h[i];
        float y[4];
#pragma unroll
        for (int q = 0; q < 4; ++q) y[q] = hv[i][q] * rstd * gg[q] * (1.0f + s1[q]) + s0[q];
        if (IN1_FP8) { const float xs = (float)(1 << X_SHIFT); int w8 = 0;
          w8 = __builtin_amdgcn_cvt_pk_fp8_f32(__builtin_amdgcn_fmed3f(y[0] * xs, -440.f, 440.f), __builtin_amdgcn_fmed3f(y[1] * xs, -440.f, 440.f), w8, false);
          w8 = __builtin_amdgcn_cvt_pk_fp8_f32(__builtin_amdgcn_fmed3f(y[2] * xs, -440.f, 440.f), __builtin_amdgcn_fmed3f(y[3] * xs, -440.f, 440.f), w8, true);
          *(int*)(p.ws + OFF_ACT8 + (size_t)t * D + cc) = w8; }
        else { u32x2 w; w.x = pack2(y[0], y[1]); w.y = pack2(y[2], y[3]);
          *(u32x2*)(act + (size_t)t * D + cc) = w; } }
    }
  }
}

DEVI void n_inproj1(const Params& p) {
  const bf16_t* act = wsp<bf16_t>(p, OFF_ACT); const bf16_t* w = wsp<bf16_t>(p, OFF_WQKV1T); bf16_t* proj = wsp<bf16_t>(p, OFF_PROJ);
  ngemm(T / 32, ODD_IN / 32, D, [&](int r) { return act + (size_t)r * D; }, [&](int n) { return w + (size_t)n * D; },
        [&](int r, int n0, int n1, float v0, float v1) { proj[(size_t)r * ODD_IN + n0] = f2bf(v0); proj[(size_t)r * ODD_IN + n1] = f2bf(v1); });
}
DEVI void n_post1(const Params& p) {
  const int wid = ltid() >> 6, lane = ltid() & 63;
  bf16_t* proj = wsp<bf16_t>(p, OFF_PROJ); const float2* t128 = wsp<float2>(p, OFF_TAB128);
  for (int t = blockIdx.x * 8 + wid; t < T; t += gridDim.x * 8) {
    bf16_t* row = proj + (size_t)t * ODD_IN; const int b = t / SB, j = t - b * SB;
    for (int hh = 0; hh < 10; ++hh) {
      unsigned* pp = (unsigned*)(row + hh * 128 + 2 * lane); const unsigned u = *pp;
      float x1 = __uint_as_float(u << 16), x2 = __uint_as_float(u & 0xffff0000u);
      const float ss = wsum(x1 * x1 + x2 * x2); const float r = rsqrtf(ss * (1.0f / 128) + EPS);
      const float* g = sm(p, hh < 8 ? SM_CQN : SM_CKN);
      x1 = x1 * r * g[2 * lane]; x2 = x2 * r * g[2 * lane + 1];
      if (j >= NC) { const int pos = j - NC; const int ps = lane < 32 ? (pos >> 6) : (pos & 63); const float2 cs = t128[ps * 32 + (lane & 31)];
        const float y1 = x1 * cs.x - x2 * cs.y, y2 = x1 * cs.y + x2 * cs.x; x1 = y1; x2 = y2; }
      *pp = pack2(x1, x2);
    }
  }
}
DEVI void n_attn1(const Params& p, unsigned char* smem) {
  const int wid = ltid() >> 6, lane = ltid() & 63;
  volatile float* sc = (volatile float*)(smem + wid * (2304 * 4 + 512)); volatile float* qs = sc + 2304;
  const bf16_t* proj = wsp<bf16_t>(p, OFF_PROJ); bf16_t* att = wsp<bf16_t>(p, OFF_ACT);
  for (int task = blockIdx.x * 8 + wid; task < TX * 8; task += gridDim.x * 8) {
    const int tx = task >> 3, h = task & 7, b = tx / S, i = tx - b * S, t = b * SB + NC + i, kvh = h >> 2;
    const bf16_t* kbase = proj + (size_t)(b * SB) * ODD_IN + 1024 + kvh * 128; const bf16_t* vbase = kbase + 256;
    float o0, o1;
    attn_row(proj + (size_t)t * ODD_IN + h * 128, 128, kbase, ODD_IN, vbase, ODD_IN, SB, 0.08838834764831845f, sc, qs, o0, o1);
    *(unsigned*)(att + (size_t)t * D + h * 128 + 2 * lane) = pack2(o0, o1);
  }
}

namespace fg {
constexpr int BM = 256, BK = 64, HALF = 128, HTB = HALF * BK * 2, STAGE_BYTES = 8 * HTB;
constexpr int LDS_XCH = STAGE_BYTES, LDS_TAB = STAGE_BYTES + 4096, LDS_ROPE = STAGE_BYTES + 6144, LDS_GAIN = LDS_ROPE + 16384;
DEVI int lds_byte(int r, int c) { const int st = (r >> 4) * 2 + (c >> 5), rr = r & 15, cc = c & 31, ob = rr * 64 + cc * 2; return st * 1024 + (ob ^ (((ob >> 9) & 1) << 5)); }
DEVI void stage_rc(int b, int& R, int& C) { const int st = b / 1024, sb = b % 1024, swz = sb ^ (((sb >> 9) & 1) << 5); R = (st >> 1) * 16 + swz / 64; C = (st & 1) * 32 + (swz % 64) / 2; }
DEVI int perm32(int rho) { const int n = rho >> 4, i = rho & 15; return 8 * (i >> 2) + 4 * n + (i & 3); }
DEVI unsigned cvt_pk_bf16(float lo, float hi) { unsigned r; asm volatile("v_cvt_pk_bf16_f32 %0, %1, %2" : "=v"(r) : "v"(lo), "v"(hi)); return r; }
typedef float f32x2 __attribute__((ext_vector_type(2)));
DEVI f32x2 gelu_pk(f32x2 v) {
  const f32x2 av = __builtin_elementwise_abs(v), d = av * 0.2316418882f + 1.0f;
  f32x2 t; t.x = __builtin_amdgcn_rcpf(d.x); t.y = __builtin_amdgcn_rcpf(d.y);
  f32x2 q = t * 0.5307027145f + (-0.7265760135f); q = q * t + 0.7107068705f; q = q * t + (-0.142248368f); q = q * t + 0.127414796f; q = q * t;
  const f32x2 s = (v * v) * (-0.72134752044f);
  f32x2 e; e.x = __builtin_amdgcn_exp2f(s.x); e.y = __builtin_amdgcn_exp2f(s.y);
  const f32x2 m = v * (q * e), r = v - m;
  f32x2 o; o.x = v.x < 0.f ? m.x : r.x; o.y = v.y < 0.f ? m.y : r.y; return o;
}
struct Unit { const char* A; const char* B0; const char* B1; int pm, pn, e, cnt, off; };
typedef f32x4 Acc[2][2][4][2];
typedef int v8i_t __attribute__((ext_vector_type(8)));
template <int K> DEVI unsigned boff_m1(int R, int C) { return (unsigned)((64 * (R >> 5) + perm32(R & 31)) * K + C) * 2u; }
template <int K> DEVI unsigned boff_m2(int R, int C) { return (unsigned)(((R & ~31) + perm32(R & 31)) * K + C) * 2u; }

template <class Job>
DEVI void gemm_phase(LAS unsigned char* lds, Job& J) {
  constexpr int K = Job::K, nt = K / BK;
  const int tid = ltid(), wid = __builtin_amdgcn_readfirstlane(tid >> 6), lane = tid & 63, wr = wid >> 2, wc = wid & 3, fr = lane & 15, fq = lane >> 4;
  int Rr[2], Cc[2];
#pragma unroll
  for (int i = 0; i < 2; ++i) stage_rc(tid * 16 + i * 8192, Rr[i], Cc[i]);
  unsigned voffB[2];
#pragma unroll
  for (int i = 0; i < 2; ++i) voffB[i] = J.boff(Rr[i], Cc[i]);
  int lraw[2][2] = {{0, 0}, {0, 0}};
  unsigned cv[2][2]; unsigned nv[2][2];
  constexpr size_t AH = Job::GATHER ? 0 : (size_t)HALF * K * 2;
#define CV1 cv[Job::GATHER ? 1 : 0]
  constexpr size_t kstep = (size_t)(BK * 2);
  const unsigned ldsw = (unsigned)wid * 1024u;
  const int aoff = lds_byte(wr * 64 + fr, fq * 8), boff = lds_byte(wc * 32 + fr, fq * 8);
  LAS unsigned char* abase = lds + aoff; LAS unsigned char* bbase = lds + 4 * HTB + boff;
  asm volatile("" : "+v"(abase), "+v"(bbase));
#define FG_SA(b, h) (((b) * 2 + (h)) * HTB)
#define FG_SB(b, h) ((4 + (b) * 2 + (h)) * HTB)
#define FG_STAGE(bufoff, gbase, voff) do { _Pragma("unroll") for (int _i = 0; _i < 2; ++_i) { \
    const unsigned _la = (unsigned)(uintptr_t)(lds + ldsw) + (unsigned)((bufoff) + _i * 8192); const char* _gb = (const char*)(gbase); \
    asm volatile("s_mov_b32 m0, %0\n\ts_nop 0\n\tglobal_load_lds_dwordx4 %1, %2" :: "s"(_la), "v"((voff)[_i]), "s"(_gb) : "memory", "m0"); } } while (0)
#define FG_LDA(dst, b, h) do { _Pragma("unroll") for (int m = 0; m < 4; ++m) _Pragma("unroll") for (int k = 0; k < 2; ++k) dst[m][k] = *(const LAS bf16x8*)(abase + (FG_SA(b, h) + m * 2048 + k * 1024)); } while (0)
#define FG_LDB(dst, b, h) do { _Pragma("unroll") for (int n = 0; n < 2; ++n) _Pragma("unroll") for (int k = 0; k < 2; ++k) dst[n][k] = *(const LAS bf16x8*)(bbase + (FG_SB(b, h) - 4 * HTB + n * 2048 + k * 1024)); } while (0)
#define FG_MMA(ai, bj, At, Bt) do { __builtin_amdgcn_s_setprio(1); _Pragma("unroll") for (int m = 0; m < 4; ++m) _Pragma("unroll") for (int n = 0; n < 2; ++n) _Pragma("unroll") for (int k = 0; k < 2; ++k) \
    acc[ai][bj][m][n] = __builtin_amdgcn_mfma_f32_16x16x32_bf16(Bt[n][k], At[m][k], acc[ai][bj][m][n], 0, 0, 0); __builtin_amdgcn_s_setprio(0); } while (0)
#define FG_MMA8(ai, bj, At, Bt) do { __builtin_amdgcn_s_setprio(1); _Pragma("unroll") for (int m = 0; m < 4; ++m) _Pragma("unroll") for (int n = 0; n < 2; ++n) { \
      v8i_t _b, _a; { const u32x4 b0 = *(const u32x4*)&Bt[n][0], b1 = *(const u32x4*)&Bt[n][1], a0 = *(const u32x4*)&At[m][0], a1 = *(const u32x4*)&At[m][1]; \
        _b = (v8i_t){(int)b0[0], (int)b0[1], (int)b0[2], (int)b0[3], (int)b1[0], (int)b1[1], (int)b1[2], (int)b1[3]}; _a = (v8i_t){(int)a0[0], (int)a0[1], (int)a0[2], (int)a0[3], (int)a1[0], (int)a1[1], (int)a1[2], (int)a1[3]}; } \
      acc[ai][bj][m][n] = __builtin_amdgcn_mfma_scale_f32_16x16x128_f8f6f4(_b, _a, acc[ai][bj][m][n], 0, 0, 0, Job::SCALE, 0, Job::SCALE); } __builtin_amdgcn_s_setprio(0); } while (0)
#define FG_WAIT_V(n) asm volatile("s_waitcnt vmcnt(" #n ")" ::: "memory")
#define FG_WAIT_L(n) asm volatile("s_waitcnt lgkmcnt(" #n ")" ::: "memory")
#define FG_MM(ai, bj, At, Bt) do { if constexpr (Job::FP8) FG_MMA8(ai, bj, At, Bt); else FG_MMA(ai, bj, At, Bt); } while (0)
#define FG_BAR __builtin_amdgcn_s_barrier()
#define FG_SCHED __builtin_amdgcn_sched_barrier(0)
  Unit cur, nxt;
  if (!J.next(cur)) return;
  Acc acc;
#pragma unroll
  for (int a = 0; a < 2; ++a)
#pragma unroll
    for (int b = 0; b < 2; ++b)
#pragma unroll
      for (int m = 0; m < 4; ++m)
#pragma unroll
        for (int n = 0; n < 2; ++n) acc[a][b][m][n] = (f32x4){0.f, 0.f, 0.f, 0.f};
  bf16x8 At[4][2], B0[2][2], B1[2][2];
  J.aoffs(cur, Rr, Cc, cv);
  asm volatile("s_waitcnt vmcnt(0)" ::: "memory");
  FG_STAGE(FG_SB(0, 0), cur.B0, voffB); FG_STAGE(FG_SA(0, 0), cur.A, cv[0]); FG_STAGE(FG_SB(0, 1), cur.B1, voffB); FG_STAGE(FG_SA(0, 1), cur.A + AH, CV1);
  if (wr == 1) FG_BAR;
  FG_WAIT_V(4); FG_BAR;
  FG_STAGE(FG_SB(1, 0), cur.B0 + kstep, voffB); FG_STAGE(FG_SA(1, 0), cur.A + kstep, cv[0]); FG_STAGE(FG_SB(1, 1), cur.B1 + kstep, voffB);
  FG_WAIT_V(6); FG_BAR;
  for (;;) {
    const bool has_next = J.next(nxt);
    const char* nA = has_next ? nxt.A : cur.A; const char* nB0 = has_next ? nxt.B0 : cur.B0; const char* nB1 = has_next ? nxt.B1 : cur.B1;
    for (int t = 0; t < nt; t += 2) {
      const bool last = (t == nt - 2);
      const char* a1 = cur.A + (size_t)(t + 1) * kstep;
      const char* a2 = last ? nA : cur.A + (size_t)(t + 2) * kstep;
      const char* b20 = last ? nB0 : cur.B0 + (size_t)(t + 2) * kstep; const char* b21 = last ? nB1 : cur.B1 + (size_t)(t + 2) * kstep;
      const char* a3 = a2 + kstep; const char* b30 = b20 + kstep; const char* b31 = b21 + kstep;
      asm volatile("" : "+s"(a1), "+s"(a2), "+s"(a3), "+s"(b20), "+s"(b21), "+s"(b30), "+s"(b31));
      if constexpr (Job::GATHER) {
        if constexpr (nt >= 4) { if (t == nt - 4 && has_next) J.aoffs_load(nxt, Rr, lraw); }
        if (last && has_next) { if constexpr (nt < 4) J.aoffs_load(nxt, Rr, lraw); J.aoffs_fin(nxt, lraw, Cc, nv); asm volatile("s_waitcnt vmcnt(0)" ::: "memory"); } }
      FG_LDB(B0, 0, 0); FG_SCHED; FG_LDA(At, 0, 0); FG_STAGE(FG_SA(1, 1), a1 + AH, CV1);
      if constexpr (Job::GATHER) { if (last && has_next) { cv[0][0] = nv[0][0]; cv[0][1] = nv[0][1]; cv[1][0] = nv[1][0]; cv[1][1] = nv[1][1]; } }
      FG_WAIT_L(8); FG_BAR; FG_WAIT_L(0); FG_MM(0, 0, At, B0); FG_BAR; FG_SCHED;
      FG_LDB(B1, 0, 1); FG_STAGE(FG_SB(0, 0), b20, voffB);
      FG_BAR; FG_WAIT_L(0); FG_MM(0, 1, At, B1); FG_BAR;
      FG_LDA(At, 0, 1); FG_STAGE(FG_SA(0, 0), a2, cv[0]);
      FG_BAR; FG_WAIT_L(0); FG_MM(1, 0, At, B0); FG_BAR; FG_SCHED;
      FG_STAGE(FG_SB(0, 1), b21, voffB);
      FG_WAIT_V(6); FG_BAR; FG_MM(1, 1, At, B1); FG_BAR;
      FG_LDB(B0, 1, 0); FG_SCHED; FG_LDA(At, 1, 0); FG_STAGE(FG_SA(0, 1), a2 + AH, CV1);
      FG_WAIT_L(8); FG_BAR; FG_WAIT_L(0); FG_MM(0, 0, At, B0); FG_BAR; FG_SCHED;
      FG_LDB(B1, 1, 1); FG_STAGE(FG_SB(1, 0), b30, voffB);
      FG_BAR; FG_WAIT_L(0); FG_MM(0, 1, At, B1); FG_BAR;
      FG_LDA(At, 1, 1); FG_STAGE(FG_SA(1, 0), a3, cv[0]);
      FG_BAR; FG_WAIT_L(0); FG_MM(1, 0, At, B0); FG_BAR; FG_SCHED;
      FG_STAGE(FG_SB(1, 1), b31, voffB);
      FG_WAIT_V(6); FG_BAR; FG_MM(1, 1, At, B1); FG_BAR;
    }
    if (wr == 0) FG_BAR;
    { int l2; asm volatile("v_mbcnt_lo_u32_b32 %0, -1, 0\n\tv_mbcnt_hi_u32_b32 %0, -1, %0" : "=v"(l2));
      J.epilogue(acc, cur, wr, wc, l2 & 15, l2 >> 4, lds); }
    if (!has_next) break;
#pragma unroll
    for (int a = 0; a < 2; ++a)
#pragma unroll
      for (int b = 0; b < 2; ++b)
#pragma unroll
        for (int m = 0; m < 4; ++m)
#pragma unroll
          for (int n = 0; n < 2; ++n) acc[a][b][m][n] = (f32x4){0.f, 0.f, 0.f, 0.f};
    cur = nxt;
    if (wr == 1) FG_BAR;
  }
  FG_WAIT_V(0);
  FG_BAR;
#undef CV1
#undef FG_SA
#undef FG_SB
#undef FG_STAGE
#undef FG_LDA
#undef FG_LDB
#undef FG_MMA
#undef FG_MMA8
#undef FG_MM
#undef FG_WAIT_V
#undef FG_WAIT_L
#undef FG_BAR
#undef FG_SCHED
}

DEVI bool dense_decode(long L, int nM, int nN, int& pm, int& pn) {
  const int nwg = nM * nN; if (L >= nwg) return false;
  int wgid = (int)L; { const int q = nwg / 8, r = nwg % 8, xcd = wgid % 8, off = wgid / 8; wgid = (xcd < r ? xcd * (q + 1) : r * (q + 1) + (xcd - r) * q) + off; }
  const int nig = 8 * nN, gid = wgid / nig, fm = gid * 8, gsz = (nM - fm) < 8 ? (nM - fm) : 8;
  pm = fm + ((wgid % nig) % gsz); pn = (wgid % nig) / gsz; return true;
}
template <int K> DEVI void dense_aoffs(const int (&Rr)[2], const int (&Cc)[2], unsigned (&v)[2][2]) {
#pragma unroll
  for (int i = 0; i < 2; ++i) { v[0][i] = (unsigned)(Rr[i] * K + Cc[i]) * 2u; v[1][i] = 0u; }
}


struct Slab { LAS unsigned char* w0; LAS unsigned char* wf; LAS unsigned char* r0; };
DEVI Slab slab_init(LAS unsigned char* lds, int wid, int fr, int fq) {
  Slab s; LAS unsigned char* b = lds + 3 * HTB + wid * 1024;
  s.w0 = b + fr * 64 + fq * 16; s.wf = b + (fq >> 1) * 8192 + fr * 64 + (fq & 1) * 32; s.r0 = b + (fq * 16 + fr) * 16; return s; }
DEVI void slab_x16(const Slab& s, u32x4 a, u32x4 b, u32x4& ra, u32x4& rb) { *(LAS u32x4*)s.w0 = a; *(LAS u32x4*)(s.w0 + 8192) = b; ra = *(LAS u32x4*)s.r0; rb = *(LAS u32x4*)(s.r0 + 8192); }
DEVI void slab_x16(const Slab& s, u32x4 a, u32x4& ra) { *(LAS u32x4*)s.w0 = a; ra = *(LAS u32x4*)s.r0; }
DEVI void slab_x32(const Slab& s, f32x4 a, f32x4 b, f32x4& ra, f32x4& rb) { *(LAS f32x4*)s.wf = a; *(LAS f32x4*)(s.wf + 16) = b; ra = *(LAS f32x4*)s.r0; rb = *(LAS f32x4*)(s.r0 + 8192); }

template <int LAYER> struct JobOut {
  static constexpr bool FP8 = LAYER == 0 ? OUT0_FP8 : OUT1_FP8;
  static constexpr int K = FP8 ? D / 2 : D; static constexpr bool GATHER = false;
  static constexpr int SCALE = 0x01010101 * (127 - (WQ_SHIFT + A_SHIFT) / 2); static_assert((WQ_SHIFT + A_SHIFT) % 2 == 0, "");
  const Params& p; int i, c, G;
  DEVI JobOut(const Params& p_) : p(p_), i(0), c(vbid()), G(gridDim.x) {}
  DEVI unsigned boff(int R, int C) const { return boff_m2<K>(R, C); }
  DEVI bool next(Unit& u) {
    for (;;) { int pm, pn; if (!dense_decode((long)i * G + c, T / 256, D / 256, pm, pn)) return false; ++i;
      if (LAYER == 1 && pm % 9 == 0) continue;
      u.pm = pm; u.pn = pn; u.A = (const char*)(p.ws + (FP8 ? OFF_ACT8 : OFF_ACT)) + (size_t)pm * 256 * K * 2;
      u.B0 = (const char*)wsp<bf16_t>(p, LAYER == 0 ? OFF_WOUT0T : OFF_WOUT1T) + (size_t)(256 * pn) * K * 2; u.B1 = u.B0 + (size_t)128 * K * 2; return true; }
  }
  DEVI void aoffs(const Unit&, const int (&Rr)[2], const int (&Cc)[2], unsigned (&v)[2][2]) const { dense_aoffs<K>(Rr, Cc, v); }
  DEVI void epilogue(const Acc& acc, const Unit& u, int wr, int wc, int fr, int fq, LAS unsigned char* lds) const {
    asm volatile("" : "+v"(fr), "+v"(fq));
    const int t0 = u.pm * 256;
    const float* res = in_row(p, t0); bf16_t* dst = wsp<bf16_t>(p, OFF_HB) + (size_t)t0 * D;
    const float* gate = modv(p, LAYER, t0, 2);
    const int col0 = u.pn * 256 + wc * 32 + 8 * fq, lane = fq * 16 + fr;
    const Slab sl = slab_init(lds, wr * 4 + wc, fr, fq);
    const size_t rb = (size_t)(wr * 64 + (lane >> 2)) * D + u.pn * 256 + wc * 32 + 4 * (lane & 3);
    res += rb; dst += rb;
    asm volatile("" : "+v"(res), "+v"(dst));
    f32x4 gv[2][2];
#pragma unroll
    for (int bj = 0; bj < 2; ++bj)
#pragma unroll
      for (int n = 0; n < 2; ++n) gv[bj][n] = *(const f32x4*)(gate + col0 + bj * 128 + 4 * n);
#pragma unroll
    for (int ai = 0; ai < 2; ++ai) {
      f32x4 r4[4][2][2];
#pragma unroll
      for (int m = 0; m < 4; ++m) { const size_t ro = (size_t)(ai * 128 + m * 16) * D;
#pragma unroll
        for (int bj = 0; bj < 2; ++bj) {
          if (LAYER == 0) { r4[m][bj][0] = *(const f32x4*)(res + ro + bj * 128); r4[m][bj][1] = *(const f32x4*)(res + ro + bj * 128 + 16); }
          else { r4[m][bj][0] = bf4(*(const u32x2*)(dst + ro + bj * 128)); r4[m][bj][1] = bf4(*(const u32x2*)(dst + ro + bj * 128 + 16)); } } }
#pragma unroll
      for (int m = 0; m < 4; ++m) { const size_t ro = (size_t)(ai * 128 + m * 16) * D;
#pragma unroll
        for (int bj = 0; bj < 2; ++bj) { f32x4 x0, x1; slab_x32(sl, gv[bj][0] * acc[ai][bj][m][0], gv[bj][1] * acc[ai][bj][m][1], x0, x1);
          x0 += r4[m][bj][0]; x1 += r4[m][bj][1];
          u32x2 w0, w1; w0.x = pack2(x0[0], x0[1]); w0.y = pack2(x0[2], x0[3]); w1.x = pack2(x1[0], x1[1]); w1.y = pack2(x1[2], x1[3]);
          *(u32x2*)(dst + ro + bj * 128) = w0; *(u32x2*)(dst + ro + bj * 128 + 16) = w1; } }
      asm volatile("" ::: "memory"); }
  }
};

DEVI void load_rope_lds(const Params& p, size_t tab_off, int nrope, int gq, int gk, int ng, LAS unsigned char* lds) {
  const int tid = ltid(); __syncthreads();
  const f32x4* src = (const f32x4*)(p.ws + tab_off); LAS f32x4* dst = (LAS f32x4*)(lds + LDS_ROPE);
  for (int i = tid; i < nrope; i += 512) dst[i] = src[i];
  LAS float* g = (LAS float*)(lds + LDS_GAIN);
  if (tid < 2 * ng) g[tid] = tid < ng ? sm(p, gq)[tid] : sm(p, gk)[tid - ng];
  __syncthreads();
}
struct JobIn0 {
  static constexpr int K = IN0_FP8 ? D / 2 : D; static constexpr bool GATHER = false, FP8 = IN0_FP8;
  static constexpr int SCALE = 0x01010101 * (127 - (WQ_SHIFT + X_SHIFT) / 2);
  const Params& p; int i, c, G; int dry;
  DEVI JobIn0(const Params& p_, int dry_ = 0) : p(p_), i(0), c(vbid()), G(gridDim.x), dry(dry_) {}
  DEVI unsigned boff(int R, int C) const { return boff_m1<K>(R, C); }
  DEVI bool next(Unit& u) {
    int pm, pn; if (!dense_decode((long)i * G + c, T / 256, EVEN_IN / 256, pm, pn)) return false; ++i;
    u.pm = pm; u.pn = pn; u.A = (const char*)(p.ws + (IN0_FP8 ? OFF_ACT8 : OFF_ACT)) + (size_t)pm * 256 * K * 2;
    u.B0 = (const char*)wsp<bf16_t>(p, OFF_WIN0T) + (size_t)(256 * pn) * K * 2; u.B1 = u.B0 + (size_t)32 * K * 2; return true;
  }
  DEVI void aoffs(const Unit&, const int (&Rr)[2], const int (&Cc)[2], unsigned (&v)[2][2]) const { dense_aoffs<K>(Rr, Cc, v); }
  DEVI void epilogue(const Acc& acc, const Unit& u, int wr, int wc, int fr, int fq, LAS unsigned char* lds) const {
    asm volatile("" : "+v"(fr), "+v"(fq));
    if (dry == 1) {
#pragma unroll
      for (int ai = 0; ai < 2; ++ai)
#pragma unroll
        for (int bj = 0; bj < 2; ++bj)
#pragma unroll
          for (int m = 0; m < 4; ++m)
#pragma unroll
            for (int n = 0; n < 2; ++n) asm volatile("" :: "v"(acc[ai][bj][m][n]));
      return; }
    const int lane = fq * 16 + fr; const Slab sl = slab_init(lds, wr * 4 + wc, fr, fq);
    bf16_t* outp = wsp<bf16_t>(p, OFF_PROJ) + (size_t)(u.pm * 256 + wr * 64 + (lane >> 2)) * EVEN_IN + u.pn * 256 + wc * 64 + 8 * (lane & 3);
    asm volatile("" : "+v"(outp));
    const int pn = u.pn;
    if (pn < 4) {
#pragma unroll
      for (int ai = 0; ai < 2; ++ai)
#pragma unroll
        for (int m = 0; m < 4; ++m) {
          u32x4 wq[2];
#pragma unroll
          for (int bj = 0; bj < 2; ++bj) { const f32x4 v0 = acc[ai][bj][m][0], v1 = acc[ai][bj][m][1];
            const f32x2 a = gelu_pk((f32x2){v0[0], v0[1]}), b = gelu_pk((f32x2){v0[2], v0[3]}), c2 = gelu_pk((f32x2){v1[0], v1[1]}), d = gelu_pk((f32x2){v1[2], v1[3]});
            u32x4 w; w.x = cvt_pk_bf16(a.x, a.y); w.y = cvt_pk_bf16(b.x, b.y); w.z = cvt_pk_bf16(c2.x, c2.y); w.w = cvt_pk_bf16(d.x, d.y);
            wq[bj] = w; }
          { u32x4 ra, rb; slab_x16(sl, wq[0], wq[1], ra, rb); *(u32x4*)(outp + (size_t)(ai * 128 + m * 16) * EVEN_IN) = ra; *(u32x4*)(outp + (size_t)(ai * 128 + m * 16) * EVEN_IN + 32) = rb; } }
    } else if (pn >= 8 && ATT0_F8) {
      LAS unsigned char* sb = lds + 3 * HTB + (wr * 4 + wc) * 1024;
      const int bb = u.pm / 9, hh = (pn - 8) * 2 + (wc >> 1); const float vs = (float)(1 << VS_SHIFT);
      unsigned char* vt = p.ws + OFF_VT8_0 + ((size_t)((bb * 4 + hh) * 128 + (wc & 1) * 64 + lane)) * SB + (size_t)((u.pm % 9) * 4 + wr) * 64;
      asm volatile("" : "+v"(vt));
#pragma unroll
      for (int ai = 0; ai < 2; ++ai)
#pragma unroll
        for (int m = 0; m < 4; ++m) {
#pragma unroll
          for (int bj = 0; bj < 2; ++bj)
#pragma unroll
            for (int n = 0; n < 2; ++n) { const f32x4 x = acc[ai][bj][m][n];
              const int w01 = __builtin_amdgcn_cvt_pk_fp8_f32(__builtin_amdgcn_fmed3f(x[0] * vs, -440.f, 440.f), __builtin_amdgcn_fmed3f(x[1] * vs, -440.f, 440.f), 0, false);
              const int w23 = __builtin_amdgcn_cvt_pk_fp8_f32(__builtin_amdgcn_fmed3f(x[2] * vs, -440.f, 440.f), __builtin_amdgcn_fmed3f(x[3] * vs, -440.f, 440.f), 0, false);
              LAS unsigned char* d = sb + (32 * bj + 8 * fq + 4 * n) * 16 + fr;
              d[0] = (unsigned char)(w01 & 0xff); d[16] = (unsigned char)((w01 >> 8) & 0xff); d[32] = (unsigned char)(w23 & 0xff); d[48] = (unsigned char)((w23 >> 8) & 0xff); }
          const u32x4 rw = *(LAS u32x4*)(sb + lane * 16);
          unsigned char* dst = vt + ai * 128 + 16 * (m >> 1) + 8 * (m & 1);
          *(u32x2*)dst = (u32x2){rw.x, rw.z}; *(u32x2*)(dst + 32) = (u32x2){rw.y, rw.w};
          asm volatile("" ::: "memory"); }
    } else if (pn >= 8) {
#pragma unroll
      for (int ai = 0; ai < 2; ++ai)
#pragma unroll
        for (int m = 0; m < 4; ++m) {
          u32x4 wq[2];
#pragma unroll
          for (int bj = 0; bj < 2; ++bj) { const f32x4 v0 = acc[ai][bj][m][0], v1 = acc[ai][bj][m][1];
            u32x4 w; w.x = cvt_pk_bf16(v0[0], v0[1]); w.y = cvt_pk_bf16(v0[2], v0[3]); w.z = cvt_pk_bf16(v1[0], v1[1]); w.w = cvt_pk_bf16(v1[2], v1[3]);
            wq[bj] = w; }
          { u32x4 ra, rb; slab_x16(sl, wq[0], wq[1], ra, rb); *(u32x4*)(outp + (size_t)(ai * 128 + m * 16) * EVEN_IN) = ra; *(u32x4*)(outp + (size_t)(ai * 128 + m * 16) * EVEN_IN + 32) = rb; } }
    } else {
      LAS const float* gn = (LAS const float*)(lds + LDS_GAIN) + (pn < 6 ? 0 : 64) + 8 * fq;
      f32x4 g4[2][2];
#pragma unroll
      for (int bj = 0; bj < 2; ++bj)
#pragma unroll
        for (int n = 0; n < 2; ++n) g4[bj][n] = *(LAS const f32x4*)(gn + bj * 32 + 4 * n);
      const int jt = u.pm % 9; const bool lat = jt != 0;
      LAS const f32x4* t64 = (LAS const f32x4*)(lds + LDS_ROPE);
#pragma unroll
      for (int ai = 0; ai < 2; ++ai)
#pragma unroll
        for (int m = 0; m < 4; ++m) {
          f32x4 cs[2][2];
          if (lat) { const int il = (jt - 1) * 256 + ai * 128 + wr * 64 + m * 16 + fr; const int prow = il >> 6, pcol = il & 63;
#pragma unroll
            for (int bj = 0; bj < 2; ++bj)
#pragma unroll
              for (int n = 0; n < 2; ++n) cs[bj][n] = t64[(bj ? pcol : prow) * 8 + 2 * fq + n]; }
          float ss = 0.f;
#pragma unroll
          for (int bj = 0; bj < 2; ++bj)
#pragma unroll
            for (int n = 0; n < 2; ++n) { const f32x4 x = acc[ai][bj][m][n]; ss += (x[0] * x[0] + x[1] * x[1]) + (x[2] * x[2] + x[3] * x[3]); }
          ss += shx<16>(ss); ss = sum32x(ss);
          const float rstd = rsqrtf(ss * (1.0f / 64) + EPS);
          u32x4 wq[2];
#pragma unroll
          for (int bj = 0; bj < 2; ++bj) { f32x4 y[2];
#pragma unroll
            for (int n = 0; n < 2; ++n) { f32x4 x = acc[ai][bj][m][n] * rstd * g4[bj][n];
              if (lat) { const f32x4 c4 = cs[bj][n]; x = (f32x4){x[0] * c4[0] - x[1] * c4[1], x[0] * c4[1] + x[1] * c4[0], x[2] * c4[2] - x[3] * c4[3], x[2] * c4[3] + x[3] * c4[2]}; }
              y[n] = x; }
            if (ATT0_F8) { const float qs = (float)(1 << QS_SHIFT) * (pn < 6 ? 0.125f * 1.4426950408889634f : 1.0f); int lo = 0, hi8 = 0;
#pragma unroll
              for (int n = 0; n < 2; ++n)
#pragma unroll
                for (int j = 0; j < 4; ++j) y[n][j] = __builtin_amdgcn_fmed3f(y[n][j] * qs, -440.f, 440.f);
              lo = __builtin_amdgcn_cvt_pk_fp8_f32(y[0][0], y[0][1], lo, false); lo = __builtin_amdgcn_cvt_pk_fp8_f32(y[0][2], y[0][3], lo, true);
              hi8 = __builtin_amdgcn_cvt_pk_fp8_f32(y[1][0], y[1][1], hi8, false); hi8 = __builtin_amdgcn_cvt_pk_fp8_f32(y[1][2], y[1][3], hi8, true);
              *(LAS u32x2*)(lds + 3 * HTB + (wr * 4 + wc) * 1024 + fr * 64 + bj * 32 + fq * 8) = (u32x2){(unsigned)lo, (unsigned)hi8}; }
            else {
            u32x4 w; w.x = cvt_pk_bf16(y[0][0], y[0][1]); w.y = cvt_pk_bf16(y[0][2], y[0][3]); w.z = cvt_pk_bf16(y[1][0], y[1][1]); w.w = cvt_pk_bf16(y[1][2], y[1][3]);
            wq[bj] = w; } }
          if (ATT0_F8) { const u32x4 rw = *(LAS u32x4*)(lds + 3 * HTB + (wr * 4 + wc) * 1024 + lane * 16);
            *(u32x4*)(p.ws + OFF_QK8_0 + (size_t)(u.pm * 256 + wr * 64 + (lane >> 2) + ai * 128 + m * 16) * 1024 + (pn - 4) * 256 + wc * 64 + 16 * (lane & 3)) = rw; }
          else { u32x4 ra, rb; slab_x16(sl, wq[0], wq[1], ra, rb); *(u32x4*)(outp + (size_t)(ai * 128 + m * 16) * EVEN_IN) = ra; *(u32x4*)(outp + (size_t)(ai * 128 + m * 16) * EVEN_IN + 32) = rb; }
          asm volatile("" ::: "memory");
        }
    }
  }
};

struct JobIn1 {
  static constexpr int K = IN1_FP8 ? D / 2 : D; static constexpr bool GATHER = false, FP8 = IN1_FP8;
  static constexpr int SCALE = 0x01010101 * (127 - (WQ_SHIFT + X_SHIFT) / 2); static_assert((WQ_SHIFT + X_SHIFT) % 2 == 0, "");
  const Params& p; int i, c, G;
  DEVI JobIn1(const Params& p_) : p(p_), i(0), c(vbid()), G(gridDim.x) {}
  DEVI unsigned boff(int R, int C) const { return boff_m1<K>(R, C); }
  DEVI bool next(Unit& u) {
    for (;;) { int pm, pn; if (!dense_decode((long)i * G + c, T / 256, ODD_IN / 256, pm, pn)) return false; ++i;
      if (pm % 9 == 0 && pn < 4) continue;
      u.pm = pm; u.pn = pn; u.A = (const char*)(p.ws + (IN1_FP8 ? OFF_ACT8 : OFF_ACT)) + (size_t)pm * 256 * K * 2;
      u.B0 = (const char*)wsp<bf16_t>(p, OFF_WQKV1T) + (size_t)(256 * pn) * K * 2; u.B1 = u.B0 + (size_t)32 * K * 2; return true; }
  }
  DEVI void aoffs(const Unit&, const int (&Rr)[2], const int (&Cc)[2], unsigned (&v)[2][2]) const { dense_aoffs<K>(Rr, Cc, v); }
  DEVI void epilogue(const Acc& acc, const Unit& u, int wr, int wc, int fr, int fq, LAS unsigned char* lds) const {
    asm volatile("" : "+v"(fr), "+v"(fq));
    const int lane = fq * 16 + fr; const Slab sl = slab_init(lds, wr * 4 + wc, fr, fq);
    int ooff = (u.pm * 256 + wr * 64 + (lane >> 2)) * ODD_IN + u.pn * 256 + wc * 64 + 8 * (lane & 3);
    asm volatile("" : "+v"(ooff));
    bf16_t* outp = wsp<bf16_t>(p, OFF_PROJ) + ooff;
    asm volatile("" : "+v"(outp));
    const int pn = u.pn;
    if (pn == 5 && ATT1_PV8) {
      LAS unsigned char* sb = lds + 3 * HTB + (wr * 4 + wc) * 1024;
      const int bb = u.pm / 9, kvh = wc >> 1; const float vs = (float)(1 << VS_SHIFT);
      unsigned char* vt = p.ws + OFF_VT8 + ((size_t)((bb * 2 + kvh) * 128 + (wc & 1) * 64 + lane)) * SB + (size_t)((u.pm % 9) * 4 + wr) * 64;
      asm volatile("" : "+v"(vt));
#pragma unroll
      for (int ai = 0; ai < 2; ++ai)
#pragma unroll
        for (int m = 0; m < 4; ++m) {
#pragma unroll
          for (int bj = 0; bj < 2; ++bj)
#pragma unroll
            for (int n = 0; n < 2; ++n) { const f32x4 x = acc[ai][bj][m][n];
              const int w01 = __builtin_amdgcn_cvt_pk_fp8_f32(__builtin_amdgcn_fmed3f(x[0] * vs, -440.f, 440.f), __builtin_amdgcn_fmed3f(x[1] * vs, -440.f, 440.f), 0, false);
              const int w23 = __builtin_amdgcn_cvt_pk_fp8_f32(__builtin_amdgcn_fmed3f(x[2] * vs, -440.f, 440.f), __builtin_amdgcn_fmed3f(x[3] * vs, -440.f, 440.f), 0, false);
              LAS unsigned char* d = sb + (32 * bj + 8 * fq + 4 * n) * 16 + fr;
              d[0] = (unsigned char)(w01 & 0xff); d[16] = (unsigned char)((w01 >> 8) & 0xff); d[32] = (unsigned char)(w23 & 0xff); d[48] = (unsigned char)((w23 >> 8) & 0xff); }
          const u32x4 rw = *(LAS u32x4*)(sb + lane * 16);
          unsigned char* dst = vt + ai * 128 + 16 * (m >> 1) + 8 * (m & 1);
          *(u32x2*)dst = (u32x2){rw.x, rw.z}; *(u32x2*)(dst + 32) = (u32x2){rw.y, rw.w};
          asm volatile("" ::: "memory"); }
    } else if (pn == 5) {
#pragma unroll
      for (int ai = 0; ai < 2; ++ai)
#pragma unroll
        for (int m = 0; m < 4; ++m) {
          u32x4 wq[2];
#pragma unroll
          for (int bj = 0; bj < 2; ++bj) { const f32x4 v0 = acc[ai][bj][m][0], v1 = acc[ai][bj][m][1];
            u32x4 w; w.x = cvt_pk_bf16(v0[0], v0[1]); w.y = cvt_pk_bf16(v0[2], v0[3]); w.z = cvt_pk_bf16(v1[0], v1[1]); w.w = cvt_pk_bf16(v1[2], v1[3]);
            wq[bj] = w; }
          { u32x4 ra, rb; slab_x16(sl, wq[0], wq[1], ra, rb); *(u32x4*)(outp + (size_t)(ai * 128 + m * 16) * ODD_IN) = ra; *(u32x4*)(outp + (size_t)(ai * 128 + m * 16) * ODD_IN + 32) = rb; } }
    } else {
      const int wid = wr * 4 + wc;
      LAS float* xw = (LAS float*)(lds + LDS_XCH) + wid * 128 + fr; LAS float* xr = (LAS float*)(lds + LDS_XCH) + (wid ^ 1) * 128 + fr;
      asm volatile("" : "+v"(xw), "+v"(xr));
      float ssr[2][4];
#pragma unroll
      for (int ai = 0; ai < 2; ++ai)
#pragma unroll
        for (int m = 0; m < 4; ++m) { float ss = 0.f;
#pragma unroll
          for (int bj = 0; bj < 2; ++bj)
#pragma unroll
            for (int n = 0; n < 2; ++n) { const f32x4 x = acc[ai][bj][m][n]; ss += (x[0] * x[0] + x[1] * x[1]) + (x[2] * x[2] + x[3] * x[3]); }
          ss += shx<16>(ss); ss = sum32x(ss); ssr[ai][m] = ss;
          if (fq == 0) xw[ai * 64 + m * 16] = ss; }
      asm volatile("s_waitcnt lgkmcnt(0)" ::: "memory"); __builtin_amdgcn_s_barrier(); asm volatile("" ::: "memory");
#pragma unroll
      for (int ai = 0; ai < 2; ++ai)
#pragma unroll
        for (int m = 0; m < 4; ++m) ssr[ai][m] += xr[ai * 64 + m * 16];
      const int hh = wc & 1;
      LAS const float* gn = (LAS const float*)(lds + LDS_GAIN) + (pn < 4 ? 0 : 128) + 64 * hh + 8 * fq;
      asm volatile("" : "+v"(gn));
      const int jt = u.pm % 9; const bool lat = jt != 0;
      LAS const f32x4* t128 = (LAS const f32x4*)(lds + LDS_ROPE);
#pragma unroll
      for (int ai = 0; ai < 2; ++ai)
#pragma unroll
        for (int m = 0; m < 4; ++m) {
          f32x4 g4[2][2];
#pragma unroll
          for (int bj = 0; bj < 2; ++bj)
#pragma unroll
            for (int n = 0; n < 2; ++n) g4[bj][n] = *(LAS const f32x4*)(gn + bj * 32 + 4 * n);
          f32x4 cs[2][2];
          if (lat) { const int il = (jt - 1) * 256 + ai * 128 + wr * 64 + m * 16 + fr; const int pos = hh ? (il & 63) : (il >> 6);
#pragma unroll
            for (int bj = 0; bj < 2; ++bj)
#pragma unroll
              for (int n = 0; n < 2; ++n) cs[bj][n] = t128[pos * 16 + 8 * bj + 2 * fq + n]; }
          const float rstd = rsqrtf(ssr[ai][m] * (1.0f / 128) + EPS);
          u32x4 wq[2];
#pragma unroll
          for (int bj = 0; bj < 2; ++bj) { f32x4 y[2];
#pragma unroll
            for (int n = 0; n < 2; ++n) { f32x4 x = acc[ai][bj][m][n] * rstd * g4[bj][n];
              if (lat) { const f32x4 c4 = cs[bj][n]; x = (f32x4){x[0] * c4[0] - x[1] * c4[1], x[0] * c4[1] + x[1] * c4[0], x[2] * c4[2] - x[3] * c4[3], x[2] * c4[3] + x[3] * c4[2]}; }
              y[n] = x; }
            if (ATT1_QK8) { const float qs = (float)(1 << QS_SHIFT) * (pn < 4 ? 0.08838834764831845f * 1.4426950408889634f : 1.0f); int lo = 0, hi8 = 0;
#pragma unroll
              for (int n = 0; n < 2; ++n)
#pragma unroll
                for (int j = 0; j < 4; ++j) y[n][j] = __builtin_amdgcn_fmed3f(y[n][j] * qs, -440.f, 440.f);
              lo = __builtin_amdgcn_cvt_pk_fp8_f32(y[0][0], y[0][1], lo, false); lo = __builtin_amdgcn_cvt_pk_fp8_f32(y[0][2], y[0][3], lo, true);
              hi8 = __builtin_amdgcn_cvt_pk_fp8_f32(y[1][0], y[1][1], hi8, false); hi8 = __builtin_amdgcn_cvt_pk_fp8_f32(y[1][2], y[1][3], hi8, true);
              *(LAS u32x2*)(lds + 3 * HTB + (wr * 4 + wc) * 1024 + fr * 64 + bj * 32 + fq * 8) = (u32x2){(unsigned)lo, (unsigned)hi8}; }
            else {
            u32x4 w; w.x = cvt_pk_bf16(y[0][0], y[0][1]); w.y = cvt_pk_bf16(y[0][2], y[0][3]); w.z = cvt_pk_bf16(y[1][0], y[1][1]); w.w = cvt_pk_bf16(y[1][2], y[1][3]);
            wq[bj] = w; } }
          if (ATT1_QK8) { const u32x4 rw = *(LAS u32x4*)(lds + 3 * HTB + (wr * 4 + wc) * 1024 + lane * 16);
            *(u32x4*)(p.ws + OFF_QK8 + (size_t)(u.pm * 256 + wr * 64 + (lane >> 2) + ai * 128 + m * 16) * 1280 + pn * 256 + wc * 64 + 16 * (lane & 3)) = rw; }
          else { u32x4 ra, rb; slab_x16(sl, wq[0], wq[1], ra, rb); *(u32x4*)(outp + (size_t)(ai * 128 + m * 16) * ODD_IN) = ra; *(u32x4*)(outp + (size_t)(ai * 128 + m * 16) * ODD_IN + 32) = rb; }
          asm volatile("" ::: "memory");
        }
    }
  }
};

DEVI void moe_tables(const Params& p, const LCfg c, int half, int nN, LAS unsigned char* lds) {
  LAS int* tb = (LAS int*)(lds + LDS_TAB);
  const int tid = ltid();
  __syncthreads();
  if (tid <= NE) tb[tid] = tid < NE ? ((const int*)(p.ws + OFF_CNT))[c.l * 128 + half * 64 + tid] : c.nph;
  __syncthreads();
  if (tid == 0) { int up = 0, off = 0; for (int e = 0; e <= NE; ++e) { const int n = tb[e]; tb[72 + e] = up; tb[144 + e] = off; up += ((n + 255) >> 8) * nN; off += n; } tb[72 + 65] = up; tb[144 + 65] = off; }
  __syncthreads();
}
struct MoeIter {
  int g, gend, step, e;
  int su64, sc64, so64;
  int vu, vun, vc, vo;
  DEVI void init(LAS const int* tb) { const int vb = vbid(); const int U = __builtin_amdgcn_readfirstlane(tb[72 + 65]), chunk = (U + 7) >> 3, x = vb & 7; g = x * chunk + (vb >> 3); gend = (x + 1) * chunk < U ? (x + 1) * chunk : U; step = gridDim.x >> 3; e = 0;
    int lane; asm volatile("v_mbcnt_lo_u32_b32 %0, -1, 0\n\tv_mbcnt_hi_u32_b32 %0, -1, %0" : "=v"(lane));
    vu = tb[72 + lane]; vun = tb[72 + lane + 1]; vc = tb[lane]; vo = tb[144 + lane];
    su64 = __builtin_amdgcn_readfirstlane(tb[72 + 64]); sc64 = __builtin_amdgcn_readfirstlane(tb[64]); so64 = __builtin_amdgcn_readfirstlane(tb[144 + 64]); }
  DEVI bool next(LAS const int* tb, int nN, int& ee, int& mt, int& pn) { if (g >= gend) return false;
    e = __builtin_popcountll(__ballot(vun <= g));
    const int r = g - (e < 64 ? __builtin_amdgcn_readlane(vu, e) : su64); mt = r / nN; pn = r - mt * nN; ee = e; g += step; return true; }
  DEVI int cnt_of(int ee) const { return ee < 64 ? __builtin_amdgcn_readlane(vc, ee) : sc64; }
  DEVI int off_of(int ee) const { return ee < 64 ? __builtin_amdgcn_readlane(vo, ee) : so64; }
};
struct JobGU {
  static constexpr int K = D / 2; static constexpr bool GATHER = true, FP8 = true;
  static constexpr int SCALE = 0x01010101 * (127 - (WG_SHIFT + X_SHIFT) / 2); static_assert((WG_SHIFT + X_SHIFT) % 2 == 0, "");
  const Params& p; const LCfg c; int half; LAS const int* tb; MoeIter it; int dry;
  DEVI JobGU(const Params& p_, const LCfg c_, int half_, LAS unsigned char* lds, int dry_ = 0) : p(p_), c(c_), half(half_), tb((LAS const int*)(lds + LDS_TAB)), dry(dry_) { it.init(tb); }
  DEVI unsigned boff(int R, int C) const { return boff_m2<K>(R, C); }
  DEVI bool next(Unit& u) {
    int e, mt, pn; if (!it.next(tb, 2, e, mt, pn)) return false;
    u.e = e; u.pm = mt; u.pn = pn; u.cnt = it.cnt_of(e); u.off = it.off_of(e); u.A = (const char*)(p.ws + OFF_ACT8);
    const char* w = e < NE ? (const char*)wsp<bf16_t>(p, OFF_EGU) + (size_t)e * 512 * K * 2 : (const char*)wsp<bf16_t>(p, OFF_SHGU) + (size_t)c.l * 512 * K * 2;
    u.B0 = w + (size_t)(128 * pn) * K * 2; u.B1 = w + (size_t)(256 + 128 * pn) * K * 2; return true;
  }
  DEVI void aoffs(const Unit& u, const int (&Rr)[2], const int (&Cc)[2], unsigned (&v)[2][2]) const {
    const int* le = wsp<int>(p, OFF_LIST) + ((size_t)(half * 64 + (u.e < NE ? u.e : 0))) * LCAP;
#pragma unroll
    for (int h = 0; h < 2; ++h)
#pragma unroll
      for (int i = 0; i < 2; ++i) { int r = u.pm * 256 + h * 128 + Rr[i]; r = r < u.cnt ? r : 0;
        int tl = r; if (u.e < NE) tl = le[r] / 6;
        v[h][i] = (unsigned)(act_tok(c, half, tl) * K + Cc[i]) * 2u; }
  }
  DEVI void aoffs_load(const Unit& u, const int (&Rr)[2], int (&raw)[2][2]) const {
    const int* le = wsp<int>(p, OFF_LIST) + ((size_t)(half * 64 + (u.e < NE ? u.e : 0))) * LCAP;
#pragma unroll
    for (int h = 0; h < 2; ++h)
#pragma unroll
      for (int i = 0; i < 2; ++i) { int r = u.pm * 256 + h * 128 + Rr[i]; r = r < u.cnt ? r : 0; raw[h][i] = u.e < NE ? le[r] : r * 6; }
  }
  DEVI void aoffs_fin(const Unit& u, const int (&raw)[2][2], const int (&Cc)[2], unsigned (&v)[2][2]) const {
#pragma unroll
    for (int h = 0; h < 2; ++h)
#pragma unroll
      for (int i = 0; i < 2; ++i) v[h][i] = (unsigned)(act_tok(c, half, raw[h][i] / 6) * K + Cc[i]) * 2u;
  }
  DEVI void epilogue(const Acc& acc, const Unit& u, int wr, int wc, int fr, int fq, LAS unsigned char* lds) const {
    asm volatile("" : "+v"(fr), "+v"(fq));
    if (dry == 1) {
#pragma unroll
      for (int ai = 0; ai < 2; ++ai)
#pragma unroll
        for (int bj = 0; bj < 2; ++bj)
#pragma unroll
          for (int m = 0; m < 4; ++m)
#pragma unroll
            for (int n = 0; n < 2; ++n) asm volatile("" :: "v"(acc[ai][bj][m][n]));
      return; }
    const int lane = fq * 16 + fr;
    LAS unsigned char* sb = lds + 3 * HTB + (wr * 4 + wc) * 1024;
    const int r0 = u.pm * 256 + wr * 64 + (lane >> 2);
    unsigned char* hid = p.ws + OFF_HID + ((size_t)u.off + r0) * DE + u.pn * 128 + wc * 32 + 8 * (lane & 3);
    asm volatile("" : "+v"(hid));
    const float hs = (float)(1 << H_SHIFT);
#pragma unroll
    for (int ai = 0; ai < 2; ++ai)
#pragma unroll
      for (int m = 0; m < 4; ++m) { const int r = r0 + ai * 128 + m * 16;
        float h[8];
#pragma unroll
        for (int n = 0; n < 2; ++n)
#pragma unroll
          for (int j = 0; j < 4; ++j) { const float gg = acc[ai][0][m][n][j]; h[n * 4 + j] = __builtin_amdgcn_fmed3f(gg * __builtin_amdgcn_rcpf(1.0f + __expf(-gg)) * acc[ai][1][m][n][j] * hs, -440.f, 440.f); }
        int lo = 0, hi = 0;
        lo = __builtin_amdgcn_cvt_pk_fp8_f32(h[0], h[1], lo, false); lo = __builtin_amdgcn_cvt_pk_fp8_f32(h[2], h[3], lo, true);
        hi = __builtin_amdgcn_cvt_pk_fp8_f32(h[4], h[5], hi, false); hi = __builtin_amdgcn_cvt_pk_fp8_f32(h[6], h[7], hi, true);
        *(LAS u32x2*)(sb + fr * 32 + fq * 8) = (u32x2){(unsigned)lo, (unsigned)hi};
        const u32x2 rw = *(LAS u32x2*)(sb + lane * 8);
        if (r < u.cnt) *(u32x2*)(hid + (size_t)(ai * 128 + m * 16) * DE) = rw; }
  }
};
struct JobDown {
  static constexpr int K = DE / 2; static constexpr bool GATHER = false, FP8 = true;
  static constexpr int SCALE = 0x01010101 * (127 - (WD_SHIFT + H_SHIFT) / 2); static_assert((WD_SHIFT + H_SHIFT) % 2 == 0, "");
  const Params& p; const LCfg c; int half; LAS const int* tb; MoeIter it; float dscale;
  DEVI JobDown(const Params& p_, const LCfg c_, int half_, LAS unsigned char* lds, float ds = 1.0f) : p(p_), c(c_), half(half_), tb((LAS const int*)(lds + LDS_TAB)), dscale(ds) { it.init(tb); }
  DEVI unsigned boff(int R, int C) const { return boff_m1<K>(R, C); }
  DEVI bool next(Unit& u) {
    int e, mt, pn; if (!it.next(tb, 4, e, mt, pn)) return false;
    u.e = e; u.pm = mt; u.pn = pn; u.cnt = it.cnt_of(e); u.off = it.off_of(e);
    u.A = (const char*)wsp<bf16_t>(p, OFF_HID) + ((size_t)(u.off + mt * 256)) * K * 2;
    const char* w = e < NE ? (const char*)wsp<bf16_t>(p, OFF_ED) + (size_t)e * D * K * 2 : (const char*)wsp<bf16_t>(p, OFF_SHD) + (size_t)c.l * D * K * 2;
    u.B0 = w + (size_t)(256 * pn) * K * 2; u.B1 = u.B0 + (size_t)32 * K * 2; return true;
  }
  DEVI void aoffs(const Unit&, const int (&Rr)[2], const int (&Cc)[2], unsigned (&v)[2][2]) const { dense_aoffs<K>(Rr, Cc, v); }
  DEVI void epilogue(const Acc& acc, const Unit& u, int wr, int wc, int fr, int fq, LAS unsigned char* lds) const {
    asm volatile("" : "+v"(fr), "+v"(fq));
    const int lane = fq * 16 + fr;
    if (dscale < 0.f) {
#pragma unroll
      for (int ai = 0; ai < 2; ++ai)
#pragma unroll
        for (int bj = 0; bj < 2; ++bj)
#pragma unroll
          for (int m = 0; m < 4; ++m)
#pragma unroll
            for (int n = 0; n < 2; ++n) asm volatile("" :: "v"(acc[ai][bj][m][n]));
      return; }
    LAS unsigned char* sb = lds + 3 * HTB + (wr * 4 + wc) * 1024;
    const int r0 = u.pm * 256 + wr * 64 + (lane >> 2);
    unsigned char* slot = p.ws + OFF_SLOT + ((size_t)u.off + r0) * D + u.pn * 256 + wc * 64 + 16 * (lane & 3);
    asm volatile("" : "+v"(slot));
#pragma unroll
    for (int ai = 0; ai < 2; ++ai)
#pragma unroll
      for (int m = 0; m < 4; ++m) {
#pragma unroll
        for (int bj = 0; bj < 2; ++bj) { f32x4 v0 = acc[ai][bj][m][0], v1 = acc[ai][bj][m][1]; int lo = 0, hi = 0;
#pragma unroll
          for (int j = 0; j < 4; ++j) { v0[j] = __builtin_amdgcn_fmed3f(v0[j], -440.f, 440.f); v1[j] = __builtin_amdgcn_fmed3f(v1[j], -440.f, 440.f); }
          lo = __builtin_amdgcn_cvt_pk_fp8_f32(v0[0], v0[1], lo, false); lo = __builtin_amdgcn_cvt_pk_fp8_f32(v0[2], v0[3], lo, true);
          hi = __builtin_amdgcn_cvt_pk_fp8_f32(v1[0], v1[1], hi, false); hi = __builtin_amdgcn_cvt_pk_fp8_f32(v1[2], v1[3], hi, true);
          *(LAS u32x2*)(sb + fr * 64 + bj * 32 + fq * 8) = (u32x2){(unsigned)lo, (unsigned)hi}; }
        const u32x4 rw = *(LAS u32x4*)(sb + lane * 16);
        if (r0 + ai * 128 + m * 16 < u.cnt) *(u32x4*)(slot + (size_t)(ai * 128 + m * 16) * D) = rw; }
  }
};
}
namespace fa {
constexpr int NW = 8, QBLK = 32, KVBLK = 64;
constexpr float THR = 8.f;
constexpr size_t SHM_V = KVBLK * 128 * 2, SHM_K = KVBLK * 128 * 2, SHM_ATTN = 2 * SHM_V + 2 * SHM_K + NW * 64 * 4;
using s16x4 = __attribute__((ext_vector_type(4))) short;
using f32x16 = __attribute__((ext_vector_type(16))) float;
#define KSWZ(row, colB) ((row) * 256 + ((colB) ^ (((row) & 7) << 4)))
#define SBAR() __builtin_amdgcn_sched_barrier(0)
DEVI int crow(int r, int hi) { return (r & 3) + 8 * (r >> 2) + 4 * hi; }
DEVI unsigned cvtpk(float lo, float hi) { unsigned r; asm volatile("v_cvt_pk_bf16_f32 %0, %1, %2" : "=v"(r) : "v"(lo), "v"(hi)); return r; }

template <int SCALE_NUM> struct ScaleC;
DEVI void partialSM(f32x16& p0, f32x16& p1, float& m_reg, float& mn, float& alpha, const float SCALE, const float THRv = THR, const float ebias = 0.f) {
  const float C = SCALE * 1.4426950408889634f;
  float pmax = p0[0];
#pragma unroll
  for (int r = 1; r < 16; ++r) pmax = fmaxf(pmax, p0[r]);
#pragma unroll
  for (int r = 0; r < 16; ++r) pmax = fmaxf(pmax, p1[r]);
  { auto rr = __builtin_amdgcn_permlane32_swap(__float_as_uint(pmax), __float_as_uint(pmax), false, false);
    pmax = fmaxf(__uint_as_float(rr[0]), __uint_as_float(rr[1])); }
  if (__builtin_expect(__all(pmax - m_reg <= THRv / SCALE), 1)) { mn = m_reg; alpha = 1.f; }
  else { mn = fmaxf(m_reg, pmax); alpha = __builtin_amdgcn_exp2f((m_reg - mn) * C); m_reg = mn; }
  float mnC = -mn * C + ebias;
#pragma unroll
  for (int r = 0; r < 16; ++r) p0[r] = fmaf(p0[r], C, mnC);
#pragma unroll
  for (int r = 0; r < 16; ++r) p1[r] = fmaf(p1[r], C, mnC);
#pragma unroll
  for (int r = 0; r < 16; ++r) p0[r] = __builtin_amdgcn_exp2f(p0[r]);
}
DEVI void finishSM(f32x16& p0, f32x16& p1, float alpha, float& l_reg, bf16x8& pa0, bf16x8& pa1, bf16x8& pa2, bf16x8& pa3) {
#pragma unroll
  for (int r = 0; r < 16; ++r) p1[r] = __builtin_amdgcn_exp2f(p1[r]);
  float ps = 0;
#pragma unroll
  for (int r = 0; r < 16; ++r) ps += p0[r];
#pragma unroll
  for (int r = 0; r < 16; ++r) ps += p1[r];
  { auto rr = __builtin_amdgcn_permlane32_swap(__float_as_uint(ps), __float_as_uint(ps), false, false);
    ps = __uint_as_float(rr[0]) + __uint_as_float(rr[1]); }
  l_reg = l_reg * alpha + ps;
#define PK4(P, BASE, OUT) do { unsigned a0 = cvtpk(P[BASE + 0], P[BASE + 1]), a1 = cvtpk(P[BASE + 2], P[BASE + 3]);   \
    unsigned b0 = cvtpk(P[BASE + 4], P[BASE + 5]), b1 = cvtpk(P[BASE + 6], P[BASE + 7]);                              \
    auto r0 = __builtin_amdgcn_permlane32_swap(a0, b0, false, false); auto r1 = __builtin_amdgcn_permlane32_swap(a1, b1, false, false); \
    u32x4 w = {r0[0], r1[0], r0[1], r1[1]}; OUT = *reinterpret_cast<bf16x8*>(&w); } while (0)
  PK4(p0, 0, pa0); PK4(p0, 8, pa1); PK4(p1, 0, pa2); PK4(p1, 8, pa3);
#undef PK4
}
template <int ND0> DEVI void qkt(f32x16& p0, f32x16& p1, const char* Ks, const bf16x8* qr, int r32, int hi, int cbase) {
  p0 = f32x16{}; p1 = f32x16{};
#pragma unroll
  for (int d0 = 0; d0 < ND0; ++d0) { int cb = cbase + (d0 * 16 + hi * 8) * 2;
    bf16x8 b0 = *reinterpret_cast<const bf16x8*>(Ks + KSWZ(r32, cb));
    bf16x8 b1 = *reinterpret_cast<const bf16x8*>(Ks + KSWZ(32 + r32, cb));
    p0 = __builtin_amdgcn_mfma_f32_32x32x16_bf16(b0, qr[d0], p0, 0, 0, 0);
    p1 = __builtin_amdgcn_mfma_f32_32x32x16_bf16(b1, qr[d0], p1, 0, 0, 0); }
}
using fg::v8i_t;
#define K8SWZ(row, chunk) ((row) * 128 + ((((chunk)) ^ (((row) >> 1) & 7)) << 4))
template <int NKS> DEVI void qkt8(f32x16& p0, f32x16& p1, const char* Ks, const v8i_t* q8, int r32, int hi, int cb8, const f32x16& negm) {
  p0 = negm; p1 = negm;
  constexpr int SC = 0x01010101 * (127 - QS_SHIFT);
#pragma unroll
  for (int ks = 0; ks < NKS; ++ks) { const int c0 = cb8 + ks * 4 + hi * 2;
    const u32x4 a0 = *reinterpret_cast<const u32x4*>(Ks + K8SWZ(r32, c0)), a1 = *reinterpret_cast<const u32x4*>(Ks + K8SWZ(r32, c0 + 1));
    const u32x4 b0 = *reinterpret_cast<const u32x4*>(Ks + K8SWZ(32 + r32, c0)), b1 = *reinterpret_cast<const u32x4*>(Ks + K8SWZ(32 + r32, c0 + 1));
    const v8i_t ka = {(int)a0[0], (int)a0[1], (int)a0[2], (int)a0[3], (int)a1[0], (int)a1[1], (int)a1[2], (int)a1[3]};
    const v8i_t kb = {(int)b0[0], (int)b0[1], (int)b0[2], (int)b0[3], (int)b1[0], (int)b1[1], (int)b1[2], (int)b1[3]};
    p0 = __builtin_amdgcn_mfma_scale_f32_32x32x64_f8f6f4(ka, q8[ks], p0, 0, 0, 0, SC, 0, SC);
    p1 = __builtin_amdgcn_mfma_scale_f32_32x32x64_f8f6f4(kb, q8[ks], p1, 0, 0, 0, SC, 0, SC); }
}
constexpr float THR8 = 3.f;
#define VT8SWZ(d, c) ((d) * 64 + ((((c)) ^ (((d) >> 2) & 3)) << 4))
DEVI void partialSM8(f32x16& p0, f32x16& p1, f32x16& negm, float& alpha, const bool first) {
  float pmax = p0[0];
#pragma unroll
  for (int r = 1; r < 16; ++r) pmax = fmaxf(pmax, p0[r]);
#pragma unroll
  for (int r = 0; r < 16; ++r) pmax = fmaxf(pmax, p1[r]);
  { auto rr = __builtin_amdgcn_permlane32_swap(__float_as_uint(pmax), __float_as_uint(pmax), false, false);
    pmax = fmaxf(__uint_as_float(rr[0]), __uint_as_float(rr[1])); }
  const float d = pmax - (float)PS_SHIFT;
  alpha = 1.f;
  if (first || !__all(d <= THR8 * 1.4426950408889634f)) {
    const float delta = first ? d : fmaxf(d, 0.f);
    if (!first) alpha = __builtin_amdgcn_exp2f(-delta);
#pragma unroll
    for (int r = 0; r < 16; ++r) { p0[r] -= delta; p1[r] -= delta; negm[r] -= delta; } }
#pragma unroll
  for (int r = 0; r < 16; ++r) p0[r] = __builtin_amdgcn_exp2f(p0[r]);
}
DEVI void finishSM8(f32x16& p0, f32x16& p1, v8i_t& pa) {
#pragma unroll
  for (int r = 0; r < 16; ++r) p1[r] = __builtin_amdgcn_exp2f(p1[r]);
#pragma unroll
  for (int w = 0; w < 4; ++w) { int a = 0, b = 0;
    a = __builtin_amdgcn_cvt_pk_fp8_f32(p0[4 * w], p0[4 * w + 1], a, false); a = __builtin_amdgcn_cvt_pk_fp8_f32(p0[4 * w + 2], p0[4 * w + 3], a, true);
    b = __builtin_amdgcn_cvt_pk_fp8_f32(p1[4 * w], p1[4 * w + 1], b, false); b = __builtin_amdgcn_cvt_pk_fp8_f32(p1[4 * w + 2], p1[4 * w + 3], b, true);
    pa[w] = a; pa[4 + w] = b; }
}
DEVI void pv8(f32x16* o, f32x16& ol, const char* Vs, const v8i_t pa, int r32, int hi) {
  constexpr int SC = 0x01010101 * (127 - (PS_SHIFT + VS_SHIFT) / 2); static_assert((PS_SHIFT + VS_SHIFT) % 2 == 0, "");
  u32x4 lo[4], hh[4];
#pragma unroll
  for (int d0 = 0; d0 < 4; ++d0) { const int d = d0 * 32 + r32; lo[d0] = *reinterpret_cast<const u32x4*>(Vs + VT8SWZ(d, 2 * hi)); hh[d0] = *reinterpret_cast<const u32x4*>(Vs + VT8SWZ(d, 2 * hi + 1)); }
  asm volatile("s_waitcnt lgkmcnt(0)" ::: "memory"); SBAR();
#pragma unroll
  for (int d0 = 0; d0 < 4; ++d0) { const v8i_t vb = {(int)lo[d0][0], (int)lo[d0][1], (int)lo[d0][2], (int)lo[d0][3], (int)hh[d0][0], (int)hh[d0][1], (int)hh[d0][2], (int)hh[d0][3]};
    o[d0] = __builtin_amdgcn_mfma_scale_f32_32x32x64_f8f6f4(pa, vb, o[d0], 0, 0, 0, SC, 0, SC); }
  const v8i_t ones = {0x38383838, 0x38383838, 0x38383838, 0x38383838, 0x38383838, 0x38383838, 0x38383838, 0x38383838};
  ol = __builtin_amdgcn_mfma_scale_f32_32x32x64_f8f6f4(pa, ones, ol, 0, 0, 0, SC, 0, SC);
}
DEVI int v_st(int k, int c) { const int kk = (k & ~0xC) | ((k & 4) << 1) | ((k & 8) >> 1); return ((kk >> 3) * 4 + (c >> 5)) * 512 + ((kk & 7) * 32 + (c & 31)) * 2; }
DEVI int v_rd_base(int lane) { return ((lane & 3) << 3) | (((lane >> 2) & 3) << 6) | (((lane >> 4) & 1) << 5) | (((lane >> 5) & 1) << 8); }
constexpr int v_rd_off(int d0, int ks, int half) { return d0 * 512 + ks * 4096 + half * 2048; }
template <int OFF> DEVI s16x4 tr_read(int vb) { s16x4 r; asm volatile("ds_read_b64_tr_b16 %0, %1 offset:%2" : "=&v"(r) : "v"(vb), "i"(OFF) : "memory"); return r; }
template <int D0> DEVI void pv_one(f32x16& od, int vb, bf16x8 pa0, bf16x8 pa1, bf16x8 pa2, bf16x8 pa3) {
  const s16x4 l0 = tr_read<v_rd_off(D0, 0, 0)>(vb), h0 = tr_read<v_rd_off(D0, 0, 1)>(vb), l1 = tr_read<v_rd_off(D0, 1, 0)>(vb), h1 = tr_read<v_rd_off(D0, 1, 1)>(vb);
  const s16x4 l2 = tr_read<v_rd_off(D0, 2, 0)>(vb), h2 = tr_read<v_rd_off(D0, 2, 1)>(vb), l3 = tr_read<v_rd_off(D0, 3, 0)>(vb), h3 = tr_read<v_rd_off(D0, 3, 1)>(vb);
  asm volatile("s_waitcnt lgkmcnt(0)" ::: "memory"); SBAR();
#define PK(L, H) (bf16x8){L[0], L[1], L[2], L[3], H[0], H[1], H[2], H[3]}
  od = __builtin_amdgcn_mfma_f32_32x32x16_bf16(pa0, PK(l0, h0), od, 0, 0, 0);
  od = __builtin_amdgcn_mfma_f32_32x32x16_bf16(pa1, PK(l1, h1), od, 0, 0, 0);
  od = __builtin_amdgcn_mfma_f32_32x32x16_bf16(pa2, PK(l2, h2), od, 0, 0, 0);
  od = __builtin_amdgcn_mfma_f32_32x32x16_bf16(pa3, PK(l3, h3), od, 0, 0, 0);
#undef PK
}
DEVI void pv_d0(f32x16* o, int vb, bf16x8 pa0, bf16x8 pa1, bf16x8 pa2, bf16x8 pa3) {
  pv_one<0>(o[0], vb, pa0, pa1, pa2, pa3); pv_one<1>(o[1], vb, pa0, pa1, pa2, pa3); pv_one<2>(o[2], vb, pa0, pa1, pa2, pa3); pv_one<3>(o[3], vb, pa0, pa1, pa2, pa3);
}

template <int ND0, int LD, bool KF8 = false, bool PV8 = false>
DEVI void attn_loop(const bf16_t* __restrict__ Qw, const bf16_t* __restrict__ Kh, const bf16_t* __restrict__ Vh, int seq, char* lds, int kcol_bytes, const float SCALE,
                    f32x16 (&o)[4], float& l_out, f32x16& lsum) {
  const int tid = ltid(), wid = tid >> 6, lane = tid & 63, r32 = lane & 31, hi = lane >> 5;
  char* V_lds = lds; char* K_lds = lds + 2 * SHM_V;
  float* ws = (float*)(lds + 2 * SHM_V + 2 * SHM_K) + wid * 64; float* al_l = ws + 32;
  float m_reg = -1e30f, l_reg = 0; bf16x8 qr[ND0]; v8i_t q8[2];
#pragma unroll
  for (int d = 0; d < 4; ++d) o[d] = f32x16{};
  lsum = f32x16{};
  if constexpr (KF8) {
#pragma unroll
    for (int ks = 0; ks < ND0 / 4; ++ks) q8[ks] = *reinterpret_cast<const v8i_t*>((const unsigned char*)Qw + ks * 64);
  } else {
#pragma unroll
  for (int d0 = 0; d0 < ND0; ++d0) qr[d0] = *reinterpret_cast<const bf16x8*>(Qw + d0 * 16);
  }
  const int sr = tid >> 4, sc = (tid & 15) * 8, vst0 = v_st(sr, sc), vst1 = v_st(32 + sr, sc);
  const int vb0 = (int)(uintptr_t)V_lds + v_rd_base(lane);
  struct { bf16x8 vs0, vs1, ks0, ks1; } sr_[2];
#define SLOAD(i, k0) do { if constexpr (PV8) { sr_[i].vs0 = *reinterpret_cast<const bf16x8*>((const unsigned char*)Vh + (long)(tid >> 2) * SB + (k0) + (tid & 3) * 16); } else { \
    sr_[i].vs0 = *reinterpret_cast<const bf16x8*>(&Vh[(long)((k0) + sr) * LD + sc]); sr_[i].vs1 = *reinterpret_cast<const bf16x8*>(&Vh[(long)((k0) + 32 + sr) * LD + sc]); } \
    if constexpr (KF8) { sr_[i].ks0 = *reinterpret_cast<const bf16x8*>((const unsigned char*)Kh + (long)((k0) + (tid >> 3)) * (ND0 == 8 ? 1280 : 1024) + (tid & 7) * 16); } else { \
    sr_[i].ks0 = *reinterpret_cast<const bf16x8*>(&Kh[(long)((k0) + sr) * LD + sc]); sr_[i].ks1 = *reinterpret_cast<const bf16x8*>(&Kh[(long)((k0) + 32 + sr) * LD + sc]); } } while (0)
#define SWRITE(b, i) do { if constexpr (PV8) { *(bf16x8*)(V_lds + (b) * SHM_V + VT8SWZ(tid >> 2, tid & 3)) = sr_[i].vs0; } else { *(bf16x8*)(V_lds + (b) * SHM_V + vst0) = sr_[i].vs0;          \
    *(bf16x8*)(V_lds + (b) * SHM_V + vst1) = sr_[i].vs1; } int kc = sc * 2;               \
    if constexpr (KF8) { *(bf16x8*)(K_lds + (b) * SHM_K + K8SWZ(tid >> 3, tid & 7)) = sr_[i].ks0; } else { \
    *(bf16x8*)(K_lds + (b) * SHM_K + KSWZ(sr, kc)) = sr_[i].ks0;                       \
    *(bf16x8*)(K_lds + (b) * SHM_K + KSWZ(32 + sr, kc)) = sr_[i].ks1; } } while (0)
#define SWAIT() do { if constexpr (KF8 && PV8) asm volatile("s_waitcnt vmcnt(2)" ::: "memory"); else if constexpr (KF8) asm volatile("s_waitcnt vmcnt(3)" ::: "memory"); else asm volatile("s_waitcnt vmcnt(4)" ::: "memory"); } while (0)
#define FINSM(P0, P1, al) do { if constexpr (PV8) finishSM8(P0, P1, pa8); else finishSM(P0, P1, al, l_reg, pa0, pa1, pa2, pa3); } while (0)
#define PVD(vboff) do { if constexpr (PV8) pv8(o, lsum, V_lds + (vboff), pa8, r32, hi); else pv_d0(o, vb0 + (int)(vboff), pa0, pa1, pa2, pa3); } while (0)
#define PSM(P0, P1, mn, al) do { if constexpr (PV8) partialSM(P0, P1, m_reg, mn, al, SCALE, THR8, (float)PS_SHIFT); else partialSM(P0, P1, m_reg, mn, al, SCALE); } while (0)
#define QKT(P0, P1, KS) do { if constexpr (KF8) qkt8<ND0 / 4>(P0, P1, KS, q8, r32, hi, kcol_bytes >> 5, f32x16{}); else qkt<ND0>(P0, P1, KS, qr, r32, hi, kcol_bytes); } while (0)
#define RESC(a) do { if (__any((a) < 1.f)) { if (hi == 0) al_l[r32] = (a); asm volatile("s_waitcnt lgkmcnt(0)" ::: "memory"); \
    _Pragma("unroll") for (int d = 0; d < 4; ++d) _Pragma("unroll") for (int r = 0; r < 16; ++r) o[d][r] *= al_l[crow(r, hi)]; \
    if constexpr (PV8) { _Pragma("unroll") for (int r = 0; r < 16; ++r) lsum[r] *= al_l[crow(r, hi)]; } } } while (0)
  f32x16 pA0, pA1, pB0, pB1; float mnA, mnB, alA, alB; bf16x8 pa0, pa1, pa2, pa3; v8i_t pa8; const int NT = seq / KVBLK;
  constexpr int SE = 0, SO = 1;
  SLOAD(SE, 0); asm volatile("s_waitcnt vmcnt(0)" ::: "memory"); SWRITE(0, SE); __syncthreads();
  QKT(pA0, pA1, K_lds); PSM(pA0, pA1, mnA, alA);
  SLOAD(SO, KVBLK); if (2 < NT) SLOAD(SE, 2 * KVBLK);
  SWAIT(); SWRITE(1, SO); __syncthreads();
  for (int j = 1; j + 1 < NT; j += 2) {
    SBAR(); QKT(pB0, pB1, K_lds + SHM_K);
    FINSM(pA0, pA1, alA); SBAR();
    SLOAD(SO, (j + 2) * KVBLK); SBAR();
    PVD(0); PSM(pB0, pB1, mnB, alB);
    __syncthreads(); SWAIT(); SWRITE(0, SE);
    RESC(alB); __syncthreads();
    SBAR(); QKT(pA0, pA1, K_lds);
    FINSM(pB0, pB1, alB); SBAR();
    if (j + 3 < NT) SLOAD(SE, (j + 3) * KVBLK); SBAR();
    PVD(SHM_V); PSM(pA0, pA1, mnA, alA);
    __syncthreads(); SWAIT(); SWRITE(1, SO);
    RESC(alA); __syncthreads();
  }
  SBAR(); QKT(pB0, pB1, K_lds + SHM_K);
  FINSM(pA0, pA1, alA); SBAR();
  PVD(0); PSM(pB0, pB1, mnB, alB);
  __syncthreads(); RESC(alB);
  FINSM(pB0, pB1, alB); SBAR();
  PVD(SHM_V);
  asm volatile("s_waitcnt vmcnt(0)" ::: "memory");
  l_out = l_reg;
#undef QKT
#undef FINSM
#undef PVD
#undef PSM
#undef SLOAD
#undef SWRITE
#undef SWAIT
#undef RESC
}

template <int NKS> DEVI void mstep8(f32x16& p0, f32x16& p1, f32x16* o, f32x16& ol, const char* Ks, const char* Vs, const v8i_t* q8, const v8i_t pa, int r32, int hi, int cb8, const f32x16& negm) {
  constexpr int SCQ = 0x01010101 * (127 - QS_SHIFT), SCV = 0x01010101 * (127 - (PS_SHIFT + VS_SHIFT) / 2);
  u32x4 ka[NKS][2], kb[NKS][2], lo[4], hh[4];
#pragma unroll
  for (int ks = 0; ks < NKS; ++ks) { const int c0 = cb8 + ks * 4 + hi * 2;
    ka[ks][0] = *reinterpret_cast<const u32x4*>(Ks + K8SWZ(r32, c0)); ka[ks][1] = *reinterpret_cast<const u32x4*>(Ks + K8SWZ(r32, c0 + 1));
    kb[ks][0] = *reinterpret_cast<const u32x4*>(Ks + K8SWZ(32 + r32, c0)); kb[ks][1] = *reinterpret_cast<const u32x4*>(Ks + K8SWZ(32 + r32, c0 + 1)); }
#pragma unroll
  for (int d0 = 0; d0 < 4; ++d0) { const int d = d0 * 32 + r32; lo[d0] = *reinterpret_cast<const u32x4*>(Vs + VT8SWZ(d, 2 * hi)); hh[d0] = *reinterpret_cast<const u32x4*>(Vs + VT8SWZ(d, 2 * hi + 1)); }
  asm volatile("s_waitcnt lgkmcnt(0)" ::: "memory"); SBAR();
  p0 = negm; p1 = negm;
#pragma unroll
  for (int ks = 0; ks < NKS; ++ks) {
    const v8i_t a = {(int)ka[ks][0][0], (int)ka[ks][0][1], (int)ka[ks][0][2], (int)ka[ks][0][3], (int)ka[ks][1][0], (int)ka[ks][1][1], (int)ka[ks][1][2], (int)ka[ks][1][3]};
    const v8i_t b = {(int)kb[ks][0][0], (int)kb[ks][0][1], (int)kb[ks][0][2], (int)kb[ks][0][3], (int)kb[ks][1][0], (int)kb[ks][1][1], (int)kb[ks][1][2], (int)kb[ks][1][3]};
    p0 = __builtin_amdgcn_mfma_scale_f32_32x32x64_f8f6f4(a, q8[ks], p0, 0, 0, 0, SCQ, 0, SCQ);
    p1 = __builtin_amdgcn_mfma_scale_f32_32x32x64_f8f6f4(b, q8[ks], p1, 0, 0, 0, SCQ, 0, SCQ); }
#pragma unroll
  for (int d0 = 0; d0 < 4; ++d0) { const v8i_t vb = {(int)lo[d0][0], (int)lo[d0][1], (int)lo[d0][2], (int)lo[d0][3], (int)hh[d0][0], (int)hh[d0][1], (int)hh[d0][2], (int)hh[d0][3]};
    o[d0] = __builtin_amdgcn_mfma_scale_f32_32x32x64_f8f6f4(pa, vb, o[d0], 0, 0, 0, SCV, 0, SCV); }
  int one4 = 0x38383838; asm volatile("" : "+v"(one4));
  const v8i_t ones = {one4, one4, one4, one4, one4, one4, one4, one4};
  ol = __builtin_amdgcn_mfma_scale_f32_32x32x64_f8f6f4(pa, ones, ol, 0, 0, 0, SCV, 0, SCV);
  SBAR();
}

template <int ND0>
DEVI void attn_loop8(const unsigned char* __restrict__ Qw, const unsigned char* __restrict__ Kh, const unsigned char* __restrict__ Vh, int seq, char* lds, int cb8, const float SCALE,
                     f32x16 (&o)[4], f32x16& lsum) {
  constexpr int LDK = ND0 == 8 ? 1280 : 1024, NKS = ND0 / 4, SLOT = 16384;
  const int tid = ltid(), wid = __builtin_amdgcn_readfirstlane(tid >> 6), lane = tid & 63, r32 = lane & 31, hi = lane >> 5;
  float* al_l = (float*)(lds + 4 * SLOT) + wid * 64 + 32;
  float m_reg = -1e30f; v8i_t q8[NKS];
#pragma unroll
  for (int d = 0; d < 4; ++d) o[d] = f32x16{};
  lsum = f32x16{};
#pragma unroll
  for (int ks = 0; ks < NKS; ++ks) q8[ks] = *reinterpret_cast<const v8i_t*>(Qw + ks * 64);
  const unsigned kso = (unsigned)((tid >> 3) * LDK + (((tid & 7) ^ ((tid >> 4) & 7)) << 4));
  const unsigned vso = (unsigned)((tid >> 2) * SB + (((tid & 3) ^ ((tid >> 4) & 3)) << 4));
  const unsigned ldsK = (unsigned)(uintptr_t)lds + (unsigned)wid * 1024u;
#define DMA8(t) do { const unsigned la_ = ldsK + (unsigned)(((t) & 3) * SLOT); const unsigned char* kb_ = Kh + (size_t)(t) * (KVBLK * LDK); const unsigned char* vb_ = Vh + (size_t)(t) * KVBLK; \
    asm volatile("s_mov_b32 m0, %0\n\ts_nop 0\n\tglobal_load_lds_dwordx4 %1, %2" :: "s"(la_), "v"(kso), "s"(kb_) : "memory", "m0"); \
    asm volatile("s_mov_b32 m0, %0\n\ts_nop 0\n\tglobal_load_lds_dwordx4 %1, %2" :: "s"(la_ + 8192u), "v"(vso), "s"(vb_) : "memory", "m0"); } while (0)
#define RESC8(a) do { if (__any((a) < 1.f)) { if (hi == 0) al_l[r32] = (a); asm volatile("s_waitcnt lgkmcnt(0)" ::: "memory"); \
    _Pragma("unroll") for (int d = 0; d < 4; ++d) _Pragma("unroll") for (int r = 0; r < 16; ++r) o[d][r] *= al_l[crow(r, hi)]; \
    _Pragma("unroll") for (int r = 0; r < 16; ++r) lsum[r] *= al_l[crow(r, hi)]; } } while (0)
#define BAR8() do { asm volatile("s_waitcnt lgkmcnt(0)" ::: "memory"); __builtin_amdgcn_s_barrier(); asm volatile("" ::: "memory"); } while (0)
  f32x16 p0, p1; v8i_t pa8; float al_; const int NT = seq / KVBLK; const int half = wid >> 2;
  f32x16 negm; { float z = (float)PS_SHIFT; asm volatile("" : "+v"(z));
#pragma unroll
    for (int r = 0; r < 16; ++r) negm[r] = z; }
  DMA8(0); DMA8(1);
  asm volatile("s_waitcnt vmcnt(2)" ::: "memory");
  if (half == 1) BAR8();
  BAR8();
  SBAR(); qkt8<NKS>(p0, p1, lds, q8, r32, hi, cb8, negm);
  if (2 < NT) { DMA8(2); asm volatile("s_waitcnt vmcnt(2)" ::: "memory"); } else asm volatile("s_waitcnt vmcnt(0)" ::: "memory");
  BAR8();
  for (int t = 0; t < NT; ++t) {
    partialSM8(p0, p1, negm, al_, t == 0); finishSM8(p0, p1, pa8); RESC8(al_);
    BAR8();
    SBAR();
    if (t + 1 < NT) { if (t + 3 < NT) DMA8(t + 3);
      mstep8<NKS>(p0, p1, o, lsum, lds + ((t + 1) & 3) * SLOT, lds + (t & 3) * SLOT + 8192, q8, pa8, r32, hi, cb8, negm); }
    else pv8(o, lsum, lds + (t & 3) * SLOT + 8192, pa8, r32, hi);
    if (t + 1 < NT) { if (t + 3 < NT) asm volatile("s_waitcnt vmcnt(2)" ::: "memory"); else asm volatile("s_waitcnt vmcnt(0)" ::: "memory"); }
    BAR8();
  }
  if (half == 0) BAR8();
#undef BAR8
#undef DMA8
#undef RESC8
}

DEVI void store_tile_bf16(const f32x16 (&o)[4], const float (&scl)[16], bf16_t* Ow, int ldo, int r32, int hi) {
#pragma unroll
  for (int d0 = 0; d0 < 4; ++d0)
#pragma unroll
    for (int r = 0; r < 16; r += 2) {
      const float va = o[d0][r] * scl[r], vb = o[d0][r + 1] * scl[r + 1];
      const float snd = (r32 & 1) ? va : vb; const float got = shx<1>(snd);
      const int row = (r32 & 1) ? crow(r + 1, hi) : crow(r, hi); const int col = d0 * 32 + (r32 & ~1);
      const unsigned w = (r32 & 1) ? cvtpk(got, vb) : cvtpk(va, got);
      *(unsigned*)(Ow + (long)row * ldo + col) = w; }
}

DEVI void store_tile_fp8(const f32x16 (&o)[4], const float (&scl)[16], unsigned char* Ow, int ldo, int r32, int hi, const float xs) {
  const int q = r32 & 3; const bool b0 = q & 1, b1 = q & 2;
#pragma unroll
  for (int d0 = 0; d0 < 4; ++d0)
#pragma unroll
    for (int r4 = 0; r4 < 16; r4 += 4) {
      float v[4];
#pragma unroll
      for (int kk = 0; kk < 4; ++kk) v[kk] = __builtin_amdgcn_fmed3f(o[d0][r4 + kk] * scl[r4 + kk] * xs, -440.f, 440.f);
      const float gA = shx<1>(b0 ? v[0] : v[1]), gB = shx<1>(b0 ? v[2] : v[3]);
      const float aLo = b0 ? gA : v[0], aHi = b0 ? v[1] : gA;
      const float bLo = b0 ? gB : v[2], bHi = b0 ? v[3] : gB;
      const int pA = __builtin_amdgcn_cvt_pk_fp8_f32(aLo, aHi, 0, false) & 0xffff, pB = __builtin_amdgcn_cvt_pk_fp8_f32(bLo, bHi, 0, false) & 0xffff;
      const int got = __float_as_int(shx<2>(__int_as_float(b1 ? pA : pB))) & 0xffff;
      const unsigned w = b1 ? ((unsigned)got | ((unsigned)pB << 16)) : ((unsigned)pA | ((unsigned)got << 16));
      *(unsigned*)(Ow + (long)crow(r4 + q, hi) * ldo + d0 * 32 + (r32 & ~3)) = w; }
}

DEVI void phase_attn1(const Params& p, const PrepIn& pin, unsigned char* smem) {
  const bf16_t* qkv = wsp<bf16_t>(p, OFF_PROJ); bf16_t* att = wsp<bf16_t>(p, OFF_ACT);
  const int vb_ = vbid(); const int xcd = vb_ & 7, slot = vb_ >> 3, nslot = gridDim.x >> 3;
  for (int it = slot; it < 4 * 32; it += nslot) {
    int tid = ltid(); asm volatile("" : "+v"(tid));
    const int wid = tid >> 6, lane = tid & 63, r32 = lane & 31, hi = lane >> 5;
    float* li_l = (float*)((char*)smem + 2 * SHM_V + 2 * SHM_K) + wid * 64;
    const int g = xcd + 8 * (it >> 5), item = it & 31, b = g >> 1, kvh = g & 1, h = kvh * 4 + (item >> 3), qb = item & 7;
    const bf16_t* Qb = qkv + (size_t)(b * SB + NC + qb * 256) * ODD_IN + h * 128;
    const bf16_t* Kh = qkv + (size_t)(b * SB) * ODD_IN + 1024 + kvh * 128; const bf16_t* Vh = Kh + 256;
    const unsigned char* Q8 = p.ws + OFF_QK8 + (size_t)(b * SB + NC + qb * 256) * 1280 + h * 128; const unsigned char* K8 = p.ws + OFF_QK8 + (size_t)(b * SB) * 1280 + 1024 + kvh * 128;
    f32x16 o[4]; float l; f32x16 ls;
    __syncthreads();
    if constexpr (ATT1_QK8 && ATT1_PV8) attn_loop8<8>(Q8 + (long)(wid * QBLK + r32) * 1280 + hi * 32, K8, p.ws + OFF_VT8 + (size_t)((b * 2 + kvh) * 128) * SB, SB, (char*)smem, 0, 0.08838834764831845f, o, ls);
    else if constexpr (ATT1_QK8) attn_loop<8, ODD_IN, true>((const bf16_t*)(Q8 + (long)(wid * QBLK + r32) * 1280 + hi * 32), (const bf16_t*)K8, Vh, SB, (char*)smem, 0, 0.08838834764831845f, o, l, ls);
    else attn_loop<8, ODD_IN>(Qb + (long)(wid * QBLK + r32) * ODD_IN + hi * 8, Kh, Vh, SB, (char*)smem, 0, 0.08838834764831845f, o, l, ls);
    float rli[16];
    if constexpr (ATT1_QK8 && ATT1_PV8) {
#pragma unroll
      for (int r = 0; r < 16; ++r) rli[r] = __builtin_amdgcn_rcpf(ls[r] * (float)(1 << VS_SHIFT));
    } else {
    if (hi == 0) li_l[r32] = l; asm volatile("s_waitcnt lgkmcnt(0)" ::: "memory");
#pragma unroll
    for (int r = 0; r < 16; ++r) rli[r] = __builtin_amdgcn_rcpf(li_l[crow(r, hi)]);
    }
    if (OUT1_FP8) store_tile_fp8(o, rli, p.ws + OFF_ACT8 + (size_t)(b * SB + NC + qb * 256 + wid * QBLK) * D + h * 128, D, r32, hi, (float)(1 << A_SHIFT));
    else store_tile_bf16(o, rli, att + (size_t)(b * SB + NC + qb * 256 + wid * QBLK) * D + h * 128, D, r32, hi);
  }
}

DEVI void phase_attn0(const Params& p, const PrepIn& pin, unsigned char* smem) {
  const bf16_t* proj = wsp<bf16_t>(p, OFF_PROJ); bf16_t* cat = wsp<bf16_t>(p, OFF_ACT);
  const int vb_ = vbid(); const int xcd = vb_ & 7, slot = vb_ >> 3, nslot = gridDim.x >> 3;
  const float lam = wsp<float>(p, OFF_LAM)[0];
  const float* subln = sm(p, SM_SUBLN);
  for (int it = slot; it < 8 * 18; it += nslot) {
    int tid = ltid(); asm volatile("" : "+v"(tid));
    const int wid = tid >> 6, lane = tid & 63, r32 = lane & 31, hi = lane >> 5, mp = wid >> 2, w4 = wid & 3;
    float* li_l = (float*)((char*)smem + 2 * SHM_V + 2 * SHM_K) + wid * 64;
    float* ex = (float*)smem + (size_t)w4 * 4096 + lane;
    int g, qrow0, seq;
    if (it < 128) { g = xcd + 8 * (it >> 4); qrow0 = NC + (it & 15) * 128; seq = SB; }
    else { const int j = it - 128; g = xcd + 8 * (j >> 1); qrow0 = (j & 1) * 128; seq = NC; }
    const int b = g >> 2, h = g & 3;
    const bf16_t* Qw = proj + (size_t)(b * SB + qrow0 + w4 * QBLK + r32) * EVEN_IN + 1024 + h * 128 + mp * 64 + hi * 8;
    const bf16_t* Kh = proj + (size_t)(b * SB) * EVEN_IN + 1536 + h * 128; const bf16_t* Vh = Kh + 512;
    f32x16 o[4]; float l; f32x16 ls;
    __syncthreads();
    if constexpr (ATT0_F8) attn_loop8<4>(p.ws + OFF_QK8_0 + (size_t)(b * SB + qrow0 + w4 * QBLK + r32) * 1024 + h * 128 + mp * 64 + hi * 32,
                                         p.ws + OFF_QK8_0 + (size_t)(b * SB) * 1024 + 512 + h * 128, p.ws + OFF_VT8_0 + (size_t)((b * 4 + h) * 128) * SB,
                                         seq, (char*)smem, mp * 4, 0.125f, o, ls);
    else attn_loop<4, EVEN_IN>(Qw, Kh, Vh, seq, (char*)smem, mp * 128, 0.125f, o, l, ls);
    float rli[16];
    if constexpr (ATT0_F8) {
#pragma unroll
      for (int r = 0; r < 16; ++r) rli[r] = __builtin_amdgcn_rcpf(ls[r] * (float)(1 << VS_SHIFT));
    } else {
    if (hi == 0) li_l[r32] = l; asm volatile("s_waitcnt lgkmcnt(0)" ::: "memory");
#pragma unroll
    for (int r = 0; r < 16; ++r) rli[r] = __builtin_amdgcn_rcpf(li_l[crow(r, hi)]);
    }
    __syncthreads();
    if (mp == 1) {
#pragma unroll
      for (int d0 = 0; d0 < 4; ++d0)
#pragma unroll
        for (int r = 0; r < 16; ++r) ex[(d0 * 16 + r) * 64] = o[d0][r] * rli[r];
    }
    __syncthreads();
    if (mp == 0) {
      float ss[16];
#pragma unroll
      for (int r = 0; r < 16; ++r) ss[r] = 0.f;
#pragma unroll
      for (int d0 = 0; d0 < 4; ++d0) { const float gcol = subln[d0 * 32 + r32];
#pragma unroll
        for (int r = 0; r < 16; ++r) { const float dv = o[d0][r] * rli[r] - lam * ex[(d0 * 16 + r) * 64]; ss[r] += dv * dv; o[d0][r] = dv * gcol; } }
#pragma unroll
      for (int r = 0; r < 16; ++r) { float v = ss[r];
        v += shx<1>(v); v += shx<2>(v); v += shx<4>(v); v += shx<8>(v); v += shx<16>(v);
        ss[r] = rsqrtf(v * (1.0f / 128) + EPS) * 0.8f; }
      if (OUT0_FP8) store_tile_fp8(o, ss, p.ws + OFF_ACT8 + (size_t)(b * SB + qrow0 + w4 * QBLK) * D + 512 + h * 128, D, r32, hi, (float)(1 << A_SHIFT));
      else store_tile_bf16(o, ss, cat + (size_t)(b * SB + qrow0 + w4 * QBLK) * D + 512 + h * 128, D, r32, hi);
    }
  }
}

DEVI void phase_gmlp(const Params& p, unsigned char* smem) {
  const bf16_t* proj = wsp<bf16_t>(p, OFF_PROJ); bf16_t* cat = wsp<bf16_t>(p, OFF_ACT); const bf16_t* wsa = wsp<bf16_t>(p, OFF_WSA);
  const float* lng = sm(p, SM_ALNG); const float* lnb = sm(p, SM_ALNB); const float* abs_ = sm(p, SM_ABS);
  for (int it = blockIdx.x; it < (T / 128 + 1) / 2; it += gridDim.x) {
    const int tid = ltid(), hf = tid >> 8, ht = tid & 255, wl = ht >> 6, lane = tid & 63, fr = lane & 15, fq = lane >> 4;
    bf16_t* Tl = (bf16_t*)(smem + hf * 36864);
    const int ch = it * 2 + hf; const bool live = ch < T / 128; const int t0 = (live ? ch : 0) * 128;
    const int q = ht >> 1, part = ht & 1;
    u32x4 xc[8];
    { const bf16_t* vg = proj + (size_t)(t0 + q) * EVEN_IN + 512 + part * 64;
#pragma unroll
      for (int i = 0; i < 8; ++i) xc[i] = *(const u32x4*)(vg + i * 8); }
    float mu, rstd;
    { const bf16_t* vr = proj + (size_t)(t0 + q) * EVEN_IN + 512 + part * 256;
      float s = 0.f, s2 = 0.f;
#pragma unroll
      for (int i = 0; i < 32; ++i) { const u32x4 x = *(const u32x4*)(vr + i * 8);
#pragma unroll
        for (int e = 0; e < 4; ++e) { const float f0 = __uint_as_float(x[e] << 16), f1 = __uint_as_float(x[e] & 0xffff0000u); s += f0 + f1; s2 += f0 * f0 + f1 * f1; } }
      s += shx<1>(s); s2 += shx<1>(s2);
      mu = s * (1.0f / 512); rstd = rsqrtf(fmaxf(s2 * (1.0f / 512) - mu * mu, 0.f) + EPS); }
    for (int g = 0; g < 4; ++g) {
      bf16x8 af[2][4];
#pragma unroll
      for (int m = 0; m < 2; ++m)
#pragma unroll
        for (int k = 0; k < 4; ++k) af[m][k] = *(const bf16x8*)(wsa + (size_t)(g * 128 + wl * 32 + m * 16 + fr) * 128 + k * 32 + fq * 8);
      __syncthreads();
      {
#pragma unroll
        for (int i = 0; i < 8; ++i) { const u32x4 x = xc[i]; const int d0 = part * 64 + i * 8;
          const f32x4 ga = *(const f32x4*)(lng + g * 128 + d0), gb = *(const f32x4*)(lng + g * 128 + d0 + 4), ba = *(const f32x4*)(lnb + g * 128 + d0), bb = *(const f32x4*)(lnb + g * 128 + d0 + 4);
#pragma unroll
          for (int e = 0; e < 4; ++e) { const float f0 = __uint_as_float(x[e] << 16), f1 = __uint_as_float(x[e] & 0xffff0000u);
            const float gg0 = e < 2 ? ga[2 * e] : gb[2 * e - 4], gg1 = e < 2 ? ga[2 * e + 1] : gb[2 * e - 3], bb0 = e < 2 ? ba[2 * e] : bb[2 * e - 4], bb1 = e < 2 ? ba[2 * e + 1] : bb[2 * e - 3];
            const unsigned w = cvtpk((f0 - mu) * rstd * gg0 + bb0, (f1 - mu) * rstd * gg1 + bb1);
            Tl[(d0 + 2 * e) * 136 + q] = (bf16_t)(w & 0xffff); Tl[(d0 + 2 * e + 1) * 136 + q] = (bf16_t)(w >> 16); } }
      }
      __syncthreads();
      if (g < 3) { const bf16_t* vg = proj + (size_t)(t0 + q) * EVEN_IN + 512 + (g + 1) * 128 + part * 64;
#pragma unroll
        for (int i = 0; i < 8; ++i) xc[i] = *(const u32x4*)(vg + i * 8); }
      u32x2 uuv[2][8];
#pragma unroll
      for (int m = 0; m < 2; ++m)
#pragma unroll
        for (int n = 0; n < 8; ++n) uuv[m][n] = *(const u32x2*)(proj + ((size_t)t0 + wl * 32 + m * 16 + fr) * EVEN_IN + g * 128 + 16 * n + 4 * fq);
      f32x4 acc[2][8];
#pragma unroll
      for (int m = 0; m < 2; ++m)
#pragma unroll
        for (int n = 0; n < 8; ++n) acc[m][n] = (f32x4){0.f, 0.f, 0.f, 0.f};
#pragma unroll
      for (int k = 0; k < 4; ++k)
#pragma unroll
        for (int n = 0; n < 8; ++n) { const bf16x8 bfr = *(const bf16x8*)(Tl + (16 * n + fr) * 136 + k * 32 + fq * 8);
          acc[0][n] = __builtin_amdgcn_mfma_f32_16x16x32_bf16(bfr, af[0][k], acc[0][n], 0, 0, 0);
          acc[1][n] = __builtin_amdgcn_mfma_f32_16x16x32_bf16(bfr, af[1][k], acc[1][n], 0, 0, 0); }
      if (live) {
#pragma unroll
        for (int m = 0; m < 2; ++m) { const int pp = wl * 32 + m * 16 + fr; const size_t t = (size_t)t0 + pp; const float bias = abs_[g * 128 + pp];
#pragma unroll
          for (int n = 0; n < 8; ++n) { const int c = g * 128 + 16 * n + 4 * fq;
            const u32x2 uu = uuv[m][n];
            const float o0 = __uint_as_float(uu.x << 16) * (acc[m][n][0] + bias), o1 = __uint_as_float(uu.x & 0xffff0000u) * (acc[m][n][1] + bias);
            const float o2 = __uint_as_float(uu.y << 16) * (acc[m][n][2] + bias), o3 = __uint_as_float(uu.y & 0xffff0000u) * (acc[m][n][3] + bias);
            if (OUT0_FP8) { const float xs = (float)(1 << A_SHIFT); int w8 = 0;
              w8 = __builtin_amdgcn_cvt_pk_fp8_f32(__builtin_amdgcn_fmed3f(o0 * xs, -440.f, 440.f), __builtin_amdgcn_fmed3f(o1 * xs, -440.f, 440.f), w8, false);
              w8 = __builtin_amdgcn_cvt_pk_fp8_f32(__builtin_amdgcn_fmed3f(o2 * xs, -440.f, 440.f), __builtin_amdgcn_fmed3f(o3 * xs, -440.f, 440.f), w8, true);
              *(int*)(p.ws + OFF_ACT8 + t * D + c) = w8; }
            else { u32x2 w; w.x = cvtpk(o0, o1); w.y = cvtpk(o2, o3);
              *(u32x2*)(cat + t * D + c) = w; } } }
      }
    }
  }
}
#undef KSWZ
#undef SBAR
}
#define REP_PREP 1
#define REP_NORM1 1
#define REP_IN0 1
#define REP_ATT0 1
#define REP_GMLP 1
#define REP_OUT0 1
#define REP_GU 1
#define REP_IN1 1
#define REP_ATT1 1
#define REP_SYNC 0
#define DRY_IN0 0
#define DRY_DOWN 0
#define DRY_GU 0
#define REP_ROUTER 1
#define REP_DOWN 1
#define REP_COMB 1
#define REPEAT(n, stmt) { int _n = (n); if ((n) > 1) asm volatile("" : "+s"(_n)); for (int _r = 0; _r < _n; ++_r) { stmt; if (_r + 1 < _n) GSYNC(); } }
__global__ __launch_bounds__(512) void mega(Params p0, PrepIn pin) {
  cg::grid_group grid = cg::this_grid();
  LAS unsigned char* lds = (LAS unsigned char*)smem;
  volatile LAS unsigned* xst = (volatile LAS unsigned*)(lds + SMEM_BYTES - 16);
  if (threadIdx.x == 0) { xst[0] = 0u; xst[1] = 0u; }
  ltid_init();
  XcdBarrier xb = xcd_barrier_post((unsigned*)(p0.ws + OFF_ZERO), xst);
  if (threadIdx.x == 0) { volatile LAS int* vbp = (volatile LAS int*)(lds + LDS_VBID); vbp[0] = (int)blockIdx.x;
    vbp[1] = (int)xb_add((unsigned*)(p0.ws + OFF_XRANK) + xb.x, 1u); }
#define GSYNC() xcd_barrier(xb)
#define ROUTER(c) { int _n = REP_ROUTER; if (REP_ROUTER > 1) asm volatile("" : "+s"(_n)); for (int _r = 0; _r < _n; ++_r) { \
      if (_r > 0) { if (blockIdx.x == 0 && threadIdx.x < 128) ((int*)(p0.ws + OFF_CNT))[c.l * 128 + threadIdx.x] = 0; GSYNC(); } \
      stage_router(launder(p0), c, smem); if (_r + 1 < _n) GSYNC(); } }
#define MOE_HALF(c, half, FUSE) do { \
    REPEAT(REP_GU, { const Params pl = launder(p0); fg::moe_tables(pl, c, half, 2, lds); int dry = (DRY_GU && _r > 0) ? DRY_GU : 0; if (DRY_GU) { asm volatile("" : "+v"(dry)); dry = __builtin_amdgcn_readfirstlane(dry); } fg::JobGU J(pl, c, half, lds, dry); fg::gemm_phase(lds, J); }) \
    GSYNC(); \
    { int _n = REP_DOWN; if (REP_DOWN > 1) asm volatile("" : "+s"(_n)); for (int _r = 0; _r < _n; ++_r) { float ds = _r == 0 ? 1.0f : (DRY_DOWN ? -1.0f : 0.0f); if (REP_DOWN > 1) { asm volatile("" : "+v"(ds)); ds = __int_as_float(__builtin_amdgcn_readfirstlane(__float_as_int(ds))); } \
        const Params pl = launder(p0); fg::moe_tables(pl, c, half, 4, lds); fg::JobDown J(pl, c, half, lds, ds); fg::gemm_phase(lds, J); if (_r + 1 < _n) GSYNC(); } } \
    GSYNC(); \
    { int _n = REP_COMB; if (REP_COMB > 1) asm volatile("" : "+s"(_n)); for (int _r = 0; _r < _n; ++_r) { float ds = _r == 0 ? 1.0f : 0.0f; if (REP_COMB > 1) asm volatile("" : "+v"(ds)); \
        stage_combine<FUSE>(launder(p0), c, half, smem, ds); if (_r + 1 < _n) GSYNC(); } } \
    } while (0)
  for (int _r = 0; _r < REP_PREP; ++_r) { stage_prep(p0, pin, smem); if (_r + 1 < REP_PREP) __syncthreads(); }
  grid.sync();
  if (threadIdx.x == 0) {
    bool ok = true; const unsigned per = gridDim.x >> 3;
    for (int j = 0; j < 16; ++j) { const unsigned c = xb_ld((unsigned*)(p0.ws + OFF_XRANK) + j); ok = ok && (c == (j < 8 ? per : 0u)); }
    volatile LAS int* vbp = (volatile LAS int*)(lds + LDS_VBID);
    if (ok && (gridDim.x & 7) == 0) vbp[0] = (int)xb.x + 8 * vbp[1]; }
  __syncthreads();
  REPEAT(REP_NORM1, stage_norm1<0>(launder(p0))) GSYNC();
  REPEAT(REP_IN0, { const Params pl = launder(p0); fg::load_rope_lds(pl, OFF_TAB64, 512, SM_BQN, SM_BKN, 64, lds); int dry = (DRY_IN0 && _r > 0) ? DRY_IN0 : 0; if (DRY_IN0) { asm volatile("" : "+v"(dry)); dry = __builtin_amdgcn_readfirstlane(dry); } fg::JobIn0 J(pl, dry); fg::gemm_phase(lds, J); })
  GSYNC();
  REPEAT(REP_ATT0, fa::phase_attn0(launder(p0), pin, smem))
  REPEAT(REP_GMLP, fa::phase_gmlp(launder(p0), smem))
  GSYNC();
  REPEAT(REP_OUT0, { const Params pl = launder(p0); fg::JobOut<0> J(pl); fg::gemm_phase(lds, J); })
  expert_prep_steal(launder(p0), pin, smem, 0);
  GSYNC();
  { const LCfg c{0, SB, 0, 16 * SB};
    ROUTER(c); GSYNC();
    MOE_HALF(c, 0, true); GSYNC(); }
  { int _n = REP_SYNC; if (REP_SYNC > 0) asm volatile("" : "+s"(_n)); for (int _r = 0; _r < _n; ++_r) GSYNC(); }
  REPEAT(REP_IN1, { const Params pl = launder(p0); fg::load_rope_lds(pl, OFF_TAB128, 1024, SM_CQN, SM_CKN, 128, lds); fg::JobIn1 J(pl); fg::gemm_phase(lds, J); })
  expert_prep_steal(launder(p0), pin, smem, 1);
  GSYNC();
  REPEAT(REP_ATT1, fa::phase_attn1(launder(p0), pin, smem))
  GSYNC();
  { const Params pl = launder(p0); fg::JobOut<1> J(pl); fg::gemm_phase(lds, J); }
  GSYNC();
  { const LCfg c{1, S, NC, 16 * S};
    ROUTER(c); GSYNC();
    MOE_HALF(c, 0, false); }
}

extern "C" void kernel_launch(void* const* d_in, const int* in_sizes, int n_in, void* d_out, int out_size, void* d_ws, size_t ws_size, hipStream_t stream) {
  static int grid_blocks = 0;
  if (!grid_blocks) {
    if (n_in != 33 || ws_size < WS_TOTAL) { fprintf(stderr, "kernel_launch: bad n_in %d or ws %zu < %zu\n", n_in, ws_size, (size_t)WS_TOTAL); return; }
    if (hipFuncSetAttribute((const void*)mega, hipFuncAttributeMaxDynamicSharedMemorySize, SMEM_BYTES) != hipSuccess) { fprintf(stderr, "set attr failed\n"); return; }
    int dev = 0, cus = 0, per_cu = 0;
    hipGetDevice(&dev); hipDeviceGetAttribute(&cus, hipDeviceAttributeMultiprocessorCount, dev);
    hipOccupancyMaxActiveBlocksPerMultiprocessor(&per_cu, mega, 512, SMEM_BYTES);
    if (per_cu < 1) { fprintf(stderr, "occupancy 0\n"); return; }
    grid_blocks = cus;
  }
  Params p; memset(&p, 0, sizeof(p)); PrepIn pin; memset(&pin, 0, sizeof(pin));
  for (int i = 0; i < 33; ++i) pin.in[i] = (const float*)d_in[i];
  p.out = (float*)d_out; p.ws = (unsigned char*)d_ws;
  p.x = pin.in[I_X]; p.ctx = pin.in[I_CTX];
  hipMemsetAsync(d_ws, 0, ZERO_BYTES, stream);
  void* args[] = {&p, &pin};
  hipError_t e = hipLaunchCooperativeKernel((void*)mega, dim3(grid_blocks), dim3(512), args, SMEM_BYTES, stream);
  if (e != hipSuccess) fprintf(stderr, "cooperative launch failed: %s (grid %d)\n", hipGetErrorString(e), grid_blocks);
}
```
